# Optimizing an MI355X kernel written in HIP

```python
import jax, jax.numpy as jnp
from jax import lax
import numpy as np

D_MODEL = 1024
BATCH = 16
SEQ = 2048
DEPTH = 1

N_MEM = 256
HEAD_DIM = 64
RWKV_HEADS = 6
RWKV_WIDTH = RWKV_HEADS * HEAD_DIM
DECAY_LORA = 32
ICLR_LORA = 32
GATE_LORA = 64
RWKV_IN = 3 * RWKV_WIDTH + GATE_LORA + 2 * DECAY_LORA + 2 * ICLR_LORA
ATT_HEADS = 6
ATT_WIDTH = ATT_HEADS * HEAD_DIM
DILATED_BRANCHES = ((128, 1), (512, 4), (2048, 16))
MEM_HEADS = 4
MEM_WIDTH = MEM_HEADS * HEAD_DIM
MIX_WIDTH = RWKV_WIDTH + ATT_WIDTH + MEM_WIDTH
IN_WIDTH = RWKV_IN + 3 * ATT_WIDTH + MEM_WIDTH
N_EXPERTS = 32
TOP_K = 4
D_EXPERT = D_MODEL
SWIGLU_LIMIT = 7.0
SWIGLU_ALPHA = 1.702
MOE_BLOCK = 128
LN_EPS = 1e-5
RWKV_GN_EPS = 64e-5
NEG_INF = -1e30
DEEPNORM_ALPHA = (2 * DEPTH) ** 0.25
DEEPNORM_BETA = (8 * DEPTH) ** -0.25

kernel_name = "hybrid_rwkv7_dilated_alibi_memxattn_moe_deepnorm"


def layer_norm(x, g, b):
    xf = x.astype(jnp.float32)
    mu = jnp.mean(xf, -1, keepdims=True)
    var = jnp.mean(jnp.square(xf - mu), -1, keepdims=True)
    return ((xf - mu) * lax.rsqrt(var + LN_EPS) * g + b).astype(x.dtype)


def rwkv7_bidirectional(p, mu, w0, w_up, a0, a_up, g_up, k_k, k_a, r_k, gn_g, gn_b):
    B, S, _ = p.shape
    H, N, C = RWKV_HEADS, HEAD_DIM, RWKV_WIDTH
    f32 = jnp.float32
    prev = jnp.pad(p[:, :-1], ((0, 0), (1, 0), (0, 0)))
    nxt = jnp.pad(p[:, 1:], ((0, 0), (0, 1), (0, 0)))
    p = (p + mu * (0.5 * (prev + nxt) - p)).astype(f32)
    r, k, v = p[..., :C], p[..., C:2 * C], p[..., 2 * C:3 * C]
    o = 3 * C
    g_lo = p[..., o:o + GATE_LORA]
    o += GATE_LORA
    w_lo = p[..., o:o + 2 * DECAY_LORA].reshape(B, S, 2, DECAY_LORA)
    o += 2 * DECAY_LORA
    a_lo = p[..., o:].reshape(B, S, 2, ICLR_LORA)
    w_logit = w0 + jnp.einsum('bsdr,drc->bsdc', jnp.tanh(w_lo), w_up)
    decay = jnp.exp(-jnp.exp(-jax.nn.softplus(-w_logit) - 0.5))
    a = jax.nn.sigmoid(a0 + jnp.einsum('bsdr,drc->bsdc', a_lo, a_up))
    g = jax.nn.sigmoid(g_lo) @ g_up
    kk = (k * k_k).reshape(B, S, H, N)
    kk = kk / jnp.maximum(jnp.sqrt(jnp.sum(kk * kk, -1, keepdims=True)), 1e-12)
    k_dir = (k[:, :, None, :] * (1.0 + (a - 1.0) * k_a)).reshape(B, S, 2, H, N)
    r_h = r.reshape(B, S, H, N)
    v_h = v.reshape(B, S, H, N)

    def both(t):
        return jnp.stack([t, t], axis=2)

    def time_major(t):
        t = jnp.stack([t[:, :, 0], jnp.flip(t[:, :, 1], axis=1)], axis=0)
        return jnp.transpose(t, (2, 0, 1, 3, 4))

    kk2 = both(kk)
    xs = (time_major(both(r_h)), time_major(decay.reshape(B, S, 2, H, N)), time_major(k_dir),
          time_major(both(v_h)), time_major(kk2), time_major(kk2 * a.reshape(B, S, 2, H, N)))

    def step(state, inp):
        r_t, w_t, k_t, v_t, kk_t, b_t = inp
        sa = jnp.einsum('dbhij,dbhj->dbhi', state, kk_t)
        state = state * w_t[..., None, :] - sa[..., :, None] * b_t[..., None, :] + v_t[..., :, None] * k_t[..., None, :]
        return state, jnp.einsum('dbhij,dbhj->dbhi', state, r_t)

    _, ys = lax.scan(step, jnp.zeros((2, B, H, N, N), f32), xs)
    y = jnp.transpose(ys[:, 0] + jnp.flip(ys[:, 1], axis=0), (1, 0, 2, 3))
    mean = jnp.mean(y, -1, keepdims=True)
    var = jnp.mean(jnp.square(y - mean), -1, keepdims=True)
    y = ((y - mean) * lax.rsqrt(var + RWKV_GN_EPS)).reshape(B, S, C) * gn_g + gn_b
    bonus = jnp.sum(r_h[:, :, None] * k_dir * r_k, axis=(2, 4))[..., None] * v_h
    return (y + bonus.reshape(B, S, C)) * g


def dilated_branch(q, k, v, slopes, window, dil):
    B, H, S, N = q.shape
    half = window // (2 * dil)
    L = S // dil
    nb = -(-L // half)
    pad = nb * half - L

    def by_residue(t):
        return jnp.transpose(t.reshape(B, H, L, dil, N), (0, 1, 3, 2, 4))

    qb = jnp.pad(by_residue(q), ((0, 0), (0, 0), (0, 0), (0, pad), (0, 0))).reshape(B, H, dil, nb, half, N)

    def windows(t):
        t = jnp.pad(by_residue(t), ((0, 0), (0, 0), (0, 0), (half, pad + half), (0, 0))).reshape(B, H, dil, nb + 2, half, N)
        return jnp.concatenate([t[:, :, :, :-2], t[:, :, :, 1:-1], t[:, :, :, 2:]], axis=4)

    kw, vw = windows(k), windows(v)
    s = jnp.einsum('bhrnqd,bhrnkd->bhrnqk', qb, kw).astype(jnp.float32)
    qi = jnp.arange(half)[:, None]
    kj = jnp.arange(3 * half)[None, :]
    delta = kj - half - qi
    lk = jnp.arange(nb)[:, None, None] * half - half + kj[None]
    valid = (jnp.abs(delta) <= half)[None] & (lk >= 0) & (lk < L)
    dist = (jnp.abs(delta) * dil).astype(jnp.float32)
    s = jnp.where(valid, s - slopes[None, :, None, None, None, None] * dist, NEG_INF)
    m = jnp.max(s, -1, keepdims=True)
    pr = jnp.exp(s - m)
    den = jnp.sum(pr, -1, keepdims=True)
    o = jnp.einsum('bhrnqk,bhrnkd->bhrnqd', pr, vw) / den
    lse = (m + jnp.log(den))[..., 0]

    def back(t):
        t = t.reshape((B, H, dil, nb * half) + t.shape[5:])[:, :, :, :L]
        t = jnp.moveaxis(t, 2, 3)
        return t.reshape((B, H, S) + t.shape[4:])

    return back(o), back(lse)


def dilated_mixture_attention(q, k, v):
    slopes = jnp.exp2(-8.0 * jnp.arange(1, ATT_HEADS + 1, dtype=jnp.float32) / ATT_HEADS)
    outs, lses = [], []
    for window, dil in DILATED_BRANCHES:
        o_b, lse_b = dilated_branch(q, k, v, slopes, window, dil)
        outs.append(o_b)
        lses.append(lse_b)
    wts = jax.nn.softmax(jnp.stack(lses), axis=0)
    return jnp.sum(wts[..., None] * jnp.stack(outs), axis=0)


def parallel_mixer(h, mem, w_in, mu, w0, w_up, a0, a_up, g_up, k_k, k_a, r_k, gn_g, gn_b, w_mem_kv, w_out):
    B, S, _ = h.shape
    f32 = jnp.float32
    p = h @ w_in
    y_rwkv = rwkv7_bidirectional(p[..., :RWKV_IN], mu, w0, w_up, a0, a_up, g_up, k_k, k_a, r_k, gn_g, gn_b)
    o = RWKV_IN

    def heads_first(t, n):
        return jnp.transpose(t.reshape(B, S, n, HEAD_DIM), (0, 2, 1, 3)).astype(f32)

    q = heads_first(p[..., o:o + ATT_WIDTH], ATT_HEADS) * HEAD_DIM ** -0.5
    k = heads_first(p[..., o + ATT_WIDTH:o + 2 * ATT_WIDTH], ATT_HEADS)
    v = heads_first(p[..., o + 2 * ATT_WIDTH:o + 3 * ATT_WIDTH], ATT_HEADS)
    y_att = jnp.transpose(dilated_mixture_attention(q, k, v), (0, 2, 1, 3)).reshape(B, S, ATT_WIDTH)
    o += 3 * ATT_WIDTH
    q_m = p[..., o:].reshape(B, S, MEM_HEADS, HEAD_DIM).astype(f32)
    kv_m = (mem @ w_mem_kv).reshape(B, N_MEM, 2, MEM_HEADS, HEAD_DIM).astype(f32)
    s_m = jnp.einsum('bshd,bmhd->bhsm', q_m, kv_m[:, :, 0]) * HEAD_DIM ** -0.5
    y_mem = jnp.einsum('bhsm,bmhd->bshd', jax.nn.softmax(s_m, axis=-1), kv_m[:, :, 1]).reshape(B, S, MEM_WIDTH)
    y = jnp.concatenate([y_rwkv, y_att, y_mem], axis=-1).astype(h.dtype)
    return y @ w_out


def moe(h, w_router, b_router, w_gate_up, b_gate_up, w_down, b_down):
    B, S, D = h.shape
    T = B * S
    n_assign = T * TOP_K
    xt = h.reshape(T, D)
    logits = (xt @ w_router).astype(jnp.float32) + b_router
    top_v, top_e = lax.top_k(logits, TOP_K)
    gates = jax.nn.softmax(top_v, axis=-1)
    flat_e = top_e.reshape(-1)
    order = jnp.argsort(flat_e)
    sorted_e = flat_e[order]
    counts = jnp.bincount(flat_e, length=N_EXPERTS)
    padded = (counts + MOE_BLOCK - 1) // MOE_BLOCK * MOE_BLOCK
    starts = jnp.cumsum(counts) - counts
    pends = jnp.cumsum(padded)
    pstarts = pends - padded
    dest_sorted = pstarts[sorted_e] + jnp.arange(n_assign) - starts[sorted_e]
    dest = jnp.zeros((n_assign,), jnp.int32).at[order].set(dest_sorted.astype(jnp.int32))
    n_rows = n_assign + N_EXPERTS * MOE_BLOCK
    n_blocks = n_rows // MOE_BLOCK
    row_token = jnp.full((n_rows,), T, jnp.int32).at[dest].set(jnp.arange(n_assign, dtype=jnp.int32) // TOP_K)
    x_rows = jnp.concatenate([xt, jnp.zeros((1, D), xt.dtype)], axis=0)[row_token].reshape(n_blocks, MOE_BLOCK, D)
    block_e = jnp.minimum(jnp.searchsorted(pends, jnp.arange(n_blocks) * MOE_BLOCK, side='right'), N_EXPERTS - 1)

    def expert_block(args):
        xb, e = args
        gu = xb @ w_gate_up[e] + b_gate_up[e]
        gate = jnp.minimum(gu[:, :D_EXPERT], SWIGLU_LIMIT)
        up = jnp.clip(gu[:, D_EXPERT:], -SWIGLU_LIMIT, SWIGLU_LIMIT)
        act = (up + 1.0) * gate * jax.nn.sigmoid(SWIGLU_ALPHA * gate)
        return act @ w_down[e] + b_down[e]

    y_rows = lax.map(expert_block, (x_rows, block_e)).reshape(n_rows, D)
    y = jnp.einsum('tkd,tk->td', y_rows[dest].reshape(T, TOP_K, D), gates.astype(y_rows.dtype))
    return y.reshape(B, S, D)


def setup_inputs(seed: int = 0) -> dict:
    key = jax.random.key(seed)
    ks = jax.random.split(key, 32)
    f32 = jnp.float32
    L, C, D, E, F = DEPTH, RWKV_WIDTH, D_MODEL, N_EXPERTS, D_EXPERT

    def nrm(i, shape, scale):
        return scale * jax.random.normal(ks[i], shape, f32)

    ramp = (jnp.arange(C, dtype=f32) / (C - 1)) ** 0.9
    return {
        'x': nrm(0, (BATCH, SEQ, D), 1.0),
        'mem': nrm(1, (BATCH, N_MEM, D), 1.0),
        'ln_in_g': 1.0 + nrm(2, (D,), 0.02),
        'ln_in_b': nrm(3, (D,), 0.02),
        'w_in': nrm(4, (L, D, IN_WIDTH), D ** -0.5),
        'mu_shift': jax.random.uniform(ks[5], (L, RWKV_IN), f32),
        'w0': -5.5 + 5.0 * ramp + nrm(6, (L, 2, C), 0.1),
        'w_up': nrm(7, (L, 2, DECAY_LORA, C), 0.5 * DECAY_LORA ** -0.5),
        'a0': nrm(8, (L, 2, C), 0.1),
        'a_up': nrm(9, (L, 2, ICLR_LORA, C), 0.5 * ICLR_LORA ** -0.5),
        'g_up': nrm(10, (L, GATE_LORA, C), GATE_LORA ** -0.5),
        'k_k': 0.85 + nrm(11, (L, C), 0.05),
        'k_a': 1.0 + nrm(12, (L, C), 0.05),
        'r_k': nrm(13, (L, RWKV_HEADS, HEAD_DIM), 0.1),
        'gn_g': 1.0 + nrm(14, (L, C), 0.02),
        'gn_b': nrm(15, (L, C), 0.02),
        'w_mem_kv': nrm(16, (L, D, 2 * MEM_WIDTH), D ** -0.5),
        'w_out': nrm(17, (L, MIX_WIDTH, D), DEEPNORM_BETA * MIX_WIDTH ** -0.5),
        'ln1_g': 1.0 + nrm(18, (L, D), 0.02),
        'ln1_b': nrm(19, (L, D), 0.02),
        'w_router': nrm(20, (L, D, E), D ** -0.5),
        'b_router': nrm(21, (L, E), 0.01),
        'w_gate_up': nrm(22, (L, E, D, 2 * F), D ** -0.5),
        'b_gate_up': nrm(23, (L, E, 2 * F), 0.01),
        'w_down': nrm(24, (L, E, F, D), DEEPNORM_BETA * F ** -0.5),
        'b_down': nrm(25, (L, E, D), 0.01),
        'ln2_g': 1.0 + nrm(26, (L, D), 0.02),
        'ln2_b': nrm(27, (L, D), 0.02),
    }


def reference(x, mem, ln_in_g, ln_in_b, w_in, mu_shift, w0, w_up, a0, a_up, g_up, k_k, k_a, r_k, gn_g, gn_b,
              w_mem_kv, w_out, ln1_g, ln1_b, w_router, b_router, w_gate_up, b_gate_up, w_down, b_down, ln2_g, ln2_b):
    h = layer_norm(x, ln_in_g, ln_in_b)
    for l in range(DEPTH):
        mix = parallel_mixer(h, mem, w_in[l], mu_shift[l], w0[l], w_up[l], a0[l], a_up[l], g_up[l], k_k[l], k_a[l],
                             r_k[l], gn_g[l], gn_b[l], w_mem_kv[l], w_out[l])
        h = layer_norm(DEEPNORM_ALPHA * h + mix, ln1_g[l], ln1_b[l])
        ffn = moe(h, w_router[l], b_router[l], w_gate_up[l], b_gate_up[l], w_down[l], b_down[l])
        h = layer_norm(DEEPNORM_ALPHA * h + ffn, ln2_g[l], ln2_b[l])
    return h
```

```cpp
#include <hip/hip_runtime.h>
#include <hip/hip_cooperative_groups.h>
#include <cstdio>
#include <cstdint>
namespace cg = cooperative_groups;

#ifndef MK_ONE_LAUNCH
#define MK_ONE_LAUNCH 0
#endif

typedef unsigned short bf16_t;
typedef short bf16x8 __attribute__((ext_vector_type(8)));
typedef short bf16x4 __attribute__((ext_vector_type(4)));
typedef float f32x4 __attribute__((ext_vector_type(4)));
typedef float f32x2 __attribute__((ext_vector_type(2)));
typedef unsigned u32x4 __attribute__((ext_vector_type(4)));
typedef unsigned u32x2 __attribute__((ext_vector_type(2)));

constexpr int D = 1024, BATCH = 16, SEQ = 2048, T = BATCH * SEQ;
constexpr int NMEM = 256, HD = 64;
constexpr int RH = 6, RC = 384;
constexpr int RWKV_IN = 1344;
constexpr int AH = 6, AW = 384, MH = 4, MW = 256;
constexpr int IN_W = 2752, IN_WP = 2816;
constexpr int PA_W = IN_WP - RWKV_IN;
constexpr int NE = 32, TOPK = 4, FF = 1024;
constexpr float LN_EPS = 1e-5f, GN_EPS = 64e-5f;
constexpr float ALPHA = 1.189207115002721f;
constexpr int NTHR = 512, NWAVES = 8;

constexpr size_t MiB = 1u << 20;
constexpr size_t WS_CTL = 0;
constexpr size_t WS_WT_IN = 1 * MiB;
constexpr size_t WS_WT_OUT = 7 * MiB;
constexpr size_t WS_WT_KV = 9 * MiB;
constexpr size_t WS_KVM = 10 * MiB;
constexpr size_t WS_MEMB = 14 * MiB;
constexpr size_t WS_LIST = 22 * MiB;
constexpr size_t WS_ROWGATE = 26 * MiB;
constexpr size_t WS_SEL = 30 * MiB;
constexpr size_t WS_BONUS = 31 * MiB;
constexpr size_t WS_WRT = 31 * MiB + 800 * 1024;
constexpr size_t WS_WT_GU = 32 * MiB;
constexpr size_t WS_WT_DN = 160 * MiB;
constexpr size_t WS_H0B = 224 * MiB;
constexpr size_t WS_H1B = 288 * MiB;
constexpr size_t WS_YMIX = 352 * MiB;
constexpr size_t WS_PR = 416 * MiB;
constexpr size_t WS_ATTO = 416 * MiB;
constexpr size_t WS_PA = 500 * MiB;
constexpr size_t WS_SSH = 592 * MiB;
constexpr size_t WS_SDIR = 736 * MiB;
constexpr size_t WS_ACT = 352 * MiB;
constexpr size_t WS_YROWS = 624 * MiB;
constexpr size_t WS_END = 1024 * MiB;
constexpr size_t DO_Y = 0, DO_G = 96 * MiB, DO_LSE = 120 * MiB;
constexpr int ROWS_PAD = T * TOPK + NE * 256;

constexpr int CW_CNT = 0;
constexpr int CW_ATTQ = 64;
constexpr int CW_SCANQ = 128;

#define LAS __attribute__((address_space(3)))

struct Params { const float* in[28]; float* out; unsigned char* ws; int ph_lo, ph_hi; };

__device__ __forceinline__ unsigned f2bf(float f) { unsigned u = __builtin_bit_cast(unsigned, f); return (u + 0x7fffu + ((u >> 16) & 1u)) >> 16; }
__device__ __forceinline__ unsigned pk2(float lo, float hi) { return f2bf(lo) | (f2bf(hi) << 16); }
__device__ __forceinline__ float bf2f(unsigned b) { return __builtin_bit_cast(float, b << 16); }
__device__ __forceinline__ float bflo(unsigned w) { return __builtin_bit_cast(float, w << 16); }
__device__ __forceinline__ float bfhi(unsigned w) { return __builtin_bit_cast(float, w & 0xffff0000u); }
__device__ __forceinline__ float wave_sum(float v) {
#pragma unroll
    for (int o = 1; o < 64; o <<= 1) v += __shfl_xor(v, o);
    return v;
}
__device__ __forceinline__ float wave_max(float v) {
#pragma unroll
    for (int o = 1; o < 64; o <<= 1) v = fmaxf(v, __shfl_xor(v, o));
    return v;
}
template <int CTRL> __device__ __forceinline__ float dpp_mov(float v) {
    return __builtin_bit_cast(float, __builtin_amdgcn_update_dpp(0, __builtin_bit_cast(int, v), CTRL, 0xF, 0xF, true));
}
__device__ __forceinline__ float sum8(float v) {
    v += dpp_mov<0xB1>(v);
    v += dpp_mov<0x4E>(v);
    v += dpp_mov<0x141>(v);
    return v;
}
__device__ __forceinline__ float sigmoidf_(float x) { return 1.f / (1.f + __expf(-x)); }

__device__ __forceinline__ void p0_transpose_item(const float* __restrict__ W, int K, int N, bf16_t* WT, LAS float* scr, int item, int lane) {
    const int nblk = N / 32, kb = item / nblk, nb = item % nblk, k0 = 64 * kb, n0 = 32 * nb;
#pragma unroll 8
    for (int i = 0; i < 32; ++i) { const int kk = 2 * i + (lane >> 5); scr[kk * 33 + (lane & 31)] = W[(size_t)(k0 + kk) * N + n0 + (lane & 31)]; }
    asm volatile("s_waitcnt lgkmcnt(0)" ::: "memory");
    const int c = lane & 7;
#pragma unroll
    for (int j = 0; j < 4; ++j) { const int n = (lane >> 3) + 8 * j; const LAS float* s = scr + (8 * c) * 33 + n;
        u32x4 o; o.x = pk2(s[0 * 33], s[1 * 33]); o.y = pk2(s[2 * 33], s[3 * 33]); o.z = pk2(s[4 * 33], s[5 * 33]); o.w = pk2(s[6 * 33], s[7 * 33]);
        *(u32x4*)(WT + (size_t)(n0 + n) * K + k0 + 8 * c) = o; }
    asm volatile("s_waitcnt lgkmcnt(0)" ::: "memory");
}
__device__ __forceinline__ void ln_row(f32x4 (&v)[4], const float* __restrict__ g, const float* __restrict__ b, int lane) {
    float s = 0.f;
#pragma unroll
    for (int j = 0; j < 4; ++j) s += (v[j].x + v[j].y) + (v[j].z + v[j].w);
    const float mean = wave_sum(s) * (1.f / D); float s2 = 0.f;
#pragma unroll
    for (int j = 0; j < 4; ++j) { v[j] = v[j] - mean; s2 += (v[j].x * v[j].x + v[j].y * v[j].y) + (v[j].z * v[j].z + v[j].w * v[j].w); }
    const float rstd = 1.f / sqrtf(wave_sum(s2) * (1.f / D) + LN_EPS);
#pragma unroll
    for (int j = 0; j < 4; ++j) { const f32x4 gg = *(const f32x4*)(g + 4 * lane + 256 * j), bb = *(const f32x4*)(b + 4 * lane + 256 * j); v[j] = v[j] * rstd * gg + bb; }
}
__device__ __forceinline__ void store_row_bf16(bf16_t* orow, const f32x4 (&v)[4], int lane) {
#pragma unroll
    for (int j = 0; j < 4; ++j) { u32x2 o; o.x = pk2(v[j].x, v[j].y); o.y = pk2(v[j].z, v[j].w); *(u32x2*)(orow + 4 * lane + 256 * j) = o; }
}

__device__ __forceinline__ void phase0(const Params& p, LAS unsigned char* lds) {
    const int tid = threadIdx.x, lane = tid & 63, wave = tid >> 6;
    const int gw = blockIdx.x * NWAVES + wave, NGW = gridDim.x * NWAVES;
    LAS float* scr = (LAS float*)(lds + wave * 16384);
    unsigned char* ws = p.ws;
    constexpr int I_IN = 16 * (IN_W / 32), I_OUT = 16 * 32, I_KV = 16 * 16, I_GU = 16 * 64, I_DN = 16 * 32;
    constexpr int NITEMS = I_IN + I_OUT + I_KV + NE * I_GU + NE * I_DN;
    for (int it = gw; it < NITEMS; it += NGW) {
        int r = it;
        if (r < I_IN) { p0_transpose_item(p.in[4], D, IN_W, (bf16_t*)(ws + WS_WT_IN), scr, r, lane); continue; } r -= I_IN;
        if (r < I_OUT) { p0_transpose_item(p.in[17], D, D, (bf16_t*)(ws + WS_WT_OUT), scr, r, lane); continue; } r -= I_OUT;
        if (r < I_KV) { p0_transpose_item(p.in[16], D, 2 * MW, (bf16_t*)(ws + WS_WT_KV), scr, r, lane); continue; } r -= I_KV;
        if (r < NE * I_GU) { const int e = r / I_GU; p0_transpose_item(p.in[22] + (size_t)e * D * 2 * FF, D, 2 * FF, (bf16_t*)(ws + WS_WT_GU) + (size_t)e * 2 * FF * D, scr, r % I_GU, lane); continue; } r -= NE * I_GU;
        { const int e = r / I_DN; p0_transpose_item(p.in[24] + (size_t)e * FF * D, FF, D, (bf16_t*)(ws + WS_WT_DN) + (size_t)e * D * FF, scr, r % I_DN, lane); }
    }
    { u32x4* z = (u32x4*)((bf16_t*)(ws + WS_WT_IN) + (size_t)IN_W * D); const int n16 = (IN_WP - IN_W) * D * 2 / 16;
      for (int i = blockIdx.x * NTHR + tid; i < n16; i += gridDim.x * NTHR) z[i] = (u32x4){0u, 0u, 0u, 0u}; }
    { const float* wr = p.in[20]; float* wt = (float*)(ws + WS_WRT);
      for (int i = blockIdx.x * NTHR + tid; i < NE * D; i += gridDim.x * NTHR) { const int e = i / D, k = i % D; wt[i] = wr[k * NE + e]; } }
    for (int m = gw; m < T; m += NGW) {
        const f32x4* xr = (const f32x4*)(p.in[0] + (size_t)m * D) + lane; f32x4 v[4];
#pragma unroll
        for (int j = 0; j < 4; ++j) v[j] = xr[64 * j];
        ln_row(v, p.in[2], p.in[3], lane);
        store_row_bf16((bf16_t*)(ws + WS_H0B) + (size_t)m * D, v, lane);
    }
    for (int m = gw; m < BATCH * NMEM; m += NGW) {
        const f32x4* xr = (const f32x4*)(p.in[1] + (size_t)m * D) + lane; f32x4 v[4];
#pragma unroll
        for (int j = 0; j < 4; ++j) v[j] = xr[64 * j];
        store_row_bf16((bf16_t*)(ws + WS_MEMB) + (size_t)m * D, v, lane);
    }
}

template <class ARow, class BRow, class Epi>
__device__ __forceinline__ void sgemm_tile(int K, ARow arow, BRow brow, Epi epi) {
    const int tid = threadIdx.x, wid = tid >> 6, lane = tid & 63, wm = wid >> 1, wn = wid & 1, fr = lane & 15, fq = lane >> 4;
    f32x4 acc[2][4];
#pragma unroll
    for (int m = 0; m < 2; ++m)
#pragma unroll
        for (int n = 0; n < 4; ++n) acc[m][n] = (f32x4){0.f, 0.f, 0.f, 0.f};
    const bf16_t* ap[2]; const bf16_t* bp[4];
#pragma unroll
    for (int m = 0; m < 2; ++m) ap[m] = arow(wm * 32 + m * 16 + fr) + fq * 8;
#pragma unroll
    for (int n = 0; n < 4; ++n) bp[n] = brow(wn * 64 + n * 16 + fr) + fq * 8;
    for (int k = 0; k < K; k += 32) {
        bf16x8 a[2], b[4];
#pragma unroll
        for (int m = 0; m < 2; ++m) a[m] = *(const bf16x8*)(ap[m] + k);
#pragma unroll
        for (int n = 0; n < 4; ++n) b[n] = *(const bf16x8*)(bp[n] + k);
#pragma unroll
        for (int m = 0; m < 2; ++m)
#pragma unroll
            for (int n = 0; n < 4; ++n) acc[m][n] = __builtin_amdgcn_mfma_f32_16x16x32_bf16(b[n], a[m], acc[m][n], 0, 0, 0);
    }
#pragma unroll
    for (int m = 0; m < 2; ++m)
#pragma unroll
        for (int n = 0; n < 4; ++n) epi(wm * 32 + m * 16 + fr, wn * 64 + n * 16 + 4 * fq, acc[m][n], n);
}

__device__ __forceinline__ void phase1(const Params& p) {
    unsigned char* ws = p.ws;
    const bf16_t* H0B = (const bf16_t*)(ws + WS_H0B); const bf16_t* WT = (const bf16_t*)(ws + WS_WT_IN);
    bf16_t* PR = (bf16_t*)(ws + WS_PR); bf16_t* PA = (bf16_t*)(ws + WS_PA);
    constexpr int NT_N = IN_WP / 128, NT_M = T / 128, U_P = NT_M * NT_N;
    constexpr int U_KV = (BATCH * NMEM / 128) * (2 * MW / 128);
    for (int u = blockIdx.x; u < U_P + U_KV; u += gridDim.x) {
        if (u < U_P) {
            const int pn = u % NT_N, pm = u / NT_N, r0 = pm * 128, c0 = pn * 128;
            sgemm_tile(D, [&](int r) { return H0B + (size_t)(r0 + r) * D; }, [&](int c) { return WT + (size_t)(c0 + c) * D; },
                [&](int r, int c, f32x4 v, int) { const int col = c0 + c; const int row = r0 + r;
                    if (col < RWKV_IN) { u32x2 o; o.x = pk2(v.x, v.y); o.y = pk2(v.z, v.w); *(u32x2*)(PR + (size_t)row * RWKV_IN + col) = o; }
                    else { const int ca = col - RWKV_IN; const float sc = (ca < AW || (ca >= 3 * AW && ca < 3 * AW + MW)) ? 0.125f : 1.f;
                        u32x2 o; o.x = pk2(v.x * sc, v.y * sc); o.y = pk2(v.z * sc, v.w * sc); *(u32x2*)(PA + (size_t)row * PA_W + ca) = o; } });
        } else {
            const int uu = u - U_P, pn = uu % 4, pm = uu / 4, r0 = pm * 128, c0 = pn * 128;
            const bf16_t* MB = (const bf16_t*)(ws + WS_MEMB); const bf16_t* WK = (const bf16_t*)(ws + WS_WT_KV); bf16_t* KVM = (bf16_t*)(ws + WS_KVM);
            sgemm_tile(D, [&](int r) { return MB + (size_t)(r0 + r) * D; }, [&](int c) { return WK + (size_t)(c0 + c) * D; },
                [&](int r, int c, f32x4 v, int) { u32x2 o; o.x = pk2(v.x, v.y); o.y = pk2(v.z, v.w); *(u32x2*)(KVM + (size_t)(r0 + r) * (2 * MW) + c0 + c) = o; });
        }
    }
}

__device__ __forceinline__ void phase2(const Params& p, LAS unsigned char* lds) {
    const int tid = threadIdx.x, lane = tid & 63, wave = tid >> 6;
    unsigned char* ws = p.ws;
    const bf16_t* PR = (const bf16_t*)(ws + WS_PR);
    const float* mu = p.in[5];
    LAS float* wu = (LAS float*)lds; LAS float* au = wu + 4096; LAS float* gu = au + 4096;
    LAS float* tw = gu + 4096; LAS float* al = tw + 2048; LAS float* sg = al + 2048;
    float* SSH = (float*)(ws + WS_SSH); float* SDIR = (float*)(ws + WS_SDIR);
    bf16_t* G = (bf16_t*)((unsigned char*)p.out + DO_G); float* BON = (float*)(ws + WS_BONUS);
    constexpr int NTILE = T / 32, NITEM = NTILE * RH;
    int cur_h = -1;
    for (int it = blockIdx.x; it < NITEM; it += gridDim.x) {
        const int h = it / NTILE, tile = it % NTILE, t0 = tile * 32;
        __syncthreads();
        if (h != cur_h) { cur_h = h;
            for (int i = tid; i < 4096; i += NTHR) { const int dj = i >> 6, c = i & 63;
                wu[i] = p.in[7][(size_t)dj * RC + h * 64 + c]; au[i] = p.in[9][(size_t)dj * RC + h * 64 + c]; gu[i] = p.in[10][(size_t)dj * RC + h * 64 + c]; }
        }
        for (int i = tid; i < 32 * 192; i += NTHR) { const int tt = i / 192, ch = i % 192, col = 3 * RC + ch; const int t = t0 + tt, s = t & (SEQ - 1);
            const float pc = bf2f(PR[(size_t)t * RWKV_IN + col]);
            const float pp = s > 0 ? bf2f(PR[(size_t)(t - 1) * RWKV_IN + col]) : 0.f, pnx = s < SEQ - 1 ? bf2f(PR[(size_t)(t + 1) * RWKV_IN + col]) : 0.f;
            const float v = pc + mu[col] * (0.5f * (pp + pnx) - pc);
            if (ch < 64) sg[tt * 64 + ch] = sigmoidf_(v);
            else if (ch < 128) tw[tt * 64 + (ch - 64)] = tanhf(v);
            else al[tt * 64 + (ch - 128)] = v; }
        __syncthreads();
        const int ch = h * 64 + lane;
        float wl0[4], wl1[4], aa0[4], aa1[4], gg[4];
#pragma unroll
        for (int q = 0; q < 4; ++q) { wl0[q] = 0.f; wl1[q] = 0.f; aa0[q] = 0.f; aa1[q] = 0.f; gg[q] = 0.f; }
#pragma unroll 1
        for (int j = 0; j < 32; j += 4) {
            float w0v[4], w1v[4], a0v[4], a1v[4];
#pragma unroll
            for (int jj = 0; jj < 4; ++jj) { w0v[jj] = wu[(j + jj) * 64 + lane]; w1v[jj] = wu[(32 + j + jj) * 64 + lane]; a0v[jj] = au[(j + jj) * 64 + lane]; a1v[jj] = au[(32 + j + jj) * 64 + lane]; }
#pragma unroll
            for (int q = 0; q < 4; ++q) { const int tt = 4 * wave + q;
                const f32x4 t0v = *(const LAS f32x4*)(tw + tt * 64 + j), t1v = *(const LAS f32x4*)(tw + tt * 64 + 32 + j);
                const f32x4 l0v = *(const LAS f32x4*)(al + tt * 64 + j), l1v = *(const LAS f32x4*)(al + tt * 64 + 32 + j);
#pragma unroll
                for (int jj = 0; jj < 4; ++jj) { wl0[q] += t0v[jj] * w0v[jj]; wl1[q] += t1v[jj] * w1v[jj]; aa0[q] += l0v[jj] * a0v[jj]; aa1[q] += l1v[jj] * a1v[jj]; } }
        }
#pragma unroll 1
        for (int j = 0; j < 64; j += 4) {
            float gv[4];
#pragma unroll
            for (int jj = 0; jj < 4; ++jj) gv[jj] = gu[(j + jj) * 64 + lane];
#pragma unroll
            for (int q = 0; q < 4; ++q) { const f32x4 sv = *(const LAS f32x4*)(sg + (4 * wave + q) * 64 + j);
#pragma unroll
                for (int jj = 0; jj < 4; ++jj) gg[q] += sv[jj] * gv[jj]; }
        }
        const float w00 = p.in[6][ch], w01 = p.in[6][RC + ch], a00 = p.in[8][ch], a01 = p.in[8][RC + ch];
        const float kkw = p.in[11][ch], kaw = p.in[12][ch], rkw = p.in[13][ch];
        const float mur = mu[ch], muk = mu[RC + ch], muv = mu[2 * RC + ch];
#pragma unroll
        for (int q = 0; q < 4; ++q) {
            const int t = t0 + 4 * wave + q, s = t & (SEQ - 1), b = t >> 11;
            const bf16_t* pr = PR + (size_t)t * RWKV_IN;
            float rc = bf2f(pr[ch]), kc = bf2f(pr[RC + ch]), vc = bf2f(pr[2 * RC + ch]);
            float rp = 0.f, kp = 0.f, vp = 0.f, rn = 0.f, kn = 0.f, vn = 0.f;
            if (s > 0) { rp = bf2f(pr[ch - RWKV_IN]); kp = bf2f(pr[RC + ch - RWKV_IN]); vp = bf2f(pr[2 * RC + ch - RWKV_IN]); }
            if (s < SEQ - 1) { rn = bf2f(pr[ch + RWKV_IN]); kn = bf2f(pr[RC + ch + RWKV_IN]); vn = bf2f(pr[2 * RC + ch + RWKV_IN]); }
            const float r = rc + mur * (0.5f * (rp + rn) - rc), k = kc + muk * (0.5f * (kp + kn) - kc), v = vc + muv * (0.5f * (vp + vn) - vc);
            const float dec0 = __expf(-0.6065306597126334f * sigmoidf_(w00 + wl0[q])), dec1 = __expf(-0.6065306597126334f * sigmoidf_(w01 + wl1[q]));
            const float a0 = sigmoidf_(a00 + aa0[q]), a1 = sigmoidf_(a01 + aa1[q]);
            const float kkv = k * kkw; const float nrm = sqrtf(wave_sum(kkv * kkv)); const float kkn = kkv / fmaxf(nrm, 1e-12f);
            const float kd0 = k * (1.f + (a0 - 1.f) * kaw), kd1 = k * (1.f + (a1 - 1.f) * kaw);
            const float bon = wave_sum(r * (kd0 + kd1) * rkw);
            float* sh = SSH + ((size_t)(b * RH + h) * SEQ + s) * 192;
            sh[lane] = r; sh[64 + lane] = v; sh[128 + lane] = kkn;
            float* d0 = SDIR + ((size_t)((0 * BATCH + b) * RH + h) * SEQ + s) * 192; float* d1 = SDIR + ((size_t)((1 * BATCH + b) * RH + h) * SEQ + s) * 192;
            d0[lane] = dec0; d0[64 + lane] = kd0; d0[128 + lane] = kkn * a0;
            d1[lane] = dec1; d1[64 + lane] = kd1; d1[128 + lane] = kkn * a1;
            G[(size_t)t * RC + ch] = (bf16_t)f2bf(gg[q]);
            if (lane == 0) BON[t * RH + h] = bon;
        }
    }
}

constexpr int SC_TC = 32;
constexpr int SC_STEP = 6 * 64;
template <int Q0> __device__ __forceinline__ void scan_load8(const float* __restrict__ gsrc, long gstep, f32x4 (&reg)[8]) {
#pragma unroll
    for (int q = 0; q < 8; ++q) reg[q] = *(const f32x4*)(gsrc + (long)(2 * (Q0 + q)) * gstep);
}
template <int Q0> __device__ __forceinline__ void scan_store8(LAS float* ldst, const f32x4 (&reg)[8]) {
#pragma unroll
    for (int q = 0; q < 8; ++q) *(LAS f32x4*)(ldst + 2 * (Q0 + q) * SC_STEP) = reg[q];
}
__device__ __forceinline__ void scan_produce(const float* __restrict__ sh, const float* __restrict__ dr, int dir, int c, LAS float* buf, int ptid) {
    if (ptid >= 192) return;
    const int wi = ptid % 96, st0 = ptid / 96, src = wi / 48, f4 = wi % 48, vec = f4 / 16, e4 = f4 % 16;
    const int dst = src ? (vec == 0 ? 1 : (vec == 1 ? 3 : 2)) : (vec == 0 ? 4 : (vec == 1 ? 5 : 0));
    const int tau0 = c * SC_TC + st0; const long t0 = dir ? (SEQ - 1 - tau0) : tau0; const long gstep = dir ? -192 : 192;
    const float* gsrc = (src ? dr : sh) + t0 * 192 + f4 * 4;
    LAS float* ldst = buf + st0 * SC_STEP + dst * 64 + e4 * 4;
    f32x4 reg[8];
    scan_load8<0>(gsrc, gstep, reg); scan_store8<0>(ldst, reg);
    scan_load8<8>(gsrc, gstep, reg); scan_store8<8>(ldst, reg);
}
__device__ __forceinline__ void scan_block(const Params& p, LAS unsigned char* lds, int sid) {
    const int tid = threadIdx.x, lane = tid & 63, wave = tid >> 6;
    const int dir = sid / (BATCH * RH), bh = sid % (BATCH * RH), b = bh / RH, h = bh % RH;
    const float* sh = (const float*)(p.ws + WS_SSH) + (size_t)bh * SEQ * 192;
    const float* dr = (const float*)(p.ws + WS_SDIR) + (size_t)(dir * BATCH * RH + bh) * SEQ * 192;
    float* Y = (float*)((unsigned char*)p.out + DO_Y) + (size_t)dir * T * RC;
    LAS float* buf0 = (LAS float*)lds; LAS float* buf1 = buf0 + SC_TC * SC_STEP;
    constexpr int NCH = SEQ / SC_TC;
    __syncthreads();
    if (wave >= 4) scan_produce(sh, dr, dir, 0, buf0, tid - 256);
    __syncthreads();
    const int rp = lane >> 3, cgp = lane & 7;
    f32x2 s0[4], s1[4];
#pragma unroll
    for (int j = 0; j < 4; ++j) { s0[j] = (f32x2){0.f, 0.f}; s1[j] = (f32x2){0.f, 0.f}; }
    for (int c = 0; c < NCH; ++c) {
        LAS float* cur = (c & 1) ? buf1 : buf0; LAS float* nxt = (c & 1) ? buf0 : buf1;
        if (wave >= 4) {
            if (c + 1 < NCH) scan_produce(sh, dr, dir, c + 1, nxt, tid - 256);
        } else {
            const LAS float* base = cur + cgp * 8;
            const LAS float* vb = cur + 5 * 64 + 16 * wave + 2 * rp;
#pragma unroll 2
            for (int st = 0; st < SC_TC; ++st) {
                const LAS float* q = base + st * SC_STEP;
                const f32x4 kkA = *(const LAS f32x4*)(q), kkB = *(const LAS f32x4*)(q + 4);
                const f32x4 wA = *(const LAS f32x4*)(q + 64), wB = *(const LAS f32x4*)(q + 68);
                const f32x4 bA = *(const LAS f32x4*)(q + 128), bB = *(const LAS f32x4*)(q + 132);
                const f32x4 kA = *(const LAS f32x4*)(q + 192), kB = *(const LAS f32x4*)(q + 196);
                const f32x4 rA = *(const LAS f32x4*)(q + 256), rB = *(const LAS f32x4*)(q + 260);
                const f32x2 vv = *(const LAS f32x2*)(vb + st * SC_STEP);
                const f32x2 kk2[4] = {{kkA.x, kkA.y}, {kkA.z, kkA.w}, {kkB.x, kkB.y}, {kkB.z, kkB.w}};
                const f32x2 w2[4] = {{wA.x, wA.y}, {wA.z, wA.w}, {wB.x, wB.y}, {wB.z, wB.w}};
                const f32x2 b2[4] = {{bA.x, bA.y}, {bA.z, bA.w}, {bB.x, bB.y}, {bB.z, bB.w}};
                const f32x2 k2[4] = {{kA.x, kA.y}, {kA.z, kA.w}, {kB.x, kB.y}, {kB.z, kB.w}};
                const f32x2 r2[4] = {{rA.x, rA.y}, {rA.z, rA.w}, {rB.x, rB.y}, {rB.z, rB.w}};
                f32x2 a0 = s0[0] * kk2[0], a1 = s1[0] * kk2[0];
#pragma unroll
                for (int j = 1; j < 4; ++j) { a0 += s0[j] * kk2[j]; a1 += s1[j] * kk2[j]; }
                const float sa0 = sum8(a0.x + a0.y), sa1 = sum8(a1.x + a1.y);
                const f32x2 v0 = {vv.x, vv.x}, v1 = {vv.y, vv.y}, n0 = {-sa0, -sa0}, n1 = {-sa1, -sa1};
#pragma unroll
                for (int j = 0; j < 4; ++j) { s0[j] = s0[j] * w2[j] + v0 * k2[j] + n0 * b2[j]; s1[j] = s1[j] * w2[j] + v1 * k2[j] + n1 * b2[j]; }
                f32x2 y0 = s0[0] * r2[0], y1 = s1[0] * r2[0];
#pragma unroll
                for (int j = 1; j < 4; ++j) { y0 += s0[j] * r2[j]; y1 += s1[j] * r2[j]; }
                const float yy0 = sum8(y0.x + y0.y), yy1 = sum8(y1.x + y1.y);
                if (cgp == 0) { const int tau = c * SC_TC + st, t = dir ? (SEQ - 1 - tau) : tau;
                    *(f32x2*)(Y + ((size_t)(b * SEQ + t)) * RC + h * 64 + 16 * wave + 2 * rp) = (f32x2){yy0, yy1}; }
            }
        }
        __syncthreads();
    }
}

constexpr int AT_VP = 264;
constexpr int AT_LDS_UNIT = 64 * AT_VP * 2;
struct AttUnit { const bf16_t* q; const bf16_t* k; const bf16_t* v; long qs, ks; int nk; int kind; int n, L, dil; float slope; bf16_t* o; long os; float* lse; long ls; };
template <int NKT  >
__device__ __forceinline__ void att_unit(const AttUnit& U, LAS unsigned char* ldsu, int w4  , int lane, int utid  ) {
    const int fr = lane & 15, fq = lane >> 4;
    LAS bf16_t* VT = (LAS bf16_t*)ldsu;
    const bool dil = U.kind == 0;
    for (int i = utid; i < NKT * 16 * 8; i += 256) { const int key = i >> 3, d0 = (i & 7) * 8; int lk = key; bool ok = true;
        if (dil) { lk = U.n * 64 - 64 + key; ok = lk >= 0 && lk < U.L; lk = ok ? lk : 0; }
        u32x4 raw = *(const u32x4*)(U.v + (long)lk * U.ks + d0);
        if (!ok) raw = (u32x4){0u, 0u, 0u, 0u};
        const unsigned wv[4] = {raw.x, raw.y, raw.z, raw.w};
#pragma unroll
        for (int e = 0; e < 4; ++e) { VT[(d0 + 2 * e) * AT_VP + key] = (bf16_t)(wv[e] & 0xffffu); VT[(d0 + 2 * e + 1) * AT_VP + key] = (bf16_t)(wv[e] >> 16); } }
    const bf16_t* qp = U.q + (long)(16 * w4 + fr) * U.qs + fq * 8;
    const bf16x8 q0 = *(const bf16x8*)qp, q1 = *(const bf16x8*)(qp + 32);
    f32x4 sT[NKT];
#pragma unroll
    for (int t = 0; t < NKT; ++t) { int lk = 16 * t + fr; if (dil) { lk = U.n * 64 - 64 + lk; lk = (lk >= 0 && lk < U.L) ? lk : 0; }
        const bf16_t* kp = U.k + (long)lk * U.ks + fq * 8;
        const bf16x8 k0 = *(const bf16x8*)kp, k1 = *(const bf16x8*)(kp + 32);
        f32x4 a = (f32x4){0.f, 0.f, 0.f, 0.f};
        a = __builtin_amdgcn_mfma_f32_16x16x32_bf16(k0, q0, a, 0, 0, 0);
        a = __builtin_amdgcn_mfma_f32_16x16x32_bf16(k1, q1, a, 0, 0, 0);
        sT[t] = a; if ((t & 3) == 3) asm volatile("" ::: "memory"); }
    float m = -3.0e38f;
    const int qi = 16 * w4 + fr;
#pragma unroll
    for (int t = 0; t < NKT; ++t)
#pragma unroll
        for (int r = 0; r < 4; ++r) { float s = sT[t][r];
            if (dil) { const int kj = 16 * t + 4 * fq + r, delta = kj - 64 - qi, lk = U.n * 64 - 64 + kj; const int ad = delta < 0 ? -delta : delta;
                const bool valid = ad <= 64 && lk >= 0 && lk < U.L; s = valid ? s - U.slope * (float)(ad * U.dil) : -1e30f; }
            sT[t][r] = s; m = fmaxf(m, s); }
    m = fmaxf(m, __shfl_xor(m, 16)); m = fmaxf(m, __shfl_xor(m, 32));
    float l = 0.f;
#pragma unroll
    for (int t = 0; t < NKT; ++t)
#pragma unroll
        for (int r = 0; r < 4; ++r) { const float e = __expf(sT[t][r] - m); sT[t][r] = e; l += e; }
    l += __shfl_xor(l, 16); l += __shfl_xor(l, 32);
    __syncthreads();
    f32x4 oT[4];
#pragma unroll
    for (int dt = 0; dt < 4; ++dt) oT[dt] = (f32x4){0.f, 0.f, 0.f, 0.f};
#pragma unroll
    for (int tp = 0; tp < NKT / 2; ++tp) {
        u32x4 pw; pw.x = pk2(sT[2 * tp][0], sT[2 * tp][1]); pw.y = pk2(sT[2 * tp][2], sT[2 * tp][3]); pw.z = pk2(sT[2 * tp + 1][0], sT[2 * tp + 1][1]); pw.w = pk2(sT[2 * tp + 1][2], sT[2 * tp + 1][3]);
        const bf16x8 pb = __builtin_bit_cast(bf16x8, pw);
#pragma unroll
        for (int dt = 0; dt < 4; ++dt) { const LAS bf16_t* vp = VT + (16 * dt + fr) * AT_VP + 32 * tp + 4 * fq;
            const u32x2 lo = *(const LAS u32x2*)vp, hi = *(const LAS u32x2*)(vp + 16);
            u32x4 vw; vw.x = lo.x; vw.y = lo.y; vw.z = hi.x; vw.w = hi.y;
            oT[dt] = __builtin_amdgcn_mfma_f32_16x16x32_bf16(__builtin_bit_cast(bf16x8, vw), pb, oT[dt], 0, 0, 0); } }
    const float inv = 1.f / l;
    bf16_t* op = U.o + (long)(16 * w4 + fr) * U.os;
#pragma unroll
    for (int dt = 0; dt < 4; ++dt) { u32x2 o; o.x = pk2(oT[dt][0] * inv, oT[dt][1] * inv); o.y = pk2(oT[dt][2] * inv, oT[dt][3] * inv); *(u32x2*)(op + 16 * dt + 4 * fq) = o; }
    if (U.lse && fq == 0) U.lse[(long)(16 * w4 + fr) * U.ls] = m + __logf(l);
    __syncthreads();
}
constexpr int ATT_DIL_UNITS = BATCH * AH * 96;
constexpr int ATT_MEM_UNITS = BATCH * MH * 32;
constexpr int ATT_UNITS = ATT_DIL_UNITS + ATT_MEM_UNITS;
__device__ __forceinline__ void att_make_unit(const Params& p, int u, AttUnit& U) {
    unsigned char* ws = p.ws; const bf16_t* PA = (const bf16_t*)(ws + WS_PA);
    if (u < ATT_DIL_UNITS) {
        const int bh = u / 96, x = u % 96, b = bh / AH, h = bh % AH, br = x / 32, y = x % 32;
        const int dil = br == 0 ? 1 : (br == 1 ? 4 : 16), L = SEQ / dil, nb = L / 64, r = y / nb, n = y % nb;
        const bf16_t* base = PA + (size_t)(b * SEQ + r) * PA_W + h * 64;
        U.kind = 0; U.n = n; U.L = L; U.dil = dil; U.nk = 192; U.slope = exp2f(-8.f * (float)(h + 1) / (float)AH);
        U.qs = (long)dil * PA_W; U.ks = U.qs;
        U.q = base + (long)(n * 64) * U.qs; U.k = base + AW; U.v = base + 2 * AW;
        U.o = (bf16_t*)(ws + WS_ATTO) + (size_t)br * T * AW + (size_t)(b * SEQ + r + (long)n * 64 * dil) * AW + h * 64; U.os = (long)dil * AW;
        U.lse = (float*)((unsigned char*)p.out + DO_LSE) + (size_t)br * T * AH + (size_t)(b * SEQ + r + (long)n * 64 * dil) * AH + h; U.ls = (long)dil * AH;
    } else {
        const int v = u - ATT_DIL_UNITS, bh = v / 32, qb = v % 32, b = bh / MH, h = bh % MH;
        const bf16_t* KVM = (const bf16_t*)(ws + WS_KVM);
        U.kind = 1; U.n = 0; U.L = NMEM; U.dil = 1; U.nk = 256; U.slope = 0.f;
        U.q = PA + (size_t)(b * SEQ + qb * 64) * PA_W + 3 * AW + h * 64; U.qs = PA_W;
        U.k = KVM + (size_t)(b * NMEM) * (2 * MW) + h * 64; U.v = U.k + MW; U.ks = 2 * MW;
        U.o = (bf16_t*)(ws + WS_YMIX) + (size_t)(b * SEQ + qb * 64) * D + RC + AW + h * 64; U.os = D;
        U.lse = nullptr; U.ls = 0;
    }
}
__device__ __forceinline__ void phase3(const Params& p, LAS unsigned char* lds) {
    const int tid = threadIdx.x, lane = tid & 63, wave = tid >> 6;
    unsigned* ctl = (unsigned*)(p.ws + WS_CTL);
    LAS unsigned* bc = (LAS unsigned*)(lds + 2 * SC_TC * SC_STEP * 4);
    for (;;) {
        __syncthreads();
        if (tid == 0) bc[0] = atomicAdd(ctl + CW_SCANQ, 1u);
        __syncthreads();
        const unsigned sid = bc[0];
        if (sid >= 2u * BATCH * RH) break;
        scan_block(p, lds, (int)sid);
    }
    for (;;) {
        __syncthreads();
        if (tid == 0) bc[0] = atomicAdd(ctl + CW_ATTQ, 2u);
        __syncthreads();
        const unsigned u0 = bc[0];
        if (u0 >= (unsigned)ATT_UNITS) break;
        const int half = wave >> 2; AttUnit U; att_make_unit(p, (int)u0 + half, U);
        if (u0 < (unsigned)ATT_DIL_UNITS) att_unit<12>(U, lds + half * AT_LDS_UNIT, wave & 3, lane, tid & 255);
        else att_unit<16>(U, lds + half * AT_LDS_UNIT, wave & 3, lane, tid & 255);
    }
}

__device__ __forceinline__ void phase4(const Params& p) {
    const int tid = threadIdx.x, lane = tid & 63, wave = tid >> 6;
    const int gw = blockIdx.x * NWAVES + wave, NGW = gridDim.x * NWAVES;
    unsigned char* ws = p.ws; const unsigned char* dob = (const unsigned char*)p.out;
    const float* Yf = (const float*)(dob + DO_Y); const float* Yb = Yf + (size_t)T * RC;
    const bf16_t* G = (const bf16_t*)(dob + DO_G); const float* LSE = (const float*)(dob + DO_LSE);
    const float* BON = (const float*)(ws + WS_BONUS); const float* SSH = (const float*)(ws + WS_SSH);
    const bf16_t* AO = (const bf16_t*)(ws + WS_ATTO); bf16_t* YM = (bf16_t*)(ws + WS_YMIX);
    for (int t = gw; t < T; t += NGW) {
        const int b = t >> 11, s = t & (SEQ - 1);
#pragma unroll
        for (int h = 0; h < RH; ++h) { const int ch = h * 64 + lane;
            const float y = Yf[(size_t)t * RC + ch] + Yb[(size_t)t * RC + ch];
            const float mean = wave_sum(y) * (1.f / 64.f); const float dlt = y - mean; const float var = wave_sum(dlt * dlt) * (1.f / 64.f);
            const float yn = dlt * (1.f / sqrtf(var + GN_EPS)) * p.in[14][ch] + p.in[15][ch];
            const float v = SSH[((size_t)(b * RH + h) * SEQ + s) * 192 + 64 + lane];
            const float o = (yn + BON[t * RH + h] * v) * bf2f(G[(size_t)t * RC + ch]);
            YM[(size_t)t * D + ch] = (bf16_t)f2bf(o); }
#pragma unroll
        for (int h = 0; h < AH; ++h) { const int ch = h * 64 + lane;
            const float l0 = LSE[(size_t)t * AH + h], l1 = LSE[(size_t)T * AH + (size_t)t * AH + h], l2 = LSE[(size_t)2 * T * AH + (size_t)t * AH + h];
            const float mx = fmaxf(l0, fmaxf(l1, l2)); const float e0 = __expf(l0 - mx), e1 = __expf(l1 - mx), e2 = __expf(l2 - mx); const float inv = 1.f / (e0 + e1 + e2);
            const float o = (e0 * bf2f(AO[(size_t)t * AW + ch]) + e1 * bf2f(AO[(size_t)T * AW + (size_t)t * AW + ch]) + e2 * bf2f(AO[(size_t)2 * T * AW + (size_t)t * AW + ch])) * inv;
            YM[(size_t)t * D + RC + ch] = (bf16_t)f2bf(o); }
    }
}

__device__ __forceinline__ void phase5(const Params& p) {
    unsigned char* ws = p.ws; const bf16_t* YM = (const bf16_t*)(ws + WS_YMIX); const bf16_t* WT = (const bf16_t*)(ws + WS_WT_OUT); const bf16_t* H0B = (const bf16_t*)(ws + WS_H0B);
    float* PRE = p.out;
    constexpr int NT_N = D / 128, NT_M = T / 128;
    for (int u = blockIdx.x; u < NT_N * NT_M; u += gridDim.x) { const int pn = u % NT_N, pm = u / NT_N, r0 = pm * 128, c0 = pn * 128;
        sgemm_tile(D, [&](int r) { return YM + (size_t)(r0 + r) * D; }, [&](int c) { return WT + (size_t)(c0 + c) * D; },
            [&](int r, int c, f32x4 v, int) { const size_t off = (size_t)(r0 + r) * D + c0 + c; const u32x2 hb = *(const u32x2*)(H0B + off);
                f32x4 o; o.x = v.x + ALPHA * bflo(hb.x); o.y = v.y + ALPHA * bfhi(hb.x); o.z = v.z + ALPHA * bflo(hb.y); o.w = v.w + ALPHA * bfhi(hb.y); *(f32x4*)(PRE + off) = o; });
    }
}

__device__ __forceinline__ void phase6(const Params& p, LAS unsigned char* lds) {
    const int tid = threadIdx.x, lane = tid & 63, wave = tid >> 6;
    const int gw = blockIdx.x * NWAVES + wave, NGW = gridDim.x * NWAVES;
    unsigned char* ws = p.ws; unsigned* ctl = (unsigned*)(ws + WS_CTL);
    const float* WRT = (const float*)(ws + WS_WRT);
    LAS float* hrow = (LAS float*)(lds + wave * 4096);
    int* LIST = (int*)(ws + WS_LIST); float* RG = (float*)(ws + WS_ROWGATE); int* SEL = (int*)(ws + WS_SEL);
    for (int t = gw; t < T; t += NGW) {
        const f32x4* xr = (const f32x4*)(p.out + (size_t)t * D) + lane; f32x4 v[4];
#pragma unroll
        for (int j = 0; j < 4; ++j) v[j] = xr[64 * j];
        ln_row(v, p.in[18], p.in[19], lane);
        store_row_bf16((bf16_t*)(ws + WS_H1B) + (size_t)t * D, v, lane);
#pragma unroll
        for (int j = 0; j < 4; ++j) *(LAS f32x4*)(hrow + 4 * lane + 256 * j) = v[j];
        asm volatile("s_waitcnt lgkmcnt(0)" ::: "memory");
        const int e = lane & 31, half = lane >> 5;
        const float* wr = WRT + (size_t)e * D + half * 512; const LAS float* hh = hrow + half * 512;
        float a0 = 0.f, a1 = 0.f, a2 = 0.f, a3 = 0.f;
#pragma unroll 4
        for (int k = 0; k < 512; k += 4) { const f32x4 wv = *(const f32x4*)(wr + k); const f32x4 hv = *(const LAS f32x4*)(hh + k); a0 += wv.x * hv.x; a1 += wv.y * hv.y; a2 += wv.z * hv.z; a3 += wv.w * hv.w; }
        float logit = (a0 + a1) + (a2 + a3); logit += __shfl_xor(logit, 32); logit += p.in[21][e];
        float cur = logit; float tv0 = 0.f, tv1 = 0.f, tv2 = 0.f, tv3 = 0.f; int te0 = 0, te1 = 0, te2 = 0, te3 = 0;
#pragma unroll
        for (int k = 0; k < 4; ++k) { float bv = cur; int bi = e;
#pragma unroll
            for (int o = 1; o < 32; o <<= 1) { const float ov = __shfl_xor(bv, o); const int oi = __shfl_xor(bi, o); if (ov > bv || (ov == bv && oi < bi)) { bv = ov; bi = oi; } }
            if (k == 0) { tv0 = bv; te0 = bi; } if (k == 1) { tv1 = bv; te1 = bi; } if (k == 2) { tv2 = bv; te2 = bi; } if (k == 3) { tv3 = bv; te3 = bi; }
            if (e == bi) cur = -3.0e38f; }
        const float e1 = __expf(tv1 - tv0), e2 = __expf(tv2 - tv0), e3 = __expf(tv3 - tv0); const float inv = 1.f / (1.f + e1 + e2 + e3);
        if (lane < 4) { int ee = te0; float gg = inv;
            if (lane == 1) { ee = te1; gg = e1 * inv; } if (lane == 2) { ee = te2; gg = e2 * inv; } if (lane == 3) { ee = te3; gg = e3 * inv; }
            const unsigned rank = atomicAdd(ctl + CW_CNT + ee, 1u);
            LIST[(size_t)ee * T + rank] = t; RG[(size_t)ee * T + rank] = gg; SEL[((size_t)t * 4 + lane) * 2] = ee; SEL[((size_t)t * 4 + lane) * 2 + 1] = (int)rank; }
    }
}

__device__ __forceinline__ void build_expert_tables(const Params& p, LAS int* tab) {
    const unsigned* ctl = (const unsigned*)(p.ws + WS_CTL);
    __syncthreads();
    if (threadIdx.x == 0) { int ps = 0, ts = 0;
        for (int e = 0; e < NE; ++e) { const int c = (int)__hip_atomic_load(ctl + CW_CNT + e, __ATOMIC_RELAXED, __HIP_MEMORY_SCOPE_AGENT); tab[e] = c; tab[32 + e] = ps; tab[64 + e] = ts; ps += (c + 255) / 256 * 256; ts += (c + 127) / 128; }
        tab[64 + NE] = ts; }
    __syncthreads();
}

__device__ __forceinline__ void phase7(const Params& p, LAS unsigned char* lds) {
    LAS int* tab = (LAS int*)lds; build_expert_tables(p, tab);
    unsigned char* ws = p.ws; const bf16_t* H1B = (const bf16_t*)(ws + WS_H1B); const bf16_t* WG = (const bf16_t*)(ws + WS_WT_GU);
    const int* LIST = (const int*)(ws + WS_LIST); bf16_t* ACT = (bf16_t*)(ws + WS_ACT); const float* BGU = p.in[23];
    const int ntile = tab[64 + NE]; constexpr int NT_N = 2 * FF / 128;
    for (int u = blockIdx.x; u < ntile * NT_N; u += gridDim.x) {
        const int pn = u % NT_N, mt_g = u / NT_N; int e = 0;
        for (int i = 1; i < NE; ++i) if (mt_g >= tab[64 + i]) e = i;
        const int mt = mt_g - tab[64 + e], cnt = tab[e], r0 = mt * 128, prow0 = tab[32 + e] + r0;
        const int* lst = LIST + (size_t)e * T + r0; const bf16_t* W = WG + (size_t)e * 2 * FF * D; const float* bias = BGU + (size_t)e * 2 * FF;
        const int f0 = pn * 64;
        f32x4 gate_keep[2];
        sgemm_tile(D, [&](int r) { const int rr = r0 + r < cnt ? r : 0; return H1B + (size_t)lst[rr] * D; },
            [&](int c) { const int grp = c >> 5, wi = c & 31; return W + (size_t)((wi >> 4) * FF + f0 + 16 * grp + (wi & 15)) * D; },
            [&](int r, int c, f32x4 v, int n) {
                if ((n & 1) == 0) { gate_keep[0] = v; }
                else { const int grp = c >> 5, fcol = f0 + 16 * grp + ((c & 15)); const f32x4 g = gate_keep[0];
                    const f32x4 bg = *(const f32x4*)(bias + fcol), bu = *(const f32x4*)(bias + FF + fcol); f32x4 a;
#pragma unroll
                    for (int i = 0; i < 4; ++i) { const float gc = fminf(g[i] + bg[i], 7.f), uc = fminf(fmaxf(v[i] + bu[i], -7.f), 7.f); a[i] = (uc + 1.f) * gc * sigmoidf_(1.702f * gc); }
                    if (r0 + r < cnt) { u32x2 o; o.x = pk2(a[0], a[1]); o.y = pk2(a[2], a[3]); *(u32x2*)(ACT + (size_t)(prow0 + r) * FF + fcol) = o; } } });
    }
}

__device__ __forceinline__ void phase8(const Params& p, LAS unsigned char* lds) {
    LAS int* tab = (LAS int*)lds; build_expert_tables(p, tab);
    unsigned char* ws = p.ws; const bf16_t* ACT = (const bf16_t*)(ws + WS_ACT); const bf16_t* WD = (const bf16_t*)(ws + WS_WT_DN);
    const float* RG = (const float*)(ws + WS_ROWGATE); bf16_t* YR = (bf16_t*)(ws + WS_YROWS); const float* BD = p.in[25];
    const int ntile = tab[64 + NE]; constexpr int NT_N = D / 128;
    for (int u = blockIdx.x; u < ntile * NT_N; u += gridDim.x) {
        const int pn = u % NT_N, mt_g = u / NT_N; int e = 0;
        for (int i = 1; i < NE; ++i) if (mt_g >= tab[64 + i]) e = i;
        const int mt = mt_g - tab[64 + e], cnt = tab[e], r0 = mt * 128, prow0 = tab[32 + e] + r0, c0 = pn * 128;
        const bf16_t* W = WD + (size_t)e * D * FF; const float* bias = BD + (size_t)e * D; const float* rg = RG + (size_t)e * T + r0;
        sgemm_tile(FF, [&](int r) { const int rr = r0 + r < cnt ? r : 0; return ACT + (size_t)(prow0 + rr) * FF; }, [&](int c) { return W + (size_t)(c0 + c) * FF; },
            [&](int r, int c, f32x4 v, int) { if (r0 + r < cnt) { const float g = rg[r]; const f32x4 bb = *(const f32x4*)(bias + c0 + c);
                u32x2 o; o.x = pk2((v.x + bb.x) * g, (v.y + bb.y) * g); o.y = pk2((v.z + bb.z) * g, (v.w + bb.w) * g); *(u32x2*)(YR + (size_t)(prow0 + r) * D + c0 + c) = o; } });
    }
}

__device__ __forceinline__ void phase9(const Params& p, LAS unsigned char* lds) {
    LAS int* tab = (LAS int*)lds; build_expert_tables(p, tab);
    const int tid = threadIdx.x, lane = tid & 63, wave = tid >> 6;
    const int gw = blockIdx.x * NWAVES + wave, NGW = gridDim.x * NWAVES;
    unsigned char* ws = p.ws; const bf16_t* H1B = (const bf16_t*)(ws + WS_H1B); const bf16_t* YR = (const bf16_t*)(ws + WS_YROWS); const int* SEL = (const int*)(ws + WS_SEL);
    for (int t = gw; t < T; t += NGW) {
        f32x4 v[4];
#pragma unroll
        for (int j = 0; j < 4; ++j) { const u32x2 hb = *(const u32x2*)(H1B + (size_t)t * D + 4 * lane + 256 * j); v[j] = (f32x4){ALPHA * bflo(hb.x), ALPHA * bfhi(hb.x), ALPHA * bflo(hb.y), ALPHA * bfhi(hb.y)}; }
#pragma unroll
        for (int k = 0; k < 4; ++k) { const int e = SEL[((size_t)t * 4 + k) * 2], rank = SEL[((size_t)t * 4 + k) * 2 + 1]; const bf16_t* yr = YR + (size_t)(tab[32 + e] + rank) * D;
#pragma unroll
            for (int j = 0; j < 4; ++j) { const u32x2 yb = *(const u32x2*)(yr + 4 * lane + 256 * j); v[j].x += bflo(yb.x); v[j].y += bfhi(yb.x); v[j].z += bflo(yb.y); v[j].w += bfhi(yb.y); } }
        ln_row(v, p.in[26], p.in[27], lane);
        f32x4* orow = (f32x4*)(p.out + (size_t)t * D) + lane;
#pragma unroll
        for (int j = 0; j < 4; ++j) orow[64 * j] = v[j];
    }
}

constexpr int NPHASE = 10;
constexpr int LDS_BYTES = 131072 + 1024;
__global__ void __launch_bounds__(NTHR, 2) mk_fwd(Params p) {
    extern __shared__ __attribute__((aligned(16))) unsigned char lds_raw[];
    LAS unsigned char* lds = (LAS unsigned char*)lds_raw;
    const int lo = p.ph_lo, hi = p.ph_hi;
#ifdef ONLY_PHASE
#define IN(k) ((k) == ONLY_PHASE && lo <= (k) && (k) < hi)
#else
#define IN(k) (lo <= (k) && (k) < hi)
#endif
#define SEAM(k) do { if (IN(k) && IN((k) + 1)) { cg::this_grid().sync(); } } while (0)
    if (IN(0)) phase0(p, lds);
    SEAM(0);
    if (IN(1)) phase1(p);
    SEAM(1);
    if (IN(2)) phase2(p, lds);
    SEAM(2);
    if (IN(3)) phase3(p, lds);
    SEAM(3);
    if (IN(4)) phase4(p);
    SEAM(4);
    if (IN(5)) phase5(p);
    SEAM(5);
    if (IN(6)) phase6(p, lds);
    SEAM(6);
    if (IN(7)) phase7(p, lds);
    SEAM(7);
    if (IN(8)) phase8(p, lds);
    SEAM(8);
    if (IN(9)) phase9(p, lds);
#undef IN
#undef SEAM
}

extern "C" void kernel_launch(void* const* d_in, const int* in_sizes, int n_in, void* d_out, int out_size, void* d_ws, size_t ws_size, hipStream_t stream) {
    static int grid = 0;
    if (grid == 0) {
        if (n_in != 28 || out_size != T * D || ws_size < WS_END) { fprintf(stderr, "kernel_launch: unexpected shapes: n_in %d out %d ws %zu (need %zu)\n", n_in, out_size, ws_size, (size_t)WS_END); grid = -1; return; }
        int dev = 0, cus = 0, per_cu = 0;
        hipGetDevice(&dev); hipDeviceGetAttribute(&cus, hipDeviceAttributeMultiprocessorCount, dev);
        hipFuncSetAttribute((const void*)mk_fwd, hipFuncAttributeMaxDynamicSharedMemorySize, LDS_BYTES);
        hipOccupancyMaxActiveBlocksPerMultiprocessor(&per_cu, (const void*)mk_fwd, NTHR, LDS_BYTES);
        (void)hipGetLastError();
        if (per_cu < 1) { fprintf(stderr, "kernel_launch: occupancy query says %d blocks per CU\n", per_cu); per_cu = 1; }
        grid = cus;
    }
    if (grid < 0) return;
    hipMemsetAsync((char*)d_ws + WS_CTL, 0, 4096, stream);
    Params p{};
    for (int i = 0; i < 28; ++i) p.in[i] = (const float*)d_in[i];
    p.out = (float*)d_out; p.ws = (unsigned char*)d_ws;
#if MK_ONE_LAUNCH
    p.ph_lo = 0; p.ph_hi = NPHASE;
    void* args[] = {&p};
    hipError_t e = hipLaunchCooperativeKernel((const void*)mk_fwd, dim3(grid), dim3(NTHR), args, LDS_BYTES, stream);
    if (e != hipSuccess) fprintf(stderr, "cooperative launch failed: %s (grid %d)\n", hipGetErrorString(e), grid);
#else
    for (int ph = 0; ph < NPHASE; ++ph) { p.ph_lo = ph; p.ph_hi = ph + 1; hipLaunchKernelGGL(mk_fwd, dim3(grid), dim3(NTHR), LDS_BYTES, stream, p); }
#endif
}
```

```cpp
#include <hip/hip_runtime.h>
#include <hip/hip_cooperative_groups.h>
#include <cstdio>
#include <cstdint>
namespace cg = cooperative_groups;

#ifndef REPEAT_PHASE
#define REPEAT_PHASE -1
#endif
#ifndef MK_ONE_LAUNCH
#define MK_ONE_LAUNCH 1
#endif

typedef unsigned short bf16_t;
typedef short bf16x8 __attribute__((ext_vector_type(8)));
typedef short bf16x4 __attribute__((ext_vector_type(4)));
typedef float f32x4 __attribute__((ext_vector_type(4)));
typedef float f32x2 __attribute__((ext_vector_type(2)));
typedef unsigned u32x4 __attribute__((ext_vector_type(4)));
typedef unsigned u32x2 __attribute__((ext_vector_type(2)));

constexpr int D = 1024, BATCH = 16, SEQ = 2048, T = BATCH * SEQ;
constexpr int NMEM = 256, HD = 64;
constexpr int RH = 6, RC = 384;
constexpr int RWKV_IN = 1344;
constexpr int AH = 6, AW = 384, MH = 4, MW = 256;
constexpr int IN_W = 2752, IN_WP = 2816;
constexpr int PA_W = IN_WP - RWKV_IN;
constexpr int NE = 32, TOPK = 4, FF = 1024;
constexpr float LN_EPS = 1e-5f, GN_EPS = 64e-5f;
constexpr float ALPHA = 1.189207115002721f;
constexpr int NTHR = 512, NWAVES = 8;

constexpr size_t MiB = 1u << 20;
constexpr size_t WS_CTL = 0;
constexpr size_t WS_WT_IN = 1 * MiB;
constexpr size_t WS_LORA = 6 * MiB + 512 * 1024;
constexpr size_t WS_WT_OUT = 7 * MiB;
constexpr size_t WS_WT_KV = 9 * MiB;
constexpr size_t WS_KVM = 10 * MiB;
constexpr size_t WS_MEMB = 14 * MiB;
constexpr size_t WS_LIST = 22 * MiB;
constexpr size_t WS_ROWGATE = 26 * MiB;
constexpr size_t WS_SEL = 30 * MiB;
constexpr size_t WS_BONUS = 31 * MiB;
constexpr size_t WS_WRT = 31 * MiB + 800 * 1024;
constexpr size_t WS_WT_GU = 32 * MiB;
constexpr size_t WS_WT_DN = 160 * MiB;
constexpr size_t WS_H0B = 224 * MiB;
constexpr size_t WS_H1B = 288 * MiB;
constexpr size_t WS_YMIX = 352 * MiB;
constexpr size_t WS_PR = 416 * MiB;
constexpr size_t WS_ATTO = 416 * MiB;
constexpr size_t WS_PA = 500 * MiB;
constexpr size_t WS_SSH = 592 * MiB;
constexpr size_t WS_SDIR = 736 * MiB;
constexpr size_t WS_ACT = 352 * MiB;
constexpr size_t WS_YROWS = 624 * MiB;
constexpr size_t WS_END = 1024 * MiB;
constexpr size_t DO_Y = 0, DO_G = 96 * MiB, DO_LSE = 120 * MiB;
constexpr int ROWS_PAD = T * TOPK + NE * 256;

constexpr int CW_CNT = 0;
constexpr int CNT_SET = (REPEAT_PHASE == 6) ? 32 : 0;
constexpr int CW_ATTQ = 64;
constexpr int CW_SCANQ = 128;
constexpr int CW_BAR = 4096;
constexpr int CTL_ZERO_BYTES = 65536;
constexpr int BARST_OFF = 131072 + 1536;

#define LAS __attribute__((address_space(3)))

struct Params { const float* in[28]; float* out; unsigned char* ws; int ph_lo, ph_hi; };

__device__ __forceinline__ unsigned f2bf(float f) { unsigned u = __builtin_bit_cast(unsigned, f); return (u + 0x7fffu + ((u >> 16) & 1u)) >> 16; }
__device__ __forceinline__ unsigned pk2(float lo, float hi) { return f2bf(lo) | (f2bf(hi) << 16); }
__device__ __forceinline__ float bf2f(unsigned b) { return __builtin_bit_cast(float, b << 16); }
__device__ __forceinline__ float bflo(unsigned w) { return __builtin_bit_cast(float, w << 16); }
__device__ __forceinline__ float bfhi(unsigned w) { return __builtin_bit_cast(float, w & 0xffff0000u); }
template <int CTRL> __device__ __forceinline__ float dpp_mov(float v) {
    return __builtin_bit_cast(float, __builtin_amdgcn_update_dpp(0, __builtin_bit_cast(int, v), CTRL, 0xF, 0xF, true));
}
__device__ __forceinline__ float sum16(float v) {
    v += dpp_mov<0xB1>(v);
    v += dpp_mov<0x4E>(v);
    v += dpp_mov<0x141>(v);
    v += dpp_mov<0x140>(v);
    return v;
}
__device__ __forceinline__ float wave_sum(float v) {
    v = sum16(v);
    const int iv = __builtin_bit_cast(int, v);
    const float a = __builtin_bit_cast(float, __builtin_amdgcn_readlane(iv, 0)), b = __builtin_bit_cast(float, __builtin_amdgcn_readlane(iv, 16));
    const float c = __builtin_bit_cast(float, __builtin_amdgcn_readlane(iv, 32)), d = __builtin_bit_cast(float, __builtin_amdgcn_readlane(iv, 48));
    return (a + b) + (c + d);
}
__device__ __forceinline__ float sigmoidf_(float x) { return 1.f / (1.f + __expf(-x)); }

struct P0Item { const float* W; bf16_t* WT; int K, N, item; };
__device__ __forceinline__ void p0_item_load(const P0Item& I, float (&reg)[32], int lane) {
    const int nblk = I.N / 32, kb = I.item / nblk, nb = I.item % nblk, k0 = 64 * kb, n0 = 32 * nb;
    const float* src = I.W + (size_t)(k0 + (lane >> 5)) * I.N + n0 + (lane & 31);
#pragma unroll
    for (int i = 0; i < 32; ++i) reg[i] = src[(size_t)(2 * i) * I.N];
}
__device__ __forceinline__ void p0_item_store(const P0Item& I, const float (&reg)[32], LAS float* scr, int lane) {
    const int nblk = I.N / 32, kb = I.item / nblk, nb = I.item % nblk, k0 = 64 * kb, n0 = 32 * nb;
#pragma unroll
    for (int i = 0; i < 32; ++i) scr[(2 * i + (lane >> 5)) * 33 + (lane & 31)] = reg[i];
    asm volatile("s_waitcnt lgkmcnt(0)" ::: "memory");
    const int c = lane & 7;
#pragma unroll
    for (int j = 0; j < 4; ++j) { const int n = (lane >> 3) + 8 * j; const LAS float* s = scr + (8 * c) * 33 + n;
        u32x4 o; o.x = pk2(s[0 * 33], s[1 * 33]); o.y = pk2(s[2 * 33], s[3 * 33]); o.z = pk2(s[4 * 33], s[5 * 33]); o.w = pk2(s[6 * 33], s[7 * 33]);
        *(u32x4*)(I.WT + (size_t)(n0 + n) * I.K + k0 + 8 * c) = o; }
    asm volatile("s_waitcnt lgkmcnt(0)" ::: "memory");
}
__device__ __forceinline__ void ln_row(f32x4 (&v)[4], const float* __restrict__ g, const float* __restrict__ b, int lane) {
    float s = 0.f;
#pragma unroll
    for (int j = 0; j < 4; ++j) s += (v[j].x + v[j].y) + (v[j].z + v[j].w);
    const float mean = wave_sum(s) * (1.f / D); float s2 = 0.f;
#pragma unroll
    for (int j = 0; j < 4; ++j) { v[j] = v[j] - mean; s2 += (v[j].x * v[j].x + v[j].y * v[j].y) + (v[j].z * v[j].z + v[j].w * v[j].w); }
    const float rstd = 1.f / sqrtf(wave_sum(s2) * (1.f / D) + LN_EPS);
#pragma unroll
    for (int j = 0; j < 4; ++j) { const f32x4 gg = *(const f32x4*)(g + 4 * lane + 256 * j), bb = *(const f32x4*)(b + 4 * lane + 256 * j); v[j] = v[j] * rstd * gg + bb; }
}
__device__ __forceinline__ void store_row_bf16(bf16_t* orow, const f32x4 (&v)[4], int lane) {
#pragma unroll
    for (int j = 0; j < 4; ++j) { u32x2 o; o.x = pk2(v[j].x, v[j].y); o.y = pk2(v[j].z, v[j].w); *(u32x2*)(orow + 4 * lane + 256 * j) = o; }
}

__device__ __forceinline__ void phase0(const Params& p, LAS unsigned char* lds) {
    const int tid = threadIdx.x, lane = tid & 63, wave = tid >> 6;
    const int gw = blockIdx.x * NWAVES + wave, NGW = gridDim.x * NWAVES;
    LAS float* scr = (LAS float*)(lds + wave * 16384);
    unsigned char* ws = p.ws;
    constexpr int I_IN = 16 * (IN_W / 32), I_OUT = 16 * 32, I_KV = 16 * 16, I_GU = 16 * 64, I_DN = 16 * 32;
    constexpr int NITEMS = I_IN + I_OUT + I_KV + NE * I_GU + NE * I_DN;
    auto mk = [&](int it) { P0Item I; int r = it;
        if (r < I_IN) { I.W = p.in[4]; I.WT = (bf16_t*)(ws + WS_WT_IN); I.K = D; I.N = IN_W; I.item = r; return I; } r -= I_IN;
        if (r < I_OUT) { I.W = p.in[17]; I.WT = (bf16_t*)(ws + WS_WT_OUT); I.K = D; I.N = D; I.item = r; return I; } r -= I_OUT;
        if (r < I_KV) { I.W = p.in[16]; I.WT = (bf16_t*)(ws + WS_WT_KV); I.K = D; I.N = 2 * MW; I.item = r; return I; } r -= I_KV;
        if (r < NE * I_GU) { const int e = r / I_GU; I.W = p.in[22] + (size_t)e * D * 2 * FF; I.WT = (bf16_t*)(ws + WS_WT_GU) + (size_t)e * 2 * FF * D; I.K = D; I.N = 2 * FF; I.item = r % I_GU; return I; } r -= NE * I_GU;
        { const int e = r / I_DN; I.W = p.in[24] + (size_t)e * FF * D; I.WT = (bf16_t*)(ws + WS_WT_DN) + (size_t)e * D * FF; I.K = FF; I.N = D; I.item = r % I_DN; return I; } };
    { float ra[32], rb[32]; int it = gw;
      if (it < NITEMS) { const P0Item I0 = mk(it); p0_item_load(I0, ra, lane); }
      for (; it < NITEMS; it += 2 * NGW) {
          const P0Item Ia = mk(it); const bool hb = it + NGW < NITEMS; P0Item Ib = Ia;
          if (hb) { Ib = mk(it + NGW); p0_item_load(Ib, rb, lane); }
          p0_item_store(Ia, ra, scr, lane);
          if (it + 2 * NGW < NITEMS) { const P0Item Ic = mk(it + 2 * NGW); p0_item_load(Ic, ra, lane); }
          if (hb) p0_item_store(Ib, rb, scr, lane);
      } }
    { u32x4* z = (u32x4*)((bf16_t*)(ws + WS_WT_IN) + (size_t)IN_W * D); const int n16 = (IN_WP - IN_W) * D * 2 / 16;
      for (int i = blockIdx.x * NTHR + tid; i < n16; i += gridDim.x * NTHR) z[i] = (u32x4){0u, 0u, 0u, 0u}; }
    { const float* wr = p.in[20]; bf16_t* wh = (bf16_t*)(ws + WS_WRT); bf16_t* wl = wh + NE * D;
      for (int i = blockIdx.x * NTHR + tid; i < NE * D; i += gridDim.x * NTHR) { const int e = i / D, k = i % D; const float w = wr[k * NE + e]; const unsigned h = f2bf(w); wh[i] = (bf16_t)h; wl[i] = (bf16_t)f2bf(w - bf2f(h)); } }
    { bf16_t* wu = (bf16_t*)(ws + WS_LORA); bf16_t* au = wu + 2 * RC * 32; bf16_t* gu = au + 2 * RC * 32;
      for (int i = blockIdx.x * NTHR + tid; i < 2 * RC * 32; i += gridDim.x * NTHR) { const int dch = i >> 5, j = i & 31, d = dch / RC, ch = dch % RC; wu[i] = (bf16_t)f2bf(p.in[7][(size_t)(d * 32 + j) * RC + ch]); au[i] = (bf16_t)f2bf(p.in[9][(size_t)(d * 32 + j) * RC + ch]); }
      for (int i = blockIdx.x * NTHR + tid; i < RC * 64; i += gridDim.x * NTHR) { const int ch = i >> 6, j = i & 63; gu[i] = (bf16_t)f2bf(p.in[10][(size_t)j * RC + ch]); } }
    for (int m = gw; m < T; m += NGW) {
        const f32x4* xr = (const f32x4*)(p.in[0] + (size_t)m * D) + lane; f32x4 v[4];
#pragma unroll
        for (int j = 0; j < 4; ++j) v[j] = xr[64 * j];
        ln_row(v, p.in[2], p.in[3], lane);
        store_row_bf16((bf16_t*)(ws + WS_H0B) + (size_t)m * D, v, lane);
    }
    for (int m = gw; m < BATCH * NMEM; m += NGW) {
        const f32x4* xr = (const f32x4*)(p.in[1] + (size_t)m * D) + lane; f32x4 v[4];
#pragma unroll
        for (int j = 0; j < 4; ++j) v[j] = xr[64 * j];
        store_row_bf16((bf16_t*)(ws + WS_MEMB) + (size_t)m * D, v, lane);
    }
}

template <class ARow, class BRow, class Epi>
__device__ __forceinline__ void sgemm_tile(int K, ARow arow, BRow brow, Epi epi) {
    const int tid = threadIdx.x, wid = tid >> 6, lane = tid & 63, wm = wid >> 1, wn = wid & 1, fr = lane & 15, fq = lane >> 4;
    f32x4 acc[2][4];
#pragma unroll
    for (int m = 0; m < 2; ++m)
#pragma unroll
        for (int n = 0; n < 4; ++n) acc[m][n] = (f32x4){0.f, 0.f, 0.f, 0.f};
    const bf16_t* ap[2]; const bf16_t* bp[4];
#pragma unroll
    for (int m = 0; m < 2; ++m) ap[m] = arow(wm * 32 + m * 16 + fr) + fq * 8;
#pragma unroll
    for (int n = 0; n < 4; ++n) bp[n] = brow(wn * 64 + n * 16 + fr) + fq * 8;
    for (int k = 0; k < K; k += 32) {
        bf16x8 a[2], b[4];
#pragma unroll
        for (int m = 0; m < 2; ++m) a[m] = *(const bf16x8*)(ap[m] + k);
#pragma unroll
        for (int n = 0; n < 4; ++n) b[n] = *(const bf16x8*)(bp[n] + k);
#pragma unroll
        for (int m = 0; m < 2; ++m)
#pragma unroll
            for (int n = 0; n < 4; ++n) acc[m][n] = __builtin_amdgcn_mfma_f32_16x16x32_bf16(b[n], a[m], acc[m][n], 0, 0, 0);
    }
#pragma unroll
    for (int m = 0; m < 2; ++m)
#pragma unroll
        for (int n = 0; n < 4; ++n) epi(wm * 32 + m * 16 + fr, wn * 64 + n * 16 + 4 * fq, acc[m][n], n);
}


namespace pg8 {
constexpr int BM = 256, BK = 64, HALF = 128, HTB = HALF * BK * 2, STAGE_BYTES = 8 * HTB, NXCD = 8, WGM = 8;
__host__ __device__ __forceinline__ int lds_byte(int r, int c) { const int st = (r >> 4) * 2 + (c >> 5), rr = r & 15, cc = c & 31, ob = rr * 64 + cc * 2; return st * 1024 + (ob ^ (((ob >> 9) & 1) << 5)); }
__host__ __device__ __forceinline__ void stage_rc(int b, int& R, int& C) { const int st = b / 1024, sb = b % 1024, swz = sb ^ (((sb >> 9) & 1) << 5); R = (st >> 1) * 16 + swz / 64; C = (st & 1) * 32 + (swz % 64) / 2; }
__host__ __device__ __forceinline__ int perm32(int rho) { const int n = rho >> 4, i = rho & 15; return 8 * (i >> 2) + 4 * n + (i & 3); }
struct Unit { const char* A; const char* B0; const char* B1; int x0, x1, x2, x3, x4; };
__device__ __forceinline__ unsigned cvt_pk_bf16(float lo, float hi) { unsigned r; asm volatile("v_cvt_pk_bf16_f32 %0, %1, %2" : "=v"(r) : "v"(lo), "v"(hi)); return r; }

__device__ __forceinline__ const char* uni_ptr(const char* p) { const unsigned long long v = (unsigned long long)p; const unsigned lo = __builtin_amdgcn_readfirstlane((unsigned)v), hi = __builtin_amdgcn_readfirstlane((unsigned)(v >> 32)); return (const char*)(((unsigned long long)hi << 32) | lo); }
__device__ __forceinline__ bool static_order(int nM, int nN, int G, int c, int i, int& pm, int& pn) {
    const int nwg = nM * nN; const long L = (long)i * G + c; if (L >= nwg) return false;
    int wgid = (int)L; { const int q = nwg / NXCD, r = nwg % NXCD, xcd = wgid % NXCD, off = wgid / NXCD; wgid = (xcd < r ? xcd * (q + 1) : r * (q + 1) + (xcd - r) * q) + off; }
    const int nig = WGM * nN, gid = wgid / nig, fm = gid * WGM, gsz = (nM - fm) < WGM ? (nM - fm) : WGM;
    pm = fm + ((wgid % nig) % gsz); pn = (wgid % nig) / gsz; return true;
}

template <class Pol>
__device__ __forceinline__ void gemm_phase(LAS unsigned char* lds, const Pol& P, const int K) {
    const int tid = threadIdx.x, wid = __builtin_amdgcn_readfirstlane(tid >> 6), lane = tid & 63, wr = wid >> 2, wc = wid & 3, fr = lane & 15, fq = lane >> 4;
    const int nt = K / BK;
    int R0, C0; stage_rc(tid * 16, R0, C0);
    const int Rb0 = Pol::PERM ? ((R0 & ~31) + perm32(R0 & 31)) : R0;
    const unsigned vB = (unsigned)(Rb0 * K + C0) * 2u;
    const size_t pstep = (size_t)64 * K * 2;
    const size_t kstep = (size_t)(BK * 2);
    const unsigned ldsw = (unsigned)wid * 1024u;
    const int aoff = lds_byte(wr * 64 + fr, fq * 8), boff = lds_byte(wc * 32 + fr, fq * 8);
#define PG8_SA(b, h) (((b) * 2 + (h)) * HTB)
#define PG8_SB(b, h) ((4 + (b) * 2 + (h)) * HTB)
#define PG8_STAGE_B(bufoff, gbase) do { _Pragma("unroll") for (int _i = 0; _i < 2; ++_i) \
        __builtin_amdgcn_global_load_lds((const unsigned*)(uni_ptr((const char*)(gbase) + _i * pstep) + vB), (LAS unsigned*)(lds + (bufoff) + ldsw + _i * 8192), 16, 0, 0); } while (0)
#define PG8_STAGE_A(bufoff, gbase, vo, h) do { _Pragma("unroll") for (int _i = 0; _i < 2; ++_i) { \
        if constexpr (Pol::GATHER) __builtin_amdgcn_global_load_lds((const unsigned*)(uni_ptr((const char*)(gbase)) + (vo)[h][_i]), (LAS unsigned*)(lds + (bufoff) + ldsw + _i * 8192), 16, 0, 0); \
        else __builtin_amdgcn_global_load_lds((const unsigned*)(uni_ptr((const char*)(gbase) + ((h) * 2 + _i) * pstep) + (vo)[0][0]), (LAS unsigned*)(lds + (bufoff) + ldsw + _i * 8192), 16, 0, 0); } } while (0)
#define PG8_LDA(dst, b, h) do { _Pragma("unroll") for (int m = 0; m < 4; ++m) _Pragma("unroll") for (int k = 0; k < 2; ++k) dst[m][k] = *(const LAS bf16x8*)(lds + PG8_SA(b, h) + aoff + m * 2048 + k * 1024); } while (0)
#define PG8_LDB(dst, b, h) do { _Pragma("unroll") for (int n = 0; n < 2; ++n) _Pragma("unroll") for (int k = 0; k < 2; ++k) dst[n][k] = *(const LAS bf16x8*)(lds + PG8_SB(b, h) + boff + n * 2048 + k * 1024); } while (0)
#define PG8_MMA(ai, bj, At, Bt) do { __builtin_amdgcn_s_setprio(1); _Pragma("unroll") for (int m = 0; m < 4; ++m) _Pragma("unroll") for (int n = 0; n < 2; ++n) _Pragma("unroll") for (int k = 0; k < 2; ++k) \
        acc[ai][bj][m][n] = __builtin_amdgcn_mfma_f32_16x16x32_bf16(Bt[n][k], At[m][k], acc[ai][bj][m][n], 0, 0, 0); __builtin_amdgcn_s_setprio(0); } while (0)
#define PG8_WAIT_V(n) asm volatile("s_waitcnt vmcnt(" #n ")" ::: "memory")
#define PG8_WAIT_L(n) asm volatile("s_waitcnt lgkmcnt(" #n ")" ::: "memory")
#define PG8_BAR __builtin_amdgcn_s_barrier()
#define PG8_SCHED __builtin_amdgcn_sched_barrier(0)
    Unit cur, nxt; int ui = 0;
    if (!P.next(0, cur)) return;
    f32x4 acc[2][2][4][2];
#pragma unroll
    for (int a = 0; a < 2; ++a)
#pragma unroll
        for (int b = 0; b < 2; ++b)
#pragma unroll
            for (int m = 0; m < 4; ++m)
#pragma unroll
                for (int n = 0; n < 2; ++n) acc[a][b][m][n] = (f32x4){0.f, 0.f, 0.f, 0.f};
    bf16x8 At[4][2], B0[2][2], B1[2][2];
    unsigned vAc[2][2], vAn[2][2];
    if constexpr (Pol::GATHER) { P.rows_issue(cur, R0, vAc); P.rows_finish(C0, K, vAc); }
    else { vAc[0][0] = (unsigned)(R0 * K + C0) * 2u; vAc[0][1] = vAc[1][0] = vAc[1][1] = 0u; }
    asm volatile("s_waitcnt vmcnt(0)" ::: "memory");
    PG8_STAGE_B(PG8_SB(0, 0), cur.B0); PG8_STAGE_B(PG8_SB(0, 1), cur.B1); PG8_STAGE_A(PG8_SA(0, 0), cur.A, vAc, 0); PG8_STAGE_A(PG8_SA(0, 1), cur.A, vAc, 1);
    if (wr == 1) PG8_BAR;
    PG8_WAIT_V(2); PG8_BAR;
    PG8_STAGE_B(PG8_SB(1, 0), cur.B0 + kstep); PG8_STAGE_A(PG8_SA(1, 0), cur.A + kstep, vAc, 0); PG8_STAGE_B(PG8_SB(1, 1), cur.B1 + kstep);
    PG8_WAIT_V(6); PG8_BAR;
    for (;;) {
        const bool has_next = P.next(ui + 1, nxt);
        if (!has_next) nxt = cur;
        for (int t = 0; t < nt; t += 2) {
            const bool last = (t == nt - 2);
            if constexpr (Pol::GATHER) {
                if (t == nt - 4) { if (has_next) P.rows_issue(nxt, R0, vAn); }
                if (last && has_next) { vAc[0][0] = (vAn[0][0] * (unsigned)K + (unsigned)C0) * 2u; vAc[0][1] = (vAn[0][1] * (unsigned)K + (unsigned)C0) * 2u; }
            }
            const char* a1 = cur.A + (size_t)(t + 1) * kstep;
            const char* a2 = last ? nxt.A : cur.A + (size_t)(t + 2) * kstep;
            const char* b20 = last ? nxt.B0 : cur.B0 + (size_t)(t + 2) * kstep; const char* b21 = last ? nxt.B1 : cur.B1 + (size_t)(t + 2) * kstep;
            const char* a3 = a2 + kstep; const char* b30 = b20 + kstep; const char* b31 = b21 + kstep;
            PG8_LDB(B0, 0, 0); PG8_LDB(B1, 0, 1); PG8_SCHED; PG8_LDA(At, 0, 0); PG8_STAGE_A(PG8_SA(1, 1), a1, vAc, 1);
            if constexpr (Pol::GATHER) { if (last && has_next) { vAc[1][0] = (vAn[1][0] * (unsigned)K + (unsigned)C0) * 2u; vAc[1][1] = (vAn[1][1] * (unsigned)K + (unsigned)C0) * 2u; } }
            PG8_WAIT_V(8); PG8_WAIT_L(0); PG8_BAR; PG8_MMA(0, 0, At, B0); PG8_MMA(0, 1, At, B1); PG8_BAR; PG8_SCHED;
            PG8_LDA(At, 0, 1); PG8_STAGE_B(PG8_SB(0, 0), b20); PG8_STAGE_B(PG8_SB(0, 1), b21); PG8_STAGE_A(PG8_SA(0, 0), a2, vAc, 0);
            PG8_WAIT_V(8); PG8_WAIT_L(0); PG8_BAR; PG8_MMA(1, 0, At, B0); PG8_MMA(1, 1, At, B1); PG8_BAR; PG8_SCHED;
            PG8_LDB(B0, 1, 0); PG8_LDB(B1, 1, 1); PG8_SCHED; PG8_LDA(At, 1, 0); PG8_STAGE_A(PG8_SA(0, 1), a2, vAc, 1);
            PG8_WAIT_V(8); PG8_WAIT_L(0); PG8_BAR; PG8_MMA(0, 0, At, B0); PG8_MMA(0, 1, At, B1); PG8_BAR; PG8_SCHED;
            PG8_LDA(At, 1, 1); PG8_STAGE_B(PG8_SB(1, 0), b30); PG8_STAGE_B(PG8_SB(1, 1), b31); PG8_STAGE_A(PG8_SA(1, 0), a3, vAc, 0);
            PG8_WAIT_V(8); PG8_WAIT_L(0); PG8_BAR; PG8_MMA(1, 0, At, B0); PG8_MMA(1, 1, At, B1); PG8_BAR; PG8_SCHED;
        }
        if (wr == 0) PG8_BAR;
        P.epi(acc, cur, wr, wc, fr, fq);
        if (!has_next) break;
#pragma unroll
        for (int a = 0; a < 2; ++a)
#pragma unroll
            for (int b = 0; b < 2; ++b)
#pragma unroll
                for (int m = 0; m < 4; ++m)
#pragma unroll
                    for (int n = 0; n < 2; ++n) acc[a][b][m][n] = (f32x4){0.f, 0.f, 0.f, 0.f};
        cur = nxt; ++ui;
        if (wr == 1) PG8_BAR;
    }
    PG8_WAIT_V(0);
    PG8_BAR;
#undef PG8_SA
#undef PG8_SB
#undef PG8_STAGE_A
#undef PG8_STAGE_B
#undef PG8_LDA
#undef PG8_LDB
#undef PG8_MMA
#undef PG8_WAIT_V
#undef PG8_WAIT_L
#undef PG8_BAR
#undef PG8_SCHED
}
}

struct PolP1 {
    static constexpr bool PERM = true, GATHER = false;
    const bf16_t* A; const bf16_t* Bt; bf16_t* PR; bf16_t* PA; int G, c;
    __device__ __forceinline__ bool next(int i, pg8::Unit& u) const { int pm, pn; if (!pg8::static_order(T / 256, IN_WP / 256, G, c, i, pm, pn)) return false;
        u.A = (const char*)(A + (size_t)pm * 256 * D); u.B0 = (const char*)(Bt + (size_t)pn * 256 * D); u.B1 = u.B0 + (size_t)128 * D * 2; u.x0 = pm; u.x1 = pn; u.x2 = 0; u.x3 = 0; u.x4 = 0; return true; }
    __device__ __forceinline__ void epi(const f32x4 (&acc)[2][2][4][2], const pg8::Unit& u, int wr, int wc, int fr, int fq) const {
        const int row0 = u.x0 * 256 + wr * 64 + fr;
#pragma unroll
        for (int bj = 0; bj < 2; ++bj) { const int col = u.x1 * 256 + bj * 128 + wc * 32 + 8 * fq;
            bf16_t* base; int pitch; float sc = 1.f;
            if (col < RWKV_IN) { base = PR + col; pitch = RWKV_IN; }
            else { const int ca = col - RWKV_IN; base = PA + ca; pitch = PA_W; sc = (ca < AW || (ca >= 3 * AW && ca < 3 * AW + MW)) ? 0.125f : 1.f; }
#pragma unroll
            for (int ai = 0; ai < 2; ++ai)
#pragma unroll
                for (int m = 0; m < 4; ++m) { const f32x4 v0 = acc[ai][bj][m][0] * sc, v1 = acc[ai][bj][m][1] * sc;
                    u32x4 w; w.x = pg8::cvt_pk_bf16(v0[0], v0[1]); w.y = pg8::cvt_pk_bf16(v0[2], v0[3]); w.z = pg8::cvt_pk_bf16(v1[0], v1[1]); w.w = pg8::cvt_pk_bf16(v1[2], v1[3]);
                    *(u32x4*)(base + (size_t)(row0 + ai * 128 + m * 16) * pitch) = w; } }
    }
};
__device__ __forceinline__ void phase1(const Params& p, LAS unsigned char* lds) {
    unsigned char* ws = p.ws;
    { PolP1 P{(const bf16_t*)(ws + WS_H0B), (const bf16_t*)(ws + WS_WT_IN), (bf16_t*)(ws + WS_PR), (bf16_t*)(ws + WS_PA), (int)gridDim.x, (int)blockIdx.x};
      pg8::gemm_phase(lds, P, D); }
    constexpr int U_KV = (BATCH * NMEM / 128) * (2 * MW / 128);
    for (int u = blockIdx.x; u < U_KV; u += gridDim.x) {
        const int pn = u % 4, pm = u / 4, r0 = pm * 128, c0 = pn * 128;
        const bf16_t* MB = (const bf16_t*)(ws + WS_MEMB); const bf16_t* WK = (const bf16_t*)(ws + WS_WT_KV); bf16_t* KVM = (bf16_t*)(ws + WS_KVM);
        sgemm_tile(D, [&](int r) { return MB + (size_t)(r0 + r) * D; }, [&](int c) { return WK + (size_t)(c0 + c) * D; },
            [&](int r, int c, f32x4 v, int) { u32x2 o; o.x = pk2(v.x, v.y); o.y = pk2(v.z, v.w); *(u32x2*)(KVM + (size_t)(r0 + r) * (2 * MW) + c0 + c) = o; });
    }
}

constexpr int P2_AP = 200;
__device__ __forceinline__ f32x4 p2_shift(const bf16_t* cur, int po, int no, float pm, float nm, const float* mu) {
    const u32x2 c = *(const u32x2*)cur, pv = *(const u32x2*)(cur + po), nv = *(const u32x2*)(cur + no);
    const f32x4 m = *(const f32x4*)mu;
    const f32x4 cc = {bflo(c.x), bfhi(c.x), bflo(c.y), bfhi(c.y)}, pp = {bflo(pv.x), bfhi(pv.x), bflo(pv.y), bfhi(pv.y)}, nn = {bflo(nv.x), bfhi(nv.x), bflo(nv.y), bfhi(nv.y)};
    return cc + m * (0.5f * (pp * pm + nn * nm) - cc);
}
__device__ __forceinline__ void phase2(const Params& p, LAS unsigned char* lds) {
    const int tid = threadIdx.x, lane = tid & 63, wave = tid >> 6, fr = lane & 15, fq = lane >> 4;
    unsigned char* ws = p.ws;
    const bf16_t* PR = (const bf16_t*)(ws + WS_PR);
    const float* mu = p.in[5];
    const bf16_t* WU = (const bf16_t*)(ws + WS_LORA); const bf16_t* AU = WU + 2 * RC * 32; const bf16_t* GU = AU + 2 * RC * 32;
    LAS bf16_t* ACT = (LAS bf16_t*)(lds + wave * (16 * P2_AP * 2));
    float* SSH = (float*)(ws + WS_SSH); float* SDIR = (float*)(ws + WS_SDIR);
    bf16_t* G = (bf16_t*)((unsigned char*)p.out + DO_G); float* BON = (float*)(ws + WS_BONUS);
    for (int tile = blockIdx.x * NWAVES + wave; tile < T / 16; tile += gridDim.x * NWAVES) {
        const int t0 = tile * 16;
#pragma unroll 4
        for (int i = 0; i < 12; ++i) { const int grp = lane + 64 * i, tok = grp / 48, c4 = (grp % 48) * 4, t = t0 + tok, sq = t & (SEQ - 1);
            f32x4 v = p2_shift(PR + (size_t)t * RWKV_IN + 3 * RC + c4, sq > 0 ? -RWKV_IN : 0, sq < SEQ - 1 ? RWKV_IN : 0, sq > 0 ? 1.f : 0.f, sq < SEQ - 1 ? 1.f : 0.f, mu + 3 * RC + c4);
            { const float sc = c4 < 64 ? 1.f : 2.f, mul = c4 < 64 ? 1.f : 2.f, add = c4 < 64 ? 0.f : -1.f; const bool raw = c4 >= 128;
#pragma unroll
              for (int e = 0; e < 4; ++e) { const float a = sigmoidf_(sc * v[e]) * mul + add; v[e] = raw ? v[e] : a; } }
            u32x2 o; o.x = pk2(v.x, v.y); o.y = pk2(v.z, v.w); *(LAS u32x2*)(ACT + tok * P2_AP + c4) = o; }
        asm volatile("s_waitcnt lgkmcnt(0)" ::: "memory");
        const int t = t0 + fr, sq = t & (SEQ - 1), b = t >> 11; const int po = sq > 0 ? -RWKV_IN : 0, no = sq < SEQ - 1 ? RWKV_IN : 0; const float pm = sq > 0 ? 1.f : 0.f, nm = sq < SEQ - 1 ? 1.f : 0.f;
        const bf16_t* prow = PR + (size_t)t * RWKV_IN;
        const bf16x8 bsg0 = *(const LAS bf16x8*)(ACT + fr * P2_AP + 8 * fq), bsg1 = *(const LAS bf16x8*)(ACT + fr * P2_AP + 32 + 8 * fq);
        const bf16x8 btw0 = *(const LAS bf16x8*)(ACT + fr * P2_AP + 64 + 8 * fq), btw1 = *(const LAS bf16x8*)(ACT + fr * P2_AP + 96 + 8 * fq);
        const bf16x8 bal0 = *(const LAS bf16x8*)(ACT + fr * P2_AP + 128 + 8 * fq), bal1 = *(const LAS bf16x8*)(ACT + fr * P2_AP + 160 + 8 * fq);
#pragma unroll 1
        for (int h = 0; h < RH; ++h) {
            f32x4 kp[4]; float ss = 0.f;
#pragma unroll
            for (int ct = 0; ct < 4; ++ct) { const int ch = h * 64 + 16 * ct + 4 * fq; kp[ct] = p2_shift(prow + RC + ch, po, no, pm, nm, mu + RC + ch);
                const f32x4 kkv = kp[ct] * *(const f32x4*)(p.in[11] + ch); ss += (kkv.x * kkv.x + kkv.y * kkv.y) + (kkv.z * kkv.z + kkv.w * kkv.w); }
            ss += __shfl_xor(ss, 16); ss += __shfl_xor(ss, 32);
            const float rn = 1.f / fmaxf(sqrtf(ss), 1e-12f);
            float bon = 0.f;
            unsigned char* shrec = (unsigned char*)SSH + ((size_t)(b * RH + h) * SEQ + sq) * 384;
            unsigned char* d0rec = (unsigned char*)SDIR + ((size_t)((0 * BATCH + b) * RH + h) * SEQ + sq) * 512; unsigned char* d1rec = (unsigned char*)SDIR + ((size_t)((1 * BATCH + b) * RH + h) * SEQ + sq) * 512;
#pragma unroll
            for (int ct = 0; ct < 4; ++ct) { const int ch = h * 64 + 16 * ct + 4 * fq, cl = 16 * ct + 4 * fq;
                const f32x4 r = p2_shift(prow + ch, po, no, pm, nm, mu + ch), v = p2_shift(prow + 2 * RC + ch, po, no, pm, nm, mu + 2 * RC + ch), k = kp[ct];
                const bf16_t* wrow = WU + (size_t)(h * 64 + 16 * ct + fr) * 32 + 8 * fq; const bf16_t* arow = AU + (size_t)(h * 64 + 16 * ct + fr) * 32 + 8 * fq;
                const bf16_t* grow = GU + (size_t)(h * 64 + 16 * ct + fr) * 64 + 8 * fq;
                const f32x4 z = {0.f, 0.f, 0.f, 0.f};
                const f32x4 wl0 = __builtin_amdgcn_mfma_f32_16x16x32_bf16(*(const bf16x8*)wrow, btw0, z, 0, 0, 0);
                const f32x4 wl1 = __builtin_amdgcn_mfma_f32_16x16x32_bf16(*(const bf16x8*)(wrow + RC * 32), btw1, z, 0, 0, 0);
                const f32x4 al0 = __builtin_amdgcn_mfma_f32_16x16x32_bf16(*(const bf16x8*)arow, bal0, z, 0, 0, 0);
                const f32x4 al1 = __builtin_amdgcn_mfma_f32_16x16x32_bf16(*(const bf16x8*)(arow + RC * 32), bal1, z, 0, 0, 0);
                f32x4 gg = __builtin_amdgcn_mfma_f32_16x16x32_bf16(*(const bf16x8*)grow, bsg0, z, 0, 0, 0);
                gg = __builtin_amdgcn_mfma_f32_16x16x32_bf16(*(const bf16x8*)(grow + 32), bsg1, gg, 0, 0, 0);
                const f32x4 w00 = *(const f32x4*)(p.in[6] + ch), w01 = *(const f32x4*)(p.in[6] + RC + ch), a00 = *(const f32x4*)(p.in[8] + ch), a01 = *(const f32x4*)(p.in[8] + RC + ch);
                const f32x4 kkw = *(const f32x4*)(p.in[11] + ch), kaw = *(const f32x4*)(p.in[12] + ch), rkw = *(const f32x4*)(p.in[13] + ch);
                f32x4 dec0, dec1, kd0, kd1, bb0, bb1, kkn;
#pragma unroll
                for (int e = 0; e < 4; ++e) {
                    dec0[e] = __expf(-0.6065306597126334f * sigmoidf_(w00[e] + wl0[e])); dec1[e] = __expf(-0.6065306597126334f * sigmoidf_(w01[e] + wl1[e]));
                    const float a0 = sigmoidf_(a00[e] + al0[e]), a1 = sigmoidf_(a01[e] + al1[e]);
                    kkn[e] = k[e] * kkw[e] * rn; kd0[e] = k[e] * (1.f + (a0 - 1.f) * kaw[e]); kd1[e] = k[e] * (1.f + (a1 - 1.f) * kaw[e]);
                    bb0[e] = kkn[e] * a0; bb1[e] = kkn[e] * a1; bon += r[e] * (kd0[e] + kd1[e]) * rkw[e]; }
                { u32x2 o; o.x = pk2(r.x, r.y); o.y = pk2(r.z, r.w); *(u32x2*)(shrec + cl * 2) = o; o.x = pk2(v.x, v.y); o.y = pk2(v.z, v.w); *(u32x2*)(shrec + 128 + cl * 2) = o;
                  o.x = pk2(kkn.x, kkn.y); o.y = pk2(kkn.z, kkn.w); *(u32x2*)(shrec + 256 + cl * 2) = o;
                  *(f32x4*)(d0rec + cl * 4) = dec0; o.x = pk2(kd0.x, kd0.y); o.y = pk2(kd0.z, kd0.w); *(u32x2*)(d0rec + 256 + cl * 2) = o; o.x = pk2(bb0.x, bb0.y); o.y = pk2(bb0.z, bb0.w); *(u32x2*)(d0rec + 384 + cl * 2) = o;
                  *(f32x4*)(d1rec + cl * 4) = dec1; o.x = pk2(kd1.x, kd1.y); o.y = pk2(kd1.z, kd1.w); *(u32x2*)(d1rec + 256 + cl * 2) = o; o.x = pk2(bb1.x, bb1.y); o.y = pk2(bb1.z, bb1.w); *(u32x2*)(d1rec + 384 + cl * 2) = o; }
                u32x2 go; go.x = pk2(gg.x, gg.y); go.y = pk2(gg.z, gg.w); *(u32x2*)(G + (size_t)t * RC + ch) = go;
            }
            bon += __shfl_xor(bon, 16); bon += __shfl_xor(bon, 32);
            if (fq == 0) BON[t * RH + h] = bon;
        }
    }
}

constexpr int SC_TC = 16;
constexpr int SC_STEPB = 1408;
constexpr int SC_BUFB = SC_TC * SC_STEPB;
struct ScanProd { const unsigned char* gsrc; long gstep; int ldst; int conv; };
__device__ __forceinline__ ScanProd scan_prod_init(const unsigned char* sh, const unsigned char* dr, int dir, int ptid) {
    ScanProd P; const int wi = ptid % 56, st0 = ptid / 56; const unsigned char* src; int shift = 0; bool fromsh = false;
    if (wi < 16) { src = dr + wi * 16; P.ldst = wi * 16; P.conv = 0; }
    else if (wi < 24) { src = dr + 256 + (wi - 16) * 16; P.ldst = 512 + (wi - 16) * 32; P.conv = 1; }
    else if (wi < 32) { src = dr + 384 + (wi - 24) * 16; P.ldst = 256 + (wi - 24) * 32; P.conv = 1; }
    else if (wi < 40) { src = sh + 128 + (wi - 32) * 16; P.ldst = 768 + (wi - 32) * 32; P.conv = 1; fromsh = true; }
    else if (wi < 48) { src = sh + 256 + (wi - 40) * 16; P.ldst = 1024 + (wi - 40) * 16; P.conv = 0; fromsh = true; }
    else { src = sh + (wi - 48) * 16; P.ldst = 1152 + (wi - 48) * 16; P.conv = 0; shift = 1; fromsh = true; }
    const long rec = fromsh ? 384 : 512;
    const long t0 = dir ? (long)(SEQ - 1 - (st0 - shift)) : (long)(st0 - shift);
    P.gsrc = src + t0 * rec; P.gstep = dir ? -rec : rec; P.ldst += st0 * SC_STEPB; return P;
}
__device__ __forceinline__ void scan_fetch(const ScanProd& P, int c, u32x4 (&reg)[SC_TC / 4]) {
    const unsigned char* g = P.gsrc + (long)(c * SC_TC) * P.gstep;
#pragma unroll
    for (int q = 0; q < SC_TC / 4; ++q) reg[q] = *(const u32x4*)(g + (long)(4 * q) * P.gstep);
}
__device__ __forceinline__ void scan_put(const ScanProd& P, LAS unsigned char* buf, const u32x4 (&reg)[SC_TC / 4]) {
    LAS unsigned char* d = buf + P.ldst;
    if (P.conv) {
#pragma unroll
        for (int q = 0; q < SC_TC / 4; ++q) { const u32x4 x = reg[q];
            *(LAS f32x4*)(d + 4 * q * SC_STEPB) = (f32x4){bflo(x.x), bfhi(x.x), bflo(x.y), bfhi(x.y)}; *(LAS f32x4*)(d + 4 * q * SC_STEPB + 16) = (f32x4){bflo(x.z), bfhi(x.z), bflo(x.w), bfhi(x.w)}; }
    } else {
#pragma unroll
        for (int q = 0; q < SC_TC / 4; ++q) *(LAS u32x4*)(d + 4 * q * SC_STEPB) = reg[q];
    }
}
__device__ __forceinline__ void scan_block(const Params& p, LAS unsigned char* lds, int sid) {
    const int tid = threadIdx.x, lane = tid & 63, wave = tid >> 6;
    const int dir = sid / (BATCH * RH), bh = sid % (BATCH * RH), b = bh / RH, h = bh % RH;
    const unsigned char* sh = p.ws + WS_SSH + (size_t)bh * SEQ * 384;
    const unsigned char* dr = p.ws + WS_SDIR + (size_t)(dir * BATCH * RH + bh) * SEQ * 512;
    float* Y = (float*)((unsigned char*)p.out + DO_Y) + (size_t)dir * T * RC;
    LAS unsigned char* buf0 = lds; LAS unsigned char* buf1 = lds + SC_BUFB;
    constexpr int NCH = SEQ / SC_TC;
    __syncthreads();
    for (int i = tid; i < 2 * SC_TC * 32; i += NTHR) { const int st = i >> 5, e = i & 31; *(LAS unsigned*)(lds + st * SC_STEPB + 1280 + e * 4) = 0u; }
    const ScanProd SP = scan_prod_init(sh, dr, dir, (tid - 256) & 255);
    const bool prod = wave >= 4 && tid - 256 < 224;
    u32x4 preg[SC_TC / 4];
    if (prod) { scan_fetch(SP, 0, preg); scan_put(SP, buf0, preg); scan_fetch(SP, 1, preg); }
    __syncthreads();
    const int fr = lane & 15, fq = lane >> 4, sel = (fr & 3) < 2 ? (fr & 3) : 2;
    float s[16];
#pragma unroll
    for (int j = 0; j < 16; ++j) s[j] = 0.f;
    bf16x8 sb0 = (bf16x8){0, 0, 0, 0, 0, 0, 0, 0}, sb1 = sb0;
    float* yrow = Y + (size_t)b * SEQ * RC + h * 64 + 16 * wave + fr;
    float yk = 0.f;
    for (int c = 0; c < NCH; ++c) {
        LAS unsigned char* cur = (c & 1) ? buf1 : buf0; LAS unsigned char* nxt = (c & 1) ? buf0 : buf1;
        if (wave >= 4) {
            if (prod && c + 1 < NCH) { scan_put(SP, nxt, preg); if (c + 2 < NCH) scan_fetch(SP, c + 2, preg); }
        } else {
            const LAS unsigned char* cb = cur + fq * 32;
            const LAS unsigned char* ab = cur + 1024 + 128 * sel + fq * 16;
            const LAS unsigned char* vb = cur + 768 + (16 * wave + fr) * 4;
            bf16x8 cA0, cA1, nA0, nA1; f32x4 cW[4], cK[4], cB[4], nW[4], nK[4], nB[4]; float cV, nV;
#define SC_LOAD(A0, A1, W, K, B, V, st) do { const LAS unsigned char* q_ = cb + (st) * SC_STEPB; \
                A0 = *(const LAS bf16x8*)(ab + (st) * SC_STEPB); A1 = *(const LAS bf16x8*)(ab + (st) * SC_STEPB + 64); \
                W[0] = *(const LAS f32x4*)(q_); W[1] = *(const LAS f32x4*)(q_ + 16); W[2] = *(const LAS f32x4*)(q_ + 128); W[3] = *(const LAS f32x4*)(q_ + 144); \
                K[0] = *(const LAS f32x4*)(q_ + 512); K[1] = *(const LAS f32x4*)(q_ + 528); K[2] = *(const LAS f32x4*)(q_ + 640); K[3] = *(const LAS f32x4*)(q_ + 656); \
                B[0] = *(const LAS f32x4*)(q_ + 256); B[1] = *(const LAS f32x4*)(q_ + 272); B[2] = *(const LAS f32x4*)(q_ + 384); B[3] = *(const LAS f32x4*)(q_ + 400); \
                V = *(const LAS float*)(vb + (st) * SC_STEPB); } while (0)
            SC_LOAD(cA0, cA1, cW, cK, cB, cV, 0);
#pragma unroll 1
            for (int g = 0; g < SC_TC / 4; ++g) {
#pragma unroll
                for (int u = 0; u < 4; ++u) {
                    const int st = 4 * g + u;
                    f32x4 d = (f32x4){0.f, 0.f, 0.f, 0.f};
                    d = __builtin_amdgcn_mfma_f32_16x16x32_bf16(cA0, sb0, d, 0, 0, 0);
                    d = __builtin_amdgcn_mfma_f32_16x16x32_bf16(cA1, sb1, d, 0, 0, 0);
                    if (st + 1 < SC_TC) SC_LOAD(nA0, nA1, nW, nK, nB, nV, st + 1);
#define OPQ(x) asm("" : "+v"(x))
                    float tt[16];
#pragma unroll
                    for (int j = 0; j < 16; ++j) { tt[j] = cV * cK[j >> 2][j & 3]; OPQ(tt[j]); }
#pragma unroll
                    for (int j = 0; j < 16; ++j) { tt[j] = s[j] * cW[j >> 2][j & 3] + tt[j]; OPQ(tt[j]); }
                    const float nsa = -d[0];
                    yk = (((u + 3) & 3) == fq) ? d[1] : yk;
                    if (u == 0) {
                        const int tau = c * SC_TC + 4 * g - 4 + fq;
                        if (tau >= 0) { const int t = dir ? (SEQ - 1 - tau) : tau; yrow[(size_t)t * RC] = yk; } }
#pragma unroll
                    for (int j = 0; j < 16; ++j) { s[j] = nsa * cB[j >> 2][j & 3] + tt[j]; OPQ(s[j]); }
#undef OPQ
                    u32x4 p0, p1;
                    p0.x = pg8::cvt_pk_bf16(s[0], s[1]); p0.y = pg8::cvt_pk_bf16(s[2], s[3]); p0.z = pg8::cvt_pk_bf16(s[4], s[5]); p0.w = pg8::cvt_pk_bf16(s[6], s[7]);
                    p1.x = pg8::cvt_pk_bf16(s[8], s[9]); p1.y = pg8::cvt_pk_bf16(s[10], s[11]); p1.z = pg8::cvt_pk_bf16(s[12], s[13]); p1.w = pg8::cvt_pk_bf16(s[14], s[15]);
                    sb0 = __builtin_bit_cast(bf16x8, p0); sb1 = __builtin_bit_cast(bf16x8, p1);
                    cA0 = nA0; cA1 = nA1; cV = nV;
#pragma unroll
                    for (int i = 0; i < 4; ++i) { cW[i] = nW[i]; cK[i] = nK[i]; cB[i] = nB[i]; }
                    asm volatile("" ::: "memory");
                }
            }
#undef SC_LOAD
        }
        __syncthreads();
    }
    if (wave < 4) {
        if (fq < 3) { const int tau = SEQ - 4 + fq, t = dir ? (SEQ - 1 - tau) : tau; yrow[(size_t)t * RC] = yk; }
        const int t = dir ? 0 : (SEQ - 1); const bf16_t* rr = (const bf16_t*)(sh + (size_t)t * 384);
        float acc = 0.f;
#pragma unroll
        for (int j = 0; j < 8; ++j) { acc += bf2f((unsigned)(unsigned short)sb0[j]) * bf2f(rr[8 * fq + j]); acc += bf2f((unsigned)(unsigned short)sb1[j]) * bf2f(rr[32 + 8 * fq + j]); }
        acc += __shfl_xor(acc, 16); acc += __shfl_xor(acc, 32);
        if (fq == 0) yrow[(size_t)t * RC] = acc;
    }
    __syncthreads();
}

constexpr int AT_P = 72;
constexpr int AT_KOFF = 0, AT_VOFF = 256 * AT_P * 2;
constexpr int ATT_DIL_UNITS = BATCH * AH * 48;
constexpr int ATT_MEM_UNITS = BATCH * MH * 16;
constexpr int ATT_UNITS = ATT_DIL_UNITS + ATT_MEM_UNITS;
struct AttU { const bf16_t* q; const bf16_t* k; const bf16_t* v; long qs, ks; int kind, win0, L, dil; float slope; bf16_t* o; long os; float* lse; long ls; };
__device__ __forceinline__ void att_make_unit(const Params& p, int u, AttU& U) {
    unsigned char* ws = p.ws; const bf16_t* PA = (const bf16_t*)(ws + WS_PA);
    if (u < ATT_DIL_UNITS) {
        const int bh = u / 48, x = u % 48, b = bh / AH, h = bh % AH, br = x >> 4, y = x & 15;
        const int dil = br == 0 ? 1 : (br == 1 ? 4 : 16), L = SEQ / dil, npr = L / 128, r = y / npr, np = y % npr;
        const bf16_t* base = PA + (size_t)(b * SEQ + r) * PA_W + h * 64;
        U.kind = 0; U.win0 = (2 * np - 1) * 64; U.L = L; U.dil = dil; U.slope = exp2f(-8.f * (float)(h + 1) / (float)AH);
        U.qs = (long)dil * PA_W; U.ks = U.qs;
        U.q = base + (long)(np * 128) * U.qs; U.k = base + AW; U.v = base + 2 * AW;
        const size_t tok0 = (size_t)(b * SEQ + r) + (size_t)np * 128 * dil;
        U.o = (bf16_t*)(ws + WS_ATTO) + (size_t)br * T * AW + tok0 * AW + h * 64; U.os = (long)dil * AW;
        U.lse = (float*)((unsigned char*)p.out + DO_LSE) + (size_t)br * T * AH + tok0 * AH + h; U.ls = (long)dil * AH;
    } else {
        const int v = u - ATT_DIL_UNITS, bh = v >> 4, qb = v & 15, b = bh / MH, h = bh % MH;
        const bf16_t* KVM = (const bf16_t*)(ws + WS_KVM);
        U.kind = 1; U.win0 = 0; U.L = NMEM; U.dil = 1; U.slope = 0.f;
        U.q = PA + (size_t)(b * SEQ + qb * 128) * PA_W + 3 * AW + h * 64; U.qs = PA_W;
        U.k = KVM + (size_t)(b * NMEM) * (2 * MW) + h * 64; U.v = U.k + MW; U.ks = 2 * MW;
        U.o = (bf16_t*)(ws + WS_YMIX) + (size_t)(b * SEQ + qb * 128) * D + RC + AW + h * 64; U.os = D;
        U.lse = nullptr; U.ls = 0;
    }
}
__device__ __forceinline__ void att_fetch(const AttU& U, u32x4 (&reg)[8], int tid) {
#pragma unroll
    for (int q = 0; q < 8; ++q) { const int rem = (tid + NTHR * q) & 2047, row = rem >> 3, ch = rem & 7; const int lk = U.win0 + row; const bool ok = lk >= 0 && lk < U.L;
        const bf16_t* src = (q < 4 ? U.k : U.v) + (long)(ok ? lk : 0) * U.ks + ch * 8;
        u32x4 raw = *(const u32x4*)src; if (!ok) raw = (u32x4){0u, 0u, 0u, 0u}; reg[q] = raw; }
}
__device__ __forceinline__ void att_put(LAS unsigned char* lds, const u32x4 (&reg)[8], int tid) {
#pragma unroll
    for (int q = 0; q < 8; ++q) { const int rem = (tid + NTHR * q) & 2047, row = rem >> 3, ch = rem & 7;
        *(LAS u32x4*)(lds + (q < 4 ? AT_KOFF : AT_VOFF) + row * (AT_P * 2) + ch * 16) = reg[q]; }
}
typedef short v4i16_t __attribute__((ext_vector_type(4)));
template <int NT  , bool DIL>
__device__ __forceinline__ void att_compute(const AttU& U, LAS unsigned char* lds, int w, int lane) {
    const int fr = lane & 15, fq = lane >> 4;
    const bf16_t* qp = U.q + (long)(16 * w + fr) * U.qs + fq * 8;
    const bf16x8 q0 = *(const bf16x8*)qp, q1 = *(const bf16x8*)(qp + 32);
    f32x4 sT[NT];
#pragma unroll
    for (int i = 0; i < NT; ++i) {
        if (DIL && i == 9) { sT[i] = (f32x4){-1e30f, -1e30f, -1e30f, -1e30f}; continue; }
        int tt = DIL ? w + i : i; tt = tt > 15 ? 15 : tt;
        const LAS unsigned char* kp = lds + AT_KOFF + (16 * tt + fr) * (AT_P * 2) + fq * 16;
        const bf16x8 k0 = *(const LAS bf16x8*)kp, k1 = *(const LAS bf16x8*)(kp + 64);
        f32x4 a = (f32x4){0.f, 0.f, 0.f, 0.f};
        a = __builtin_amdgcn_mfma_f32_16x16x32_bf16(k0, q0, a, 0, 0, 0);
        a = __builtin_amdgcn_mfma_f32_16x16x32_bf16(k1, q1, a, 0, 0, 0);
        sT[i] = a; if ((i & 3) == 3) asm volatile("" ::: "memory"); }
    float m = -3.0e38f;
    if (DIL) {
        const int c0 = 4 * fq - fr, lb = U.win0 + 16 * w + 4 * fq; const float sd = U.slope * (float)U.dil; const unsigned Lc = (unsigned)U.L;
#pragma unroll
        for (int i = 0; i < NT; ++i) { if (i == 9) continue;
#pragma unroll
            for (int r = 0; r < 4; ++r) { const int dl = 16 * i + r - 64 + c0, ad = dl < 0 ? -dl : dl;
                bool valid = (unsigned)(lb + 16 * i + r) < Lc; if (i == 0 || i >= 7) valid = valid && ad <= 64;
                const float sv = valid ? sT[i][r] - sd * (float)ad : -1e30f; sT[i][r] = sv; m = fmaxf(m, sv); } }
    } else {
#pragma unroll
        for (int i = 0; i < NT; ++i)
#pragma unroll
            for (int r = 0; r < 4; ++r) m = fmaxf(m, sT[i][r]);
    }
    m = fmaxf(m, __shfl_xor(m, 16)); m = fmaxf(m, __shfl_xor(m, 32));
    float l = 0.f;
#pragma unroll
    for (int i = 0; i < NT; ++i)
#pragma unroll
        for (int r = 0; r < 4; ++r) { const float e = __expf(sT[i][r] - m); sT[i][r] = e; l += e; }
    l += __shfl_xor(l, 16); l += __shfl_xor(l, 32);
    f32x4 oT[4];
#pragma unroll
    for (int dt = 0; dt < 4; ++dt) oT[dt] = (f32x4){0.f, 0.f, 0.f, 0.f};
#pragma unroll
    for (int tp = 0; tp < NT / 2; ++tp) {
        int ta = DIL ? w + 2 * tp : 2 * tp, tb = ta + 1; ta = ta > 15 ? 15 : ta; tb = tb > 15 ? 15 : tb;
        u32x4 pw; pw.x = pk2(sT[2 * tp][0], sT[2 * tp][1]); pw.y = pk2(sT[2 * tp][2], sT[2 * tp][3]); pw.z = pk2(sT[2 * tp + 1][0], sT[2 * tp + 1][1]); pw.w = pk2(sT[2 * tp + 1][2], sT[2 * tp + 1][3]);
        const bf16x8 pb = __builtin_bit_cast(bf16x8, pw);
        const LAS unsigned char* va = lds + AT_VOFF + (16 * ta + 4 * fq + (fr >> 2)) * (AT_P * 2) + 8 * (fr & 3);
        const LAS unsigned char* vb = lds + AT_VOFF + (16 * tb + 4 * fq + (fr >> 2)) * (AT_P * 2) + 8 * (fr & 3);
#pragma unroll
        for (int dt = 0; dt < 4; ++dt) {
            const v4i16_t lo = __builtin_amdgcn_ds_read_tr16_b64_v4i16((LAS v4i16_t*)(va + 32 * dt)), hi = __builtin_amdgcn_ds_read_tr16_b64_v4i16((LAS v4i16_t*)(vb + 32 * dt));
            bf16x8 vf; vf[0] = lo[0]; vf[1] = lo[1]; vf[2] = lo[2]; vf[3] = lo[3]; vf[4] = hi[0]; vf[5] = hi[1]; vf[6] = hi[2]; vf[7] = hi[3];
            oT[dt] = __builtin_amdgcn_mfma_f32_16x16x32_bf16(vf, pb, oT[dt], 0, 0, 0); }
        if (tp & 1) asm volatile("" ::: "memory");
    }
    const float inv = 1.f / l;
    bf16_t* op = U.o + (long)(16 * w + fr) * U.os;
#pragma unroll
    for (int dt = 0; dt < 4; ++dt) { u32x2 o; o.x = pk2(oT[dt][0] * inv, oT[dt][1] * inv); o.y = pk2(oT[dt][2] * inv, oT[dt][3] * inv); *(u32x2*)(op + 16 * dt + 4 * fq) = o; }
    if (DIL && fq == 0) U.lse[(long)(16 * w + fr) * U.ls] = m + __logf(l);
}
__device__ __forceinline__ void phase3(const Params& p, LAS unsigned char* lds, int rep) {
    const int tid = threadIdx.x, lane = tid & 63, wave = tid >> 6;
    unsigned* ctl = (unsigned*)(p.ws + WS_CTL);
    LAS unsigned* bc = (LAS unsigned*)(lds + 98304);
    for (;;) {
        __syncthreads();
        if (tid == 0) bc[0] = atomicAdd(ctl + CW_SCANQ + 16 * rep, 1u);
        __syncthreads();
        const unsigned sid = __builtin_amdgcn_readfirstlane(bc[0]);
        if (sid >= 2u * BATCH * RH) break;
#pragma unroll 1
        for (int tw = 0; tw < (REPEAT_PHASE == 31 ? 2 : 1); ++tw) scan_block(p, lds, (int)sid);
    }
    constexpr unsigned ATT_BATCH = 2;
    for (;;) {
        __syncthreads();
        if (tid == 0) bc[1] = atomicAdd(ctl + CW_ATTQ + 16 * rep, ATT_BATCH);
        __syncthreads();
        const unsigned ubase = __builtin_amdgcn_readfirstlane(bc[1]);
        if (ubase >= (unsigned)ATT_UNITS) break;
        const unsigned uend = ubase + ATT_BATCH < (unsigned)ATT_UNITS ? ubase + ATT_BATCH : (unsigned)ATT_UNITS;
        { AttU U; att_make_unit(p, (int)ubase, U); u32x4 reg[8]; att_fetch(U, reg, tid); att_put(lds, reg, tid); }
#pragma unroll 1
        for (unsigned ucur = ubase; ucur < uend; ++ucur) {
            __syncthreads();
            u32x4 reg[8];
            if (ucur + 1 < uend) { AttU Un; att_make_unit(p, (int)ucur + 1, Un); att_fetch(Un, reg, tid); }
            { AttU U; att_make_unit(p, (int)ucur, U);
#pragma unroll 1
              for (int tw = 0; tw < (REPEAT_PHASE == 32 ? 2 : 1); ++tw) {
                if (ucur < (unsigned)ATT_DIL_UNITS) att_compute<10, true>(U, lds, wave, lane); else att_compute<16, false>(U, lds, wave, lane); } }
            __syncthreads();
            if (ucur + 1 < uend) att_put(lds, reg, tid);
        }
    }
}

__device__ __forceinline__ void phase4(const Params& p) {
    const int tid = threadIdx.x, lane = tid & 63, wave = tid >> 6;
    const int gw = blockIdx.x * NWAVES + wave, NGW = gridDim.x * NWAVES;
    unsigned char* ws = p.ws; const unsigned char* dob = (const unsigned char*)p.out;
    const float* Yf = (const float*)(dob + DO_Y); const float* Yb = Yf + (size_t)T * RC;
    const bf16_t* G = (const bf16_t*)(dob + DO_G); const float* LSE = (const float*)(dob + DO_LSE);
    const float* BON = (const float*)(ws + WS_BONUS); const float* SSH = (const float*)(ws + WS_SSH);
    const bf16_t* AO = (const bf16_t*)(ws + WS_ATTO); bf16_t* YM = (bf16_t*)(ws + WS_YMIX);
    for (int t = gw; t < T; t += NGW) {
        const int b = t >> 11, s = t & (SEQ - 1);
        float yf[RH], yb[RH], vv[RH], bo[RH]; unsigned short gg[RH], a0[AH], a1[AH], a2[AH]; float l0[AH], l1[AH], l2[AH];
#pragma unroll
        for (int h = 0; h < RH; ++h) { const int ch = h * 64 + lane;
            yf[h] = Yf[(size_t)t * RC + ch]; yb[h] = Yb[(size_t)t * RC + ch]; gg[h] = G[(size_t)t * RC + ch];
            vv[h] = bf2f(((const bf16_t*)SSH)[((size_t)(b * RH + h) * SEQ + s) * 192 + 64 + lane]); bo[h] = BON[t * RH + h];
            a0[h] = AO[(size_t)t * AW + ch]; a1[h] = AO[(size_t)T * AW + (size_t)t * AW + ch]; a2[h] = AO[(size_t)2 * T * AW + (size_t)t * AW + ch];
            l0[h] = LSE[(size_t)t * AH + h]; l1[h] = LSE[(size_t)T * AH + (size_t)t * AH + h]; l2[h] = LSE[(size_t)2 * T * AH + (size_t)t * AH + h]; }
#pragma unroll
        for (int h = 0; h < RH; ++h) { const int ch = h * 64 + lane;
            const float y = yf[h] + yb[h];
            const float mean = wave_sum(y) * (1.f / 64.f); const float dlt = y - mean; const float var = wave_sum(dlt * dlt) * (1.f / 64.f);
            const float yn = dlt * (1.f / sqrtf(var + GN_EPS)) * p.in[14][ch] + p.in[15][ch];
            const float o = (yn + bo[h] * vv[h]) * bf2f(gg[h]);
            YM[(size_t)t * D + ch] = (bf16_t)f2bf(o); }
#pragma unroll
        for (int h = 0; h < AH; ++h) { const int ch = h * 64 + lane;
            const float mx = fmaxf(l0[h], fmaxf(l1[h], l2[h])); const float e0 = __expf(l0[h] - mx), e1 = __expf(l1[h] - mx), e2 = __expf(l2[h] - mx); const float inv = 1.f / (e0 + e1 + e2);
            const float o = (e0 * bf2f(a0[h]) + e1 * bf2f(a1[h]) + e2 * bf2f(a2[h])) * inv;
            YM[(size_t)t * D + RC + ch] = (bf16_t)f2bf(o); }
    }
}

struct PolP5 {
    static constexpr bool PERM = false, GATHER = false;
    const bf16_t* A; const bf16_t* Bt; const bf16_t* H0B; float* PRE; int G, c;
    __device__ __forceinline__ bool next(int i, pg8::Unit& u) const { int pm, pn; if (!pg8::static_order(T / 256, D / 256, G, c, i, pm, pn)) return false;
        u.A = (const char*)(A + (size_t)pm * 256 * D); u.B0 = (const char*)(Bt + (size_t)pn * 256 * D); u.B1 = u.B0 + (size_t)128 * D * 2; u.x0 = pm; u.x1 = pn; u.x2 = 0; u.x3 = 0; u.x4 = 0; return true; }
    __device__ __forceinline__ void epi(const f32x4 (&acc)[2][2][4][2], const pg8::Unit& u, int wr, int wc, int fr, int fq) const {
        const int row0 = u.x0 * 256 + wr * 64 + fr, col0 = u.x1 * 256 + wc * 32 + 4 * fq;
#pragma unroll
        for (int ai = 0; ai < 2; ++ai)
#pragma unroll
            for (int m = 0; m < 4; ++m) { const size_t ro = (size_t)(row0 + ai * 128 + m * 16) * D + col0;
#pragma unroll
                for (int bj = 0; bj < 2; ++bj)
#pragma unroll
                    for (int n = 0; n < 2; ++n) { const size_t off = ro + bj * 128 + n * 16; const u32x2 hb = *(const u32x2*)(H0B + off); const f32x4 v = acc[ai][bj][m][n];
                        f32x4 o; o.x = v.x + ALPHA * bflo(hb.x); o.y = v.y + ALPHA * bfhi(hb.x); o.z = v.z + ALPHA * bflo(hb.y); o.w = v.w + ALPHA * bfhi(hb.y); *(f32x4*)(PRE + off) = o; }
                asm volatile("" ::: "memory"); }
    }
};
__device__ __forceinline__ void phase5(const Params& p, LAS unsigned char* lds) {
    unsigned char* ws = p.ws;
    PolP5 P{(const bf16_t*)(ws + WS_YMIX), (const bf16_t*)(ws + WS_WT_OUT), (const bf16_t*)(ws + WS_H0B), p.out, (int)gridDim.x, (int)blockIdx.x};
    pg8::gemm_phase(lds, P, D);
}

constexpr int P6_TP = 1032;
constexpr int P6_TH = 0, P6_TL = 16 * P6_TP * 2, P6_PART = 2 * 16 * P6_TP * 2, P6_LC = P6_PART + 8 * 16 * 32 * 4, P6_BASE = P6_LC + 128, P6_ENT = P6_BASE + 128, P6_MAXENT = 2048;
__device__ __forceinline__ void phase6(const Params& p, LAS unsigned char* lds, int rep) {
    const int tid = threadIdx.x, lane = tid & 63, wave = tid >> 6, fr = lane & 15, fq = lane >> 4;
    unsigned char* ws = p.ws; unsigned* ctl = (unsigned*)(ws + WS_CTL);
    const bf16_t* WRH = (const bf16_t*)(ws + WS_WRT); const bf16_t* WRL = WRH + NE * D;
    LAS bf16_t* TH = (LAS bf16_t*)(lds + P6_TH); LAS bf16_t* TL = (LAS bf16_t*)(lds + P6_TL); LAS float* PART = (LAS float*)(lds + P6_PART);
    LAS int* LC = (LAS int*)(lds + P6_LC); LAS int* BASE = (LAS int*)(lds + P6_BASE); LAS int* ENT = (LAS int*)(lds + P6_ENT);
    int* LIST = (int*)(ws + WS_LIST); float* RG = (float*)(ws + WS_ROWGATE); int* SEL = (int*)(ws + WS_SEL);
    __syncthreads();
    if (tid < NE) LC[tid] = 0;
    __syncthreads();
    int it = 0;
    for (int tile = blockIdx.x; tile < T / 16; tile += gridDim.x, ++it) {
        const int t0 = tile * 16;
#pragma unroll
        for (int q = 0; q < 2; ++q) { const int tt = 2 * wave + q, t = t0 + tt;
            const f32x4* xr = (const f32x4*)(p.out + (size_t)t * D) + lane; f32x4 v[4];
#pragma unroll
            for (int j = 0; j < 4; ++j) v[j] = xr[64 * j];
            ln_row(v, p.in[18], p.in[19], lane);
            bf16_t* orow = (bf16_t*)(ws + WS_H1B) + (size_t)t * D;
#pragma unroll
            for (int j = 0; j < 4; ++j) { const unsigned h0 = f2bf(v[j].x), h1 = f2bf(v[j].y), h2 = f2bf(v[j].z), h3 = f2bf(v[j].w);
                u32x2 hi; hi.x = h0 | (h1 << 16); hi.y = h2 | (h3 << 16);
                u32x2 lo; lo.x = pk2(v[j].x - bf2f(h0), v[j].y - bf2f(h1)); lo.y = pk2(v[j].z - bf2f(h2), v[j].w - bf2f(h3));
                *(u32x2*)(orow + 4 * lane + 256 * j) = hi;
                *(LAS u32x2*)(TH + tt * P6_TP + 4 * lane + 256 * j) = hi; *(LAS u32x2*)(TL + tt * P6_TP + 4 * lane + 256 * j) = lo; } }
        __syncthreads();
        f32x4 acc0 = (f32x4){0.f, 0.f, 0.f, 0.f}, acc1 = acc0;
#pragma unroll
        for (int ks = 0; ks < 4; ++ks) { const int k0 = 128 * wave + 32 * ks + 8 * fq;
            const bf16x8 ah = *(const LAS bf16x8*)(TH + fr * P6_TP + k0), al = *(const LAS bf16x8*)(TL + fr * P6_TP + k0);
            const bf16x8 bh0 = *(const bf16x8*)(WRH + (size_t)fr * D + k0), bl0 = *(const bf16x8*)(WRL + (size_t)fr * D + k0);
            const bf16x8 bh1 = *(const bf16x8*)(WRH + (size_t)(16 + fr) * D + k0), bl1 = *(const bf16x8*)(WRL + (size_t)(16 + fr) * D + k0);
            acc0 = __builtin_amdgcn_mfma_f32_16x16x32_bf16(ah, bh0, acc0, 0, 0, 0); acc0 = __builtin_amdgcn_mfma_f32_16x16x32_bf16(ah, bl0, acc0, 0, 0, 0); acc0 = __builtin_amdgcn_mfma_f32_16x16x32_bf16(al, bh0, acc0, 0, 0, 0);
            acc1 = __builtin_amdgcn_mfma_f32_16x16x32_bf16(ah, bh1, acc1, 0, 0, 0); acc1 = __builtin_amdgcn_mfma_f32_16x16x32_bf16(ah, bl1, acc1, 0, 0, 0); acc1 = __builtin_amdgcn_mfma_f32_16x16x32_bf16(al, bh1, acc1, 0, 0, 0); }
#pragma unroll
        for (int r = 0; r < 4; ++r) { PART[(wave * 16 + 4 * fq + r) * 32 + fr] = acc0[r]; PART[(wave * 16 + 4 * fq + r) * 32 + 16 + fr] = acc1[r]; }
        __syncthreads();
        const int e = lane & 31, tt = 2 * wave + (lane >> 5), t = t0 + tt;
        float logit = p.in[21][e];
#pragma unroll
        for (int v = 0; v < 8; ++v) logit += PART[(v * 16 + tt) * 32 + e];
        float cur = logit; float tv0 = 0.f, tv1 = 0.f, tv2 = 0.f, tv3 = 0.f; int te0 = 0, te1 = 0, te2 = 0, te3 = 0;
#pragma unroll
        for (int k = 0; k < 4; ++k) { float bv = cur; int bi = e;
#pragma unroll
            for (int o = 1; o < 32; o <<= 1) { const float ov = __shfl_xor(bv, o); const int oi = __shfl_xor(bi, o); if (ov > bv || (ov == bv && oi < bi)) { bv = ov; bi = oi; } }
            if (k == 0) { tv0 = bv; te0 = bi; } if (k == 1) { tv1 = bv; te1 = bi; } if (k == 2) { tv2 = bv; te2 = bi; } if (k == 3) { tv3 = bv; te3 = bi; }
            if (e == bi) cur = -3.0e38f; }
        const float e1 = __expf(tv1 - tv0), e2 = __expf(tv2 - tv0), e3 = __expf(tv3 - tv0); const float inv = 1.f / (1.f + e1 + e2 + e3);
        if (e < 4) { int ee = te0; float gg = inv;
            if (e == 1) { ee = te1; gg = e1 * inv; } if (e == 2) { ee = te2; gg = e2 * inv; } if (e == 3) { ee = te3; gg = e3 * inv; }
            const int lr = __hip_atomic_fetch_add((int*)(LC + ee), 1, __ATOMIC_RELAXED, __HIP_MEMORY_SCOPE_WORKGROUP); const int n = (it * 16 + tt) * 4 + e;
            if (n < P6_MAXENT) { ENT[4 * n] = t * 4 + e; ENT[4 * n + 1] = ee; ENT[4 * n + 2] = lr; ENT[4 * n + 3] = __builtin_bit_cast(int, gg); } }
    }
    __syncthreads();
    if (tid < NE) BASE[tid] = (int)atomicAdd(ctl + CW_CNT + 32 * rep + tid, (unsigned)LC[tid]);
    __syncthreads();
    const int nent = it * 64 < P6_MAXENT ? it * 64 : P6_MAXENT;
    for (int n = tid; n < nent; n += NTHR) { const int tk = ENT[4 * n], ee = ENT[4 * n + 1], rank = BASE[ee] + ENT[4 * n + 2];
        LIST[(size_t)ee * T + rank] = tk >> 2; RG[(size_t)ee * T + rank] = __builtin_bit_cast(float, ENT[4 * n + 3]); SEL[(size_t)tk * 2] = ee; SEL[(size_t)tk * 2 + 1] = rank; }
}

__device__ __forceinline__ void build_expert_tables(const Params& p, LAS int* tab) {
    const unsigned* ctl = (const unsigned*)(p.ws + WS_CTL);
    __syncthreads();
    if (threadIdx.x < NE) tab[threadIdx.x] = (int)__hip_atomic_load(ctl + CW_CNT + CNT_SET + threadIdx.x, __ATOMIC_RELAXED, __HIP_MEMORY_SCOPE_AGENT);
    __syncthreads();
    if (threadIdx.x == 0) { int ps = 0, ts = 0;
        for (int e = 0; e < NE; ++e) { const int c = tab[e]; tab[32 + e] = ps; tab[64 + e] = ts; ps += (c + 255) / 256 * 256; ts += (c + 127) / 128; }
        tab[64 + NE] = ts; }
    __syncthreads();
}

constexpr int TAB_OFF = 131072, UTAB_OFF = 100, UTAB_MAX = 48;
__device__ __forceinline__ void build_expert_tables256(const Params& p, LAS int* tab, int npn  ) {
    const unsigned* ctl = (const unsigned*)(p.ws + WS_CTL);
    __syncthreads();
    if (threadIdx.x < NE) tab[threadIdx.x] = (int)__hip_atomic_load(ctl + CW_CNT + CNT_SET + threadIdx.x, __ATOMIC_RELAXED, __HIP_MEMORY_SCOPE_AGENT);
    __syncthreads();
    if (threadIdx.x == 0) { int ps = 0, ts = 0;
        for (int e = 0; e < NE; ++e) { const int c = tab[e]; tab[32 + e] = ps; tab[64 + e] = ts; ps += (c + 255) / 256 * 256; ts += (c + 255) / 256; }
        tab[64 + NE] = ts;
        int e = 0, n = 0;
        if (gridDim.x == 256) { const int g = blockIdx.x & 7, sl = blockIdx.x >> 3, mpx = 32 / npn  , mround = 8 * mpx;
            for (int i = 0; n < UTAB_MAX; ++i) { const int mt_g = i * mround + g * mpx + sl / npn, pn = sl % npn; if (i * mround >= ts) break; if (mt_g >= ts) continue;
                while (e + 1 < NE && mt_g >= tab[64 + e + 1]) ++e;
                const int r0 = (mt_g - tab[64 + e]) * 256;
                tab[UTAB_OFF + 4 * n] = e; tab[UTAB_OFF + 4 * n + 1] = r0; tab[UTAB_OFF + 4 * n + 2] = pn; tab[UTAB_OFF + 4 * n + 3] = tab[32 + e] + r0; ++n; }
        } else { const int nun = ts * npn;
        for (int L = blockIdx.x; L < nun && n < UTAB_MAX; L += gridDim.x, ++n) { const int pn = L % npn, mt_g = L / npn;
            while (e + 1 < NE && mt_g >= tab[64 + e + 1]) ++e;
            const int r0 = (mt_g - tab[64 + e]) * 256;
            tab[UTAB_OFF + 4 * n] = e; tab[UTAB_OFF + 4 * n + 1] = r0; tab[UTAB_OFF + 4 * n + 2] = pn; tab[UTAB_OFF + 4 * n + 3] = tab[32 + e] + r0; } }
        tab[98] = n; }
    __syncthreads();
}
struct PolP7 {
    static constexpr bool PERM = true, GATHER = true;
    const bf16_t* H1B; const bf16_t* WG; const int* LIST; bf16_t* ACT; const float* BGU; const LAS int* tab; int G, c;
    __device__ __forceinline__ bool next(int i, pg8::Unit& u) const { if (i >= __builtin_amdgcn_readfirstlane(tab[98])) return false;
        const int e = __builtin_amdgcn_readfirstlane(tab[UTAB_OFF + 4 * i]), r0 = __builtin_amdgcn_readfirstlane(tab[UTAB_OFF + 4 * i + 1]), pn = __builtin_amdgcn_readfirstlane(tab[UTAB_OFF + 4 * i + 2]);
        u.A = (const char*)H1B; u.B0 = (const char*)(WG + ((size_t)e * 2 * FF + pn * 128) * D); u.B1 = u.B0 + (size_t)FF * D * 2;
        u.x0 = e; u.x1 = r0; u.x2 = pn; u.x3 = __builtin_amdgcn_readfirstlane(tab[UTAB_OFF + 4 * i + 3]); u.x4 = __builtin_amdgcn_readfirstlane(tab[e]) - r0; return true; }
    __device__ __forceinline__ void rows_issue(const pg8::Unit& u, int R0, unsigned (&raw)[2][2]) const { const int* lst = LIST + (size_t)u.x0 * T + u.x1;
#pragma unroll
        for (int h = 0; h < 2; ++h)
#pragma unroll
            for (int i = 0; i < 2; ++i) { int r = h * 128 + i * 64 + R0; r = r < u.x4 ? r : 0; raw[h][i] = (unsigned)lst[r]; } }
    __device__ __forceinline__ void rows_finish(int C0, int K, unsigned (&raw)[2][2]) const {
#pragma unroll
        for (int h = 0; h < 2; ++h)
#pragma unroll
            for (int i = 0; i < 2; ++i) raw[h][i] = (raw[h][i] * (unsigned)K + (unsigned)C0) * 2u; }
    __device__ __forceinline__ void epi(const f32x4 (&acc)[2][2][4][2], const pg8::Unit& u, int wr, int wc, int fr, int fq) const {
        const int e = u.x0, nval = u.x4, f0 = u.x2 * 128 + wc * 32 + 8 * fq;
        const float* bias = BGU + (size_t)e * 2 * FF + f0;
        const f32x4 bg0 = *(const f32x4*)bias, bg1 = *(const f32x4*)(bias + 4), bu0 = *(const f32x4*)(bias + FF), bu1 = *(const f32x4*)(bias + FF + 4);
#pragma unroll
        for (int ai = 0; ai < 2; ++ai)
#pragma unroll
            for (int m = 0; m < 4; ++m) { const int r = ai * 128 + wr * 64 + m * 16 + fr;
                const f32x4 g0 = acc[ai][0][m][0] + bg0, g1 = acc[ai][0][m][1] + bg1, u0 = acc[ai][1][m][0] + bu0, u1 = acc[ai][1][m][1] + bu1;
                float a[8];
#pragma unroll
                for (int j = 0; j < 4; ++j) { const float gc = fminf(g0[j], 7.f), uc = fminf(fmaxf(u0[j], -7.f), 7.f); a[j] = (uc + 1.f) * gc * sigmoidf_(1.702f * gc);
                    const float gd = fminf(g1[j], 7.f), ud = fminf(fmaxf(u1[j], -7.f), 7.f); a[4 + j] = (ud + 1.f) * gd * sigmoidf_(1.702f * gd); }
                if (r < nval) { u32x4 w; w.x = pg8::cvt_pk_bf16(a[0], a[1]); w.y = pg8::cvt_pk_bf16(a[2], a[3]); w.z = pg8::cvt_pk_bf16(a[4], a[5]); w.w = pg8::cvt_pk_bf16(a[6], a[7]);
                    *(u32x4*)(ACT + (size_t)(u.x3 + r) * FF + f0) = w; } }
    }
};
__device__ __forceinline__ void phase7(const Params& p, LAS unsigned char* lds) {
    LAS int* tab = (LAS int*)(lds + TAB_OFF); build_expert_tables256(p, tab, 8);
    unsigned char* ws = p.ws;
    PolP7 P{(const bf16_t*)(ws + WS_H1B), (const bf16_t*)(ws + WS_WT_GU), (const int*)(ws + WS_LIST), (bf16_t*)(ws + WS_ACT), p.in[23], tab, (int)gridDim.x, (int)blockIdx.x};
    pg8::gemm_phase(lds, P, D);
}

struct PolP8 {
    static constexpr bool PERM = true, GATHER = false;
    const bf16_t* ACT; const bf16_t* WD; const float* RG; bf16_t* YR; const float* BD; const LAS int* tab; int G, c;
    __device__ __forceinline__ bool next(int i, pg8::Unit& u) const { if (i >= __builtin_amdgcn_readfirstlane(tab[98])) return false;
        const int e = __builtin_amdgcn_readfirstlane(tab[UTAB_OFF + 4 * i]), r0 = __builtin_amdgcn_readfirstlane(tab[UTAB_OFF + 4 * i + 1]), pn = __builtin_amdgcn_readfirstlane(tab[UTAB_OFF + 4 * i + 2]), prow0 = __builtin_amdgcn_readfirstlane(tab[UTAB_OFF + 4 * i + 3]);
        u.A = (const char*)(ACT + (size_t)prow0 * FF); u.B0 = (const char*)(WD + ((size_t)e * D + pn * 256) * FF); u.B1 = u.B0 + (size_t)128 * FF * 2;
        u.x4 = __builtin_amdgcn_readfirstlane(tab[e]) - r0;
        u.x0 = e; u.x1 = r0; u.x2 = pn; u.x3 = prow0; return true; }
    __device__ __forceinline__ void epi(const f32x4 (&acc)[2][2][4][2], const pg8::Unit& u, int wr, int wc, int fr, int fq) const {
        const int e = u.x0, nval = u.x4; const float* rg = RG + (size_t)e * T + u.x1;
#pragma unroll
        for (int ai = 0; ai < 2; ++ai)
#pragma unroll
            for (int m = 0; m < 4; ++m) { const int r = ai * 128 + wr * 64 + m * 16 + fr;
                if (r < nval) { const float g = rg[r];
#pragma unroll
                    for (int bj = 0; bj < 2; ++bj) { const int col = u.x2 * 256 + bj * 128 + wc * 32 + 8 * fq; const float* bias = BD + (size_t)e * D + col;
                        const f32x4 v0 = (acc[ai][bj][m][0] + *(const f32x4*)bias) * g, v1 = (acc[ai][bj][m][1] + *(const f32x4*)(bias + 4)) * g;
                        u32x4 w; w.x = pg8::cvt_pk_bf16(v0[0], v0[1]); w.y = pg8::cvt_pk_bf16(v0[2], v0[3]); w.z = pg8::cvt_pk_bf16(v1[0], v1[1]); w.w = pg8::cvt_pk_bf16(v1[2], v1[3]);
                        *(u32x4*)(YR + (size_t)(u.x3 + r) * D + col) = w; } } }
    }
};
__device__ __forceinline__ void phase8(const Params& p, LAS unsigned char* lds) {
    LAS int* tab = (LAS int*)(lds + TAB_OFF); build_expert_tables256(p, tab, 4);
    unsigned char* ws = p.ws;
    PolP8 P{(const bf16_t*)(ws + WS_ACT), (const bf16_t*)(ws + WS_WT_DN), (const float*)(ws + WS_ROWGATE), (bf16_t*)(ws + WS_YROWS), p.in[25], tab, (int)gridDim.x, (int)blockIdx.x};
    pg8::gemm_phase(lds, P, FF);
}

__device__ __forceinline__ void phase9(const Params& p, LAS unsigned char* lds) {
    LAS int* tab = (LAS int*)lds; build_expert_tables(p, tab);
    const int tid = threadIdx.x, lane = tid & 63, wave = tid >> 6;
    const int gw = blockIdx.x * NWAVES + wave, NGW = gridDim.x * NWAVES;
    unsigned char* ws = p.ws; const bf16_t* H1B = (const bf16_t*)(ws + WS_H1B); const bf16_t* YR = (const bf16_t*)(ws + WS_YROWS); const int* SEL = (const int*)(ws + WS_SEL);
    typedef int i32x4 __attribute__((ext_vector_type(4)));
    i32x4 sa = {0, 0, 0, 0}, sb = sa;
    if (gw < T) { sa = *(const i32x4*)(SEL + (size_t)gw * 8); sb = *(const i32x4*)(SEL + (size_t)gw * 8 + 4); }
    for (int t = gw; t < T; t += NGW) {
        const i32x4 ca = sa, cb = sb;
        if (t + NGW < T) { sa = *(const i32x4*)(SEL + (size_t)(t + NGW) * 8); sb = *(const i32x4*)(SEL + (size_t)(t + NGW) * 8 + 4); }
        const bf16_t* y0 = YR + (size_t)(tab[32 + ca.x] + ca.y) * D + 4 * lane; const bf16_t* y1 = YR + (size_t)(tab[32 + ca.z] + ca.w) * D + 4 * lane;
        const bf16_t* y2 = YR + (size_t)(tab[32 + cb.x] + cb.y) * D + 4 * lane; const bf16_t* y3 = YR + (size_t)(tab[32 + cb.z] + cb.w) * D + 4 * lane;
        const bf16_t* hr = H1B + (size_t)t * D + 4 * lane;
        u32x2 hb[4], q0[4], q1[4], q2[4], q3[4];
#pragma unroll
        for (int j = 0; j < 4; ++j) { hb[j] = *(const u32x2*)(hr + 256 * j); q0[j] = *(const u32x2*)(y0 + 256 * j); q1[j] = *(const u32x2*)(y1 + 256 * j); q2[j] = *(const u32x2*)(y2 + 256 * j); q3[j] = *(const u32x2*)(y3 + 256 * j); }
        f32x4 v[4];
#pragma unroll
        for (int j = 0; j < 4; ++j) {
            v[j].x = ALPHA * bflo(hb[j].x) + ((bflo(q0[j].x) + bflo(q1[j].x)) + (bflo(q2[j].x) + bflo(q3[j].x)));
            v[j].y = ALPHA * bfhi(hb[j].x) + ((bfhi(q0[j].x) + bfhi(q1[j].x)) + (bfhi(q2[j].x) + bfhi(q3[j].x)));
            v[j].z = ALPHA * bflo(hb[j].y) + ((bflo(q0[j].y) + bflo(q1[j].y)) + (bflo(q2[j].y) + bflo(q3[j].y)));
            v[j].w = ALPHA * bfhi(hb[j].y) + ((bfhi(q0[j].y) + bfhi(q1[j].y)) + (bfhi(q2[j].y) + bfhi(q3[j].y))); }
        ln_row(v, p.in[26], p.in[27], lane);
        f32x4* orow = (f32x4*)(p.out + (size_t)t * D) + lane;
#pragma unroll
        for (int j = 0; j < 4; ++j) orow[64 * j] = v[j];
    }
}

#define XB_TMO      128
#define XB_XCNT(j)  (256  + 64 * (j))
#define XB_XSUB(j)  (1280 + 64 * (j))
#define XB_XGEN(j)  (2304 + 64 * (j))
#define XB_TOP      3328
#define XB_TOPGEN   3392
#define XCD_BAR_WORDS 3456
#define XB_SPIN_CAP (1u << 22)
__device__ __forceinline__ unsigned xb_ld(unsigned* p)              { return __hip_atomic_load(p, __ATOMIC_RELAXED, __HIP_MEMORY_SCOPE_AGENT); }
__device__ __forceinline__ unsigned xb_add(unsigned* p, unsigned v) { return __hip_atomic_fetch_add(p, v, __ATOMIC_RELAXED, __HIP_MEMORY_SCOPE_AGENT); }
__device__ __forceinline__ unsigned xb_xcc_id() { return (unsigned)__builtin_amdgcn_s_getreg((3 << 11) | 20) & 0xFu; }
#define XB_SPIN(cond, bar) do { unsigned _sp = 0; while (cond) { __builtin_amdgcn_s_sleep(1); \
    if ((++_sp & 255u) == 0u) { if (xb_ld(&(bar)[XB_TMO])) break; if (_sp > XB_SPIN_CAP) { atomicAdd(&(bar)[XB_TMO], 1u); break; } } } } while (0)
struct XcdBarrier { unsigned* bar; unsigned x; volatile LAS unsigned* st; };
__device__ __forceinline__ XcdBarrier xcd_barrier_post(unsigned* bar, volatile LAS unsigned* st) {
    XcdBarrier b; b.bar = bar; b.x = xb_xcc_id(); b.st = st;
    if (threadIdx.x == 0) (void)xb_add(&bar[XB_XCNT(b.x)], 1u);
    return b;
}
__device__ __forceinline__ void xcd_barrier_complete(unsigned* bar, unsigned x, unsigned& nloc, unsigned& nx) {
    const unsigned G = gridDim.x * gridDim.y * gridDim.z;
    unsigned sum, cnt, mine, sp = 0u;
    for (;;) {
        sum = 0u; cnt = 0u; mine = 0u;
#pragma unroll
        for (unsigned j = 0; j < 16; ++j) { const unsigned c = xb_ld(&bar[XB_XCNT(j)]); sum += c; cnt += (c > 0u) ? 1u : 0u; mine = (j == x) ? c : mine; }
        if (sum == G) break;
        __builtin_amdgcn_s_sleep(1);
        if ((++sp & 255u) == 0u) { if (xb_ld(&bar[XB_TMO])) break; if (sp > XB_SPIN_CAP) { atomicAdd(&bar[XB_TMO], 1u); break; } }
    }
    nloc = mine > 0u ? mine : 1u; nx = cnt > 0u ? cnt : 1u;
}
__device__ __forceinline__ void xcd_barrier(const XcdBarrier& b) {
    asm volatile("s_waitcnt vmcnt(0)" ::: "memory");
    __syncthreads();
    if (threadIdx.x == 0) {
        unsigned* bar = b.bar;
        __builtin_amdgcn_s_waitcnt(0);
        unsigned nloc = b.st[0], nx = b.st[1];
        if (nloc == 0u) { xcd_barrier_complete(bar, b.x, nloc, nx); b.st[0] = nloc; b.st[1] = nx; }
        const unsigned old = xb_add(&bar[XB_XSUB(b.x)], 1u);
        const unsigned gen = old / nloc;
        if (old + 1u == (gen + 1u) * nloc) {
            __builtin_amdgcn_fence(__ATOMIC_RELEASE, "agent");
            asm volatile("s_waitcnt vmcnt(0)" ::: "memory");
            const unsigned og = xb_add(&bar[XB_TOP], 1u);
            const unsigned tg = og / nx;
            if (og + 1u == (tg + 1u) * nx) xb_add(&bar[XB_TOPGEN], 1u);
            else XB_SPIN(xb_ld(&bar[XB_TOPGEN]) == tg, bar);
            __builtin_amdgcn_fence(__ATOMIC_ACQUIRE, "agent");
            xb_add(&bar[XB_XGEN(b.x)], 1u);
            asm volatile("s_waitcnt vmcnt(0)" ::: "memory");
        } else {
            XB_SPIN(xb_ld(&bar[XB_XGEN(b.x)]) == gen, bar);
            __builtin_amdgcn_fence(__ATOMIC_ACQUIRE, "agent");
            asm volatile("s_waitcnt vmcnt(0)" ::: "memory");
        }
    }
    __syncthreads();
}

constexpr int NPHASE = 10;
constexpr int LDS_BYTES = 131072 + 2048;
__global__ void __launch_bounds__(NTHR, 2) mk_fwd(Params p) {
    extern __shared__ __attribute__((aligned(16))) unsigned char lds_raw[];
    LAS unsigned char* lds = (LAS unsigned char*)lds_raw;
    const int lo = p.ph_lo, hi = p.ph_hi;
    volatile LAS unsigned* barst = (volatile LAS unsigned*)(lds + BARST_OFF);
    if (threadIdx.x < 2) barst[threadIdx.x] = 0u;
    __syncthreads();
    const XcdBarrier xbar = xcd_barrier_post((unsigned*)(p.ws + WS_CTL) + CW_BAR, barst);
#ifdef ONLY_PHASE
#define IN(k) ((k) == ONLY_PHASE && lo <= (k) && (k) < hi)
#else
#define IN(k) (lo <= (k) && (k) < hi)
#endif
#define SEAM(k) do { if (IN(k) && IN((k) + 1)) { if ((k) == 0) cg::this_grid().sync(); else xcd_barrier(xbar); } } while (0)
#define RUN(k, call) do { if (IN(k)) { call; if (REPEAT_PHASE == (k)) { cg::this_grid().sync(); call; } } } while (0)
    { int rep = 0;
    RUN(0, phase0(p, lds));
    SEAM(0);
    RUN(1, phase1(p, lds));
    SEAM(1);
    RUN(2, phase2(p, lds));
    SEAM(2);
    if (IN(3)) { const int nrep = (REPEAT_PHASE == 3) ? 2 : 1;
#pragma unroll 1
        for (rep = 0; rep < nrep; ++rep) { if (rep) cg::this_grid().sync(); phase3(p, lds, rep); } }
    SEAM(3);
    RUN(4, phase4(p));
    SEAM(4);
    RUN(5, phase5(p, lds));
    SEAM(5);
    rep = 0; RUN(6, (phase6(p, lds, rep), ++rep));
    SEAM(6);
    RUN(7, phase7(p, lds));
    SEAM(7);
    RUN(8, phase8(p, lds));
    SEAM(8);
    RUN(9, phase9(p, lds));
    }
#undef RUN
#undef IN
#undef SEAM
}

extern "C" void kernel_launch(void* const* d_in, const int* in_sizes, int n_in, void* d_out, int out_size, void* d_ws, size_t ws_size, hipStream_t stream) {
    static int grid = 0;
    if (grid == 0) {
        if (n_in != 28 || out_size != T * D || ws_size < WS_END) { fprintf(stderr, "kernel_launch: unexpected shapes: n_in %d out %d ws %zu (need %zu)\n", n_in, out_size, ws_size, (size_t)WS_END); grid = -1; return; }
        int dev = 0, cus = 0, per_cu = 0;
        hipGetDevice(&dev); hipDeviceGetAttribute(&cus, hipDeviceAttributeMultiprocessorCount, dev);
        hipFuncSetAttribute((const void*)mk_fwd, hipFuncAttributeMaxDynamicSharedMemorySize, LDS_BYTES);
        hipOccupancyMaxActiveBlocksPerMultiprocessor(&per_cu, (const void*)mk_fwd, NTHR, LDS_BYTES);
        (void)hipGetLastError();
        if (per_cu < 1) { fprintf(stderr, "kernel_launch: occupancy query says %d blocks per CU\n", per_cu); per_cu = 1; }
        grid = cus;
    }
    if (grid < 0) return;
    hipMemsetAsync((char*)d_ws + WS_CTL, 0, CTL_ZERO_BYTES, stream);
    Params p{};
    for (int i = 0; i < 28; ++i) p.in[i] = (const float*)d_in[i];
    p.out = (float*)d_out; p.ws = (unsigned char*)d_ws;
#if MK_ONE_LAUNCH
    p.ph_lo = 0; p.ph_hi = NPHASE;
    void* args[] = {&p};
    hipError_t e = hipLaunchCooperativeKernel((const void*)mk_fwd, dim3(grid), dim3(NTHR), args, LDS_BYTES, stream);
    if (e != hipSuccess) fprintf(stderr, "cooperative launch failed: %s (grid %d)\n", hipGetErrorString(e), grid);
#else
    for (int ph = 0; ph < NPHASE; ++ph) { p.ph_lo = ph; p.ph_hi = ph + 1; hipLaunchKernelGGL(mk_fwd, dim3(grid), dim3(NTHR), LDS_BYTES, stream, p); }
#endif
}
```

```cpp
#include <hip/hip_runtime.h>
#include <hip/hip_cooperative_groups.h>
#include <cstdio>
#include <cstdint>
namespace cg = cooperative_groups;

#ifndef REPEAT_PHASE
#define REPEAT_PHASE -1
#endif
#ifndef MK_ONE_LAUNCH
#define MK_ONE_LAUNCH 1
#endif

typedef unsigned short bf16_t;
typedef short bf16x8 __attribute__((ext_vector_type(8)));
typedef short bf16x4 __attribute__((ext_vector_type(4)));
typedef float f32x4 __attribute__((ext_vector_type(4)));
typedef float f32x2 __attribute__((ext_vector_type(2)));
typedef unsigned u32x4 __attribute__((ext_vector_type(4)));
typedef unsigned u32x2 __attribute__((ext_vector_type(2)));

constexpr int D = 1024, BATCH = 16, SEQ = 2048, T = BATCH * SEQ;
constexpr int NMEM = 256, HD = 64;
constexpr int RH = 6, RC = 384;
constexpr int RWKV_IN = 1344;
constexpr int AH = 6, AW = 384, MH = 4, MW = 256;
constexpr int IN_W = 2752, IN_WP = 2816;
constexpr int PA_W = IN_WP - RWKV_IN;
constexpr int NE = 32, TOPK = 4, FF = 1024;
constexpr float LN_EPS = 1e-5f, GN_EPS = 64e-5f;
constexpr float ALPHA = 1.189207115002721f;
constexpr int NTHR = 512, NWAVES = 8;

constexpr size_t MiB = 1u << 20;
constexpr size_t WS_CTL = 0;
constexpr size_t WS_WT_IN = 1 * MiB;
constexpr size_t WS_LORA = 6 * MiB + 512 * 1024;
constexpr size_t WS_WT_OUT = 7 * MiB;
constexpr size_t WS_WT_KV = 9 * MiB;
constexpr size_t WS_KVM = 10 * MiB;
constexpr size_t WS_MEMB = 14 * MiB;
constexpr size_t WS_LIST = 22 * MiB;
constexpr size_t WS_ROWGATE = 26 * MiB;
constexpr size_t WS_SEL = 30 * MiB;
constexpr size_t WS_BONUS = 31 * MiB;
constexpr size_t WS_WRT = 31 * MiB + 800 * 1024;
constexpr size_t WS_WT_GU = 32 * MiB;
constexpr size_t WS_WT_DN = 160 * MiB;
constexpr size_t WS_H0B = 224 * MiB;
constexpr size_t WS_H1B = 288 * MiB;
constexpr size_t WS_YMIX = 352 * MiB;
constexpr size_t WS_PR = 416 * MiB;
constexpr size_t WS_ATTO = 416 * MiB;
constexpr size_t WS_PA = 500 * MiB;
constexpr size_t WS_SSH = 592 * MiB;
constexpr size_t WS_SDIR = 736 * MiB;
constexpr size_t WS_ACT = 352 * MiB;
constexpr size_t WS_YROWS = 624 * MiB;
constexpr size_t WS_END = 1024 * MiB;
constexpr size_t DO_Y = 0, DO_G = 96 * MiB, DO_LSE = 120 * MiB;
constexpr int ROWS_PAD = T * TOPK + NE * 256;

constexpr int CW_CNT = 0;
constexpr int CNT_SET = (REPEAT_PHASE == 6) ? 32 : 0;
constexpr int CW_ATTQ = 64;
constexpr int CW_SCANQ = 128;
constexpr int CW_BAR = 4096;
constexpr int CTL_ZERO_BYTES = 65536;
constexpr int BARST_OFF = 131072 + 1536;

#define LAS __attribute__((address_space(3)))

struct Params { const float* in[28]; float* out; unsigned char* ws; int ph_lo, ph_hi; };

__device__ __forceinline__ unsigned f2bf(float f) { unsigned u = __builtin_bit_cast(unsigned, f); return (u + 0x7fffu + ((u >> 16) & 1u)) >> 16; }
__device__ __forceinline__ unsigned pk2(float lo, float hi) { return f2bf(lo) | (f2bf(hi) << 16); }
__device__ __forceinline__ float bf2f(unsigned b) { return __builtin_bit_cast(float, b << 16); }
__device__ __forceinline__ float bflo(unsigned w) { return __builtin_bit_cast(float, w << 16); }
__device__ __forceinline__ float bfhi(unsigned w) { return __builtin_bit_cast(float, w & 0xffff0000u); }
template <int CTRL> __device__ __forceinline__ float dpp_mov(float v) {
    return __builtin_bit_cast(float, __builtin_amdgcn_update_dpp(0, __builtin_bit_cast(int, v), CTRL, 0xF, 0xF, true));
}
__device__ __forceinline__ float sum16(float v) {
    v += dpp_mov<0xB1>(v);
    v += dpp_mov<0x4E>(v);
    v += dpp_mov<0x141>(v);
    v += dpp_mov<0x140>(v);
    return v;
}
__device__ __forceinline__ float wave_sum(float v) {
    v = sum16(v);
    const int iv = __builtin_bit_cast(int, v);
    const float a = __builtin_bit_cast(float, __builtin_amdgcn_readlane(iv, 0)), b = __builtin_bit_cast(float, __builtin_amdgcn_readlane(iv, 16));
    const float c = __builtin_bit_cast(float, __builtin_amdgcn_readlane(iv, 32)), d = __builtin_bit_cast(float, __builtin_amdgcn_readlane(iv, 48));
    return (a + b) + (c + d);
}
__device__ __forceinline__ float sigmoidf_(float x) { return 1.f / (1.f + __expf(-x)); }

struct P0Item { const float* W; bf16_t* WT; int K, N, item; };
__device__ __forceinline__ void p0_item_load(const P0Item& I, float (&reg)[32], int lane) {
    const int nblk = I.N / 32, kb = I.item / nblk, nb = I.item % nblk, k0 = 64 * kb, n0 = 32 * nb;
    const float* src = I.W + (size_t)(k0 + (lane >> 5)) * I.N + n0 + (lane & 31);
#pragma unroll
    for (int i = 0; i < 32; ++i) reg[i] = src[(size_t)(2 * i) * I.N];
}
__device__ __forceinline__ void p0_item_store(const P0Item& I, const float (&reg)[32], LAS float* scr, int lane) {
    const int nblk = I.N / 32, kb = I.item / nblk, nb = I.item % nblk, k0 = 64 * kb, n0 = 32 * nb;
#pragma unroll
    for (int i = 0; i < 32; ++i) scr[(2 * i + (lane >> 5)) * 33 + (lane & 31)] = reg[i];
    asm volatile("s_waitcnt lgkmcnt(0)" ::: "memory");
    const int c = lane & 7;
#pragma unroll
    for (int j = 0; j < 4; ++j) { const int n = (lane >> 3) + 8 * j; const LAS float* s = scr + (8 * c) * 33 + n;
        u32x4 o; o.x = pk2(s[0 * 33], s[1 * 33]); o.y = pk2(s[2 * 33], s[3 * 33]); o.z = pk2(s[4 * 33], s[5 * 33]); o.w = pk2(s[6 * 33], s[7 * 33]);
        *(u32x4*)(I.WT + (size_t)(n0 + n) * I.K + k0 + 8 * c) = o; }
    asm volatile("s_waitcnt lgkmcnt(0)" ::: "memory");
}
__device__ __forceinline__ void ln_row(f32x4 (&v)[4], const float* __restrict__ g, const float* __restrict__ b, int lane) {
    float s = 0.f;
#pragma unroll
    for (int j = 0; j < 4; ++j) s += (v[j].x + v[j].y) + (v[j].z + v[j].w);
    const float mean = wave_sum(s) * (1.f / D); float s2 = 0.f;
#pragma unroll
    for (int j = 0; j < 4; ++j) { v[j] = v[j] - mean; s2 += (v[j].x * v[j].x + v[j].y * v[j].y) + (v[j].z * v[j].z + v[j].w * v[j].w); }
    const float rstd = 1.f / sqrtf(wave_sum(s2) * (1.f / D) + LN_EPS);
#pragma unroll
    for (int j = 0; j < 4; ++j) { const f32x4 gg = *(const f32x4*)(g + 4 * lane + 256 * j), bb = *(const f32x4*)(b + 4 * lane + 256 * j); v[j] = v[j] * rstd * gg + bb; }
}
__device__ __forceinline__ void store_row_bf16(bf16_t* orow, const f32x4 (&v)[4], int lane) {
#pragma unroll
    for (int j = 0; j < 4; ++j) { u32x2 o; o.x = pk2(v[j].x, v[j].y); o.y = pk2(v[j].z, v[j].w); *(u32x2*)(orow + 4 * lane + 256 * j) = o; }
}

__device__ __forceinline__ void phase0(const Params& p, LAS unsigned char* lds) {
    const int tid = threadIdx.x, lane = tid & 63, wave = tid >> 6;
    const int gw = blockIdx.x * NWAVES + wave, NGW = gridDim.x * NWAVES;
    LAS float* scr = (LAS float*)(lds + wave * 16384);
    unsigned char* ws = p.ws;
    constexpr int I_IN = 16 * (IN_W / 32), I_OUT = 16 * 32, I_KV = 16 * 16, I_GU = 16 * 64, I_DN = 16 * 32;
    constexpr int NITEMS = I_IN + I_OUT + I_KV + NE * I_GU + NE * I_DN;
    auto mk = [&](int it) { P0Item I; int r = it;
        if (r < I_IN) { I.W = p.in[4]; I.WT = (bf16_t*)(ws + WS_WT_IN); I.K = D; I.N = IN_W; I.item = r; return I; } r -= I_IN;
        if (r < I_OUT) { I.W = p.in[17]; I.WT = (bf16_t*)(ws + WS_WT_OUT); I.K = D; I.N = D; I.item = r; return I; } r -= I_OUT;
        if (r < I_KV) { I.W = p.in[16]; I.WT = (bf16_t*)(ws + WS_WT_KV); I.K = D; I.N = 2 * MW; I.item = r; return I; } r -= I_KV;
        if (r < NE * I_GU) { const int e = r / I_GU; I.W = p.in[22] + (size_t)e * D * 2 * FF; I.WT = (bf16_t*)(ws + WS_WT_GU) + (size_t)e * 2 * FF * D; I.K = D; I.N = 2 * FF; I.item = r % I_GU; return I; } r -= NE * I_GU;
        { const int e = r / I_DN; I.W = p.in[24] + (size_t)e * FF * D; I.WT = (bf16_t*)(ws + WS_WT_DN) + (size_t)e * D * FF; I.K = FF; I.N = D; I.item = r % I_DN; return I; } };
    { float ra[32], rb[32]; int it = gw;
      if (it < NITEMS) { const P0Item I0 = mk(it); p0_item_load(I0, ra, lane); }
      for (; it < NITEMS; it += 2 * NGW) {
          const P0Item Ia = mk(it); const bool hb = it + NGW < NITEMS; P0Item Ib = Ia;
          if (hb) { Ib = mk(it + NGW); p0_item_load(Ib, rb, lane); }
          p0_item_store(Ia, ra, scr, lane);
          if (it + 2 * NGW < NITEMS) { const P0Item Ic = mk(it + 2 * NGW); p0_item_load(Ic, ra, lane); }
          if (hb) p0_item_store(Ib, rb, scr, lane);
      } }
    { u32x4* z = (u32x4*)((bf16_t*)(ws + WS_WT_IN) + (size_t)IN_W * D); const int n16 = (IN_WP - IN_W) * D * 2 / 16;
      for (int i = blockIdx.x * NTHR + tid; i < n16; i += gridDim.x * NTHR) z[i] = (u32x4){0u, 0u, 0u, 0u}; }
    { const float* wr = p.in[20]; bf16_t* wh = (bf16_t*)(ws + WS_WRT); bf16_t* wl = wh + NE * D;
      for (int i = blockIdx.x * NTHR + tid; i < NE * D; i += gridDim.x * NTHR) { const int e = i / D, k = i % D; const float w = wr[k * NE + e]; const unsigned h = f2bf(w); wh[i] = (bf16_t)h; wl[i] = (bf16_t)f2bf(w - bf2f(h)); } }
    { bf16_t* wu = (bf16_t*)(ws + WS_LORA); bf16_t* au = wu + 2 * RC * 32; bf16_t* gu = au + 2 * RC * 32;
      for (int i = blockIdx.x * NTHR + tid; i < 2 * RC * 32; i += gridDim.x * NTHR) { const int dch = i >> 5, j = i & 31, d = dch / RC, ch = dch % RC; wu[i] = (bf16_t)f2bf(p.in[7][(size_t)(d * 32 + j) * RC + ch]); au[i] = (bf16_t)f2bf(p.in[9][(size_t)(d * 32 + j) * RC + ch]); }
      for (int i = blockIdx.x * NTHR + tid; i < RC * 64; i += gridDim.x * NTHR) { const int ch = i >> 6, j = i & 63; gu[i] = (bf16_t)f2bf(p.in[10][(size_t)j * RC + ch]); } }
    for (int m = gw; m < T; m += NGW) {
        const f32x4* xr = (const f32x4*)(p.in[0] + (size_t)m * D) + lane; f32x4 v[4];
#pragma unroll
        for (int j = 0; j < 4; ++j) v[j] = xr[64 * j];
        ln_row(v, p.in[2], p.in[3], lane);
        store_row_bf16((bf16_t*)(ws + WS_H0B) + (size_t)m * D, v, lane);
    }
    for (int m = gw; m < BATCH * NMEM; m += NGW) {
        const f32x4* xr = (const f32x4*)(p.in[1] + (size_t)m * D) + lane; f32x4 v[4];
#pragma unroll
        for (int j = 0; j < 4; ++j) v[j] = xr[64 * j];
        store_row_bf16((bf16_t*)(ws + WS_MEMB) + (size_t)m * D, v, lane);
    }
}

template <class ARow, class BRow, class Epi>
__device__ __forceinline__ void sgemm_tile(int K, ARow arow, BRow brow, Epi epi) {
    const int tid = threadIdx.x, wid = tid >> 6, lane = tid & 63, wm = wid >> 1, wn = wid & 1, fr = lane & 15, fq = lane >> 4;
    f32x4 acc[2][4];
#pragma unroll
    for (int m = 0; m < 2; ++m)
#pragma unroll
        for (int n = 0; n < 4; ++n) acc[m][n] = (f32x4){0.f, 0.f, 0.f, 0.f};
    const bf16_t* ap[2]; const bf16_t* bp[4];
#pragma unroll
    for (int m = 0; m < 2; ++m) ap[m] = arow(wm * 32 + m * 16 + fr) + fq * 8;
#pragma unroll
    for (int n = 0; n < 4; ++n) bp[n] = brow(wn * 64 + n * 16 + fr) + fq * 8;
    for (int k = 0; k < K; k += 32) {
        bf16x8 a[2], b[4];
#pragma unroll
        for (int m = 0; m < 2; ++m) a[m] = *(const bf16x8*)(ap[m] + k);
#pragma unroll
        for (int n = 0; n < 4; ++n) b[n] = *(const bf16x8*)(bp[n] + k);
#pragma unroll
        for (int m = 0; m < 2; ++m)
#pragma unroll
            for (int n = 0; n < 4; ++n) acc[m][n] = __builtin_amdgcn_mfma_f32_16x16x32_bf16(b[n], a[m], acc[m][n], 0, 0, 0);
    }
#pragma unroll
    for (int m = 0; m < 2; ++m)
#pragma unroll
        for (int n = 0; n < 4; ++n) epi(wm * 32 + m * 16 + fr, wn * 64 + n * 16 + 4 * fq, acc[m][n], n);
}


namespace pg8 {
constexpr int BM = 256, BK = 64, HALF = 128, HTB = HALF * BK * 2, STAGE_BYTES = 8 * HTB, NXCD = 8, WGM = 8;
__host__ __device__ __forceinline__ int lds_byte(int r, int c) { const int st = (r >> 4) * 2 + (c >> 5), rr = r & 15, cc = c & 31, ob = rr * 64 + cc * 2; return st * 1024 + (ob ^ (((ob >> 9) & 1) << 5)); }
__host__ __device__ __forceinline__ void stage_rc(int b, int& R, int& C) { const int st = b / 1024, sb = b % 1024, swz = sb ^ (((sb >> 9) & 1) << 5); R = (st >> 1) * 16 + swz / 64; C = (st & 1) * 32 + (swz % 64) / 2; }
__host__ __device__ __forceinline__ int perm32(int rho) { const int n = rho >> 4, i = rho & 15; return 8 * (i >> 2) + 4 * n + (i & 3); }
struct Unit { const char* A; const char* B0; const char* B1; int x0, x1, x2, x3, x4; };
__device__ __forceinline__ unsigned cvt_pk_bf16(float lo, float hi) { unsigned r; asm volatile("v_cvt_pk_bf16_f32 %0, %1, %2" : "=v"(r) : "v"(lo), "v"(hi)); return r; }

__device__ __forceinline__ const char* uni_ptr(const char* p) { const unsigned long long v = (unsigned long long)p; const unsigned lo = __builtin_amdgcn_readfirstlane((unsigned)v), hi = __builtin_amdgcn_readfirstlane((unsigned)(v >> 32)); return (const char*)(((unsigned long long)hi << 32) | lo); }
__device__ __forceinline__ bool static_order(int nM, int nN, int G, int c, int i, int& pm, int& pn) {
    const int nwg = nM * nN; const long L = (long)i * G + c; if (L >= nwg) return false;
    int wgid = (int)L; { const int q = nwg / NXCD, r = nwg % NXCD, xcd = wgid % NXCD, off = wgid / NXCD; wgid = (xcd < r ? xcd * (q + 1) : r * (q + 1) + (xcd - r) * q) + off; }
    const int nig = WGM * nN, gid = wgid / nig, fm = gid * WGM, gsz = (nM - fm) < WGM ? (nM - fm) : WGM;
    pm = fm + ((wgid % nig) % gsz); pn = (wgid % nig) / gsz; return true;
}

template <class Pol>
__device__ __forceinline__ void gemm_phase(LAS unsigned char* lds, const Pol& P, const int K) {
    const int tid = threadIdx.x, wid = __builtin_amdgcn_readfirstlane(tid >> 6), lane = tid & 63, wr = wid >> 2, wc = wid & 3, fr = lane & 15, fq = lane >> 4;
    const int nt = K / BK;
    int R0, C0; stage_rc(tid * 16, R0, C0);
    const int Rb0 = Pol::PERM ? ((R0 & ~31) + perm32(R0 & 31)) : R0;
    const unsigned vB = (unsigned)(Rb0 * K + C0) * 2u;
    const size_t pstep = (size_t)64 * K * 2;
    const size_t kstep = (size_t)(BK * 2);
    const unsigned ldsw = (unsigned)wid * 1024u;
    const int aoff = lds_byte(wr * 64 + fr, fq * 8), boff = lds_byte(wc * 32 + fr, fq * 8);
#define PG8_SA(b, h) (((b) * 2 + (h)) * HTB)
#define PG8_SB(b, h) ((4 + (b) * 2 + (h)) * HTB)
#define PG8_STAGE_B(bufoff, gbase) do { _Pragma("unroll") for (int _i = 0; _i < 2; ++_i) \
        __builtin_amdgcn_global_load_lds((const unsigned*)(uni_ptr((const char*)(gbase) + _i * pstep) + vB), (LAS unsigned*)(lds + (bufoff) + ldsw + _i * 8192), 16, 0, 0); } while (0)
#define PG8_STAGE_A(bufoff, gbase, vo, h) do { _Pragma("unroll") for (int _i = 0; _i < 2; ++_i) { \
        if constexpr (Pol::GATHER) __builtin_amdgcn_global_load_lds((const unsigned*)(uni_ptr((const char*)(gbase)) + (vo)[h][_i]), (LAS unsigned*)(lds + (bufoff) + ldsw + _i * 8192), 16, 0, 0); \
        else __builtin_amdgcn_global_load_lds((const unsigned*)(uni_ptr((const char*)(gbase) + ((h) * 2 + _i) * pstep) + (vo)[0][0]), (LAS unsigned*)(lds + (bufoff) + ldsw + _i * 8192), 16, 0, 0); } } while (0)
#define PG8_LDA(dst, b, h) do { _Pragma("unroll") for (int m = 0; m < 4; ++m) _Pragma("unroll") for (int k = 0; k < 2; ++k) dst[m][k] = *(const LAS bf16x8*)(lds + PG8_SA(b, h) + aoff + m * 2048 + k * 1024); } while (0)
#define PG8_LDB(dst, b, h) do { _Pragma("unroll") for (int n = 0; n < 2; ++n) _Pragma("unroll") for (int k = 0; k < 2; ++k) dst[n][k] = *(const LAS bf16x8*)(lds + PG8_SB(b, h) + boff + n * 2048 + k * 1024); } while (0)
#define PG8_MMA(ai, bj, At, Bt) do { __builtin_amdgcn_s_setprio(1); _Pragma("unroll") for (int m = 0; m < 4; ++m) _Pragma("unroll") for (int n = 0; n < 2; ++n) _Pragma("unroll") for (int k = 0; k < 2; ++k) \
        acc[ai][bj][m][n] = __builtin_amdgcn_mfma_f32_16x16x32_bf16(Bt[n][k], At[m][k], acc[ai][bj][m][n], 0, 0, 0); __builtin_amdgcn_s_setprio(0); } while (0)
#define PG8_WAIT_V(n) asm volatile("s_waitcnt vmcnt(" #n ")" ::: "memory")
#define PG8_WAIT_L(n) asm volatile("s_waitcnt lgkmcnt(" #n ")" ::: "memory")
#define PG8_BAR __builtin_amdgcn_s_barrier()
#define PG8_SCHED __builtin_amdgcn_sched_barrier(0)
    Unit cur, nxt; int ui = 0;
    if (!P.next(0, cur)) return;
    f32x4 acc[2][2][4][2];
#pragma unroll
    for (int a = 0; a < 2; ++a)
#pragma unroll
        for (int b = 0; b < 2; ++b)
#pragma unroll
            for (int m = 0; m < 4; ++m)
#pragma unroll
                for (int n = 0; n < 2; ++n) acc[a][b][m][n] = (f32x4){0.f, 0.f, 0.f, 0.f};
    bf16x8 At[4][2], B0[2][2], B1[2][2];
    unsigned vAc[2][2], vAn[2][2];
    if constexpr (Pol::GATHER) { P.rows_issue(cur, R0, vAc); P.rows_finish(C0, K, vAc); }
    else { vAc[0][0] = (unsigned)(R0 * K + C0) * 2u; vAc[0][1] = vAc[1][0] = vAc[1][1] = 0u; }
    asm volatile("s_waitcnt vmcnt(0)" ::: "memory");
    PG8_STAGE_B(PG8_SB(0, 0), cur.B0); PG8_STAGE_B(PG8_SB(0, 1), cur.B1); PG8_STAGE_A(PG8_SA(0, 0), cur.A, vAc, 0); PG8_STAGE_A(PG8_SA(0, 1), cur.A, vAc, 1);
    if (wr == 1) PG8_BAR;
    PG8_WAIT_V(2); PG8_BAR;
    PG8_STAGE_B(PG8_SB(1, 0), cur.B0 + kstep); PG8_STAGE_A(PG8_SA(1, 0), cur.A + kstep, vAc, 0); PG8_STAGE_B(PG8_SB(1, 1), cur.B1 + kstep);
    PG8_WAIT_V(6); PG8_BAR;
    for (;;) {
        const bool has_next = P.next(ui + 1, nxt);
        if (!has_next) nxt = cur;
        for (int t = 0; t < nt; t += 2) {
            const bool last = (t == nt - 2);
            if constexpr (Pol::GATHER) {
                if (t == nt - 4) { if (has_next) P.rows_issue(nxt, R0, vAn); }
                if (last && has_next) { vAc[0][0] = (vAn[0][0] * (unsigned)K + (unsigned)C0) * 2u; vAc[0][1] = (vAn[0][1] * (unsigned)K + (unsigned)C0) * 2u; }
            }
            const char* a1 = cur.A + (size_t)(t + 1) * kstep;
            const char* a2 = last ? nxt.A : cur.A + (size_t)(t + 2) * kstep;
            const char* b20 = last ? nxt.B0 : cur.B0 + (size_t)(t + 2) * kstep; const char* b21 = last ? nxt.B1 : cur.B1 + (size_t)(t + 2) * kstep;
            const char* a3 = a2 + kstep; const char* b30 = b20 + kstep; const char* b31 = b21 + kstep;
            PG8_LDB(B0, 0, 0); PG8_LDB(B1, 0, 1); PG8_SCHED; PG8_LDA(At, 0, 0); PG8_STAGE_A(PG8_SA(1, 1), a1, vAc, 1);
            if constexpr (Pol::GATHER) { if (last && has_next) { vAc[1][0] = (vAn[1][0] * (unsigned)K + (unsigned)C0) * 2u; vAc[1][1] = (vAn[1][1] * (unsigned)K + (unsigned)C0) * 2u; } }
            PG8_WAIT_V(8); PG8_WAIT_L(0); PG8_BAR; PG8_MMA(0, 0, At, B0); PG8_MMA(0, 1, At, B1); PG8_BAR; PG8_SCHED;
            PG8_LDA(At, 0, 1); PG8_STAGE_B(PG8_SB(0, 0), b20); PG8_STAGE_B(PG8_SB(0, 1), b21); PG8_STAGE_A(PG8_SA(0, 0), a2, vAc, 0);
            PG8_WAIT_V(8); PG8_WAIT_L(0); PG8_BAR; PG8_MMA(1, 0, At, B0); PG8_MMA(1, 1, At, B1); PG8_BAR; PG8_SCHED;
            PG8_LDB(B0, 1, 0); PG8_LDB(B1, 1, 1); PG8_SCHED; PG8_LDA(At, 1, 0); PG8_STAGE_A(PG8_SA(0, 1), a2, vAc, 1);
            PG8_WAIT_V(8); PG8_WAIT_L(0); PG8_BAR; PG8_MMA(0, 0, At, B0); PG8_MMA(0, 1, At, B1); PG8_BAR; PG8_SCHED;
            PG8_LDA(At, 1, 1); PG8_STAGE_B(PG8_SB(1, 0), b30); PG8_STAGE_B(PG8_SB(1, 1), b31); PG8_STAGE_A(PG8_SA(1, 0), a3, vAc, 0);
            PG8_WAIT_V(8); PG8_WAIT_L(0); PG8_BAR; PG8_MMA(1, 0, At, B0); PG8_MMA(1, 1, At, B1); PG8_BAR; PG8_SCHED;
        }
        if (wr == 0) PG8_BAR;
        P.epi(acc, cur, wr, wc, fr, fq);
        if (!has_next) break;
#pragma unroll
        for (int a = 0; a < 2; ++a)
#pragma unroll
            for (int b = 0; b < 2; ++b)
#pragma unroll
                for (int m = 0; m < 4; ++m)
#pragma unroll
                    for (int n = 0; n < 2; ++n) acc[a][b][m][n] = (f32x4){0.f, 0.f, 0.f, 0.f};
        cur = nxt; ++ui;
        if (wr == 1) PG8_BAR;
    }
    PG8_WAIT_V(0);
    PG8_BAR;
#undef PG8_SA
#undef PG8_SB
#undef PG8_STAGE_A
#undef PG8_STAGE_B
#undef PG8_LDA
#undef PG8_LDB
#undef PG8_MMA
#undef PG8_WAIT_V
#undef PG8_WAIT_L
#undef PG8_BAR
#undef PG8_SCHED
}
}

struct PolP1 {
    static constexpr bool PERM = true, GATHER = false;
    const bf16_t* A; const bf16_t* Bt; bf16_t* PR; bf16_t* PA; int G, c;
    __device__ __forceinline__ bool next(int i, pg8::Unit& u) const { int pm, pn; if (!pg8::static_order(T / 256, IN_WP / 256, G, c, i, pm, pn)) return false;
        u.A = (const char*)(A + (size_t)pm * 256 * D); u.B0 = (const char*)(Bt + (size_t)pn * 256 * D); u.B1 = u.B0 + (size_t)128 * D * 2; u.x0 = pm; u.x1 = pn; u.x2 = 0; u.x3 = 0; u.x4 = 0; return true; }
    __device__ __forceinline__ void epi(const f32x4 (&acc)[2][2][4][2], const pg8::Unit& u, int wr, int wc, int fr, int fq) const {
        const int row0 = u.x0 * 256 + wr * 64 + fr;
#pragma unroll
        for (int bj = 0; bj < 2; ++bj) { const int col = u.x1 * 256 + bj * 128 + wc * 32 + 8 * fq;
            bf16_t* base; int pitch; float sc = 1.f;
            if (col < RWKV_IN) { base = PR + col; pitch = RWKV_IN; }
            else { const int ca = col - RWKV_IN; base = PA + ca; pitch = PA_W; sc = (ca < AW || (ca >= 3 * AW && ca < 3 * AW + MW)) ? 0.125f : 1.f; }
#pragma unroll
            for (int ai = 0; ai < 2; ++ai)
#pragma unroll
                for (int m = 0; m < 4; ++m) { const f32x4 v0 = acc[ai][bj][m][0] * sc, v1 = acc[ai][bj][m][1] * sc;
                    u32x4 w; w.x = pg8::cvt_pk_bf16(v0[0], v0[1]); w.y = pg8::cvt_pk_bf16(v0[2], v0[3]); w.z = pg8::cvt_pk_bf16(v1[0], v1[1]); w.w = pg8::cvt_pk_bf16(v1[2], v1[3]);
                    *(u32x4*)(base + (size_t)(row0 + ai * 128 + m * 16) * pitch) = w; } }
    }
};
__device__ __forceinline__ void phase1(const Params& p, LAS unsigned char* lds) {
    unsigned char* ws = p.ws;
    { PolP1 P{(const bf16_t*)(ws + WS_H0B), (const bf16_t*)(ws + WS_WT_IN), (bf16_t*)(ws + WS_PR), (bf16_t*)(ws + WS_PA), (int)gridDim.x, (int)blockIdx.x};
      pg8::gemm_phase(lds, P, D); }
    constexpr int U_KV = (BATCH * NMEM / 128) * (2 * MW / 128);
    for (int u = blockIdx.x; u < U_KV; u += gridDim.x) {
        const int pn = u % 4, pm = u / 4, r0 = pm * 128, c0 = pn * 128;
        const bf16_t* MB = (const bf16_t*)(ws + WS_MEMB); const bf16_t* WK = (const bf16_t*)(ws + WS_WT_KV); bf16_t* KVM = (bf16_t*)(ws + WS_KVM);
        sgemm_tile(D, [&](int r) { return MB + (size_t)(r0 + r) * D; }, [&](int c) { return WK + (size_t)(c0 + c) * D; },
            [&](int r, int c, f32x4 v, int) { u32x2 o; o.x = pk2(v.x, v.y); o.y = pk2(v.z, v.w); *(u32x2*)(KVM + (size_t)(r0 + r) * (2 * MW) + c0 + c) = o; });
    }
}

constexpr int P2_AP = 200;
__device__ __forceinline__ f32x4 p2_shift(const bf16_t* cur, int po, int no, float pm, float nm, const float* mu) {
    const u32x2 c = *(const u32x2*)cur, pv = *(const u32x2*)(cur + po), nv = *(const u32x2*)(cur + no);
    const f32x4 m = *(const f32x4*)mu;
    const f32x4 cc = {bflo(c.x), bfhi(c.x), bflo(c.y), bfhi(c.y)}, pp = {bflo(pv.x), bfhi(pv.x), bflo(pv.y), bfhi(pv.y)}, nn = {bflo(nv.x), bfhi(nv.x), bflo(nv.y), bfhi(nv.y)};
    return cc + m * (0.5f * (pp * pm + nn * nm) - cc);
}
__device__ __forceinline__ void phase2(const Params& p, LAS unsigned char* lds) {
    const int tid = threadIdx.x, lane = tid & 63, wave = tid >> 6, fr = lane & 15, fq = lane >> 4;
    unsigned char* ws = p.ws;
    const bf16_t* PR = (const bf16_t*)(ws + WS_PR);
    const float* mu = p.in[5];
    const bf16_t* WU = (const bf16_t*)(ws + WS_LORA); const bf16_t* AU = WU + 2 * RC * 32; const bf16_t* GU = AU + 2 * RC * 32;
    LAS bf16_t* ACT = (LAS bf16_t*)(lds + wave * (16 * P2_AP * 2));
    float* SSH = (float*)(ws + WS_SSH); float* SDIR = (float*)(ws + WS_SDIR);
    bf16_t* G = (bf16_t*)((unsigned char*)p.out + DO_G); float* BON = (float*)(ws + WS_BONUS);
    for (int tile = blockIdx.x * NWAVES + wave; tile < T / 16; tile += gridDim.x * NWAVES) {
        const int t0 = tile * 16;
#pragma unroll 4
        for (int i = 0; i < 12; ++i) { const int grp = lane + 64 * i, tok = grp / 48, c4 = (grp % 48) * 4, t = t0 + tok, sq = t & (SEQ - 1);
            f32x4 v = p2_shift(PR + (size_t)t * RWKV_IN + 3 * RC + c4, sq > 0 ? -RWKV_IN : 0, sq < SEQ - 1 ? RWKV_IN : 0, sq > 0 ? 1.f : 0.f, sq < SEQ - 1 ? 1.f : 0.f, mu + 3 * RC + c4);
            { const float sc = c4 < 64 ? 1.f : 2.f, mul = c4 < 64 ? 1.f : 2.f, add = c4 < 64 ? 0.f : -1.f; const bool raw = c4 >= 128;
#pragma unroll
              for (int e = 0; e < 4; ++e) { const float a = sigmoidf_(sc * v[e]) * mul + add; v[e] = raw ? v[e] : a; } }
            u32x2 o; o.x = pk2(v.x, v.y); o.y = pk2(v.z, v.w); *(LAS u32x2*)(ACT + tok * P2_AP + c4) = o; }
        asm volatile("s_waitcnt lgkmcnt(0)" ::: "memory");
        const int t = t0 + fr, sq = t & (SEQ - 1), b = t >> 11; const int po = sq > 0 ? -RWKV_IN : 0, no = sq < SEQ - 1 ? RWKV_IN : 0; const float pm = sq > 0 ? 1.f : 0.f, nm = sq < SEQ - 1 ? 1.f : 0.f;
        const bf16_t* prow = PR + (size_t)t * RWKV_IN;
        const bf16x8 bsg0 = *(const LAS bf16x8*)(ACT + fr * P2_AP + 8 * fq), bsg1 = *(const LAS bf16x8*)(ACT + fr * P2_AP + 32 + 8 * fq);
        const bf16x8 btw0 = *(const LAS bf16x8*)(ACT + fr * P2_AP + 64 + 8 * fq), btw1 = *(const LAS bf16x8*)(ACT + fr * P2_AP + 96 + 8 * fq);
        const bf16x8 bal0 = *(const LAS bf16x8*)(ACT + fr * P2_AP + 128 + 8 * fq), bal1 = *(const LAS bf16x8*)(ACT + fr * P2_AP + 160 + 8 * fq);
#pragma unroll 1
        for (int h = 0; h < RH; ++h) {
            f32x4 kp[4]; float ss = 0.f;
#pragma unroll
            for (int ct = 0; ct < 4; ++ct) { const int ch = h * 64 + 16 * ct + 4 * fq; kp[ct] = p2_shift(prow + RC + ch, po, no, pm, nm, mu + RC + ch);
                const f32x4 kkv = kp[ct] * *(const f32x4*)(p.in[11] + ch); ss += (kkv.x * kkv.x + kkv.y * kkv.y) + (kkv.z * kkv.z + kkv.w * kkv.w); }
            ss += __shfl_xor(ss, 16); ss += __shfl_xor(ss, 32);
            const float rn = 1.f / fmaxf(sqrtf(ss), 1e-12f);
            float bon = 0.f;
            unsigned char* shrec = (unsigned char*)SSH + ((size_t)(b * RH + h) * SEQ + sq) * 384;
            unsigned char* d0rec = (unsigned char*)SDIR + ((size_t)((0 * BATCH + b) * RH + h) * SEQ + sq) * 512; unsigned char* d1rec = (unsigned char*)SDIR + ((size_t)((1 * BATCH + b) * RH + h) * SEQ + sq) * 512;
#pragma unroll
            for (int ct = 0; ct < 4; ++ct) { const int ch = h * 64 + 16 * ct + 4 * fq, cl = 16 * ct + 4 * fq;
                const f32x4 r = p2_shift(prow + ch, po, no, pm, nm, mu + ch), v = p2_shift(prow + 2 * RC + ch, po, no, pm, nm, mu + 2 * RC + ch), k = kp[ct];
                const bf16_t* wrow = WU + (size_t)(h * 64 + 16 * ct + fr) * 32 + 8 * fq; const bf16_t* arow = AU + (size_t)(h * 64 + 16 * ct + fr) * 32 + 8 * fq;
                const bf16_t* grow = GU + (size_t)(h * 64 + 16 * ct + fr) * 64 + 8 * fq;
                const f32x4 z = {0.f, 0.f, 0.f, 0.f};
                const f32x4 wl0 = __builtin_amdgcn_mfma_f32_16x16x32_bf16(*(const bf16x8*)wrow, btw0, z, 0, 0, 0);
                const f32x4 wl1 = __builtin_amdgcn_mfma_f32_16x16x32_bf16(*(const bf16x8*)(wrow + RC * 32), btw1, z, 0, 0, 0);
                const f32x4 al0 = __builtin_amdgcn_mfma_f32_16x16x32_bf16(*(const bf16x8*)arow, bal0, z, 0, 0, 0);
                const f32x4 al1 = __builtin_amdgcn_mfma_f32_16x16x32_bf16(*(const bf16x8*)(arow + RC * 32), bal1, z, 0, 0, 0);
                f32x4 gg = __builtin_amdgcn_mfma_f32_16x16x32_bf16(*(const bf16x8*)grow, bsg0, z, 0, 0, 0);
                gg = __builtin_amdgcn_mfma_f32_16x16x32_bf16(*(const bf16x8*)(grow + 32), bsg1, gg, 0, 0, 0);
                const f32x4 w00 = *(const f32x4*)(p.in[6] + ch), w01 = *(const f32x4*)(p.in[6] + RC + ch), a00 = *(const f32x4*)(p.in[8] + ch), a01 = *(const f32x4*)(p.in[8] + RC + ch);
                const f32x4 kkw = *(const f32x4*)(p.in[11] + ch), kaw = *(const f32x4*)(p.in[12] + ch), rkw = *(const f32x4*)(p.in[13] + ch);
                f32x4 dec0, dec1, kd0, kd1, bb0, bb1, kkn;
#pragma unroll
                for (int e = 0; e < 4; ++e) {
                    dec0[e] = __expf(-0.6065306597126334f * sigmoidf_(w00[e] + wl0[e])); dec1[e] = __expf(-0.6065306597126334f * sigmoidf_(w01[e] + wl1[e]));
                    const float a0 = sigmoidf_(a00[e] + al0[e]), a1 = sigmoidf_(a01[e] + al1[e]);
                    kkn[e] = k[e] * kkw[e] * rn; kd0[e] = k[e] * (1.f + (a0 - 1.f) * kaw[e]); kd1[e] = k[e] * (1.f + (a1 - 1.f) * kaw[e]);
                    bb0[e] = kkn[e] * a0; bb1[e] = kkn[e] * a1; bon += r[e] * (kd0[e] + kd1[e]) * rkw[e]; }
                { u32x2 o; o.x = pk2(r.x, r.y); o.y = pk2(r.z, r.w); *(u32x2*)(shrec + cl * 2) = o; o.x = pk2(v.x, v.y); o.y = pk2(v.z, v.w); *(u32x2*)(shrec + 128 + cl * 2) = o;
                  o.x = pk2(kkn.x, kkn.y); o.y = pk2(kkn.z, kkn.w); *(u32x2*)(shrec + 256 + cl * 2) = o;
                  *(f32x4*)(d0rec + cl * 4) = dec0; o.x = pk2(kd0.x, kd0.y); o.y = pk2(kd0.z, kd0.w); *(u32x2*)(d0rec + 256 + cl * 2) = o; o.x = pk2(bb0.x, bb0.y); o.y = pk2(bb0.z, bb0.w); *(u32x2*)(d0rec + 384 + cl * 2) = o;
                  *(f32x4*)(d1rec + cl * 4) = dec1; o.x = pk2(kd1.x, kd1.y); o.y = pk2(kd1.z, kd1.w); *(u32x2*)(d1rec + 256 + cl * 2) = o; o.x = pk2(bb1.x, bb1.y); o.y = pk2(bb1.z, bb1.w); *(u32x2*)(d1rec + 384 + cl * 2) = o; }
                u32x2 go; go.x = pk2(gg.x, gg.y); go.y = pk2(gg.z, gg.w); *(u32x2*)(G + (size_t)t * RC + ch) = go;
            }
            bon += __shfl_xor(bon, 16); bon += __shfl_xor(bon, 32);
            if (fq == 0) BON[t * RH + h] = bon;
        }
    }
}

constexpr int SC_TC = 16;
constexpr int SC_STEPB = 1408;
constexpr int SC_BUFB = SC_TC * SC_STEPB;
struct ScanProd { const unsigned char* gsrc; long gstep; int ldst; int conv; };
__device__ __forceinline__ ScanProd scan_prod_init(const unsigned char* sh, const unsigned char* dr, int dir, int ptid) {
    ScanProd P; const int wi = ptid % 56, st0 = ptid / 56; const unsigned char* src; int shift = 0; bool fromsh = false;
    if (wi < 16) { src = dr + wi * 16; P.ldst = wi * 16; P.conv = 0; }
    else if (wi < 24) { src = dr + 256 + (wi - 16) * 16; P.ldst = 512 + (wi - 16) * 32; P.conv = 1; }
    else if (wi < 32) { src = dr + 384 + (wi - 24) * 16; P.ldst = 256 + (wi - 24) * 32; P.conv = 1; }
    else if (wi < 40) { src = sh + 128 + (wi - 32) * 16; P.ldst = 768 + (wi - 32) * 32; P.conv = 1; fromsh = true; }
    else if (wi < 48) { src = sh + 256 + (wi - 40) * 16; P.ldst = 1024 + (wi - 40) * 16; P.conv = 0; fromsh = true; }
    else { src = sh + (wi - 48) * 16; P.ldst = 1152 + (wi - 48) * 16; P.conv = 0; shift = 1; fromsh = true; }
    const long rec = fromsh ? 384 : 512;
    const long t0 = dir ? (long)(SEQ - 1 - (st0 - shift)) : (long)(st0 - shift);
    P.gsrc = src + t0 * rec; P.gstep = dir ? -rec : rec; P.ldst += st0 * SC_STEPB; return P;
}
__device__ __forceinline__ void scan_fetch(const ScanProd& P, int c, u32x4 (&reg)[SC_TC / 4]) {
    const unsigned char* g = P.gsrc + (long)(c * SC_TC) * P.gstep;
#pragma unroll
    for (int q = 0; q < SC_TC / 4; ++q) reg[q] = *(const u32x4*)(g + (long)(4 * q) * P.gstep);
}
__device__ __forceinline__ void scan_put(const ScanProd& P, LAS unsigned char* buf, const u32x4 (&reg)[SC_TC / 4]) {
    LAS unsigned char* d = buf + P.ldst;
    if (P.conv) {
#pragma unroll
        for (int q = 0; q < SC_TC / 4; ++q) { const u32x4 x = reg[q];
            *(LAS f32x4*)(d + 4 * q * SC_STEPB) = (f32x4){bflo(x.x), bfhi(x.x), bflo(x.y), bfhi(x.y)}; *(LAS f32x4*)(d + 4 * q * SC_STEPB + 16) = (f32x4){bflo(x.z), bfhi(x.z), bflo(x.w), bfhi(x.w)}; }
    } else {
#pragma unroll
        for (int q = 0; q < SC_TC / 4; ++q) *(LAS u32x4*)(d + 4 * q * SC_STEPB) = reg[q];
    }
}
__device__ __forceinline__ void scan_block(const Params& p, LAS unsigned char* lds, int sid) {
    const int tid = threadIdx.x, lane = tid & 63, wave = tid >> 6;
    const int dir = sid / (BATCH * RH), bh = sid % (BATCH * RH), b = bh / RH, h = bh % RH;
    const unsigned char* sh = p.ws + WS_SSH + (size_t)bh * SEQ * 384;
    const unsigned char* dr = p.ws + WS_SDIR + (size_t)(dir * BATCH * RH + bh) * SEQ * 512;
    float* Y = (float*)((unsigned char*)p.out + DO_Y) + (size_t)dir * T * RC;
    LAS unsigned char* buf0 = lds; LAS unsigned char* buf1 = lds + SC_BUFB;
    constexpr int NCH = SEQ / SC_TC;
    __syncthreads();
    for (int i = tid; i < 2 * SC_TC * 32; i += NTHR) { const int st = i >> 5, e = i & 31; *(LAS unsigned*)(lds + st * SC_STEPB + 1280 + e * 4) = 0u; }
    const ScanProd SP = scan_prod_init(sh, dr, dir, (tid - 256) & 255);
    const bool prod = wave >= 4 && tid - 256 < 224;
    u32x4 preg[SC_TC / 4];
    if (prod) { scan_fetch(SP, 0, preg); scan_put(SP, buf0, preg); scan_fetch(SP, 1, preg); }
    __syncthreads();
    const int fr = lane & 15, fq = lane >> 4, sel = (fr & 3) < 2 ? (fr & 3) : 2;
    float s[16];
#pragma unroll
    for (int j = 0; j < 16; ++j) s[j] = 0.f;
    bf16x8 sb0 = (bf16x8){0, 0, 0, 0, 0, 0, 0, 0}, sb1 = sb0;
    float* yrow = Y + (size_t)b * SEQ * RC + h * 64 + 16 * wave + fr;
    float yk = 0.f;
    for (int c = 0; c < NCH; ++c) {
        LAS unsigned char* cur = (c & 1) ? buf1 : buf0; LAS unsigned char* nxt = (c & 1) ? buf0 : buf1;
        if (wave >= 4) {
            if (prod && c + 1 < NCH) { scan_put(SP, nxt, preg); if (c + 2 < NCH) scan_fetch(SP, c + 2, preg); }
        } else {
            const LAS unsigned char* cb = cur + fq * 32;
            const LAS unsigned char* ab = cur + 1024 + 128 * sel + fq * 16;
            const LAS unsigned char* vb = cur + 768 + (16 * wave + fr) * 4;
            bf16x8 cA0, cA1, nA0, nA1; f32x4 cW[4], cK[4], cB[4], nW[4], nK[4], nB[4]; float cV, nV;
#define SC_LOAD(A0, A1, W, K, B, V, st) do { const LAS unsigned char* q_ = cb + (st) * SC_STEPB; \
                A0 = *(const LAS bf16x8*)(ab + (st) * SC_STEPB); A1 = *(const LAS bf16x8*)(ab + (st) * SC_STEPB + 64); \
                W[0] = *(const LAS f32x4*)(q_); W[1] = *(const LAS f32x4*)(q_ + 16); W[2] = *(const LAS f32x4*)(q_ + 128); W[3] = *(const LAS f32x4*)(q_ + 144); \
                K[0] = *(const LAS f32x4*)(q_ + 512); K[1] = *(const LAS f32x4*)(q_ + 528); K[2] = *(const LAS f32x4*)(q_ + 640); K[3] = *(const LAS f32x4*)(q_ + 656); \
                B[0] = *(const LAS f32x4*)(q_ + 256); B[1] = *(const LAS f32x4*)(q_ + 272); B[2] = *(const LAS f32x4*)(q_ + 384); B[3] = *(const LAS f32x4*)(q_ + 400); \
                V = *(const LAS float*)(vb + (st) * SC_STEPB); } while (0)
            SC_LOAD(cA0, cA1, cW, cK, cB, cV, 0);
#pragma unroll 1
            for (int g = 0; g < SC_TC / 4; ++g) {
#pragma unroll
                for (int u = 0; u < 4; ++u) {
                    const int st = 4 * g + u;
                    f32x4 d = (f32x4){0.f, 0.f, 0.f, 0.f};
                    d = __builtin_amdgcn_mfma_f32_16x16x32_bf16(cA0, sb0, d, 0, 0, 0);
                    d = __builtin_amdgcn_mfma_f32_16x16x32_bf16(cA1, sb1, d, 0, 0, 0);
                    if (st + 1 < SC_TC) SC_LOAD(nA0, nA1, nW, nK, nB, nV, st + 1);
#define OPQ(x) asm("" : "+v"(x))
                    float tt[16];
#pragma unroll
                    for (int j = 0; j < 16; ++j) { tt[j] = cV * cK[j >> 2][j & 3]; OPQ(tt[j]); }
#pragma unroll
                    for (int j = 0; j < 16; ++j) { tt[j] = s[j] * cW[j >> 2][j & 3] + tt[j]; OPQ(tt[j]); }
                    const float nsa = -d[0];
                    yk = (((u + 3) & 3) == fq) ? d[1] : yk;
                    if (u == 0) {
                        const int tau = c * SC_TC + 4 * g - 4 + fq;
                        if (tau >= 0) { const int t = dir ? (SEQ - 1 - tau) : tau; yrow[(size_t)t * RC] = yk; } }
#pragma unroll
                    for (int j = 0; j < 16; ++j) { s[j] = nsa * cB[j >> 2][j & 3] + tt[j]; OPQ(s[j]); }
#undef OPQ
                    u32x4 p0, p1;
                    p0.x = pg8::cvt_pk_bf16(s[0], s[1]); p0.y = pg8::cvt_pk_bf16(s[2], s[3]); p0.z = pg8::cvt_pk_bf16(s[4], s[5]); p0.w = pg8::cvt_pk_bf16(s[6], s[7]);
                    p1.x = pg8::cvt_pk_bf16(s[8], s[9]); p1.y = pg8::cvt_pk_bf16(s[10], s[11]); p1.z = pg8::cvt_pk_bf16(s[12], s[13]); p1.w = pg8::cvt_pk_bf16(s[14], s[15]);
                    sb0 = __builtin_bit_cast(bf16x8, p0); sb1 = __builtin_bit_cast(bf16x8, p1);
                    cA0 = nA0; cA1 = nA1; cV = nV;
#pragma unroll
                    for (int i = 0; i < 4; ++i) { cW[i] = nW[i]; cK[i] = nK[i]; cB[i] = nB[i]; }
                    asm volatile("" ::: "memory");
                }
            }
#undef SC_LOAD
        }
        __syncthreads();
    }
    if (wave < 4) {
        if (fq < 3) { const int tau = SEQ - 4 + fq, t = dir ? (SEQ - 1 - tau) : tau; yrow[(size_t)t * RC] = yk; }
        const int t = dir ? 0 : (SEQ - 1); const bf16_t* rr = (const bf16_t*)(sh + (size_t)t * 384);
        float acc = 0.f;
#pragma unroll
        for (int j = 0; j < 8; ++j) { acc += bf2f((unsigned)(unsigned short)sb0[j]) * bf2f(rr[8 * fq + j]); acc += bf2f((unsigned)(unsigned short)sb1[j]) * bf2f(rr[32 + 8 * fq + j]); }
        acc += __shfl_xor(acc, 16); acc += __shfl_xor(acc, 32);
        if (fq == 0) yrow[(size_t)t * RC] = acc;
    }
    __syncthreads();
}

constexpr int AT_P = 72;
constexpr int AT_KOFF = 0, AT_VOFF = 256 * AT_P * 2;
constexpr int ATT_DIL_UNITS = BATCH * AH * 48;
constexpr int ATT_MEM_UNITS = BATCH * MH * 16;
constexpr int ATT_UNITS = ATT_DIL_UNITS + ATT_MEM_UNITS;
struct AttU { const bf16_t* q; const bf16_t* k; const bf16_t* v; long qs, ks; int kind, win0, L, dil; float slope; bf16_t* o; long os; float* lse; long ls; };
__device__ __forceinline__ void att_make_unit(const Params& p, int u, AttU& U) {
    unsigned char* ws = p.ws; const bf16_t* PA = (const bf16_t*)(ws + WS_PA);
    if (u < ATT_DIL_UNITS) {
        const int bh = u / 48, x = u % 48, b = bh / AH, h = bh % AH, br = x >> 4, y = x & 15;
        const int dil = br == 0 ? 1 : (br == 1 ? 4 : 16), L = SEQ / dil, npr = L / 128, r = y / npr, np = y % npr;
        const bf16_t* base = PA + (size_t)(b * SEQ + r) * PA_W + h * 64;
        U.kind = 0; U.win0 = (2 * np - 1) * 64; U.L = L; U.dil = dil; U.slope = exp2f(-8.f * (float)(h + 1) / (float)AH);
        U.qs = (long)dil * PA_W; U.ks = U.qs;
        U.q = base + (long)(np * 128) * U.qs; U.k = base + AW; U.v = base + 2 * AW;
        const size_t tok0 = (size_t)(b * SEQ + r) + (size_t)np * 128 * dil;
        U.o = (bf16_t*)(ws + WS_ATTO) + (size_t)br * T * AW + tok0 * AW + h * 64; U.os = (long)dil * AW;
        U.lse = (float*)((unsigned char*)p.out + DO_LSE) + (size_t)br * T * AH + tok0 * AH + h; U.ls = (long)dil * AH;
    } else {
        const int v = u - ATT_DIL_UNITS, bh = v >> 4, qb = v & 15, b = bh / MH, h = bh % MH;
        const bf16_t* KVM = (const bf16_t*)(ws + WS_KVM);
        U.kind = 1; U.win0 = 0; U.L = NMEM; U.dil = 1; U.slope = 0.f;
        U.q = PA + (size_t)(b * SEQ + qb * 128) * PA_W + 3 * AW + h * 64; U.qs = PA_W;
        U.k = KVM + (size_t)(b * NMEM) * (2 * MW) + h * 64; U.v = U.k + MW; U.ks = 2 * MW;
        U.o = (bf16_t*)(ws + WS_YMIX) + (size_t)(b * SEQ + qb * 128) * D + RC + AW + h * 64; U.os = D;
        U.lse = nullptr; U.ls = 0;
    }
}
__device__ __forceinline__ void att_fetch(const AttU& U, u32x4 (&reg)[8], int tid) {
#pragma unroll
    for (int q = 0; q < 8; ++q) { const int rem = (tid + NTHR * q) & 2047, row = rem >> 3, ch = rem & 7; const int lk = U.win0 + row; const bool ok = lk >= 0 && lk < U.L;
        const bf16_t* src = (q < 4 ? U.k : U.v) + (long)(ok ? lk : 0) * U.ks + ch * 8;
        u32x4 raw = *(const u32x4*)src; if (!ok) raw = (u32x4){0u, 0u, 0u, 0u}; reg[q] = raw; }
}
__device__ __forceinline__ void att_put(LAS unsigned char* lds, const u32x4 (&reg)[8], int tid) {
#pragma unroll
    for (int q = 0; q < 8; ++q) { const int rem = (tid + NTHR * q) & 2047, row = rem >> 3, ch = rem & 7;
        *(LAS u32x4*)(lds + (q < 4 ? AT_KOFF : AT_VOFF) + row * (AT_P * 2) + ch * 16) = reg[q]; }
}
typedef short v4i16_t __attribute__((ext_vector_type(4)));
template <int NT  , bool DIL>
__device__ __forceinline__ void att_compute(const AttU& U, LAS unsigned char* lds, int w, int lane) {
    const int fr = lane & 15, fq = lane >> 4;
    const bf16_t* qp = U.q + (long)(16 * w + fr) * U.qs + fq * 8;
    const bf16x8 q0 = *(const bf16x8*)qp, q1 = *(const bf16x8*)(qp + 32);
    f32x4 sT[NT];
#pragma unroll
    for (int i = 0; i < NT; ++i) {
        if (DIL && i == 9) { sT[i] = (f32x4){-1e30f, -1e30f, -1e30f, -1e30f}; continue; }
        int tt = DIL ? w + i : i; tt = tt > 15 ? 15 : tt;
        const LAS unsigned char* kp = lds + AT_KOFF + (16 * tt + fr) * (AT_P * 2) + fq * 16;
        const bf16x8 k0 = *(const LAS bf16x8*)kp, k1 = *(const LAS bf16x8*)(kp + 64);
        f32x4 a = (f32x4){0.f, 0.f, 0.f, 0.f};
        a = __builtin_amdgcn_mfma_f32_16x16x32_bf16(k0, q0, a, 0, 0, 0);
        a = __builtin_amdgcn_mfma_f32_16x16x32_bf16(k1, q1, a, 0, 0, 0);
        sT[i] = a; if ((i & 3) == 3) asm volatile("" ::: "memory"); }
    float m = -3.0e38f;
    if (DIL) {
        const int c0 = 4 * fq - fr, lb = U.win0 + 16 * w + 4 * fq; const float sd = U.slope * (float)U.dil; const unsigned Lc = (unsigned)U.L;
#pragma unroll
        for (int i = 0; i < NT; ++i) { if (i == 9) continue;
#pragma unroll
            for (int r = 0; r < 4; ++r) { const int dl = 16 * i + r - 64 + c0, ad = dl < 0 ? -dl : dl;
                bool valid = (unsigned)(lb + 16 * i + r) < Lc; if (i == 0 || i >= 7) valid = valid && ad <= 64;
                const float sv = valid ? sT[i][r] - sd * (float)ad : -1e30f; sT[i][r] = sv; m = fmaxf(m, sv); } }
    } else {
#pragma unroll
        for (int i = 0; i < NT; ++i)
#pragma unroll
            for (int r = 0; r < 4; ++r) m = fmaxf(m, sT[i][r]);
    }
    m = fmaxf(m, __shfl_xor(m, 16)); m = fmaxf(m, __shfl_xor(m, 32));
    float l = 0.f;
#pragma unroll
    for (int i = 0; i < NT; ++i)
#pragma unroll
        for (int r = 0; r < 4; ++r) { const float e = __expf(sT[i][r] - m); sT[i][r] = e; l += e; }
    l += __shfl_xor(l, 16); l += __shfl_xor(l, 32);
    f32x4 oT[4];
#pragma unroll
    for (int dt = 0; dt < 4; ++dt) oT[dt] = (f32x4){0.f, 0.f, 0.f, 0.f};
#pragma unroll
    for (int tp = 0; tp < NT / 2; ++tp) {
        int ta = DIL ? w + 2 * tp : 2 * tp, tb = ta + 1; ta = ta > 15 ? 15 : ta; tb = tb > 15 ? 15 : tb;
        u32x4 pw; pw.x = pk2(sT[2 * tp][0], sT[2 * tp][1]); pw.y = pk2(sT[2 * tp][2], sT[2 * tp][3]); pw.z = pk2(sT[2 * tp + 1][0], sT[2 * tp + 1][1]); pw.w = pk2(sT[2 * tp + 1][2], sT[2 * tp + 1][3]);
        const bf16x8 pb = __builtin_bit_cast(bf16x8, pw);
        const LAS unsigned char* va = lds + AT_VOFF + (16 * ta + 4 * fq + (fr >> 2)) * (AT_P * 2) + 8 * (fr & 3);
        const LAS unsigned char* vb = lds + AT_VOFF + (16 * tb + 4 * fq + (fr >> 2)) * (AT_P * 2) + 8 * (fr & 3);
#pragma unroll
        for (int dt = 0; dt < 4; ++dt) {
            const v4i16_t lo = __builtin_amdgcn_ds_read_tr16_b64_v4i16((LAS v4i16_t*)(va + 32 * dt)), hi = __builtin_amdgcn_ds_read_tr16_b64_v4i16((LAS v4i16_t*)(vb + 32 * dt));
            bf16x8 vf; vf[0] = lo[0]; vf[1] = lo[1]; vf[2] = lo[2]; vf[3] = lo[3]; vf[4] = hi[0]; vf[5] = hi[1]; vf[6] = hi[2]; vf[7] = hi[3];
            oT[dt] = __builtin_amdgcn_mfma_f32_16x16x32_bf16(vf, pb, oT[dt], 0, 0, 0); }
        if (tp & 1) asm volatile("" ::: "memory");
    }
    const float inv = 1.f / l;
    bf16_t* op = U.o + (long)(16 * w + fr) * U.os;
#pragma unroll
    for (int dt = 0; dt < 4; ++dt) { u32x2 o; o.x = pk2(oT[dt][0] * inv, oT[dt][1] * inv); o.y = pk2(oT[dt][2] * inv, oT[dt][3] * inv); *(u32x2*)(op + 16 * dt + 4 * fq) = o; }
    if (DIL && fq == 0) U.lse[(long)(16 * w + fr) * U.ls] = m + __logf(l);
}
__device__ __forceinline__ void phase3(const Params& p, LAS unsigned char* lds, int rep) {
    const int tid = threadIdx.x, lane = tid & 63, wave = tid >> 6;
    unsigned* ctl = (unsigned*)(p.ws + WS_CTL);
    LAS unsigned* bc = (LAS unsigned*)(lds + 98304);
    for (;;) {
        __syncthreads();
        if (tid == 0) bc[0] = atomicAdd(ctl + CW_SCANQ + 16 * rep, 1u);
        __syncthreads();
        const unsigned sid = __builtin_amdgcn_readfirstlane(bc[0]);
        if (sid >= 2u * BATCH * RH) break;
#pragma unroll 1
        for (int tw = 0; tw < (REPEAT_PHASE == 31 ? 2 : 1); ++tw) scan_block(p, lds, (int)sid);
    }
    constexpr unsigned ATT_BATCH = 2;
    for (;;) {
        __syncthreads();
        if (tid == 0) bc[1] = atomicAdd(ctl + CW_ATTQ + 16 * rep, ATT_BATCH);
        __syncthreads();
        const unsigned ubase = __builtin_amdgcn_readfirstlane(bc[1]);
        if (ubase >= (unsigned)ATT_UNITS) break;
        const unsigned uend = ubase + ATT_BATCH < (unsigned)ATT_UNITS ? ubase + ATT_BATCH : (unsigned)ATT_UNITS;
        { AttU U; att_make_unit(p, (int)ubase, U); u32x4 reg[8]; att_fetch(U, reg, tid); att_put(lds, reg, tid); }
#pragma unroll 1
        for (unsigned ucur = ubase; ucur < uend; ++ucur) {
            __syncthreads();
            u32x4 reg[8];
            if (ucur + 1 < uend) { AttU Un; att_make_unit(p, (int)ucur + 1, Un); att_fetch(Un, reg, tid); }
            { AttU U; att_make_unit(p, (int)ucur, U);
#pragma unroll 1
              for (int tw = 0; tw < (REPEAT_PHASE == 32 ? 2 : 1); ++tw) {
                if (ucur < (unsigned)ATT_DIL_UNITS) att_compute<10, true>(U, lds, wave, lane); else att_compute<16, false>(U, lds, wave, lane); } }
            __syncthreads();
            if (ucur + 1 < uend) att_put(lds, reg, tid);
        }
    }
}

__device__ __forceinline__ void phase4(const Params& p) {
    const int tid = threadIdx.x, lane = tid & 63, wave = tid >> 6;
    const int gw = blockIdx.x * NWAVES + wave, NGW = gridDim.x * NWAVES;
    unsigned char* ws = p.ws; const unsigned char* dob = (const unsigned char*)p.out;
    const float* Yf = (const float*)(dob + DO_Y); const float* Yb = Yf + (size_t)T * RC;
    const bf16_t* G = (const bf16_t*)(dob + DO_G); const float* LSE = (const float*)(dob + DO_LSE);
    const float* BON = (const float*)(ws + WS_BONUS); const float* SSH = (const float*)(ws + WS_SSH);
    const bf16_t* AO = (const bf16_t*)(ws + WS_ATTO); bf16_t* YM = (bf16_t*)(ws + WS_YMIX);
    for (int t = gw; t < T; t += NGW) {
        const int b = t >> 11, s = t & (SEQ - 1);
        float yf[RH], yb[RH], vv[RH], bo[RH]; unsigned short gg[RH], a0[AH], a1[AH], a2[AH]; float l0[AH], l1[AH], l2[AH];
#pragma unroll
        for (int h = 0; h < RH; ++h) { const int ch = h * 64 + lane;
            yf[h] = Yf[(size_t)t * RC + ch]; yb[h] = Yb[(size_t)t * RC + ch]; gg[h] = G[(size_t)t * RC + ch];
            vv[h] = bf2f(((const bf16_t*)SSH)[((size_t)(b * RH + h) * SEQ + s) * 192 + 64 + lane]); bo[h] = BON[t * RH + h];
            a0[h] = AO[(size_t)t * AW + ch]; a1[h] = AO[(size_t)T * AW + (size_t)t * AW + ch]; a2[h] = AO[(size_t)2 * T * AW + (size_t)t * AW + ch];
            l0[h] = LSE[(size_t)t * AH + h]; l1[h] = LSE[(size_t)T * AH + (size_t)t * AH + h]; l2[h] = LSE[(size_t)2 * T * AH + (size_t)t * AH + h]; }
#pragma unroll
        for (int h = 0; h < RH; ++h) { const int ch = h * 64 + lane;
            const float y = yf[h] + yb[h];
            const float mean = wave_sum(y) * (1.f / 64.f); const float dlt = y - mean; const float var = wave_sum(dlt * dlt) * (1.f / 64.f);
            const float yn = dlt * (1.f / sqrtf(var + GN_EPS)) * p.in[14][ch] + p.in[15][ch];
            const float o = (yn + bo[h] * vv[h]) * bf2f(gg[h]);
            YM[(size_t)t * D + ch] = (bf16_t)f2bf(o); }
#pragma unroll
        for (int h = 0; h < AH; ++h) { const int ch = h * 64 + lane;
            const float mx = fmaxf(l0[h], fmaxf(l1[h], l2[h])); const float e0 = __expf(l0[h] - mx), e1 = __expf(l1[h] - mx), e2 = __expf(l2[h] - mx); const float inv = 1.f / (e0 + e1 + e2);
            const float o = (e0 * bf2f(a0[h]) + e1 * bf2f(a1[h]) + e2 * bf2f(a2[h])) * inv;
            YM[(size_t)t * D + RC + ch] = (bf16_t)f2bf(o); }
    }
}

struct PolP5 {
    static constexpr bool PERM = false, GATHER = false;
    const bf16_t* A; const bf16_t* Bt; const bf16_t* H0B; float* PRE; int G, c;
    __device__ __forceinline__ bool next(int i, pg8::Unit& u) const { int pm, pn; if (!pg8::static_order(T / 256, D / 256, G, c, i, pm, pn)) return false;
        u.A = (const char*)(A + (size_t)pm * 256 * D); u.B0 = (const char*)(Bt + (size_t)pn * 256 * D); u.B1 = u.B0 + (size_t)128 * D * 2; u.x0 = pm; u.x1 = pn; u.x2 = 0; u.x3 = 0; u.x4 = 0; return true; }
    __device__ __forceinline__ void epi(const f32x4 (&acc)[2][2][4][2], const pg8::Unit& u, int wr, int wc, int fr, int fq) const {
        const int row0 = u.x0 * 256 + wr * 64 + fr, col0 = u.x1 * 256 + wc * 32 + 4 * fq;
#pragma unroll
        for (int ai = 0; ai < 2; ++ai)
#pragma unroll
            for (int m = 0; m < 4; ++m) { const size_t ro = (size_t)(row0 + ai * 128 + m * 16) * D + col0;
#pragma unroll
                for (int bj = 0; bj < 2; ++bj)
#pragma unroll
                    for (int n = 0; n < 2; ++n) { const size_t off = ro + bj * 128 + n * 16; const u32x2 hb = *(const u32x2*)(H0B + off); const f32x4 v = acc[ai][bj][m][n];
                        f32x4 o; o.x = v.x + ALPHA * bflo(hb.x); o.y = v.y + ALPHA * bfhi(hb.x); o.z = v.z + ALPHA * bflo(hb.y); o.w = v.w + ALPHA * bfhi(hb.y); *(f32x4*)(PRE + off) = o; }
                asm volatile("" ::: "memory"); }
    }
};
__device__ __forceinline__ void phase5(const Params& p, LAS unsigned char* lds) {
    unsigned char* ws = p.ws;
    PolP5 P{(const bf16_t*)(ws + WS_YMIX), (const bf16_t*)(ws + WS_WT_OUT), (const bf16_t*)(ws + WS_H0B), p.out, (int)gridDim.x, (int)blockIdx.x};
    pg8::gemm_phase(lds, P, D);
}

constexpr int P6_TP = 1032;
constexpr int P6_TH = 0, P6_TL = 16 * P6_TP * 2, P6_PART = 2 * 16 * P6_TP * 2, P6_LC = P6_PART + 8 * 16 * 32 * 4, P6_BASE = P6_LC + 128, P6_ENT = P6_BASE + 128, P6_MAXENT = 2048;
__device__ __forceinline__ void phase6(const Params& p, LAS unsigned char* lds, int rep) {
    const int tid = threadIdx.x, lane = tid & 63, wave = tid >> 6, fr = lane & 15, fq = lane >> 4;
    unsigned char* ws = p.ws; unsigned* ctl = (unsigned*)(ws + WS_CTL);
    const bf16_t* WRH = (const bf16_t*)(ws + WS_WRT); const bf16_t* WRL = WRH + NE * D;
    LAS bf16_t* TH = (LAS bf16_t*)(lds + P6_TH); LAS bf16_t* TL = (LAS bf16_t*)(lds + P6_TL); LAS float* PART = (LAS float*)(lds + P6_PART);
    LAS int* LC = (LAS int*)(lds + P6_LC); LAS int* BASE = (LAS int*)(lds + P6_BASE); LAS int* ENT = (LAS int*)(lds + P6_ENT);
    int* LIST = (int*)(ws + WS_LIST); float* RG = (float*)(ws + WS_ROWGATE); int* SEL = (int*)(ws + WS_SEL);
    __syncthreads();
    if (tid < NE) LC[tid] = 0;
    __syncthreads();
    int it = 0;
    for (int tile = blockIdx.x; tile < T / 16; tile += gridDim.x, ++it) {
        const int t0 = tile * 16;
#pragma unroll
        for (int q = 0; q < 2; ++q) { const int tt = 2 * wave + q, t = t0 + tt;
            const f32x4* xr = (const f32x4*)(p.out + (size_t)t * D) + lane; f32x4 v[4];
#pragma unroll
            for (int j = 0; j < 4; ++j) v[j] = xr[64 * j];
            ln_row(v, p.in[18], p.in[19], lane);
            bf16_t* orow = (bf16_t*)(ws + WS_H1B) + (size_t)t * D;
#pragma unroll
            for (int j = 0; j < 4; ++j) { const unsigned h0 = f2bf(v[j].x), h1 = f2bf(v[j].y), h2 = f2bf(v[j].z), h3 = f2bf(v[j].w);
                u32x2 hi; hi.x = h0 | (h1 << 16); hi.y = h2 | (h3 << 16);
                u32x2 lo; lo.x = pk2(v[j].x - bf2f(h0), v[j].y - bf2f(h1)); lo.y = pk2(v[j].z - bf2f(h2), v[j].w - bf2f(h3));
                *(u32x2*)(orow + 4 * lane + 256 * j) = hi;
                *(LAS u32x2*)(TH + tt * P6_TP + 4 * lane + 256 * j) = hi; *(LAS u32x2*)(TL + tt * P6_TP + 4 * lane + 256 * j) = lo; } }
        __syncthreads();
        f32x4 acc0 = (f32x4){0.f, 0.f, 0.f, 0.f}, acc1 = acc0;
#pragma unroll
        for (int ks = 0; ks < 4; ++ks) { const int k0 = 128 * wave + 32 * ks + 8 * fq;
            const bf16x8 ah = *(const LAS bf16x8*)(TH + fr * P6_TP + k0), al = *(const LAS bf16x8*)(TL + fr * P6_TP + k0);
            const bf16x8 bh0 = *(const bf16x8*)(WRH + (size_t)fr * D + k0), bl0 = *(const bf16x8*)(WRL + (size_t)fr * D + k0);
            const bf16x8 bh1 = *(const bf16x8*)(WRH + (size_t)(16 + fr) * D + k0), bl1 = *(const bf16x8*)(WRL + (size_t)(16 + fr) * D + k0);
            acc0 = __builtin_amdgcn_mfma_f32_16x16x32_bf16(ah, bh0, acc0, 0, 0, 0); acc0 = __builtin_amdgcn_mfma_f32_16x16x32_bf16(ah, bl0, acc0, 0, 0, 0); acc0 = __builtin_amdgcn_mfma_f32_16x16x32_bf16(al, bh0, acc0, 0, 0, 0);
            acc1 = __builtin_amdgcn_mfma_f32_16x16x32_bf16(ah, bh1, acc1, 0, 0, 0); acc1 = __builtin_amdgcn_mfma_f32_16x16x32_bf16(ah, bl1, acc1, 0, 0, 0); acc1 = __builtin_amdgcn_mfma_f32_16x16x32_bf16(al, bh1, acc1, 0, 0, 0); }
#pragma unroll
        for (int r = 0; r < 4; ++r) { PART[(wave * 16 + 4 * fq + r) * 32 + fr] = acc0[r]; PART[(wave * 16 + 4 * fq + r) * 32 + 16 + fr] = acc1[r]; }
        __syncthreads();
        const int e = lane & 31, tt = 2 * wave + (lane >> 5), t = t0 + tt;
        float logit = p.in[21][e];
#pragma unroll
        for (int v = 0; v < 8; ++v) logit += PART[(v * 16 + tt) * 32 + e];
        float cur = logit; float tv0 = 0.f, tv1 = 0.f, tv2 = 0.f, tv3 = 0.f; int te0 = 0, te1 = 0, te2 = 0, te3 = 0;
#pragma unroll
        for (int k = 0; k < 4; ++k) { float bv = cur; int bi = e;
#pragma unroll
            for (int o = 1; o < 32; o <<= 1) { const float ov = __shfl_xor(bv, o); const int oi = __shfl_xor(bi, o); if (ov > bv || (ov == bv && oi < bi)) { bv = ov; bi = oi; } }
            if (k == 0) { tv0 = bv; te0 = bi; } if (k == 1) { tv1 = bv; te1 = bi; } if (k == 2) { tv2 = bv; te2 = bi; } if (k == 3) { tv3 = bv; te3 = bi; }
            if (e == bi) cur = -3.0e38f; }
        const float e1 = __expf(tv1 - tv0), e2 = __expf(tv2 - tv0), e3 = __expf(tv3 - tv0); const float inv = 1.f / (1.f + e1 + e2 + e3);
        if (e < 4) { int ee = te0; float gg = inv;
            if (e == 1) { ee = te1; gg = e1 * inv; } if (e == 2) { ee = te2; gg = e2 * inv; } if (e == 3) { ee = te3; gg = e3 * inv; }
            const int lr = __hip_atomic_fetch_add((int*)(LC + ee), 1, __ATOMIC_RELAXED, __HIP_MEMORY_SCOPE_WORKGROUP); const int n = (it * 16 + tt) * 4 + e;
            if (n < P6_MAXENT) { ENT[4 * n] = t * 4 + e; ENT[4 * n + 1] = ee; ENT[4 * n + 2] = lr; ENT[4 * n + 3] = __builtin_bit_cast(int, gg); } }
    }
    __syncthreads();
    if (tid < NE) BASE[tid] = (int)atomicAdd(ctl + CW_CNT + 32 * rep + tid, (unsigned)LC[tid]);
    __syncthreads();
    const int nent = it * 64 < P6_MAXENT ? it * 64 : P6_MAXENT;
    for (int n = tid; n < nent; n += NTHR) { const int tk = ENT[4 * n], ee = ENT[4 * n + 1], rank = BASE[ee] + ENT[4 * n + 2];
        LIST[(size_t)ee * T + rank] = tk >> 2; RG[(size_t)ee * T + rank] = __builtin_bit_cast(float, ENT[4 * n + 3]); SEL[(size_t)tk * 2] = ee; SEL[(size_t)tk * 2 + 1] = rank; }
}

__device__ __forceinline__ void build_expert_tables(const Params& p, LAS int* tab) {
    const unsigned* ctl = (const unsigned*)(p.ws + WS_CTL);
    __syncthreads();
    if (threadIdx.x < NE) tab[threadIdx.x] = (int)__hip_atomic_load(ctl + CW_CNT + CNT_SET + threadIdx.x, __ATOMIC_RELAXED, __HIP_MEMORY_SCOPE_AGENT);
    __syncthreads();
    if (threadIdx.x == 0) { int ps = 0, ts = 0;
        for (int e = 0; e < NE; ++e) { const int c = tab[e]; tab[32 + e] = ps; tab[64 + e] = ts; ps += (c + 255) / 256 * 256; ts += (c + 127) / 128; }
        tab[64 + NE] = ts; }
    __syncthreads();
}

constexpr int TAB_OFF = 131072, UTAB_OFF = 100, UTAB_MAX = 48;
__device__ __forceinline__ void build_expert_tables256(const Params& p, LAS int* tab, int npn  ) {
    const unsigned* ctl = (const unsigned*)(p.ws + WS_CTL);
    __syncthreads();
    if (threadIdx.x < NE) tab[threadIdx.x] = (int)__hip_atomic_load(ctl + CW_CNT + CNT_SET + threadIdx.x, __ATOMIC_RELAXED, __HIP_MEMORY_SCOPE_AGENT);
    __syncthreads();
    if (threadIdx.x == 0) { int ps = 0, ts = 0;
        for (int e = 0; e < NE; ++e) { const int c = tab[e]; tab[32 + e] = ps; tab[64 + e] = ts; ps += (c + 255) / 256 * 256; ts += (c + 255) / 256; }
        tab[64 + NE] = ts;
        int e = 0, n = 0;
        if (gridDim.x == 256) { const int g = blockIdx.x & 7, sl = blockIdx.x >> 3, mpx = 32 / npn  , mround = 8 * mpx;
            for (int i = 0; n < UTAB_MAX; ++i) { const int mt_g = i * mround + g * mpx + sl / npn, pn = sl % npn; if (i * mround >= ts) break; if (mt_g >= ts) continue;
                while (e + 1 < NE && mt_g >= tab[64 + e + 1]) ++e;
                const int r0 = (mt_g - tab[64 + e]) * 256;
                tab[UTAB_OFF + 4 * n] = e; tab[UTAB_OFF + 4 * n + 1] = r0; tab[UTAB_OFF + 4 * n + 2] = pn; tab[UTAB_OFF + 4 * n + 3] = tab[32 + e] + r0; ++n; }
        } else { const int nun = ts * npn;
        for (int L = blockIdx.x; L < nun && n < UTAB_MAX; L += gridDim.x, ++n) { const int pn = L % npn, mt_g = L / npn;
            while (e + 1 < NE && mt_g >= tab[64 + e + 1]) ++e;
            const int r0 = (mt_g - tab[64 + e]) * 256;
            tab[UTAB_OFF + 4 * n] = e; tab[UTAB_OFF + 4 * n + 1] = r0; tab[UTAB_OFF + 4 * n + 2] = pn; tab[UTAB_OFF + 4 * n + 3] = tab[32 + e] + r0; } }
        tab[98] = n; }
    __syncthreads();
}
struct PolP7 {
    static constexpr bool PERM = true, GATHER = true;
    const bf16_t* H1B; const bf16_t* WG; const int* LIST; bf16_t* ACT; const float* BGU; const LAS int* tab; int G, c;
    __device__ __forceinline__ bool next(int i, pg8::Unit& u) const { if (i >= __builtin_amdgcn_readfirstlane(tab[98])) return false;
        const int e = __builtin_amdgcn_readfirstlane(tab[UTAB_OFF + 4 * i]), r0 = __builtin_amdgcn_readfirstlane(tab[UTAB_OFF + 4 * i + 1]), pn = __builtin_amdgcn_readfirstlane(tab[UTAB_OFF + 4 * i + 2]);
        u.A = (const char*)H1B; u.B0 = (const char*)(WG + ((size_t)e * 2 * FF + pn * 128) * D); u.B1 = u.B0 + (size_t)FF * D * 2;
        u.x0 = e; u.x1 = r0; u.x2 = pn; u.x3 = __builtin_amdgcn_readfirstlane(tab[UTAB_OFF + 4 * i + 3]); u.x4 = __builtin_amdgcn_readfirstlane(tab[e]) - r0; return true; }
    __device__ __forceinline__ void rows_issue(const pg8::Unit& u, int R0, unsigned (&raw)[2][2]) const { const int* lst = LIST + (size_t)u.x0 * T + u.x1;
#pragma unroll
        for (int h = 0; h < 2; ++h)
#pragma unroll
            for (int i = 0; i < 2; ++i) { int r = h * 128 + i * 64 + R0; r = r < u.x4 ? r : 0; raw[h][i] = (unsigned)lst[r]; } }
    __device__ __forceinline__ void rows_finish(int C0, int K, unsigned (&raw)[2][2]) const {
#pragma unroll
        for (int h = 0; h < 2; ++h)
#pragma unroll
            for (int i = 0; i < 2; ++i) raw[h][i] = (raw[h][i] * (unsigned)K + (unsigned)C0) * 2u; }
    __device__ __forceinline__ void epi(const f32x4 (&acc)[2][2][4][2], const pg8::Unit& u, int wr, int wc, int fr, int fq) const {
        const int e = u.x0, nval = u.x4, f0 = u.x2 * 128 + wc * 32 + 8 * fq;
        const float* bias = BGU + (size_t)e * 2 * FF + f0;
        const f32x4 bg0 = *(const f32x4*)bias, bg1 = *(const f32x4*)(bias + 4), bu0 = *(const f32x4*)(bias + FF), bu1 = *(const f32x4*)(bias + FF + 4);
#pragma unroll
        for (int ai = 0; ai < 2; ++ai)
#pragma unroll
            for (int m = 0; m < 4; ++m) { const int r = ai * 128 + wr * 64 + m * 16 + fr;
                const f32x4 g0 = acc[ai][0][m][0] + bg0, g1 = acc[ai][0][m][1] + bg1, u0 = acc[ai][1][m][0] + bu0, u1 = acc[ai][1][m][1] + bu1;
                float a[8];
#pragma unroll
                for (int j = 0; j < 4; ++j) {
                    const float gc = fminf(g0[j], 7.f), uc = __builtin_amdgcn_fmed3f(u0[j], -7.f, 7.f);
                    a[j] = __builtin_fmaf(uc, gc, gc) * __builtin_amdgcn_rcpf(1.f + __builtin_amdgcn_exp2f(-2.4554669595930157f * gc));
                    const float gd = fminf(g1[j], 7.f), ud = __builtin_amdgcn_fmed3f(u1[j], -7.f, 7.f);
                    a[4 + j] = __builtin_fmaf(ud, gd, gd) * __builtin_amdgcn_rcpf(1.f + __builtin_amdgcn_exp2f(-2.4554669595930157f * gd)); }
                if (r < nval) { u32x4 w; w.x = pg8::cvt_pk_bf16(a[0], a[1]); w.y = pg8::cvt_pk_bf16(a[2], a[3]); w.z = pg8::cvt_pk_bf16(a[4], a[5]); w.w = pg8::cvt_pk_bf16(a[6], a[7]);
                    *(u32x4*)(ACT + (size_t)(u.x3 + r) * FF + f0) = w; } }
    }
};
__device__ __forceinline__ void phase7(const Params& p, LAS unsigned char* lds) {
    LAS int* tab = (LAS int*)(lds + TAB_OFF); build_expert_tables256(p, tab, 8);
    unsigned char* ws = p.ws;
    PolP7 P{(const bf16_t*)(ws + WS_H1B), (const bf16_t*)(ws + WS_WT_GU), (const int*)(ws + WS_LIST), (bf16_t*)(ws + WS_ACT), p.in[23], tab, (int)gridDim.x, (int)blockIdx.x};
    pg8::gemm_phase(lds, P, D);
}

struct PolP8 {
    static constexpr bool PERM = true, GATHER = false;
    const bf16_t* ACT; const bf16_t* WD; const float* RG; bf16_t* YR; const float* BD; const LAS int* tab; int G, c;
    __device__ __forceinline__ bool next(int i, pg8::Unit& u) const { if (i >= __builtin_amdgcn_readfirstlane(tab[98])) return false;
        const int e = __builtin_amdgcn_readfirstlane(tab[UTAB_OFF + 4 * i]), r0 = __builtin_amdgcn_readfirstlane(tab[UTAB_OFF + 4 * i + 1]), pn = __builtin_amdgcn_readfirstlane(tab[UTAB_OFF + 4 * i + 2]), prow0 = __builtin_amdgcn_readfirstlane(tab[UTAB_OFF + 4 * i + 3]);
        u.A = (const char*)(ACT + (size_t)prow0 * FF); u.B0 = (const char*)(WD + ((size_t)e * D + pn * 256) * FF); u.B1 = u.B0 + (size_t)128 * FF * 2;
        u.x4 = __builtin_amdgcn_readfirstlane(tab[e]) - r0;
        u.x0 = e; u.x1 = r0; u.x2 = pn; u.x3 = prow0; return true; }
    __device__ __forceinline__ void epi(const f32x4 (&acc)[2][2][4][2], const pg8::Unit& u, int wr, int wc, int fr, int fq) const {
        const int e = u.x0, nval = u.x4; const float* rg = RG + (size_t)e * T + u.x1;
#pragma unroll
        for (int ai = 0; ai < 2; ++ai)
#pragma unroll
            for (int m = 0; m < 4; ++m) { const int r = ai * 128 + wr * 64 + m * 16 + fr;
                if (r < nval) { const float g = rg[r];
#pragma unroll
                    for (int bj = 0; bj < 2; ++bj) { const int col = u.x2 * 256 + bj * 128 + wc * 32 + 8 * fq; const float* bias = BD + (size_t)e * D + col;
                        const f32x4 v0 = (acc[ai][bj][m][0] + *(const f32x4*)bias) * g, v1 = (acc[ai][bj][m][1] + *(const f32x4*)(bias + 4)) * g;
                        u32x4 w; w.x = pg8::cvt_pk_bf16(v0[0], v0[1]); w.y = pg8::cvt_pk_bf16(v0[2], v0[3]); w.z = pg8::cvt_pk_bf16(v1[0], v1[1]); w.w = pg8::cvt_pk_bf16(v1[2], v1[3]);
                        *(u32x4*)(YR + (size_t)(u.x3 + r) * D + col) = w; } } }
    }
};
__device__ __forceinline__ void phase8(const Params& p, LAS unsigned char* lds) {
    LAS int* tab = (LAS int*)(lds + TAB_OFF); build_expert_tables256(p, tab, 4);
    unsigned char* ws = p.ws;
    PolP8 P{(const bf16_t*)(ws + WS_ACT), (const bf16_t*)(ws + WS_WT_DN), (const float*)(ws + WS_ROWGATE), (bf16_t*)(ws + WS_YROWS), p.in[25], tab, (int)gridDim.x, (int)blockIdx.x};
    pg8::gemm_phase(lds, P, FF);
}

__device__ __forceinline__ void phase9(const Params& p, LAS unsigned char* lds) {
    LAS int* tab = (LAS int*)lds; build_expert_tables(p, tab);
    const int tid = threadIdx.x, lane = tid & 63, wave = tid >> 6;
    const int gw = blockIdx.x * NWAVES + wave, NGW = gridDim.x * NWAVES;
    unsigned char* ws = p.ws; const bf16_t* H1B = (const bf16_t*)(ws + WS_H1B); const bf16_t* YR = (const bf16_t*)(ws + WS_YROWS); const int* SEL = (const int*)(ws + WS_SEL);
    typedef int i32x4 __attribute__((ext_vector_type(4)));
    i32x4 sa = {0, 0, 0, 0}, sb = sa;
    if (gw < T) { sa = *(const i32x4*)(SEL + (size_t)gw * 8); sb = *(const i32x4*)(SEL + (size_t)gw * 8 + 4); }
    for (int t = gw; t < T; t += NGW) {
        const i32x4 ca = sa, cb = sb;
        if (t + NGW < T) { sa = *(const i32x4*)(SEL + (size_t)(t + NGW) * 8); sb = *(const i32x4*)(SEL + (size_t)(t + NGW) * 8 + 4); }
        const bf16_t* y0 = YR + (size_t)(tab[32 + ca.x] + ca.y) * D + 4 * lane; const bf16_t* y1 = YR + (size_t)(tab[32 + ca.z] + ca.w) * D + 4 * lane;
        const bf16_t* y2 = YR + (size_t)(tab[32 + cb.x] + cb.y) * D + 4 * lane; const bf16_t* y3 = YR + (size_t)(tab[32 + cb.z] + cb.w) * D + 4 * lane;
        const bf16_t* hr = H1B + (size_t)t * D + 4 * lane;
        u32x2 hb[4], q0[4], q1[4], q2[4], q3[4];
#pragma unroll
        for (int j = 0; j < 4; ++j) { hb[j] = *(const u32x2*)(hr + 256 * j); q0[j] = *(const u32x2*)(y0 + 256 * j); q1[j] = *(const u32x2*)(y1 + 256 * j); q2[j] = *(const u32x2*)(y2 + 256 * j); q3[j] = *(const u32x2*)(y3 + 256 * j); }
        f32x4 v[4];
#pragma unroll
        for (int j = 0; j < 4; ++j) {
            v[j].x = ALPHA * bflo(hb[j].x) + ((bflo(q0[j].x) + bflo(q1[j].x)) + (bflo(q2[j].x) + bflo(q3[j].x)));
            v[j].y = ALPHA * bfhi(hb[j].x) + ((bfhi(q0[j].x) + bfhi(q1[j].x)) + (bfhi(q2[j].x) + bfhi(q3[j].x)));
            v[j].z = ALPHA * bflo(hb[j].y) + ((bflo(q0[j].y) + bflo(q1[j].y)) + (bflo(q2[j].y) + bflo(q3[j].y)));
            v[j].w = ALPHA * bfhi(hb[j].y) + ((bfhi(q0[j].y) + bfhi(q1[j].y)) + (bfhi(q2[j].y) + bfhi(q3[j].y))); }
        ln_row(v, p.in[26], p.in[27], lane);
        f32x4* orow = (f32x4*)(p.out + (size_t)t * D) + lane;
#pragma unroll
        for (int j = 0; j < 4; ++j) orow[64 * j] = v[j];
    }
}

#define XB_TMO      128
#define XB_XCNT(j)  (256  + 64 * (j))
#define XB_XSUB(j)  (1280 + 64 * (j))
#define XB_XGEN(j)  (2304 + 64 * (j))
#define XB_TOP      3328
#define XB_TOPGEN   3392
#define XCD_BAR_WORDS 3456
#define XB_SPIN_CAP (1u << 22)
__device__ __forceinline__ unsigned xb_ld(unsigned* p)              { return __hip_atomic_load(p, __ATOMIC_RELAXED, __HIP_MEMORY_SCOPE_AGENT); }
__device__ __forceinline__ unsigned xb_add(unsigned* p, unsigned v) { return __hip_atomic_fetch_add(p, v, __ATOMIC_RELAXED, __HIP_MEMORY_SCOPE_AGENT); }
__device__ __forceinline__ unsigned xb_xcc_id() { return (unsigned)__builtin_amdgcn_s_getreg((3 << 11) | 20) & 0xFu; }
#define XB_SPIN(cond, bar) do { unsigned _sp = 0; while (cond) { __builtin_amdgcn_s_sleep(1); \
    if ((++_sp & 255u) == 0u) { if (xb_ld(&(bar)[XB_TMO])) break; if (_sp > XB_SPIN_CAP) { atomicAdd(&(bar)[XB_TMO], 1u); break; } } } } while (0)
struct XcdBarrier { unsigned* bar; unsigned x; volatile LAS unsigned* st; };
__device__ __forceinline__ XcdBarrier xcd_barrier_post(unsigned* bar, volatile LAS unsigned* st) {
    XcdBarrier b; b.bar = bar; b.x = xb_xcc_id(); b.st = st;
    if (threadIdx.x == 0) (void)xb_add(&bar[XB_XCNT(b.x)], 1u);
    return b;
}
__device__ __forceinline__ void xcd_barrier_complete(unsigned* bar, unsigned x, unsigned& nloc, unsigned& nx) {
    const unsigned G = gridDim.x * gridDim.y * gridDim.z;
    unsigned sum, cnt, mine, sp = 0u;
    for (;;) {
        sum = 0u; cnt = 0u; mine = 0u;
#pragma unroll
        for (unsigned j = 0; j < 16; ++j) { const unsigned c = xb_ld(&bar[XB_XCNT(j)]); sum += c; cnt += (c > 0u) ? 1u : 0u; mine = (j == x) ? c : mine; }
        if (sum == G) break;
        __builtin_amdgcn_s_sleep(1);
        if ((++sp & 255u) == 0u) { if (xb_ld(&bar[XB_TMO])) break; if (sp > XB_SPIN_CAP) { atomicAdd(&bar[XB_TMO], 1u); break; } }
    }
    nloc = mine > 0u ? mine : 1u; nx = cnt > 0u ? cnt : 1u;
}
__device__ __forceinline__ void xcd_barrier(const XcdBarrier& b) {
    asm volatile("s_waitcnt vmcnt(0)" ::: "memory");
    __syncthreads();
    if (threadIdx.x == 0) {
        unsigned* bar = b.bar;
        __builtin_amdgcn_s_waitcnt(0);
        unsigned nloc = b.st[0], nx = b.st[1];
        if (nloc == 0u) { xcd_barrier_complete(bar, b.x, nloc, nx); b.st[0] = nloc; b.st[1] = nx; }
        const unsigned old = xb_add(&bar[XB_XSUB(b.x)], 1u);
        const unsigned gen = old / nloc;
        if (old + 1u == (gen + 1u) * nloc) {
            __builtin_amdgcn_fence(__ATOMIC_RELEASE, "agent");
            asm volatile("s_waitcnt vmcnt(0)" ::: "memory");
            const unsigned og = xb_add(&bar[XB_TOP], 1u);
            const unsigned tg = og / nx;
            if (og + 1u == (tg + 1u) * nx) xb_add(&bar[XB_TOPGEN], 1u);
            else XB_SPIN(xb_ld(&bar[XB_TOPGEN]) == tg, bar);
            __builtin_amdgcn_fence(__ATOMIC_ACQUIRE, "agent");
            xb_add(&bar[XB_XGEN(b.x)], 1u);
            asm volatile("s_waitcnt vmcnt(0)" ::: "memory");
        } else {
            XB_SPIN(xb_ld(&bar[XB_XGEN(b.x)]) == gen, bar);
            __builtin_amdgcn_fence(__ATOMIC_ACQUIRE, "agent");
            asm volatile("s_waitcnt vmcnt(0)" ::: "memory");
        }
    }
    __syncthreads();
}

constexpr int NPHASE = 10;
constexpr int LDS_BYTES = 131072 + 2048;
__global__ void __launch_bounds__(NTHR, 2) mk_fwd(Params p) {
    extern __shared__ __attribute__((aligned(16))) unsigned char lds_raw[];
    LAS unsigned char* lds = (LAS unsigned char*)lds_raw;
    const int lo = p.ph_lo, hi = p.ph_hi;
    volatile LAS unsigned* barst = (volatile LAS unsigned*)(lds + BARST_OFF);
    if (threadIdx.x < 2) barst[threadIdx.x] = 0u;
    __syncthreads();
    const XcdBarrier xbar = xcd_barrier_post((unsigned*)(p.ws + WS_CTL) + CW_BAR, barst);
#ifdef ONLY_PHASE
#define IN(k) ((k) == ONLY_PHASE && lo <= (k) && (k) < hi)
#else
#define IN(k) (lo <= (k) && (k) < hi)
#endif
#define SEAM(k) do { if (IN(k) && IN((k) + 1)) { if ((k) == 0) cg::this_grid().sync(); else xcd_barrier(xbar); } } while (0)
#define RUN(k, call) do { if (IN(k)) { call; if (REPEAT_PHASE == (k)) { cg::this_grid().sync(); call; } } } while (0)
    { int rep = 0;
    RUN(0, phase0(p, lds));
    SEAM(0);
    RUN(1, phase1(p, lds));
    SEAM(1);
    RUN(2, phase2(p, lds));
    SEAM(2);
    if (IN(3)) { const int nrep = (REPEAT_PHASE == 3) ? 2 : 1;
#pragma unroll 1
        for (rep = 0; rep < nrep; ++rep) { if (rep) cg::this_grid().sync(); phase3(p, lds, rep); } }
    SEAM(3);
    RUN(4, phase4(p));
    SEAM(4);
    RUN(5, phase5(p, lds));
    SEAM(5);
    rep = 0; RUN(6, (phase6(p, lds, rep), ++rep));
    SEAM(6);
    RUN(7, phase7(p, lds));
    SEAM(7);
    RUN(8, phase8(p, lds));
    SEAM(8);
    RUN(9, phase9(p, lds));
    }
#undef RUN
#undef IN
#undef SEAM
}

extern "C" void kernel_launch(void* const* d_in, const int* in_sizes, int n_in, void* d_out, int out_size, void* d_ws, size_t ws_size, hipStream_t stream) {
    static int grid = 0;
    if (grid == 0) {
        if (n_in != 28 || out_size != T * D || ws_size < WS_END) { fprintf(stderr, "kernel_launch: unexpected shapes: n_in %d out %d ws %zu (need %zu)\n", n_in, out_size, ws_size, (size_t)WS_END); grid = -1; return; }
        int dev = 0, cus = 0, per_cu = 0;
        hipGetDevice(&dev); hipDeviceGetAttribute(&cus, hipDeviceAttributeMultiprocessorCount, dev);
        hipFuncSetAttribute((const void*)mk_fwd, hipFuncAttributeMaxDynamicSharedMemorySize, LDS_BYTES);
        hipOccupancyMaxActiveBlocksPerMultiprocessor(&per_cu, (const void*)mk_fwd, NTHR, LDS_BYTES);
        (void)hipGetLastError();
        if (per_cu < 1) { fprintf(stderr, "kernel_launch: occupancy query says %d blocks per CU\n", per_cu); per_cu = 1; }
        grid = cus;
    }
    if (grid < 0) return;
    hipMemsetAsync((char*)d_ws + WS_CTL, 0, CTL_ZERO_BYTES, stream);
    Params p{};
    for (int i = 0; i < 28; ++i) p.in[i] = (const float*)d_in[i];
    p.out = (float*)d_out; p.ws = (unsigned char*)d_ws;
#if MK_ONE_LAUNCH
    p.ph_lo = 0; p.ph_hi = NPHASE;
    void* args[] = {&p};
    hipError_t e = hipLaunchCooperativeKernel((const void*)mk_fwd, dim3(grid), dim3(NTHR), args, LDS_BYTES, stream);
    if (e != hipSuccess) fprintf(stderr, "cooperative launch failed: %s (grid %d)\n", hipGetErrorString(e), grid);
#else
    for (int ph = 0; ph < NPHASE; ++ph) { p.ph_lo = ph; p.ph_hi = ph + 1; hipLaunchKernelGGL(mk_fwd, dim3(grid), dim3(NTHR), LDS_BYTES, stream, p); }
#endif
}
```

```cpp
#include <hip/hip_runtime.h>
#include <hip/hip_cooperative_groups.h>
#include <cstdio>
#include <cstdint>
namespace cg = cooperative_groups;

#ifndef REPEAT_PHASE
#define REPEAT_PHASE -1
#endif
#ifndef MK_ONE_LAUNCH
#define MK_ONE_LAUNCH 1
#endif

typedef unsigned short bf16_t;
typedef short bf16x8 __attribute__((ext_vector_type(8)));
typedef short bf16x4 __attribute__((ext_vector_type(4)));
typedef float f32x4 __attribute__((ext_vector_type(4)));
typedef float f32x2 __attribute__((ext_vector_type(2)));
typedef unsigned u32x4 __attribute__((ext_vector_type(4)));
typedef unsigned u32x2 __attribute__((ext_vector_type(2)));

constexpr int D = 1024, BATCH = 16, SEQ = 2048, T = BATCH * SEQ;
constexpr int NMEM = 256, HD = 64;
constexpr int RH = 6, RC = 384;
constexpr int RWKV_IN = 1344;
constexpr int AH = 6, AW = 384, MH = 4, MW = 256;
constexpr int IN_W = 2752, IN_WP = 2816;
constexpr int PA_W = IN_WP - RWKV_IN;
constexpr int NE = 32, TOPK = 4, FF = 1024;
constexpr float LN_EPS = 1e-5f, GN_EPS = 64e-5f;
constexpr float ALPHA = 1.189207115002721f;
constexpr int NTHR = 512, NWAVES = 8;

constexpr size_t MiB = 1u << 20;
constexpr size_t WS_CTL = 0;
constexpr size_t WS_WT_IN = 1 * MiB;
constexpr size_t WS_LORA = 6 * MiB + 512 * 1024;
constexpr size_t WS_WT_OUT = 7 * MiB;
constexpr size_t WS_WT_KV = 9 * MiB;
constexpr size_t WS_KVM = 10 * MiB;
constexpr size_t WS_MEMB = 14 * MiB;
constexpr size_t WS_LIST = 22 * MiB;
constexpr size_t WS_ROWGATE = 26 * MiB;
constexpr size_t WS_SEL = 30 * MiB;
constexpr size_t WS_BONUS = 31 * MiB;
constexpr size_t WS_WRT = 31 * MiB + 800 * 1024;
constexpr size_t WS_WT_GU = 32 * MiB;
constexpr size_t WS_WT_DN = 160 * MiB;
constexpr size_t WS_H0B = 224 * MiB;
constexpr size_t WS_H1B = 288 * MiB;
constexpr size_t WS_YMIX = 352 * MiB;
constexpr size_t WS_PR = 416 * MiB;
constexpr size_t WS_ATTO = 416 * MiB;
constexpr size_t WS_PA = 500 * MiB;
constexpr size_t WS_SSH = 592 * MiB;
constexpr size_t WS_SDIR = 736 * MiB;
constexpr size_t WS_ACT = 352 * MiB;
constexpr size_t WS_YROWS = 624 * MiB;
constexpr size_t WS_END = 1024 * MiB;
constexpr size_t DO_Y = 0, DO_G = 96 * MiB, DO_LSE = 120 * MiB;
constexpr int ROWS_PAD = T * TOPK + NE * 256;

constexpr int CW_CNT = 0;
constexpr int CNT_SET = (REPEAT_PHASE == 6) ? 32 : 0;
constexpr int CW_ATTQ = 64;
constexpr int CW_SCANQ = 128;
constexpr int CW_BAR = 4096;
constexpr int CTL_ZERO_BYTES = 65536;
constexpr int BARST_OFF = 131072 + 1536;

#define LAS __attribute__((address_space(3)))

struct Params { const float* in[28]; float* out; unsigned char* ws; int ph_lo, ph_hi; };

__device__ __forceinline__ unsigned f2bf(float f) { unsigned u = __builtin_bit_cast(unsigned, f); return (u + 0x7fffu + ((u >> 16) & 1u)) >> 16; }
__device__ __forceinline__ unsigned pk2(float lo, float hi) { return f2bf(lo) | (f2bf(hi) << 16); }
__device__ __forceinline__ float bf2f(unsigned b) { return __builtin_bit_cast(float, b << 16); }
__device__ __forceinline__ float bflo(unsigned w) { return __builtin_bit_cast(float, w << 16); }
__device__ __forceinline__ float bfhi(unsigned w) { return __builtin_bit_cast(float, w & 0xffff0000u); }
template <int CTRL> __device__ __forceinline__ float dpp_mov(float v) {
    return __builtin_bit_cast(float, __builtin_amdgcn_update_dpp(0, __builtin_bit_cast(int, v), CTRL, 0xF, 0xF, true));
}
__device__ __forceinline__ float sum16(float v) {
    v += dpp_mov<0xB1>(v);
    v += dpp_mov<0x4E>(v);
    v += dpp_mov<0x141>(v);
    v += dpp_mov<0x140>(v);
    return v;
}
__device__ __forceinline__ float wave_sum(float v) {
    v = sum16(v);
    const int iv = __builtin_bit_cast(int, v);
    const float a = __builtin_bit_cast(float, __builtin_amdgcn_readlane(iv, 0)), b = __builtin_bit_cast(float, __builtin_amdgcn_readlane(iv, 16));
    const float c = __builtin_bit_cast(float, __builtin_amdgcn_readlane(iv, 32)), d = __builtin_bit_cast(float, __builtin_amdgcn_readlane(iv, 48));
    return (a + b) + (c + d);
}
__device__ __forceinline__ float sigmoidf_(float x) { return 1.f / (1.f + __expf(-x)); }

struct P0Item { const float* W; bf16_t* WT; int K, N, item; };
__device__ __forceinline__ void p0_item_load(const P0Item& I, float (&reg)[32], int lane) {
    const int nblk = I.N / 32, kb = I.item / nblk, nb = I.item % nblk, k0 = 64 * kb, n0 = 32 * nb;
    const float* src = I.W + (size_t)(k0 + (lane >> 5)) * I.N + n0 + (lane & 31);
#pragma unroll
    for (int i = 0; i < 32; ++i) reg[i] = src[(size_t)(2 * i) * I.N];
}
__device__ __forceinline__ void p0_item_store(const P0Item& I, const float (&reg)[32], LAS float* scr, int lane) {
    const int nblk = I.N / 32, kb = I.item / nblk, nb = I.item % nblk, k0 = 64 * kb, n0 = 32 * nb;
#pragma unroll
    for (int i = 0; i < 32; ++i) scr[(2 * i + (lane >> 5)) * 33 + (lane & 31)] = reg[i];
    asm volatile("s_waitcnt lgkmcnt(0)" ::: "memory");
    const int c = lane & 7;
#pragma unroll
    for (int j = 0; j < 4; ++j) { const int n = (lane >> 3) + 8 * j; const LAS float* s = scr + (8 * c) * 33 + n;
        u32x4 o; o.x = pk2(s[0 * 33], s[1 * 33]); o.y = pk2(s[2 * 33], s[3 * 33]); o.z = pk2(s[4 * 33], s[5 * 33]); o.w = pk2(s[6 * 33], s[7 * 33]);
        *(u32x4*)(I.WT + (size_t)(n0 + n) * I.K + k0 + 8 * c) = o; }
    asm volatile("s_waitcnt lgkmcnt(0)" ::: "memory");
}
__device__ __forceinline__ void ln_row(f32x4 (&v)[4], const float* __restrict__ g, const float* __restrict__ b, int lane) {
    float s = 0.f;
#pragma unroll
    for (int j = 0; j < 4; ++j) s += (v[j].x + v[j].y) + (v[j].z + v[j].w);
    const float mean = wave_sum(s) * (1.f / D); float s2 = 0.f;
#pragma unroll
    for (int j = 0; j < 4; ++j) { v[j] = v[j] - mean; s2 += (v[j].x * v[j].x + v[j].y * v[j].y) + (v[j].z * v[j].z + v[j].w * v[j].w); }
    const float rstd = 1.f / sqrtf(wave_sum(s2) * (1.f / D) + LN_EPS);
#pragma unroll
    for (int j = 0; j < 4; ++j) { const f32x4 gg = *(const f32x4*)(g + 4 * lane + 256 * j), bb = *(const f32x4*)(b + 4 * lane + 256 * j); v[j] = v[j] * rstd * gg + bb; }
}
__device__ __forceinline__ void store_row_bf16(bf16_t* orow, const f32x4 (&v)[4], int lane) {
#pragma unroll
    for (int j = 0; j < 4; ++j) { u32x2 o; o.x = pk2(v[j].x, v[j].y); o.y = pk2(v[j].z, v[j].w); *(u32x2*)(orow + 4 * lane + 256 * j) = o; }
}

__device__ __forceinline__ void phase0(const Params& p, LAS unsigned char* lds) {
    const int tid = threadIdx.x, lane = tid & 63, wave = tid >> 6;
    const int gw = blockIdx.x * NWAVES + wave, NGW = gridDim.x * NWAVES;
    LAS float* scr = (LAS float*)(lds + wave * 16384);
    unsigned char* ws = p.ws;
    constexpr int I_IN = 16 * (IN_W / 32), I_OUT = 16 * 32, I_KV = 16 * 16, I_GU = 16 * 64, I_DN = 16 * 32;
    constexpr int NITEMS = I_IN + I_OUT + I_KV + NE * I_GU + NE * I_DN;
    auto mk = [&](int it) { P0Item I; int r = it;
        if (r < I_IN) { I.W = p.in[4]; I.WT = (bf16_t*)(ws + WS_WT_IN); I.K = D; I.N = IN_W; I.item = r; return I; } r -= I_IN;
        if (r < I_OUT) { I.W = p.in[17]; I.WT = (bf16_t*)(ws + WS_WT_OUT); I.K = D; I.N = D; I.item = r; return I; } r -= I_OUT;
        if (r < I_KV) { I.W = p.in[16]; I.WT = (bf16_t*)(ws + WS_WT_KV); I.K = D; I.N = 2 * MW; I.item = r; return I; } r -= I_KV;
        if (r < NE * I_GU) { const int e = r / I_GU; I.W = p.in[22] + (size_t)e * D * 2 * FF; I.WT = (bf16_t*)(ws + WS_WT_GU) + (size_t)e * 2 * FF * D; I.K = D; I.N = 2 * FF; I.item = r % I_GU; return I; } r -= NE * I_GU;
        { const int e = r / I_DN; I.W = p.in[24] + (size_t)e * FF * D; I.WT = (bf16_t*)(ws + WS_WT_DN) + (size_t)e * D * FF; I.K = FF; I.N = D; I.item = r % I_DN; return I; } };
    { float ra[32], rb[32]; int it = gw;
      if (it < NITEMS) { const P0Item I0 = mk(it); p0_item_load(I0, ra, lane); }
      for (; it < NITEMS; it += 2 * NGW) {
          const P0Item Ia = mk(it); const bool hb = it + NGW < NITEMS; P0Item Ib = Ia;
          if (hb) { Ib = mk(it + NGW); p0_item_load(Ib, rb, lane); }
          p0_item_store(Ia, ra, scr, lane);
          if (it + 2 * NGW < NITEMS) { const P0Item Ic = mk(it + 2 * NGW); p0_item_load(Ic, ra, lane); }
          if (hb) p0_item_store(Ib, rb, scr, lane);
      } }
    { u32x4* z = (u32x4*)((bf16_t*)(ws + WS_WT_IN) + (size_t)IN_W * D); const int n16 = (IN_WP - IN_W) * D * 2 / 16;
      for (int i = blockIdx.x * NTHR + tid; i < n16; i += gridDim.x * NTHR) z[i] = (u32x4){0u, 0u, 0u, 0u}; }
    { const float* wr = p.in[20]; bf16_t* wh = (bf16_t*)(ws + WS_WRT); bf16_t* wl = wh + NE * D;
      for (int i = blockIdx.x * NTHR + tid; i < NE * D; i += gridDim.x * NTHR) { const int e = i / D, k = i % D; const float w = wr[k * NE + e]; const unsigned h = f2bf(w); wh[i] = (bf16_t)h; wl[i] = (bf16_t)f2bf(w - bf2f(h)); } }
    { bf16_t* wu = (bf16_t*)(ws + WS_LORA); bf16_t* au = wu + 2 * RC * 32; bf16_t* gu = au + 2 * RC * 32;
      for (int i = blockIdx.x * NTHR + tid; i < 2 * RC * 32; i += gridDim.x * NTHR) { const int dch = i >> 5, j = i & 31, d = dch / RC, ch = dch % RC; wu[i] = (bf16_t)f2bf(p.in[7][(size_t)(d * 32 + j) * RC + ch]); au[i] = (bf16_t)f2bf(p.in[9][(size_t)(d * 32 + j) * RC + ch]); }
      for (int i = blockIdx.x * NTHR + tid; i < RC * 64; i += gridDim.x * NTHR) { const int ch = i >> 6, j = i & 63; gu[i] = (bf16_t)f2bf(p.in[10][(size_t)j * RC + ch]); } }
    for (int m = gw; m < T; m += NGW) {
        const f32x4* xr = (const f32x4*)(p.in[0] + (size_t)m * D) + lane; f32x4 v[4];
#pragma unroll
        for (int j = 0; j < 4; ++j) v[j] = xr[64 * j];
        ln_row(v, p.in[2], p.in[3], lane);
        store_row_bf16((bf16_t*)(ws + WS_H0B) + (size_t)m * D, v, lane);
    }
    for (int m = gw; m < BATCH * NMEM; m += NGW) {
        const f32x4* xr = (const f32x4*)(p.in[1] + (size_t)m * D) + lane; f32x4 v[4];
#pragma unroll
        for (int j = 0; j < 4; ++j) v[j] = xr[64 * j];
        store_row_bf16((bf16_t*)(ws + WS_MEMB) + (size_t)m * D, v, lane);
    }
}

template <class ARow, class BRow, class Epi>
__device__ __forceinline__ void sgemm_tile(int K, ARow arow, BRow brow, Epi epi) {
    const int tid = threadIdx.x, wid = tid >> 6, lane = tid & 63, wm = wid >> 1, wn = wid & 1, fr = lane & 15, fq = lane >> 4;
    f32x4 acc[2][4];
#pragma unroll
    for (int m = 0; m < 2; ++m)
#pragma unroll
        for (int n = 0; n < 4; ++n) acc[m][n] = (f32x4){0.f, 0.f, 0.f, 0.f};
    const bf16_t* ap[2]; const bf16_t* bp[4];
#pragma unroll
    for (int m = 0; m < 2; ++m) ap[m] = arow(wm * 32 + m * 16 + fr) + fq * 8;
#pragma unroll
    for (int n = 0; n < 4; ++n) bp[n] = brow(wn * 64 + n * 16 + fr) + fq * 8;
    for (int k = 0; k < K; k += 32) {
        bf16x8 a[2], b[4];
#pragma unroll
        for (int m = 0; m < 2; ++m) a[m] = *(const bf16x8*)(ap[m] + k);
#pragma unroll
        for (int n = 0; n < 4; ++n) b[n] = *(const bf16x8*)(bp[n] + k);
#pragma unroll
        for (int m = 0; m < 2; ++m)
#pragma unroll
            for (int n = 0; n < 4; ++n) acc[m][n] = __builtin_amdgcn_mfma_f32_16x16x32_bf16(b[n], a[m], acc[m][n], 0, 0, 0);
    }
#pragma unroll
    for (int m = 0; m < 2; ++m)
#pragma unroll
        for (int n = 0; n < 4; ++n) epi(wm * 32 + m * 16 + fr, wn * 64 + n * 16 + 4 * fq, acc[m][n], n);
}


namespace pg8 {
constexpr int BM = 256, BK = 64, HALF = 128, HTB = HALF * BK * 2, STAGE_BYTES = 8 * HTB, NXCD = 8, WGM = 8;
__host__ __device__ __forceinline__ int lds_byte(int r, int c) { const int st = (r >> 4) * 2 + (c >> 5), rr = r & 15, cc = c & 31, ob = rr * 64 + cc * 2; return st * 1024 + (ob ^ (((ob >> 9) & 1) << 5)); }
__host__ __device__ __forceinline__ void stage_rc(int b, int& R, int& C) { const int st = b / 1024, sb = b % 1024, swz = sb ^ (((sb >> 9) & 1) << 5); R = (st >> 1) * 16 + swz / 64; C = (st & 1) * 32 + (swz % 64) / 2; }
__host__ __device__ __forceinline__ int perm32(int rho) { const int n = rho >> 4, i = rho & 15; return 8 * (i >> 2) + 4 * n + (i & 3); }
struct Unit { const char* A; const char* B0; const char* B1; int x0, x1, x2, x3, x4; };
__device__ __forceinline__ unsigned cvt_pk_bf16(float lo, float hi) { unsigned r; asm volatile("v_cvt_pk_bf16_f32 %0, %1, %2" : "=v"(r) : "v"(lo), "v"(hi)); return r; }

__device__ __forceinline__ const char* uni_ptr(const char* p) { const unsigned long long v = (unsigned long long)p; const unsigned lo = __builtin_amdgcn_readfirstlane((unsigned)v), hi = __builtin_amdgcn_readfirstlane((unsigned)(v >> 32)); return (const char*)(((unsigned long long)hi << 32) | lo); }
__device__ __forceinline__ bool static_order(int nM, int nN, int G, int c, int i, int& pm, int& pn) {
    const int nwg = nM * nN; const long L = (long)i * G + c; if (L >= nwg) return false;
    int wgid = (int)L; { const int q = nwg / NXCD, r = nwg % NXCD, xcd = wgid % NXCD, off = wgid / NXCD; wgid = (xcd < r ? xcd * (q + 1) : r * (q + 1) + (xcd - r) * q) + off; }
    const int nig = WGM * nN, gid = wgid / nig, fm = gid * WGM, gsz = (nM - fm) < WGM ? (nM - fm) : WGM;
    pm = fm + ((wgid % nig) % gsz); pn = (wgid % nig) / gsz; return true;
}

template <class Pol>
__device__ __forceinline__ void gemm_phase(LAS unsigned char* lds, const Pol& P, const int K) {
    const int tid = threadIdx.x, wid = __builtin_amdgcn_readfirstlane(tid >> 6), lane = tid & 63, wr = wid >> 2, wc = wid & 3, fr = lane & 15, fq = lane >> 4;
    const int nt = K / BK;
    int R0, C0; stage_rc(tid * 16, R0, C0);
    const int Rb0 = Pol::PERM ? ((R0 & ~31) + perm32(R0 & 31)) : R0;
    const unsigned vB = (unsigned)(Rb0 * K + C0) * 2u;
    const size_t pstep = (size_t)64 * K * 2;
    const size_t kstep = (size_t)(BK * 2);
    const unsigned ldsw = (unsigned)wid * 1024u;
    const int aoff = lds_byte(wr * 64 + fr, fq * 8), boff = lds_byte(wc * 32 + fr, fq * 8);
#define PG8_SA(b, h) (((b) * 2 + (h)) * HTB)
#define PG8_SB(b, h) ((4 + (b) * 2 + (h)) * HTB)
#define PG8_STAGE_B(bufoff, gbase) do { _Pragma("unroll") for (int _i = 0; _i < 2; ++_i) \
        __builtin_amdgcn_global_load_lds((const unsigned*)(uni_ptr((const char*)(gbase) + _i * pstep) + vB), (LAS unsigned*)(lds + (bufoff) + ldsw + _i * 8192), 16, 0, 0); } while (0)
#define PG8_STAGE_A(bufoff, gbase, vo, h) do { _Pragma("unroll") for (int _i = 0; _i < 2; ++_i) { \
        if constexpr (Pol::GATHER) __builtin_amdgcn_global_load_lds((const unsigned*)(uni_ptr((const char*)(gbase)) + (vo)[h][_i]), (LAS unsigned*)(lds + (bufoff) + ldsw + _i * 8192), 16, 0, 0); \
        else __builtin_amdgcn_global_load_lds((const unsigned*)(uni_ptr((const char*)(gbase) + ((h) * 2 + _i) * pstep) + (vo)[0][0]), (LAS unsigned*)(lds + (bufoff) + ldsw + _i * 8192), 16, 0, 0); } } while (0)
#define PG8_LDA(dst, b, h) do { _Pragma("unroll") for (int m = 0; m < 4; ++m) _Pragma("unroll") for (int k = 0; k < 2; ++k) dst[m][k] = *(const LAS bf16x8*)(lds + PG8_SA(b, h) + aoff + m * 2048 + k * 1024); } while (0)
#define PG8_LDB(dst, b, h) do { _Pragma("unroll") for (int n = 0; n < 2; ++n) _Pragma("unroll") for (int k = 0; k < 2; ++k) dst[n][k] = *(const LAS bf16x8*)(lds + PG8_SB(b, h) + boff + n * 2048 + k * 1024); } while (0)
#define PG8_MMA(ai, bj, At, Bt) do { __builtin_amdgcn_s_setprio(1); _Pragma("unroll") for (int m = 0; m < 4; ++m) _Pragma("unroll") for (int n = 0; n < 2; ++n) _Pragma("unroll") for (int k = 0; k < 2; ++k) \
        acc[ai][bj][m][n] = __builtin_amdgcn_mfma_f32_16x16x32_bf16(Bt[n][k], At[m][k], acc[ai][bj][m][n], 0, 0, 0); __builtin_amdgcn_s_setprio(0); } while (0)
#define PG8_WAIT_V(n) asm volatile("s_waitcnt vmcnt(" #n ")" ::: "memory")
#define PG8_WAIT_L(n) asm volatile("s_waitcnt lgkmcnt(" #n ")" ::: "memory")
#define PG8_BAR __builtin_amdgcn_s_barrier()
#define PG8_SCHED __builtin_amdgcn_sched_barrier(0)
    Unit cur, nxt; int ui = 0;
    if (!P.next(0, cur)) return;
    f32x4 acc[2][2][4][2];
#pragma unroll
    for (int a = 0; a < 2; ++a)
#pragma unroll
        for (int b = 0; b < 2; ++b)
#pragma unroll
            for (int m = 0; m < 4; ++m)
#pragma unroll
                for (int n = 0; n < 2; ++n) acc[a][b][m][n] = (f32x4){0.f, 0.f, 0.f, 0.f};
    bf16x8 At[4][2], B0[2][2], B1[2][2];
    unsigned vAc[2][2], vAn[2][2];
    if constexpr (Pol::GATHER) { P.rows_issue(cur, R0, vAc); P.rows_finish(C0, K, vAc); }
    else { vAc[0][0] = (unsigned)(R0 * K + C0) * 2u; vAc[0][1] = vAc[1][0] = vAc[1][1] = 0u; }
    asm volatile("s_waitcnt vmcnt(0)" ::: "memory");
    PG8_STAGE_B(PG8_SB(0, 0), cur.B0); PG8_STAGE_B(PG8_SB(0, 1), cur.B1); PG8_STAGE_A(PG8_SA(0, 0), cur.A, vAc, 0); PG8_STAGE_A(PG8_SA(0, 1), cur.A, vAc, 1);
    if (wr == 1) PG8_BAR;
    PG8_WAIT_V(2); PG8_BAR;
    PG8_STAGE_B(PG8_SB(1, 0), cur.B0 + kstep); PG8_STAGE_A(PG8_SA(1, 0), cur.A + kstep, vAc, 0); PG8_STAGE_B(PG8_SB(1, 1), cur.B1 + kstep);
    PG8_WAIT_V(6); PG8_BAR;
    for (;;) {
        const bool has_next = P.next(ui + 1, nxt);
        if (!has_next) nxt = cur;
        for (int t = 0; t < nt; t += 2) {
            const bool last = (t == nt - 2);
            if constexpr (Pol::GATHER) {
                if (last && has_next) { P.rows_issue(nxt, R0, vAn); vAc[0][0] = (vAn[0][0] * (unsigned)K + (unsigned)C0) * 2u; vAc[0][1] = (vAn[0][1] * (unsigned)K + (unsigned)C0) * 2u; }
            }
            const char* a1 = cur.A + (size_t)(t + 1) * kstep;
            const char* a2 = last ? nxt.A : cur.A + (size_t)(t + 2) * kstep;
            const char* b20 = last ? nxt.B0 : cur.B0 + (size_t)(t + 2) * kstep; const char* b21 = last ? nxt.B1 : cur.B1 + (size_t)(t + 2) * kstep;
            const char* a3 = a2 + kstep; const char* b30 = b20 + kstep; const char* b31 = b21 + kstep;
            PG8_LDB(B0, 0, 0); PG8_LDB(B1, 0, 1); PG8_SCHED; PG8_LDA(At, 0, 0); PG8_STAGE_A(PG8_SA(1, 1), a1, vAc, 1);
            if constexpr (Pol::GATHER) { if (last && has_next) { vAc[1][0] = (vAn[1][0] * (unsigned)K + (unsigned)C0) * 2u; vAc[1][1] = (vAn[1][1] * (unsigned)K + (unsigned)C0) * 2u; } }
            PG8_WAIT_V(8); PG8_WAIT_L(0); PG8_BAR; PG8_MMA(0, 0, At, B0); PG8_MMA(0, 1, At, B1); PG8_BAR; PG8_SCHED;
            PG8_LDA(At, 0, 1); PG8_STAGE_B(PG8_SB(0, 0), b20); PG8_STAGE_B(PG8_SB(0, 1), b21); PG8_STAGE_A(PG8_SA(0, 0), a2, vAc, 0);
            PG8_WAIT_V(8); PG8_WAIT_L(0); PG8_BAR; PG8_MMA(1, 0, At, B0); PG8_MMA(1, 1, At, B1); PG8_BAR; PG8_SCHED;
            PG8_LDB(B0, 1, 0); PG8_LDB(B1, 1, 1); PG8_SCHED; PG8_LDA(At, 1, 0); PG8_STAGE_A(PG8_SA(0, 1), a2, vAc, 1);
            PG8_WAIT_V(8); PG8_WAIT_L(0); PG8_BAR; PG8_MMA(0, 0, At, B0); PG8_MMA(0, 1, At, B1); PG8_BAR; PG8_SCHED;
            PG8_LDA(At, 1, 1); PG8_STAGE_B(PG8_SB(1, 0), b30); PG8_STAGE_B(PG8_SB(1, 1), b31); PG8_STAGE_A(PG8_SA(1, 0), a3, vAc, 0);
            PG8_WAIT_V(8); PG8_WAIT_L(0); PG8_BAR; PG8_MMA(1, 0, At, B0); PG8_MMA(1, 1, At, B1); PG8_BAR; PG8_SCHED;
        }
        if (wr == 0) PG8_BAR;
        P.epi(acc, cur, wr, wc, fr, fq);
        if (!has_next) break;
#pragma unroll
        for (int a = 0; a < 2; ++a)
#pragma unroll
            for (int b = 0; b < 2; ++b)
#pragma unroll
                for (int m = 0; m < 4; ++m)
#pragma unroll
                    for (int n = 0; n < 2; ++n) acc[a][b][m][n] = (f32x4){0.f, 0.f, 0.f, 0.f};
        cur = nxt; ++ui;
        if (wr == 1) PG8_BAR;
    }
    PG8_WAIT_V(0);
    PG8_BAR;
#undef PG8_SA
#undef PG8_SB
#undef PG8_STAGE_A
#undef PG8_STAGE_B
#undef PG8_LDA
#undef PG8_LDB
#undef PG8_MMA
#undef PG8_WAIT_V
#undef PG8_WAIT_L
#undef PG8_BAR
#undef PG8_SCHED
}
}

struct PolP1 {
    static constexpr bool PERM = true, GATHER = false;
    const bf16_t* A; const bf16_t* Bt; bf16_t* PR; bf16_t* PA; int G, c;
    __device__ __forceinline__ bool next(int i, pg8::Unit& u) const { int pm, pn; if (!pg8::static_order(T / 256, IN_WP / 256, G, c, i, pm, pn)) return false;
        u.A = (const char*)(A + (size_t)pm * 256 * D); u.B0 = (const char*)(Bt + (size_t)pn * 256 * D); u.B1 = u.B0 + (size_t)128 * D * 2; u.x0 = pm; u.x1 = pn; u.x2 = 0; u.x3 = 0; u.x4 = 0; return true; }
    __device__ __forceinline__ void epi(const f32x4 (&acc)[2][2][4][2], const pg8::Unit& u, int wr, int wc, int fr, int fq) const {
        const int row0 = u.x0 * 256 + wr * 64 + fr;
#pragma unroll
        for (int bj = 0; bj < 2; ++bj) { const int col = u.x1 * 256 + bj * 128 + wc * 32 + 8 * fq;
            bf16_t* base; int pitch; float sc = 1.f;
            if (col < RWKV_IN) { base = PR + col; pitch = RWKV_IN; }
            else { const int ca = col - RWKV_IN; base = PA + ca; pitch = PA_W; sc = (ca < AW || (ca >= 3 * AW && ca < 3 * AW + MW)) ? 0.125f : 1.f; }
#pragma unroll
            for (int ai = 0; ai < 2; ++ai)
#pragma unroll
                for (int m = 0; m < 4; ++m) { const f32x4 v0 = acc[ai][bj][m][0] * sc, v1 = acc[ai][bj][m][1] * sc;
                    u32x4 w; w.x = pg8::cvt_pk_bf16(v0[0], v0[1]); w.y = pg8::cvt_pk_bf16(v0[2], v0[3]); w.z = pg8::cvt_pk_bf16(v1[0], v1[1]); w.w = pg8::cvt_pk_bf16(v1[2], v1[3]);
                    *(u32x4*)(base + (size_t)(row0 + ai * 128 + m * 16) * pitch) = w; } }
    }
};
__device__ __forceinline__ void phase1(const Params& p, LAS unsigned char* lds) {
    unsigned char* ws = p.ws;
    { PolP1 P{(const bf16_t*)(ws + WS_H0B), (const bf16_t*)(ws + WS_WT_IN), (bf16_t*)(ws + WS_PR), (bf16_t*)(ws + WS_PA), (int)gridDim.x, (int)blockIdx.x};
      pg8::gemm_phase(lds, P, D); }
    constexpr int U_KV = (BATCH * NMEM / 128) * (2 * MW / 128);
    for (int u = blockIdx.x; u < U_KV; u += gridDim.x) {
        const int pn = u % 4, pm = u / 4, r0 = pm * 128, c0 = pn * 128;
        const bf16_t* MB = (const bf16_t*)(ws + WS_MEMB); const bf16_t* WK = (const bf16_t*)(ws + WS_WT_KV); bf16_t* KVM = (bf16_t*)(ws + WS_KVM);
        sgemm_tile(D, [&](int r) { return MB + (size_t)(r0 + r) * D; }, [&](int c) { return WK + (size_t)(c0 + c) * D; },
            [&](int r, int c, f32x4 v, int) { u32x2 o; o.x = pk2(v.x, v.y); o.y = pk2(v.z, v.w); *(u32x2*)(KVM + (size_t)(r0 + r) * (2 * MW) + c0 + c) = o; });
    }
}

constexpr int P2_AP = 200;
__device__ __forceinline__ f32x4 p2_shift(const bf16_t* cur, int po, int no, float pm, float nm, const float* mu) {
    const u32x2 c = *(const u32x2*)cur, pv = *(const u32x2*)(cur + po), nv = *(const u32x2*)(cur + no);
    const f32x4 m = *(const f32x4*)mu;
    const f32x4 cc = {bflo(c.x), bfhi(c.x), bflo(c.y), bfhi(c.y)}, pp = {bflo(pv.x), bfhi(pv.x), bflo(pv.y), bfhi(pv.y)}, nn = {bflo(nv.x), bfhi(nv.x), bflo(nv.y), bfhi(nv.y)};
    return cc + m * (0.5f * (pp * pm + nn * nm) - cc);
}
__device__ __forceinline__ void phase2(const Params& p, LAS unsigned char* lds) {
    const int tid = threadIdx.x, lane = tid & 63, wave = tid >> 6, fr = lane & 15, fq = lane >> 4;
    unsigned char* ws = p.ws;
    const bf16_t* PR = (const bf16_t*)(ws + WS_PR);
    const float* mu = p.in[5];
    const bf16_t* WU = (const bf16_t*)(ws + WS_LORA); const bf16_t* AU = WU + 2 * RC * 32; const bf16_t* GU = AU + 2 * RC * 32;
    LAS bf16_t* ACT = (LAS bf16_t*)(lds + wave * (16 * P2_AP * 2));
    float* SSH = (float*)(ws + WS_SSH); float* SDIR = (float*)(ws + WS_SDIR);
    bf16_t* G = (bf16_t*)((unsigned char*)p.out + DO_G); float* BON = (float*)(ws + WS_BONUS);
    for (int tile = blockIdx.x * NWAVES + wave; tile < T / 16; tile += gridDim.x * NWAVES) {
        const int t0 = tile * 16;
#pragma unroll 4
        for (int i = 0; i < 12; ++i) { const int grp = lane + 64 * i, tok = grp / 48, c4 = (grp % 48) * 4, t = t0 + tok, sq = t & (SEQ - 1);
            f32x4 v = p2_shift(PR + (size_t)t * RWKV_IN + 3 * RC + c4, sq > 0 ? -RWKV_IN : 0, sq < SEQ - 1 ? RWKV_IN : 0, sq > 0 ? 1.f : 0.f, sq < SEQ - 1 ? 1.f : 0.f, mu + 3 * RC + c4);
            { const float sc = c4 < 64 ? 1.f : 2.f, mul = c4 < 64 ? 1.f : 2.f, add = c4 < 64 ? 0.f : -1.f; const bool raw = c4 >= 128;
#pragma unroll
              for (int e = 0; e < 4; ++e) { const float a = sigmoidf_(sc * v[e]) * mul + add; v[e] = raw ? v[e] : a; } }
            u32x2 o; o.x = pk2(v.x, v.y); o.y = pk2(v.z, v.w); *(LAS u32x2*)(ACT + tok * P2_AP + c4) = o; }
        asm volatile("s_waitcnt lgkmcnt(0)" ::: "memory");
        const int t = t0 + fr, sq = t & (SEQ - 1), b = t >> 11; const int po = sq > 0 ? -RWKV_IN : 0, no = sq < SEQ - 1 ? RWKV_IN : 0; const float pm = sq > 0 ? 1.f : 0.f, nm = sq < SEQ - 1 ? 1.f : 0.f;
        const bf16_t* prow = PR + (size_t)t * RWKV_IN;
        const bf16x8 bsg0 = *(const LAS bf16x8*)(ACT + fr * P2_AP + 8 * fq), bsg1 = *(const LAS bf16x8*)(ACT + fr * P2_AP + 32 + 8 * fq);
        const bf16x8 btw0 = *(const LAS bf16x8*)(ACT + fr * P2_AP + 64 + 8 * fq), btw1 = *(const LAS bf16x8*)(ACT + fr * P2_AP + 96 + 8 * fq);
        const bf16x8 bal0 = *(const LAS bf16x8*)(ACT + fr * P2_AP + 128 + 8 * fq), bal1 = *(const LAS bf16x8*)(ACT + fr * P2_AP + 160 + 8 * fq);
#pragma unroll 1
        for (int h = 0; h < RH; ++h) {
            f32x4 kp[4]; float ss = 0.f;
#pragma unroll
            for (int ct = 0; ct < 4; ++ct) { const int ch = h * 64 + 16 * ct + 4 * fq; kp[ct] = p2_shift(prow + RC + ch, po, no, pm, nm, mu + RC + ch);
                const f32x4 kkv = kp[ct] * *(const f32x4*)(p.in[11] + ch); ss += (kkv.x * kkv.x + kkv.y * kkv.y) + (kkv.z * kkv.z + kkv.w * kkv.w); }
            ss += __shfl_xor(ss, 16); ss += __shfl_xor(ss, 32);
            const float rn = 1.f / fmaxf(sqrtf(ss), 1e-12f);
            float bon = 0.f;
            unsigned char* shrec = (unsigned char*)SSH + ((size_t)(b * RH + h) * SEQ + sq) * 384;
            unsigned char* d0rec = (unsigned char*)SDIR + ((size_t)((0 * BATCH + b) * RH + h) * SEQ + sq) * 512; unsigned char* d1rec = (unsigned char*)SDIR + ((size_t)((1 * BATCH + b) * RH + h) * SEQ + sq) * 512;
#pragma unroll
            for (int ct = 0; ct < 4; ++ct) { const int ch = h * 64 + 16 * ct + 4 * fq, cl = 16 * ct + 4 * fq;
                const f32x4 r = p2_shift(prow + ch, po, no, pm, nm, mu + ch), v = p2_shift(prow + 2 * RC + ch, po, no, pm, nm, mu + 2 * RC + ch), k = kp[ct];
                const bf16_t* wrow = WU + (size_t)(h * 64 + 16 * ct + fr) * 32 + 8 * fq; const bf16_t* arow = AU + (size_t)(h * 64 + 16 * ct + fr) * 32 + 8 * fq;
                const bf16_t* grow = GU + (size_t)(h * 64 + 16 * ct + fr) * 64 + 8 * fq;
                const f32x4 z = {0.f, 0.f, 0.f, 0.f};
                const f32x4 wl0 = __builtin_amdgcn_mfma_f32_16x16x32_bf16(*(const bf16x8*)wrow, btw0, z, 0, 0, 0);
                const f32x4 wl1 = __builtin_amdgcn_mfma_f32_16x16x32_bf16(*(const bf16x8*)(wrow + RC * 32), btw1, z, 0, 0, 0);
                const f32x4 al0 = __builtin_amdgcn_mfma_f32_16x16x32_bf16(*(const bf16x8*)arow, bal0, z, 0, 0, 0);
                const f32x4 al1 = __builtin_amdgcn_mfma_f32_16x16x32_bf16(*(const bf16x8*)(arow + RC * 32), bal1, z, 0, 0, 0);
                f32x4 gg = __builtin_amdgcn_mfma_f32_16x16x32_bf16(*(const bf16x8*)grow, bsg0, z, 0, 0, 0);
                gg = __builtin_amdgcn_mfma_f32_16x16x32_bf16(*(const bf16x8*)(grow + 32), bsg1, gg, 0, 0, 0);
                const f32x4 w00 = *(const f32x4*)(p.in[6] + ch), w01 = *(const f32x4*)(p.in[6] + RC + ch), a00 = *(const f32x4*)(p.in[8] + ch), a01 = *(const f32x4*)(p.in[8] + RC + ch);
                const f32x4 kkw = *(const f32x4*)(p.in[11] + ch), kaw = *(const f32x4*)(p.in[12] + ch), rkw = *(const f32x4*)(p.in[13] + ch);
                f32x4 dec0, dec1, kd0, kd1, bb0, bb1, kkn;
#pragma unroll
                for (int e = 0; e < 4; ++e) {
                    dec0[e] = __expf(-0.6065306597126334f * sigmoidf_(w00[e] + wl0[e])); dec1[e] = __expf(-0.6065306597126334f * sigmoidf_(w01[e] + wl1[e]));
                    const float a0 = sigmoidf_(a00[e] + al0[e]), a1 = sigmoidf_(a01[e] + al1[e]);
                    kkn[e] = k[e] * kkw[e] * rn; kd0[e] = k[e] * (1.f + (a0 - 1.f) * kaw[e]); kd1[e] = k[e] * (1.f + (a1 - 1.f) * kaw[e]);
                    bb0[e] = kkn[e] * a0; bb1[e] = kkn[e] * a1; bon += r[e] * (kd0[e] + kd1[e]) * rkw[e]; }
                { u32x2 o; o.x = pk2(r.x, r.y); o.y = pk2(r.z, r.w); *(u32x2*)(shrec + cl * 2) = o; o.x = pk2(v.x, v.y); o.y = pk2(v.z, v.w); *(u32x2*)(shrec + 128 + cl * 2) = o;
                  o.x = pk2(kkn.x, kkn.y); o.y = pk2(kkn.z, kkn.w); *(u32x2*)(shrec + 256 + cl * 2) = o;
                  *(f32x4*)(d0rec + cl * 4) = dec0; o.x = pk2(kd0.x, kd0.y); o.y = pk2(kd0.z, kd0.w); *(u32x2*)(d0rec + 256 + cl * 2) = o; o.x = pk2(bb0.x, bb0.y); o.y = pk2(bb0.z, bb0.w); *(u32x2*)(d0rec + 384 + cl * 2) = o;
                  *(f32x4*)(d1rec + cl * 4) = dec1; o.x = pk2(kd1.x, kd1.y); o.y = pk2(kd1.z, kd1.w); *(u32x2*)(d1rec + 256 + cl * 2) = o; o.x = pk2(bb1.x, bb1.y); o.y = pk2(bb1.z, bb1.w); *(u32x2*)(d1rec + 384 + cl * 2) = o; }
                u32x2 go; go.x = pk2(gg.x, gg.y); go.y = pk2(gg.z, gg.w); *(u32x2*)(G + (size_t)t * RC + ch) = go;
            }
            bon += __shfl_xor(bon, 16); bon += __shfl_xor(bon, 32);
            if (fq == 0) BON[t * RH + h] = bon;
        }
    }
}

constexpr int SC_TC = 16;
constexpr int SC_STEPB = 1408;
constexpr int SC_BUFB = SC_TC * SC_STEPB;
struct ScanProd { const unsigned char* gsrc; long gstep; int ldst; int conv; };
__device__ __forceinline__ ScanProd scan_prod_init(const unsigned char* sh, const unsigned char* dr, int dir, int ptid) {
    ScanProd P; const int wi = ptid % 56, st0 = ptid / 56; const unsigned char* src; int shift = 0; bool fromsh = false;
    if (wi < 16) { src = dr + wi * 16; P.ldst = wi * 16; P.conv = 0; }
    else if (wi < 24) { src = dr + 256 + (wi - 16) * 16; P.ldst = 512 + (wi - 16) * 32; P.conv = 1; }
    else if (wi < 32) { src = dr + 384 + (wi - 24) * 16; P.ldst = 256 + (wi - 24) * 32; P.conv = 1; }
    else if (wi < 40) { src = sh + 128 + (wi - 32) * 16; P.ldst = 768 + (wi - 32) * 32; P.conv = 1; fromsh = true; }
    else if (wi < 48) { src = sh + 256 + (wi - 40) * 16; P.ldst = 1024 + (wi - 40) * 16; P.conv = 0; fromsh = true; }
    else { src = sh + (wi - 48) * 16; P.ldst = 1152 + (wi - 48) * 16; P.conv = 0; shift = 1; fromsh = true; }
    const long rec = fromsh ? 384 : 512;
    const long t0 = dir ? (long)(SEQ - 1 - (st0 - shift)) : (long)(st0 - shift);
    P.gsrc = src + t0 * rec; P.gstep = dir ? -rec : rec; P.ldst += st0 * SC_STEPB; return P;
}
__device__ __forceinline__ void scan_fetch(const ScanProd& P, int c, u32x4 (&reg)[SC_TC / 4]) {
    const unsigned char* g = P.gsrc + (long)(c * SC_TC) * P.gstep;
#pragma unroll
    for (int q = 0; q < SC_TC / 4; ++q) reg[q] = *(const u32x4*)(g + (long)(4 * q) * P.gstep);
}
__device__ __forceinline__ void scan_put(const ScanProd& P, LAS unsigned char* buf, const u32x4 (&reg)[SC_TC / 4]) {
    LAS unsigned char* d = buf + P.ldst;
    if (P.conv) {
#pragma unroll
        for (int q = 0; q < SC_TC / 4; ++q) { const u32x4 x = reg[q];
            *(LAS f32x4*)(d + 4 * q * SC_STEPB) = (f32x4){bflo(x.x), bfhi(x.x), bflo(x.y), bfhi(x.y)}; *(LAS f32x4*)(d + 4 * q * SC_STEPB + 16) = (f32x4){bflo(x.z), bfhi(x.z), bflo(x.w), bfhi(x.w)}; }
    } else {
#pragma unroll
        for (int q = 0; q < SC_TC / 4; ++q) *(LAS u32x4*)(d + 4 * q * SC_STEPB) = reg[q];
    }
}
__device__ __forceinline__ void scan_block(const Params& p, LAS unsigned char* lds, int sid) {
    const int tid = threadIdx.x, lane = tid & 63, wave = tid >> 6;
    const int dir = sid / (BATCH * RH), bh = sid % (BATCH * RH), b = bh / RH, h = bh % RH;
    const unsigned char* sh = p.ws + WS_SSH + (size_t)bh * SEQ * 384;
    const unsigned char* dr = p.ws + WS_SDIR + (size_t)(dir * BATCH * RH + bh) * SEQ * 512;
    float* Y = (float*)((unsigned char*)p.out + DO_Y) + (size_t)dir * T * RC;
    LAS unsigned char* buf0 = lds; LAS unsigned char* buf1 = lds + SC_BUFB;
    constexpr int NCH = SEQ / SC_TC;
    __syncthreads();
    for (int i = tid; i < 2 * SC_TC * 32; i += NTHR) { const int st = i >> 5, e = i & 31; *(LAS unsigned*)(lds + st * SC_STEPB + 1280 + e * 4) = 0u; }
    const ScanProd SP = scan_prod_init(sh, dr, dir, (tid - 256) & 255);
    const bool prod = wave >= 4 && tid - 256 < 224;
    u32x4 preg[SC_TC / 4];
    if (prod) { scan_fetch(SP, 0, preg); scan_put(SP, buf0, preg); scan_fetch(SP, 1, preg); }
    __syncthreads();
    const int fr = lane & 15, fq = lane >> 4, sel = (fr & 3) < 2 ? (fr & 3) : 2;
    float s[16];
#pragma unroll
    for (int j = 0; j < 16; ++j) s[j] = 0.f;
    bf16x8 sb0 = (bf16x8){0, 0, 0, 0, 0, 0, 0, 0}, sb1 = sb0;
    float* yrow = Y + (size_t)b * SEQ * RC + h * 64 + 16 * wave + fr;
    float yk = 0.f;
    for (int c = 0; c < NCH; ++c) {
        LAS unsigned char* cur = (c & 1) ? buf1 : buf0; LAS unsigned char* nxt = (c & 1) ? buf0 : buf1;
        if (wave >= 4) {
            if (prod && c + 1 < NCH) { scan_put(SP, nxt, preg); if (c + 2 < NCH) scan_fetch(SP, c + 2, preg); }
        } else {
            const LAS unsigned char* cb = cur + fq * 32;
            const LAS unsigned char* ab = cur + 1024 + 128 * sel + fq * 16;
            const LAS unsigned char* vb = cur + 768 + (16 * wave + fr) * 4;
            bf16x8 cA0, cA1, nA0, nA1; f32x4 cW[4], cK[4], cB[4], nW[4], nK[4], nB[4]; float cV, nV;
#define SC_LOAD(A0, A1, W, K, B, V, st) do { const LAS unsigned char* q_ = cb + (st) * SC_STEPB; \
                A0 = *(const LAS bf16x8*)(ab + (st) * SC_STEPB); A1 = *(const LAS bf16x8*)(ab + (st) * SC_STEPB + 64); \
                W[0] = *(const LAS f32x4*)(q_); W[1] = *(const LAS f32x4*)(q_ + 16); W[2] = *(const LAS f32x4*)(q_ + 128); W[3] = *(const LAS f32x4*)(q_ + 144); \
                K[0] = *(const LAS f32x4*)(q_ + 512); K[1] = *(const LAS f32x4*)(q_ + 528); K[2] = *(const LAS f32x4*)(q_ + 640); K[3] = *(const LAS f32x4*)(q_ + 656); \
                B[0] = *(const LAS f32x4*)(q_ + 256); B[1] = *(const LAS f32x4*)(q_ + 272); B[2] = *(const LAS f32x4*)(q_ + 384); B[3] = *(const LAS f32x4*)(q_ + 400); \
                V = *(const LAS float*)(vb + (st) * SC_STEPB); } while (0)
            SC_LOAD(cA0, cA1, cW, cK, cB, cV, 0);
#pragma unroll 1
            for (int g = 0; g < SC_TC / 4; ++g) {
#pragma unroll
                for (int u = 0; u < 4; ++u) {
                    const int st = 4 * g + u;
                    f32x4 d = (f32x4){0.f, 0.f, 0.f, 0.f};
                    d = __builtin_amdgcn_mfma_f32_16x16x32_bf16(cA0, sb0, d, 0, 0, 0);
                    d = __builtin_amdgcn_mfma_f32_16x16x32_bf16(cA1, sb1, d, 0, 0, 0);
                    if (st + 1 < SC_TC) SC_LOAD(nA0, nA1, nW, nK, nB, nV, st + 1);
#define OPQ(x) asm("" : "+v"(x))
                    float tt[16];
#pragma unroll
                    for (int j = 0; j < 16; ++j) { tt[j] = cV * cK[j >> 2][j & 3]; OPQ(tt[j]); }
#pragma unroll
                    for (int j = 0; j < 16; ++j) { tt[j] = s[j] * cW[j >> 2][j & 3] + tt[j]; OPQ(tt[j]); }
                    const float nsa = -d[0];
                    yk = (((u + 3) & 3) == fq) ? d[1] : yk;
                    if (u == 0) {
                        const int tau = c * SC_TC + 4 * g - 4 + fq;
                        if (tau >= 0) { const int t = dir ? (SEQ - 1 - tau) : tau; yrow[(size_t)t * RC] = yk; } }
#pragma unroll
                    for (int j = 0; j < 16; ++j) { s[j] = nsa * cB[j >> 2][j & 3] + tt[j]; OPQ(s[j]); }
#undef OPQ
                    u32x4 p0, p1;
                    p0.x = pg8::cvt_pk_bf16(s[0], s[1]); p0.y = pg8::cvt_pk_bf16(s[2], s[3]); p0.z = pg8::cvt_pk_bf16(s[4], s[5]); p0.w = pg8::cvt_pk_bf16(s[6], s[7]);
                    p1.x = pg8::cvt_pk_bf16(s[8], s[9]); p1.y = pg8::cvt_pk_bf16(s[10], s[11]); p1.z = pg8::cvt_pk_bf16(s[12], s[13]); p1.w = pg8::cvt_pk_bf16(s[14], s[15]);
                    sb0 = __builtin_bit_cast(bf16x8, p0); sb1 = __builtin_bit_cast(bf16x8, p1);
                    cA0 = nA0; cA1 = nA1; cV = nV;
#pragma unroll
                    for (int i = 0; i < 4; ++i) { cW[i] = nW[i]; cK[i] = nK[i]; cB[i] = nB[i]; }
                    asm volatile("" ::: "memory");
                }
            }
#undef SC_LOAD
        }
        __syncthreads();
    }
    if (wave < 4) {
        if (fq < 3) { const int tau = SEQ - 4 + fq, t = dir ? (SEQ - 1 - tau) : tau; yrow[(size_t)t * RC] = yk; }
        const int t = dir ? 0 : (SEQ - 1); const bf16_t* rr = (const bf16_t*)(sh + (size_t)t * 384);
        float acc = 0.f;
#pragma unroll
        for (int j = 0; j < 8; ++j) { acc += bf2f((unsigned)(unsigned short)sb0[j]) * bf2f(rr[8 * fq + j]); acc += bf2f((unsigned)(unsigned short)sb1[j]) * bf2f(rr[32 + 8 * fq + j]); }
        acc += __shfl_xor(acc, 16); acc += __shfl_xor(acc, 32);
        if (fq == 0) yrow[(size_t)t * RC] = acc;
    }
    __syncthreads();
}

constexpr int AT_P = 72;
constexpr int AT_KOFF = 0, AT_VOFF = 256 * AT_P * 2;
constexpr int ATT_DIL_UNITS = BATCH * AH * 48;
constexpr int ATT_MEM_UNITS = BATCH * MH * 16;
constexpr int ATT_UNITS = ATT_DIL_UNITS + ATT_MEM_UNITS;
struct AttU { const bf16_t* q; const bf16_t* k; const bf16_t* v; long qs, ks; int kind, win0, L, dil; float slope; bf16_t* o; long os; float* lse; long ls; };
__device__ __forceinline__ void att_make_unit(const Params& p, int u, AttU& U) {
    unsigned char* ws = p.ws; const bf16_t* PA = (const bf16_t*)(ws + WS_PA);
    if (u < ATT_DIL_UNITS) {
        const int bh = u / 48, x = u % 48, b = bh / AH, h = bh % AH, br = x >> 4, y = x & 15;
        const int dil = br == 0 ? 1 : (br == 1 ? 4 : 16), L = SEQ / dil, npr = L / 128, r = y / npr, np = y % npr;
        const bf16_t* base = PA + (size_t)(b * SEQ + r) * PA_W + h * 64;
        U.kind = 0; U.win0 = (2 * np - 1) * 64; U.L = L; U.dil = dil; U.slope = exp2f(-8.f * (float)(h + 1) / (float)AH);
        U.qs = (long)dil * PA_W; U.ks = U.qs;
        U.q = base + (long)(np * 128) * U.qs; U.k = base + AW; U.v = base + 2 * AW;
        const size_t tok0 = (size_t)(b * SEQ + r) + (size_t)np * 128 * dil;
        U.o = (bf16_t*)(ws + WS_ATTO) + (size_t)br * T * AW + tok0 * AW + h * 64; U.os = (long)dil * AW;
        U.lse = (float*)((unsigned char*)p.out + DO_LSE) + (size_t)br * T * AH + tok0 * AH + h; U.ls = (long)dil * AH;
    } else {
        const int v = u - ATT_DIL_UNITS, bh = v >> 4, qb = v & 15, b = bh / MH, h = bh % MH;
        const bf16_t* KVM = (const bf16_t*)(ws + WS_KVM);
        U.kind = 1; U.win0 = 0; U.L = NMEM; U.dil = 1; U.slope = 0.f;
        U.q = PA + (size_t)(b * SEQ + qb * 128) * PA_W + 3 * AW + h * 64; U.qs = PA_W;
        U.k = KVM + (size_t)(b * NMEM) * (2 * MW) + h * 64; U.v = U.k + MW; U.ks = 2 * MW;
        U.o = (bf16_t*)(ws + WS_YMIX) + (size_t)(b * SEQ + qb * 128) * D + RC + AW + h * 64; U.os = D;
        U.lse = nullptr; U.ls = 0;
    }
}
__device__ __forceinline__ void att_fetch(const AttU& U, u32x4 (&reg)[8], int tid) {
#pragma unroll
    for (int q = 0; q < 8; ++q) { const int rem = (tid + NTHR * q) & 2047, row = rem >> 3, ch = rem & 7; const int lk = U.win0 + row; const bool ok = lk >= 0 && lk < U.L;
        const bf16_t* src = (q < 4 ? U.k : U.v) + (long)(ok ? lk : 0) * U.ks + ch * 8;
        u32x4 raw = *(const u32x4*)src; if (!ok) raw = (u32x4){0u, 0u, 0u, 0u}; reg[q] = raw; }
}
__device__ __forceinline__ void att_put(LAS unsigned char* lds, const u32x4 (&reg)[8], int tid) {
#pragma unroll
    for (int q = 0; q < 8; ++q) { const int rem = (tid + NTHR * q) & 2047, row = rem >> 3, ch = rem & 7;
        *(LAS u32x4*)(lds + (q < 4 ? AT_KOFF : AT_VOFF) + row * (AT_P * 2) + ch * 16) = reg[q]; }
}
typedef short v4i16_t __attribute__((ext_vector_type(4)));
template <int NT  , bool DIL>
__device__ __forceinline__ void att_compute(const AttU& U, LAS unsigned char* lds, int w, int lane) {
    const int fr = lane & 15, fq = lane >> 4;
    const bf16_t* qp = U.q + (long)(16 * w + fr) * U.qs + fq * 8;
    const bf16x8 q0 = *(const bf16x8*)qp, q1 = *(const bf16x8*)(qp + 32);
    f32x4 sT[NT];
#pragma unroll
    for (int i = 0; i < NT; ++i) {
        if (DIL && i == 9) { sT[i] = (f32x4){-1e30f, -1e30f, -1e30f, -1e30f}; continue; }
        int tt = DIL ? w + i : i; tt = tt > 15 ? 15 : tt;
        const LAS unsigned char* kp = lds + AT_KOFF + (16 * tt + fr) * (AT_P * 2) + fq * 16;
        const bf16x8 k0 = *(const LAS bf16x8*)kp, k1 = *(const LAS bf16x8*)(kp + 64);
        f32x4 a = (f32x4){0.f, 0.f, 0.f, 0.f};
        a = __builtin_amdgcn_mfma_f32_16x16x32_bf16(k0, q0, a, 0, 0, 0);
        a = __builtin_amdgcn_mfma_f32_16x16x32_bf16(k1, q1, a, 0, 0, 0);
        sT[i] = a; if ((i & 3) == 3) asm volatile("" ::: "memory"); }
    float m = -3.0e38f;
    if (DIL) {
        const int c0 = 4 * fq - fr, lb = U.win0 + 16 * w + 4 * fq; const float sd = U.slope * (float)U.dil; const unsigned Lc = (unsigned)U.L;
#pragma unroll
        for (int i = 0; i < NT; ++i) { if (i == 9) continue;
#pragma unroll
            for (int r = 0; r < 4; ++r) { const int dl = 16 * i + r - 64 + c0, ad = dl < 0 ? -dl : dl;
                bool valid = (unsigned)(lb + 16 * i + r) < Lc; if (i == 0 || i >= 7) valid = valid && ad <= 64;
                const float sv = valid ? sT[i][r] - sd * (float)ad : -1e30f; sT[i][r] = sv; m = fmaxf(m, sv); } }
    } else {
#pragma unroll
        for (int i = 0; i < NT; ++i)
#pragma unroll
            for (int r = 0; r < 4; ++r) m = fmaxf(m, sT[i][r]);
    }
    m = fmaxf(m, __shfl_xor(m, 16)); m = fmaxf(m, __shfl_xor(m, 32));
    float l = 0.f;
#pragma unroll
    for (int i = 0; i < NT; ++i)
#pragma unroll
        for (int r = 0; r < 4; ++r) { const float e = __expf(sT[i][r] - m); sT[i][r] = e; l += e; }
    l += __shfl_xor(l, 16); l += __shfl_xor(l, 32);
    f32x4 oT[4];
#pragma unroll
    for (int dt = 0; dt < 4; ++dt) oT[dt] = (f32x4){0.f, 0.f, 0.f, 0.f};
#pragma unroll
    for (int tp = 0; tp < NT / 2; ++tp) {
        int ta = DIL ? w + 2 * tp : 2 * tp, tb = ta + 1; ta = ta > 15 ? 15 : ta; tb = tb > 15 ? 15 : tb;
        u32x4 pw; pw.x = pk2(sT[2 * tp][0], sT[2 * tp][1]); pw.y = pk2(sT[2 * tp][2], sT[2 * tp][3]); pw.z = pk2(sT[2 * tp + 1][0], sT[2 * tp + 1][1]); pw.w = pk2(sT[2 * tp + 1][2], sT[2 * tp + 1][3]);
        const bf16x8 pb = __builtin_bit_cast(bf16x8, pw);
        const LAS unsigned char* va = lds + AT_VOFF + (16 * ta + 4 * fq + (fr >> 2)) * (AT_P * 2) + 8 * (fr & 3);
        const LAS unsigned char* vb = lds + AT_VOFF + (16 * tb + 4 * fq + (fr >> 2)) * (AT_P * 2) + 8 * (fr & 3);
#pragma unroll
        for (int dt = 0; dt < 4; ++dt) {
            const v4i16_t lo = __builtin_amdgcn_ds_read_tr16_b64_v4i16((LAS v4i16_t*)(va + 32 * dt)), hi = __builtin_amdgcn_ds_read_tr16_b64_v4i16((LAS v4i16_t*)(vb + 32 * dt));
            bf16x8 vf; vf[0] = lo[0]; vf[1] = lo[1]; vf[2] = lo[2]; vf[3] = lo[3]; vf[4] = hi[0]; vf[5] = hi[1]; vf[6] = hi[2]; vf[7] = hi[3];
            oT[dt] = __builtin_amdgcn_mfma_f32_16x16x32_bf16(vf, pb, oT[dt], 0, 0, 0); }
        if (tp & 1) asm volatile("" ::: "memory");
    }
    const float inv = 1.f / l;
    bf16_t* op = U.o + (long)(16 * w + fr) * U.os;
#pragma unroll
    for (int dt = 0; dt < 4; ++dt) { u32x2 o; o.x = pk2(oT[dt][0] * inv, oT[dt][1] * inv); o.y = pk2(oT[dt][2] * inv, oT[dt][3] * inv); *(u32x2*)(op + 16 * dt + 4 * fq) = o; }
    if (DIL && fq == 0) U.lse[(long)(16 * w + fr) * U.ls] = m + __logf(l);
}
__device__ __forceinline__ void phase3(const Params& p, LAS unsigned char* lds, int rep) {
    const int tid = threadIdx.x, lane = tid & 63, wave = tid >> 6;
    unsigned* ctl = (unsigned*)(p.ws + WS_CTL);
    LAS unsigned* bc = (LAS unsigned*)(lds + 98304);
    for (;;) {
        __syncthreads();
        if (tid == 0) bc[0] = atomicAdd(ctl + CW_SCANQ + 16 * rep, 1u);
        __syncthreads();
        const unsigned sid = __builtin_amdgcn_readfirstlane(bc[0]);
        if (sid >= 2u * BATCH * RH) break;
#pragma unroll 1
        for (int tw = 0; tw < (REPEAT_PHASE == 31 ? 2 : 1); ++tw) scan_block(p, lds, (int)sid);
    }
    constexpr unsigned ATT_BATCH = 2;
    for (;;) {
        __syncthreads();
        if (tid == 0) bc[1] = atomicAdd(ctl + CW_ATTQ + 16 * rep, ATT_BATCH);
        __syncthreads();
        const unsigned ubase = __builtin_amdgcn_readfirstlane(bc[1]);
        if (ubase >= (unsigned)ATT_UNITS) break;
        const unsigned uend = ubase + ATT_BATCH < (unsigned)ATT_UNITS ? ubase + ATT_BATCH : (unsigned)ATT_UNITS;
        { AttU U; att_make_unit(p, (int)ubase, U); u32x4 reg[8]; att_fetch(U, reg, tid); att_put(lds, reg, tid); }
#pragma unroll 1
        for (unsigned ucur = ubase; ucur < uend; ++ucur) {
            __syncthreads();
            u32x4 reg[8];
            if (ucur + 1 < uend) { AttU Un; att_make_unit(p, (int)ucur + 1, Un); att_fetch(Un, reg, tid); }
            { AttU U; att_make_unit(p, (int)ucur, U);
#pragma unroll 1
              for (int tw = 0; tw < (REPEAT_PHASE == 32 ? 2 : 1); ++tw) {
                if (ucur < (unsigned)ATT_DIL_UNITS) att_compute<10, true>(U, lds, wave, lane); else att_compute<16, false>(U, lds, wave, lane); } }
            __syncthreads();
            if (ucur + 1 < uend) att_put(lds, reg, tid);
        }
    }
}

__device__ __forceinline__ void phase4(const Params& p) {
    const int tid = threadIdx.x, lane = tid & 63, wave = tid >> 6;
    const int gw = blockIdx.x * NWAVES + wave, NGW = gridDim.x * NWAVES;
    unsigned char* ws = p.ws; const unsigned char* dob = (const unsigned char*)p.out;
    const float* Yf = (const float*)(dob + DO_Y); const float* Yb = Yf + (size_t)T * RC;
    const bf16_t* G = (const bf16_t*)(dob + DO_G); const float* LSE = (const float*)(dob + DO_LSE);
    const float* BON = (const float*)(ws + WS_BONUS); const float* SSH = (const float*)(ws + WS_SSH);
    const bf16_t* AO = (const bf16_t*)(ws + WS_ATTO); bf16_t* YM = (bf16_t*)(ws + WS_YMIX);
    for (int t = gw; t < T; t += NGW) {
        const int b = t >> 11, s = t & (SEQ - 1);
        float yf[RH], yb[RH], vv[RH], bo[RH]; unsigned short gg[RH], a0[AH], a1[AH], a2[AH]; float l0[AH], l1[AH], l2[AH];
#pragma unroll
        for (int h = 0; h < RH; ++h) { const int ch = h * 64 + lane;
            yf[h] = Yf[(size_t)t * RC + ch]; yb[h] = Yb[(size_t)t * RC + ch]; gg[h] = G[(size_t)t * RC + ch];
            vv[h] = bf2f(((const bf16_t*)SSH)[((size_t)(b * RH + h) * SEQ + s) * 192 + 64 + lane]); bo[h] = BON[t * RH + h];
            a0[h] = AO[(size_t)t * AW + ch]; a1[h] = AO[(size_t)T * AW + (size_t)t * AW + ch]; a2[h] = AO[(size_t)2 * T * AW + (size_t)t * AW + ch];
            l0[h] = LSE[(size_t)t * AH + h]; l1[h] = LSE[(size_t)T * AH + (size_t)t * AH + h]; l2[h] = LSE[(size_t)2 * T * AH + (size_t)t * AH + h]; }
#pragma unroll
        for (int h = 0; h < RH; ++h) { const int ch = h * 64 + lane;
            const float y = yf[h] + yb[h];
            const float mean = wave_sum(y) * (1.f / 64.f); const float dlt = y - mean; const float var = wave_sum(dlt * dlt) * (1.f / 64.f);
            const float yn = dlt * (1.f / sqrtf(var + GN_EPS)) * p.in[14][ch] + p.in[15][ch];
            const float o = (yn + bo[h] * vv[h]) * bf2f(gg[h]);
            YM[(size_t)t * D + ch] = (bf16_t)f2bf(o); }
#pragma unroll
        for (int h = 0; h < AH; ++h) { const int ch = h * 64 + lane;
            const float mx = fmaxf(l0[h], fmaxf(l1[h], l2[h])); const float e0 = __expf(l0[h] - mx), e1 = __expf(l1[h] - mx), e2 = __expf(l2[h] - mx); const float inv = 1.f / (e0 + e1 + e2);
            const float o = (e0 * bf2f(a0[h]) + e1 * bf2f(a1[h]) + e2 * bf2f(a2[h])) * inv;
            YM[(size_t)t * D + RC + ch] = (bf16_t)f2bf(o); }
    }
}

struct PolP5 {
    static constexpr bool PERM = false, GATHER = false;
    const bf16_t* A; const bf16_t* Bt; const bf16_t* H0B; float* PRE; int G, c;
    __device__ __forceinline__ bool next(int i, pg8::Unit& u) const { int pm, pn; if (!pg8::static_order(T / 256, D / 256, G, c, i, pm, pn)) return false;
        u.A = (const char*)(A + (size_t)pm * 256 * D); u.B0 = (const char*)(Bt + (size_t)pn * 256 * D); u.B1 = u.B0 + (size_t)128 * D * 2; u.x0 = pm; u.x1 = pn; u.x2 = 0; u.x3 = 0; u.x4 = 0; return true; }
    __device__ __forceinline__ void epi(const f32x4 (&acc)[2][2][4][2], const pg8::Unit& u, int wr, int wc, int fr, int fq) const {
        const int row0 = u.x0 * 256 + wr * 64 + fr, col0 = u.x1 * 256 + wc * 32 + 4 * fq;
#pragma unroll
        for (int ai = 0; ai < 2; ++ai)
#pragma unroll
            for (int m = 0; m < 4; ++m) { const size_t ro = (size_t)(row0 + ai * 128 + m * 16) * D + col0;
#pragma unroll
                for (int bj = 0; bj < 2; ++bj)
#pragma unroll
                    for (int n = 0; n < 2; ++n) { const size_t off = ro + bj * 128 + n * 16; const u32x2 hb = *(const u32x2*)(H0B + off); const f32x4 v = acc[ai][bj][m][n];
                        f32x4 o; o.x = v.x + ALPHA * bflo(hb.x); o.y = v.y + ALPHA * bfhi(hb.x); o.z = v.z + ALPHA * bflo(hb.y); o.w = v.w + ALPHA * bfhi(hb.y); *(f32x4*)(PRE + off) = o; }
                asm volatile("" ::: "memory"); }
    }
};
__device__ __forceinline__ void phase5(const Params& p, LAS unsigned char* lds) {
    unsigned char* ws = p.ws;
    PolP5 P{(const bf16_t*)(ws + WS_YMIX), (const bf16_t*)(ws + WS_WT_OUT), (const bf16_t*)(ws + WS_H0B), p.out, (int)gridDim.x, (int)blockIdx.x};
    pg8::gemm_phase(lds, P, D);
}

constexpr int P6_TP = 1032;
constexpr int P6_TH = 0, P6_TL = 16 * P6_TP * 2, P6_PART = 2 * 16 * P6_TP * 2, P6_LC = P6_PART + 8 * 16 * 32 * 4, P6_BASE = P6_LC + 128, P6_ENT = P6_BASE + 128, P6_MAXENT = 2048;
__device__ __forceinline__ void phase6(const Params& p, LAS unsigned char* lds, int rep) {
    const int tid = threadIdx.x, lane = tid & 63, wave = tid >> 6, fr = lane & 15, fq = lane >> 4;
    unsigned char* ws = p.ws; unsigned* ctl = (unsigned*)(ws + WS_CTL);
    const bf16_t* WRH = (const bf16_t*)(ws + WS_WRT); const bf16_t* WRL = WRH + NE * D;
    LAS bf16_t* TH = (LAS bf16_t*)(lds + P6_TH); LAS bf16_t* TL = (LAS bf16_t*)(lds + P6_TL); LAS float* PART = (LAS float*)(lds + P6_PART);
    LAS int* LC = (LAS int*)(lds + P6_LC); LAS int* BASE = (LAS int*)(lds + P6_BASE); LAS int* ENT = (LAS int*)(lds + P6_ENT);
    int* LIST = (int*)(ws + WS_LIST); float* RG = (float*)(ws + WS_ROWGATE); int* SEL = (int*)(ws + WS_SEL);
    __syncthreads();
    if (tid < NE) LC[tid] = 0;
    __syncthreads();
    int it = 0;
    for (int tile = blockIdx.x; tile < T / 16; tile += gridDim.x, ++it) {
        const int t0 = tile * 16;
#pragma unroll
        for (int q = 0; q < 2; ++q) { const int tt = 2 * wave + q, t = t0 + tt;
            const f32x4* xr = (const f32x4*)(p.out + (size_t)t * D) + lane; f32x4 v[4];
#pragma unroll
            for (int j = 0; j < 4; ++j) v[j] = xr[64 * j];
            ln_row(v, p.in[18], p.in[19], lane);
            bf16_t* orow = (bf16_t*)(ws + WS_H1B) + (size_t)t * D;
#pragma unroll
            for (int j = 0; j < 4; ++j) { const unsigned h0 = f2bf(v[j].x), h1 = f2bf(v[j].y), h2 = f2bf(v[j].z), h3 = f2bf(v[j].w);
                u32x2 hi; hi.x = h0 | (h1 << 16); hi.y = h2 | (h3 << 16);
                u32x2 lo; lo.x = pk2(v[j].x - bf2f(h0), v[j].y - bf2f(h1)); lo.y = pk2(v[j].z - bf2f(h2), v[j].w - bf2f(h3));
                *(u32x2*)(orow + 4 * lane + 256 * j) = hi;
                *(LAS u32x2*)(TH + tt * P6_TP + 4 * lane + 256 * j) = hi; *(LAS u32x2*)(TL + tt * P6_TP + 4 * lane + 256 * j) = lo; } }
        __syncthreads();
        f32x4 acc0 = (f32x4){0.f, 0.f, 0.f, 0.f}, acc1 = acc0;
#pragma unroll
        for (int ks = 0; ks < 4; ++ks) { const int k0 = 128 * wave + 32 * ks + 8 * fq;
            const bf16x8 ah = *(const LAS bf16x8*)(TH + fr * P6_TP + k0), al = *(const LAS bf16x8*)(TL + fr * P6_TP + k0);
            const bf16x8 bh0 = *(const bf16x8*)(WRH + (size_t)fr * D + k0), bl0 = *(const bf16x8*)(WRL + (size_t)fr * D + k0);
            const bf16x8 bh1 = *(const bf16x8*)(WRH + (size_t)(16 + fr) * D + k0), bl1 = *(const bf16x8*)(WRL + (size_t)(16 + fr) * D + k0);
            acc0 = __builtin_amdgcn_mfma_f32_16x16x32_bf16(ah, bh0, acc0, 0, 0, 0); acc0 = __builtin_amdgcn_mfma_f32_16x16x32_bf16(ah, bl0, acc0, 0, 0, 0); acc0 = __builtin_amdgcn_mfma_f32_16x16x32_bf16(al, bh0, acc0, 0, 0, 0);
            acc1 = __builtin_amdgcn_mfma_f32_16x16x32_bf16(ah, bh1, acc1, 0, 0, 0); acc1 = __builtin_amdgcn_mfma_f32_16x16x32_bf16(ah, bl1, acc1, 0, 0, 0); acc1 = __builtin_amdgcn_mfma_f32_16x16x32_bf16(al, bh1, acc1, 0, 0, 0); }
#pragma unroll
        for (int r = 0; r < 4; ++r) { PART[(wave * 16 + 4 * fq + r) * 32 + fr] = acc0[r]; PART[(wave * 16 + 4 * fq + r) * 32 + 16 + fr] = acc1[r]; }
        __syncthreads();
        const int e = lane & 31, tt = 2 * wave + (lane >> 5), t = t0 + tt;
        float logit = p.in[21][e];
#pragma unroll
        for (int v = 0; v < 8; ++v) logit += PART[(v * 16 + tt) * 32 + e];
        float cur = logit; float tv0 = 0.f, tv1 = 0.f, tv2 = 0.f, tv3 = 0.f; int te0 = 0, te1 = 0, te2 = 0, te3 = 0;
#pragma unroll
        for (int k = 0; k < 4; ++k) { float bv = cur; int bi = e;
#pragma unroll
            for (int o = 1; o < 32; o <<= 1) { const float ov = __shfl_xor(bv, o); const int oi = __shfl_xor(bi, o); if (ov > bv || (ov == bv && oi < bi)) { bv = ov; bi = oi; } }
            if (k == 0) { tv0 = bv; te0 = bi; } if (k == 1) { tv1 = bv; te1 = bi; } if (k == 2) { tv2 = bv; te2 = bi; } if (k == 3) { tv3 = bv; te3 = bi; }
            if (e == bi) cur = -3.0e38f; }
        const float e1 = __expf(tv1 - tv0), e2 = __expf(tv2 - tv0), e3 = __expf(tv3 - tv0); const float inv = 1.f / (1.f + e1 + e2 + e3);
        if (e < 4) { int ee = te0; float gg = inv;
            if (e == 1) { ee = te1; gg = e1 * inv; } if (e == 2) { ee = te2; gg = e2 * inv; } if (e == 3) { ee = te3; gg = e3 * inv; }
            const int lr = __hip_atomic_fetch_add((int*)(LC + ee), 1, __ATOMIC_RELAXED, __HIP_MEMORY_SCOPE_WORKGROUP); const int n = (it * 16 + tt) * 4 + e;
            if (n < P6_MAXENT) { ENT[4 * n] = t * 4 + e; ENT[4 * n + 1] = ee; ENT[4 * n + 2] = lr; ENT[4 * n + 3] = __builtin_bit_cast(int, gg); } }
    }
    __syncthreads();
    if (tid < NE) BASE[tid] = (int)atomicAdd(ctl + CW_CNT + 32 * rep + tid, (unsigned)LC[tid]);
    __syncthreads();
    const int nent = it * 64 < P6_MAXENT ? it * 64 : P6_MAXENT;
    for (int n = tid; n < nent; n += NTHR) { const int tk = ENT[4 * n], ee = ENT[4 * n + 1], rank = BASE[ee] + ENT[4 * n + 2];
        LIST[(size_t)ee * T + rank] = tk >> 2; RG[(size_t)ee * T + rank] = __builtin_bit_cast(float, ENT[4 * n + 3]); SEL[(size_t)tk * 2] = ee; SEL[(size_t)tk * 2 + 1] = rank; }
}

__device__ __forceinline__ void build_expert_tables(const Params& p, LAS int* tab) {
    const unsigned* ctl = (const unsigned*)(p.ws + WS_CTL);
    __syncthreads();
    if (threadIdx.x < NE) tab[threadIdx.x] = (int)__hip_atomic_load(ctl + CW_CNT + CNT_SET + threadIdx.x, __ATOMIC_RELAXED, __HIP_MEMORY_SCOPE_AGENT);
    __syncthreads();
    if (threadIdx.x == 0) { int ps = 0, ts = 0;
        for (int e = 0; e < NE; ++e) { const int c = tab[e]; tab[32 + e] = ps; tab[64 + e] = ts; ps += (c + 255) / 256 * 256; ts += (c + 127) / 128; }
        tab[64 + NE] = ts; }
    __syncthreads();
}

constexpr int TAB_OFF = 131072, UTAB_OFF = 100, UTAB_MAX = 48;
constexpr int IDX_OFF = 131072 + 2048, IDX_UNITS = 20;
__device__ __forceinline__ void build_expert_tables256(const Params& p, LAS int* tab, int npn  ) {
    const unsigned* ctl = (const unsigned*)(p.ws + WS_CTL);
    __syncthreads();
    if (threadIdx.x < NE) tab[threadIdx.x] = (int)__hip_atomic_load(ctl + CW_CNT + CNT_SET + threadIdx.x, __ATOMIC_RELAXED, __HIP_MEMORY_SCOPE_AGENT);
    __syncthreads();
    if (threadIdx.x == 0) { int ps = 0, ts = 0;
        for (int e = 0; e < NE; ++e) { const int c = tab[e]; tab[32 + e] = ps; tab[64 + e] = ts; ps += (c + 255) / 256 * 256; ts += (c + 255) / 256; }
        tab[64 + NE] = ts;
        int e = 0, n = 0;
        if (gridDim.x == 256) { const int g = blockIdx.x & 7, sl = blockIdx.x >> 3, mpx = 32 / npn  , mround = 8 * mpx;
            for (int i = 0; n < UTAB_MAX; ++i) { const int mt_g = i * mround + g * mpx + sl / npn, pn = sl % npn; if (i * mround >= ts) break; if (mt_g >= ts) continue;
                while (e + 1 < NE && mt_g >= tab[64 + e + 1]) ++e;
                const int r0 = (mt_g - tab[64 + e]) * 256;
                tab[UTAB_OFF + 4 * n] = e; tab[UTAB_OFF + 4 * n + 1] = r0; tab[UTAB_OFF + 4 * n + 2] = pn; tab[UTAB_OFF + 4 * n + 3] = tab[32 + e] + r0; ++n; }
        } else { const int nun = ts * npn;
        for (int L = blockIdx.x; L < nun && n < UTAB_MAX; L += gridDim.x, ++n) { const int pn = L % npn, mt_g = L / npn;
            while (e + 1 < NE && mt_g >= tab[64 + e + 1]) ++e;
            const int r0 = (mt_g - tab[64 + e]) * 256;
            tab[UTAB_OFF + 4 * n] = e; tab[UTAB_OFF + 4 * n + 1] = r0; tab[UTAB_OFF + 4 * n + 2] = pn; tab[UTAB_OFF + 4 * n + 3] = tab[32 + e] + r0; } }
        tab[98] = n; }
    __syncthreads();
}
struct PolP7 {
    static constexpr bool PERM = true, GATHER = true;
    const bf16_t* H1B; const bf16_t* WG; const LAS int* IDX; bf16_t* ACT; const float* BGU; const LAS int* tab; int G, c;
    __device__ __forceinline__ bool next(int i, pg8::Unit& u) const { if (i >= __builtin_amdgcn_readfirstlane(tab[98])) return false;
        const int e = __builtin_amdgcn_readfirstlane(tab[UTAB_OFF + 4 * i]), r0 = __builtin_amdgcn_readfirstlane(tab[UTAB_OFF + 4 * i + 1]), pn = __builtin_amdgcn_readfirstlane(tab[UTAB_OFF + 4 * i + 2]);
        u.A = (const char*)H1B; u.B0 = (const char*)(WG + ((size_t)e * 2 * FF + pn * 128) * D); u.B1 = u.B0 + (size_t)FF * D * 2;
        u.x0 = e; u.x1 = i; u.x2 = pn; u.x3 = __builtin_amdgcn_readfirstlane(tab[UTAB_OFF + 4 * i + 3]); u.x4 = __builtin_amdgcn_readfirstlane(tab[e]) - r0; return true; }
    __device__ __forceinline__ void rows_issue(const pg8::Unit& u, int R0, unsigned (&raw)[2][2]) const { const LAS int* lst = IDX + u.x1 * 256 + R0;
#pragma unroll
        for (int h = 0; h < 2; ++h)
#pragma unroll
            for (int i = 0; i < 2; ++i) raw[h][i] = (unsigned)lst[h * 128 + i * 64]; }
    __device__ __forceinline__ void rows_finish(int C0, int K, unsigned (&raw)[2][2]) const {
#pragma unroll
        for (int h = 0; h < 2; ++h)
#pragma unroll
            for (int i = 0; i < 2; ++i) raw[h][i] = (raw[h][i] * (unsigned)K + (unsigned)C0) * 2u; }
    __device__ __forceinline__ void epi(const f32x4 (&acc)[2][2][4][2], const pg8::Unit& u, int wr, int wc, int fr, int fq) const {
        const int e = u.x0, f0 = u.x2 * 128 + wc * 32 + 8 * fq;
        const float* bias = BGU + (size_t)e * 2 * FF + f0;
        const f32x4 bg0 = *(const f32x4*)bias, bg1 = *(const f32x4*)(bias + 4), bu0 = *(const f32x4*)(bias + FF), bu1 = *(const f32x4*)(bias + FF + 4);
#pragma unroll
        for (int ai = 0; ai < 2; ++ai)
#pragma unroll
            for (int m = 0; m < 4; ++m) { const int r = ai * 128 + wr * 64 + m * 16 + fr;
                const f32x4 g0 = acc[ai][0][m][0] + bg0, g1 = acc[ai][0][m][1] + bg1, u0 = acc[ai][1][m][0] + bu0, u1 = acc[ai][1][m][1] + bu1;
                float a[8];
#pragma unroll
                for (int j = 0; j < 4; ++j) {
                    const float gc = fminf(g0[j], 7.f), uc = __builtin_amdgcn_fmed3f(u0[j], -7.f, 7.f);
                    a[j] = __builtin_fmaf(uc, gc, gc) * __builtin_amdgcn_rcpf(1.f + __builtin_amdgcn_exp2f(-2.4554669595930157f * gc));
                    const float gd = fminf(g1[j], 7.f), ud = __builtin_amdgcn_fmed3f(u1[j], -7.f, 7.f);
                    a[4 + j] = __builtin_fmaf(ud, gd, gd) * __builtin_amdgcn_rcpf(1.f + __builtin_amdgcn_exp2f(-2.4554669595930157f * gd)); }
                { u32x4 w; w.x = pg8::cvt_pk_bf16(a[0], a[1]); w.y = pg8::cvt_pk_bf16(a[2], a[3]); w.z = pg8::cvt_pk_bf16(a[4], a[5]); w.w = pg8::cvt_pk_bf16(a[6], a[7]);
                    *(u32x4*)(ACT + (size_t)(u.x3 + r) * FF + f0) = w; } }
    }
};
__device__ __forceinline__ void phase7(const Params& p, LAS unsigned char* lds) {
    LAS int* tab = (LAS int*)(lds + TAB_OFF); build_expert_tables256(p, tab, 8);
    unsigned char* ws = p.ws;
    LAS int* IDX = (LAS int*)(lds + IDX_OFF);
    { const int* LIST = (const int*)(ws + WS_LIST); const int nun = tab[98] < IDX_UNITS ? tab[98] : IDX_UNITS;
      for (int j = threadIdx.x; j < nun * 256; j += NTHR) { const int n = j >> 8, i = j & 255, e = tab[UTAB_OFF + 4 * n], r0 = tab[UTAB_OFF + 4 * n + 1], nval = tab[e] - r0;
          IDX[j] = LIST[(size_t)e * T + r0 + (i < nval ? i : 0)]; }
      __syncthreads(); }
    PolP7 P{(const bf16_t*)(ws + WS_H1B), (const bf16_t*)(ws + WS_WT_GU), IDX, (bf16_t*)(ws + WS_ACT), p.in[23], tab, (int)gridDim.x, (int)blockIdx.x};
    pg8::gemm_phase(lds, P, D);
}

struct PolP8 {
    static constexpr bool PERM = true, GATHER = false;
    const bf16_t* ACT; const bf16_t* WD; const float* RG; bf16_t* YR; const float* BD; const LAS int* tab; int G, c;
    __device__ __forceinline__ bool next(int i, pg8::Unit& u) const { if (i >= __builtin_amdgcn_readfirstlane(tab[98])) return false;
        const int e = __builtin_amdgcn_readfirstlane(tab[UTAB_OFF + 4 * i]), r0 = __builtin_amdgcn_readfirstlane(tab[UTAB_OFF + 4 * i + 1]), pn = __builtin_amdgcn_readfirstlane(tab[UTAB_OFF + 4 * i + 2]), prow0 = __builtin_amdgcn_readfirstlane(tab[UTAB_OFF + 4 * i + 3]);
        u.A = (const char*)(ACT + (size_t)prow0 * FF); u.B0 = (const char*)(WD + ((size_t)e * D + pn * 256) * FF); u.B1 = u.B0 + (size_t)128 * FF * 2;
        u.x4 = __builtin_amdgcn_readfirstlane(tab[e]) - r0;
        u.x0 = e; u.x1 = r0; u.x2 = pn; u.x3 = prow0; return true; }
    __device__ __forceinline__ void epi(const f32x4 (&acc)[2][2][4][2], const pg8::Unit& u, int wr, int wc, int fr, int fq) const {
        const int e = u.x0, nval = u.x4; const float* rg = RG + (size_t)e * T + u.x1;
        float gt[2][4];
#pragma unroll
        for (int ai = 0; ai < 2; ++ai)
#pragma unroll
            for (int m = 0; m < 4; ++m) { const int r = ai * 128 + wr * 64 + m * 16 + fr; gt[ai][m] = rg[r < nval ? r : 0]; }
        f32x4 bs[2][2];
#pragma unroll
        for (int bj = 0; bj < 2; ++bj) { const float* bias = BD + (size_t)e * D + u.x2 * 256 + bj * 128 + wc * 32 + 8 * fq; bs[bj][0] = *(const f32x4*)bias; bs[bj][1] = *(const f32x4*)(bias + 4); }
#pragma unroll
        for (int ai = 0; ai < 2; ++ai)
#pragma unroll
            for (int m = 0; m < 4; ++m) { const int r = ai * 128 + wr * 64 + m * 16 + fr; const float g = gt[ai][m];
#pragma unroll
                for (int bj = 0; bj < 2; ++bj) { const int col = u.x2 * 256 + bj * 128 + wc * 32 + 8 * fq;
                    const f32x4 v0 = (acc[ai][bj][m][0] + bs[bj][0]) * g, v1 = (acc[ai][bj][m][1] + bs[bj][1]) * g;
                    u32x4 w; w.x = pg8::cvt_pk_bf16(v0[0], v0[1]); w.y = pg8::cvt_pk_bf16(v0[2], v0[3]); w.z = pg8::cvt_pk_bf16(v1[0], v1[1]); w.w = pg8::cvt_pk_bf16(v1[2], v1[3]);
                    *(u32x4*)(YR + (size_t)(u.x3 + r) * D + col) = w; } }
    }
};
__device__ __forceinline__ void phase8(const Params& p, LAS unsigned char* lds) {
    LAS int* tab = (LAS int*)(lds + TAB_OFF); build_expert_tables256(p, tab, 4);
    unsigned char* ws = p.ws;
    PolP8 P{(const bf16_t*)(ws + WS_ACT), (const bf16_t*)(ws + WS_WT_DN), (const float*)(ws + WS_ROWGATE), (bf16_t*)(ws + WS_YROWS), p.in[25], tab, (int)gridDim.x, (int)blockIdx.x};
    pg8::gemm_phase(lds, P, FF);
}

__device__ __forceinline__ void phase9(const Params& p, LAS unsigned char* lds) {
    LAS int* tab = (LAS int*)lds; build_expert_tables(p, tab);
    const int tid = threadIdx.x, lane = tid & 63, wave = tid >> 6;
    const int gw = blockIdx.x * NWAVES + wave, NGW = gridDim.x * NWAVES;
    unsigned char* ws = p.ws; const bf16_t* H1B = (const bf16_t*)(ws + WS_H1B); const bf16_t* YR = (const bf16_t*)(ws + WS_YROWS); const int* SEL = (const int*)(ws + WS_SEL);
    typedef int i32x4 __attribute__((ext_vector_type(4)));
    i32x4 sa = {0, 0, 0, 0}, sb = sa;
    if (gw < T) { sa = *(const i32x4*)(SEL + (size_t)gw * 8); sb = *(const i32x4*)(SEL + (size_t)gw * 8 + 4); }
    for (int t = gw; t < T; t += NGW) {
        const i32x4 ca = sa, cb = sb;
        if (t + NGW < T) { sa = *(const i32x4*)(SEL + (size_t)(t + NGW) * 8); sb = *(const i32x4*)(SEL + (size_t)(t + NGW) * 8 + 4); }
        const bf16_t* y0 = YR + (size_t)(tab[32 + ca.x] + ca.y) * D + 4 * lane; const bf16_t* y1 = YR + (size_t)(tab[32 + ca.z] + ca.w) * D + 4 * lane;
        const bf16_t* y2 = YR + (size_t)(tab[32 + cb.x] + cb.y) * D + 4 * lane; const bf16_t* y3 = YR + (size_t)(tab[32 + cb.z] + cb.w) * D + 4 * lane;
        const bf16_t* hr = H1B + (size_t)t * D + 4 * lane;
        u32x2 hb[4], q0[4], q1[4], q2[4], q3[4];
#pragma unroll
        for (int j = 0; j < 4; ++j) { hb[j] = *(const u32x2*)(hr + 256 * j); q0[j] = *(const u32x2*)(y0 + 256 * j); q1[j] = *(const u32x2*)(y1 + 256 * j); q2[j] = *(const u32x2*)(y2 + 256 * j); q3[j] = *(const u32x2*)(y3 + 256 * j); }
        f32x4 v[4];
#pragma unroll
        for (int j = 0; j < 4; ++j) {
            v[j].x = ALPHA * bflo(hb[j].x) + ((bflo(q0[j].x) + bflo(q1[j].x)) + (bflo(q2[j].x) + bflo(q3[j].x)));
            v[j].y = ALPHA * bfhi(hb[j].x) + ((bfhi(q0[j].x) + bfhi(q1[j].x)) + (bfhi(q2[j].x) + bfhi(q3[j].x)));
            v[j].z = ALPHA * bflo(hb[j].y) + ((bflo(q0[j].y) + bflo(q1[j].y)) + (bflo(q2[j].y) + bflo(q3[j].y)));
            v[j].w = ALPHA * bfhi(hb[j].y) + ((bfhi(q0[j].y) + bfhi(q1[j].y)) + (bfhi(q2[j].y) + bfhi(q3[j].y))); }
        ln_row(v, p.in[26], p.in[27], lane);
        f32x4* orow = (f32x4*)(p.out + (size_t)t * D) + lane;
#pragma unroll
        for (int j = 0; j < 4; ++j) orow[64 * j] = v[j];
    }
}

#define XB_TMO      128
#define XB_XCNT(j)  (256  + 64 * (j))
#define XB_XSUB(j)  (1280 + 64 * (j))
#define XB_XGEN(j)  (2304 + 64 * (j))
#define XB_TOP      3328
#define XB_TOPGEN   3392
#define XCD_BAR_WORDS 3456
#define XB_SPIN_CAP (1u << 22)
__device__ __forceinline__ unsigned xb_ld(unsigned* p)              { return __hip_atomic_load(p, __ATOMIC_RELAXED, __HIP_MEMORY_SCOPE_AGENT); }
__device__ __forceinline__ unsigned xb_add(unsigned* p, unsigned v) { return __hip_atomic_fetch_add(p, v, __ATOMIC_RELAXED, __HIP_MEMORY_SCOPE_AGENT); }
__device__ __forceinline__ unsigned xb_xcc_id() { return (unsigned)__builtin_amdgcn_s_getreg((3 << 11) | 20) & 0xFu; }
#define XB_SPIN(cond, bar) do { unsigned _sp = 0; while (cond) { __builtin_amdgcn_s_sleep(1); \
    if ((++_sp & 255u) == 0u) { if (xb_ld(&(bar)[XB_TMO])) break; if (_sp > XB_SPIN_CAP) { atomicAdd(&(bar)[XB_TMO], 1u); break; } } } } while (0)
struct XcdBarrier { unsigned* bar; unsigned x; volatile LAS unsigned* st; };
__device__ __forceinline__ XcdBarrier xcd_barrier_post(unsigned* bar, volatile LAS unsigned* st) {
    XcdBarrier b; b.bar = bar; b.x = xb_xcc_id(); b.st = st;
    if (threadIdx.x == 0) (void)xb_add(&bar[XB_XCNT(b.x)], 1u);
    return b;
}
__device__ __forceinline__ void xcd_barrier_complete(unsigned* bar, unsigned x, unsigned& nloc, unsigned& nx) {
    const unsigned G = gridDim.x * gridDim.y * gridDim.z;
    unsigned sum, cnt, mine, sp = 0u;
    for (;;) {
        sum = 0u; cnt = 0u; mine = 0u;
#pragma unroll
        for (unsigned j = 0; j < 16; ++j) { const unsigned c = xb_ld(&bar[XB_XCNT(j)]); sum += c; cnt += (c > 0u) ? 1u : 0u; mine = (j == x) ? c : mine; }
        if (sum == G) break;
        __builtin_amdgcn_s_sleep(1);
        if ((++sp & 255u) == 0u) { if (xb_ld(&bar[XB_TMO])) break; if (sp > XB_SPIN_CAP) { atomicAdd(&bar[XB_TMO], 1u); break; } }
    }
    nloc = mine > 0u ? mine : 1u; nx = cnt > 0u ? cnt : 1u;
}
__device__ __forceinline__ void xcd_barrier(const XcdBarrier& b) {
    asm volatile("s_waitcnt vmcnt(0)" ::: "memory");
    __syncthreads();
    if (threadIdx.x == 0) {
        unsigned* bar = b.bar;
        __builtin_amdgcn_s_waitcnt(0);
        unsigned nloc = b.st[0], nx = b.st[1];
        if (nloc == 0u) { xcd_barrier_complete(bar, b.x, nloc, nx); b.st[0] = nloc; b.st[1] = nx; }
        const unsigned old = xb_add(&bar[XB_XSUB(b.x)], 1u);
        const unsigned gen = old / nloc;
        if (old + 1u == (gen + 1u) * nloc) {
            __builtin_amdgcn_fence(__ATOMIC_RELEASE, "agent");
            asm volatile("s_waitcnt vmcnt(0)" ::: "memory");
            const unsigned og = xb_add(&bar[XB_TOP], 1u);
            const unsigned tg = og / nx;
            if (og + 1u == (tg + 1u) * nx) xb_add(&bar[XB_TOPGEN], 1u);
            else XB_SPIN(xb_ld(&bar[XB_TOPGEN]) == tg, bar);
            __builtin_amdgcn_fence(__ATOMIC_ACQUIRE, "agent");
            xb_add(&bar[XB_XGEN(b.x)], 1u);
            asm volatile("s_waitcnt vmcnt(0)" ::: "memory");
        } else {
            XB_SPIN(xb_ld(&bar[XB_XGEN(b.x)]) == gen, bar);
            __builtin_amdgcn_fence(__ATOMIC_ACQUIRE, "agent");
            asm volatile("s_waitcnt vmcnt(0)" ::: "memory");
        }
    }
    __syncthreads();
}

constexpr int NPHASE = 10;
constexpr int LDS_BYTES = 131072 + 2048 + IDX_UNITS * 1024;
__global__ void __launch_bounds__(NTHR, 2) mk_fwd(Params p) {
    extern __shared__ __attribute__((aligned(16))) unsigned char lds_raw[];
    LAS unsigned char* lds = (LAS unsigned char*)lds_raw;
    const int lo = p.ph_lo, hi = p.ph_hi;
    volatile LAS unsigned* barst = (volatile LAS unsigned*)(lds + BARST_OFF);
    if (threadIdx.x < 2) barst[threadIdx.x] = 0u;
    __syncthreads();
    const XcdBarrier xbar = xcd_barrier_post((unsigned*)(p.ws + WS_CTL) + CW_BAR, barst);
#ifdef ONLY_PHASE
#define IN(k) ((k) == ONLY_PHASE && lo <= (k) && (k) < hi)
#else
#define IN(k) (lo <= (k) && (k) < hi)
#endif
#define SEAM(k) do { if (IN(k) && IN((k) + 1)) { if ((k) == 0) cg::this_grid().sync(); else xcd_barrier(xbar); } } while (0)
#define RUN(k, call) do { if (IN(k)) { call; if (REPEAT_PHASE == (k)) { cg::this_grid().sync(); call; } } } while (0)
    { int rep = 0;
    RUN(0, phase0(p, lds));
    SEAM(0);
    RUN(1, phase1(p, lds));
    SEAM(1);
    RUN(2, phase2(p, lds));
    SEAM(2);
    if (IN(3)) { const int nrep = (REPEAT_PHASE == 3) ? 2 : 1;
#pragma unroll 1
        for (rep = 0; rep < nrep; ++rep) { if (rep) cg::this_grid().sync(); phase3(p, lds, rep); } }
    SEAM(3);
    RUN(4, phase4(p));
    SEAM(4);
    RUN(5, phase5(p, lds));
    SEAM(5);
    rep = 0; RUN(6, (phase6(p, lds, rep), ++rep));
    SEAM(6);
    RUN(7, phase7(p, lds));
    SEAM(7);
    RUN(8, phase8(p, lds));
    SEAM(8);
    RUN(9, phase9(p, lds));
    }
#undef RUN
#undef IN
#undef SEAM
}

extern "C" void kernel_launch(void* const* d_in, const int* in_sizes, int n_in, void* d_out, int out_size, void* d_ws, size_t ws_size, hipStream_t stream) {
    static int grid = 0;
    if (grid == 0) {
        if (n_in != 28 || out_size != T * D || ws_size < WS_END) { fprintf(stderr, "kernel_launch: unexpected shapes: n_in %d out %d ws %zu (need %zu)\n", n_in, out_size, ws_size, (size_t)WS_END); grid = -1; return; }
        int dev = 0, cus = 0, per_cu = 0;
        hipGetDevice(&dev); hipDeviceGetAttribute(&cus, hipDeviceAttributeMultiprocessorCount, dev);
        hipFuncSetAttribute((const void*)mk_fwd, hipFuncAttributeMaxDynamicSharedMemorySize, LDS_BYTES);
        hipOccupancyMaxActiveBlocksPerMultiprocessor(&per_cu, (const void*)mk_fwd, NTHR, LDS_BYTES);
        (void)hipGetLastError();
        if (per_cu < 1) { fprintf(stderr, "kernel_launch: occupancy query says %d blocks per CU\n", per_cu); per_cu = 1; }
        grid = cus;
    }
    if (grid < 0) return;
    hipMemsetAsync((char*)d_ws + WS_CTL, 0, CTL_ZERO_BYTES, stream);
    Params p{};
    for (int i = 0; i < 28; ++i) p.in[i] = (const float*)d_in[i];
    p.out = (float*)d_out; p.ws = (unsigned char*)d_ws;
#if MK_ONE_LAUNCH
    p.ph_lo = 0; p.ph_hi = NPHASE;
    void* args[] = {&p};
    hipError_t e = hipLaunchCooperativeKernel((const void*)mk_fwd, dim3(grid), dim3(NTHR), args, LDS_BYTES, stream);
    if (e != hipSuccess) fprintf(stderr, "cooperative launch failed: %s (grid %d)\n", hipGetErrorString(e), grid);
#else
    for (int ph = 0; ph < NPHASE; ++ph) { p.ph_lo = ph; p.ph_hi = ph + 1; hipLaunchKernelGGL(mk_fwd, dim3(grid), dim3(NTHR), LDS_BYTES, stream, p); }
#endif
}
```

```cpp
#include <hip/hip_runtime.h>
#include <hip/hip_cooperative_groups.h>
#include <cstdio>
#include <cstdint>
namespace cg = cooperative_groups;

#ifndef REPEAT_PHASE
#define REPEAT_PHASE -1
#endif
#ifndef MK_ONE_LAUNCH
#define MK_ONE_LAUNCH 1
#endif

typedef unsigned short bf16_t;
typedef short bf16x8 __attribute__((ext_vector_type(8)));
typedef short bf16x4 __attribute__((ext_vector_type(4)));
typedef float f32x4 __attribute__((ext_vector_type(4)));
typedef float f32x2 __attribute__((ext_vector_type(2)));
typedef unsigned u32x4 __attribute__((ext_vector_type(4)));
typedef unsigned u32x2 __attribute__((ext_vector_type(2)));

constexpr int D = 1024, BATCH = 16, SEQ = 2048, T = BATCH * SEQ;
constexpr int NMEM = 256, HD = 64;
constexpr int RH = 6, RC = 384;
constexpr int RWKV_IN = 1344;
constexpr int AH = 6, AW = 384, MH = 4, MW = 256;
constexpr int IN_W = 2752, IN_WP = 2816;
constexpr int PA_W = IN_WP - RWKV_IN;
constexpr int NE = 32, TOPK = 4, FF = 1024;
constexpr float LN_EPS = 1e-5f, GN_EPS = 64e-5f;
constexpr float ALPHA = 1.189207115002721f;
constexpr int NTHR = 512, NWAVES = 8;

constexpr size_t MiB = 1u << 20;
constexpr size_t WS_CTL = 0;
constexpr size_t WS_WT_IN = 1 * MiB;
constexpr size_t WS_LORA = 6 * MiB + 512 * 1024;
constexpr size_t WS_WT_OUT = 7 * MiB;
constexpr size_t WS_WT_KV = 9 * MiB;
constexpr size_t WS_KVM = 10 * MiB;
constexpr size_t WS_MEMB = 14 * MiB;
constexpr size_t WS_LIST = 22 * MiB;
constexpr size_t WS_ROWGATE = 26 * MiB;
constexpr size_t WS_SEL = 30 * MiB;
constexpr size_t WS_BONUS = 31 * MiB;
constexpr size_t WS_WRT = 31 * MiB + 800 * 1024;
constexpr size_t WS_WT_GU = 32 * MiB;
constexpr size_t WS_WT_DN = 160 * MiB;
constexpr size_t WS_H0B = 224 * MiB;
constexpr size_t WS_H1B = 288 * MiB;
constexpr size_t WS_YMIX = 352 * MiB;
constexpr size_t WS_PR = 416 * MiB;
constexpr size_t WS_ATTO = 416 * MiB;
constexpr size_t WS_PA = 500 * MiB;
constexpr size_t WS_SSH = 592 * MiB;
constexpr size_t WS_SDIR = 736 * MiB;
constexpr size_t WS_ACT = 352 * MiB;
constexpr size_t WS_YROWS = 624 * MiB;
constexpr size_t WS_END = 1024 * MiB;
constexpr size_t DO_Y = 0, DO_G = 96 * MiB, DO_LSE = 120 * MiB;
constexpr int ROWS_PAD = T * TOPK + NE * 256;

constexpr int CW_CNT = 0;
constexpr int CNT_SET = (REPEAT_PHASE == 6) ? 32 : 0;
constexpr int CW_ATTQ = 64;
constexpr int CW_SCANQ = 128;
constexpr int CW_BAR = 4096;
constexpr int CTL_ZERO_BYTES = 65536;
constexpr int BARST_OFF = 131072 + 1536;

#define LAS __attribute__((address_space(3)))

struct Params { const float* in[28]; float* out; unsigned char* ws; int ph_lo, ph_hi; };

__device__ __forceinline__ unsigned f2bf(float f) { unsigned u = __builtin_bit_cast(unsigned, f); return (u + 0x7fffu + ((u >> 16) & 1u)) >> 16; }
__device__ __forceinline__ unsigned pk2(float lo, float hi) { return f2bf(lo) | (f2bf(hi) << 16); }
__device__ __forceinline__ float bf2f(unsigned b) { return __builtin_bit_cast(float, b << 16); }
__device__ __forceinline__ float bflo(unsigned w) { return __builtin_bit_cast(float, w << 16); }
__device__ __forceinline__ float bfhi(unsigned w) { return __builtin_bit_cast(float, w & 0xffff0000u); }
template <int CTRL> __device__ __forceinline__ float dpp_mov(float v) {
    return __builtin_bit_cast(float, __builtin_amdgcn_update_dpp(0, __builtin_bit_cast(int, v), CTRL, 0xF, 0xF, true));
}
__device__ __forceinline__ float sum16(float v) {
    v += dpp_mov<0xB1>(v);
    v += dpp_mov<0x4E>(v);
    v += dpp_mov<0x141>(v);
    v += dpp_mov<0x140>(v);
    return v;
}
__device__ __forceinline__ float wave_sum(float v) {
    v = sum16(v);
    const int iv = __builtin_bit_cast(int, v);
    const float a = __builtin_bit_cast(float, __builtin_amdgcn_readlane(iv, 0)), b = __builtin_bit_cast(float, __builtin_amdgcn_readlane(iv, 16));
    const float c = __builtin_bit_cast(float, __builtin_amdgcn_readlane(iv, 32)), d = __builtin_bit_cast(float, __builtin_amdgcn_readlane(iv, 48));
    return (a + b) + (c + d);
}
__device__ __forceinline__ float sigmoidf_(float x) { return 1.f / (1.f + __expf(-x)); }

struct P0Item { const float* W; bf16_t* WT; int K, N, item; };
__device__ __forceinline__ void p0_item_load(const P0Item& I, float (&reg)[32], int lane) {
    const int nblk = I.N / 32, kb = I.item / nblk, nb = I.item % nblk, k0 = 64 * kb, n0 = 32 * nb;
    const float* src = I.W + (size_t)(k0 + (lane >> 5)) * I.N + n0 + (lane & 31);
#pragma unroll
    for (int i = 0; i < 32; ++i) reg[i] = src[(size_t)(2 * i) * I.N];
}
__device__ __forceinline__ void p0_item_store(const P0Item& I, const float (&reg)[32], LAS float* scr, int lane) {
    const int nblk = I.N / 32, kb = I.item / nblk, nb = I.item % nblk, k0 = 64 * kb, n0 = 32 * nb;
#pragma unroll
    for (int i = 0; i < 32; ++i) scr[(2 * i + (lane >> 5)) * 33 + (lane & 31)] = reg[i];
    asm volatile("s_waitcnt lgkmcnt(0)" ::: "memory");
    const int c = lane & 7;
#pragma unroll
    for (int j = 0; j < 4; ++j) { const int n = (lane >> 3) + 8 * j; const LAS float* s = scr + (8 * c) * 33 + n;
        u32x4 o; o.x = pk2(s[0 * 33], s[1 * 33]); o.y = pk2(s[2 * 33], s[3 * 33]); o.z = pk2(s[4 * 33], s[5 * 33]); o.w = pk2(s[6 * 33], s[7 * 33]);
        *(u32x4*)(I.WT + (size_t)(n0 + n) * I.K + k0 + 8 * c) = o; }
    asm volatile("s_waitcnt lgkmcnt(0)" ::: "memory");
}
__device__ __forceinline__ void ln_row(f32x4 (&v)[4], const float* __restrict__ g, const float* __restrict__ b, int lane) {
    float s = 0.f;
#pragma unroll
    for (int j = 0; j < 4; ++j) s += (v[j].x + v[j].y) + (v[j].z + v[j].w);
    const float mean = wave_sum(s) * (1.f / D); float s2 = 0.f;
#pragma unroll
    for (int j = 0; j < 4; ++j) { v[j] = v[j] - mean; s2 += (v[j].x * v[j].x + v[j].y * v[j].y) + (v[j].z * v[j].z + v[j].w * v[j].w); }
    const float rstd = 1.f / sqrtf(wave_sum(s2) * (1.f / D) + LN_EPS);
#pragma unroll
    for (int j = 0; j < 4; ++j) { const f32x4 gg = *(const f32x4*)(g + 4 * lane + 256 * j), bb = *(const f32x4*)(b + 4 * lane + 256 * j); v[j] = v[j] * rstd * gg + bb; }
}
__device__ __forceinline__ void store_row_bf16(bf16_t* orow, const f32x4 (&v)[4], int lane) {
#pragma unroll
    for (int j = 0; j < 4; ++j) { u32x2 o; o.x = pk2(v[j].x, v[j].y); o.y = pk2(v[j].z, v[j].w); *(u32x2*)(orow + 4 * lane + 256 * j) = o; }
}

__device__ __forceinline__ void phase0(const Params& p, LAS unsigned char* lds) {
    const int tid = threadIdx.x, lane = tid & 63, wave = tid >> 6;
    const int gw = blockIdx.x * NWAVES + wave, NGW = gridDim.x * NWAVES;
    LAS float* scr = (LAS float*)(lds + wave * 16384);
    unsigned char* ws = p.ws;
    constexpr int I_IN = 16 * (IN_W / 32), I_OUT = 16 * 32, I_KV = 16 * 16, I_GU = 16 * 64, I_DN = 16 * 32;
    constexpr int NITEMS = I_IN + I_OUT + I_KV + NE * I_GU + NE * I_DN;
    auto mk = [&](int it) { P0Item I; int r = it;
        if (r < I_IN) { I.W = p.in[4]; I.WT = (bf16_t*)(ws + WS_WT_IN); I.K = D; I.N = IN_W; I.item = r; return I; } r -= I_IN;
        if (r < I_OUT) { I.W = p.in[17]; I.WT = (bf16_t*)(ws + WS_WT_OUT); I.K = D; I.N = D; I.item = r; return I; } r -= I_OUT;
        if (r < I_KV) { I.W = p.in[16]; I.WT = (bf16_t*)(ws + WS_WT_KV); I.K = D; I.N = 2 * MW; I.item = r; return I; } r -= I_KV;
        if (r < NE * I_GU) { const int e = r / I_GU; I.W = p.in[22] + (size_t)e * D * 2 * FF; I.WT = (bf16_t*)(ws + WS_WT_GU) + (size_t)e * 2 * FF * D; I.K = D; I.N = 2 * FF; I.item = r % I_GU; return I; } r -= NE * I_GU;
        { const int e = r / I_DN; I.W = p.in[24] + (size_t)e * FF * D; I.WT = (bf16_t*)(ws + WS_WT_DN) + (size_t)e * D * FF; I.K = FF; I.N = D; I.item = r % I_DN; return I; } };
    { float ra[32], rb[32]; int it = gw;
      if (it < NITEMS) { const P0Item I0 = mk(it); p0_item_load(I0, ra, lane); }
      for (; it < NITEMS; it += 2 * NGW) {
          const P0Item Ia = mk(it); const bool hb = it + NGW < NITEMS; P0Item Ib = Ia;
          if (hb) { Ib = mk(it + NGW); p0_item_load(Ib, rb, lane); }
          p0_item_store(Ia, ra, scr, lane);
          if (it + 2 * NGW < NITEMS) { const P0Item Ic = mk(it + 2 * NGW); p0_item_load(Ic, ra, lane); }
          if (hb) p0_item_store(Ib, rb, scr, lane);
      } }
    { u32x4* z = (u32x4*)((bf16_t*)(ws + WS_WT_IN) + (size_t)IN_W * D); const int n16 = (IN_WP - IN_W) * D * 2 / 16;
      for (int i = blockIdx.x * NTHR + tid; i < n16; i += gridDim.x * NTHR) z[i] = (u32x4){0u, 0u, 0u, 0u}; }
    { const float* wr = p.in[20]; bf16_t* wh = (bf16_t*)(ws + WS_WRT); bf16_t* wl = wh + NE * D;
      for (int i = blockIdx.x * NTHR + tid; i < NE * D; i += gridDim.x * NTHR) { const int e = i / D, k = i % D; const float w = wr[k * NE + e]; const unsigned h = f2bf(w); wh[i] = (bf16_t)h; wl[i] = (bf16_t)f2bf(w - bf2f(h)); } }
    { bf16_t* wu = (bf16_t*)(ws + WS_LORA); bf16_t* au = wu + 2 * RC * 32; bf16_t* gu = au + 2 * RC * 32;
      for (int i = blockIdx.x * NTHR + tid; i < 2 * RC * 32; i += gridDim.x * NTHR) { const int dch = i >> 5, j = i & 31, d = dch / RC, ch = dch % RC; wu[i] = (bf16_t)f2bf(p.in[7][(size_t)(d * 32 + j) * RC + ch]); au[i] = (bf16_t)f2bf(p.in[9][(size_t)(d * 32 + j) * RC + ch]); }
      for (int i = blockIdx.x * NTHR + tid; i < RC * 64; i += gridDim.x * NTHR) { const int ch = i >> 6, j = i & 63; gu[i] = (bf16_t)f2bf(p.in[10][(size_t)j * RC + ch]); } }
    for (int m = gw; m < T; m += NGW) {
        const f32x4* xr = (const f32x4*)(p.in[0] + (size_t)m * D) + lane; f32x4 v[4];
#pragma unroll
        for (int j = 0; j < 4; ++j) v[j] = xr[64 * j];
        ln_row(v, p.in[2], p.in[3], lane);
        store_row_bf16((bf16_t*)(ws + WS_H0B) + (size_t)m * D, v, lane);
    }
    for (int m = gw; m < BATCH * NMEM; m += NGW) {
        const f32x4* xr = (const f32x4*)(p.in[1] + (size_t)m * D) + lane; f32x4 v[4];
#pragma unroll
        for (int j = 0; j < 4; ++j) v[j] = xr[64 * j];
        store_row_bf16((bf16_t*)(ws + WS_MEMB) + (size_t)m * D, v, lane);
    }
}

template <class ARow, class BRow, class Epi>
__device__ __forceinline__ void sgemm_tile(int K, ARow arow, BRow brow, Epi epi) {
    const int tid = threadIdx.x, wid = tid >> 6, lane = tid & 63, wm = wid >> 1, wn = wid & 1, fr = lane & 15, fq = lane >> 4;
    f32x4 acc[2][4];
#pragma unroll
    for (int m = 0; m < 2; ++m)
#pragma unroll
        for (int n = 0; n < 4; ++n) acc[m][n] = (f32x4){0.f, 0.f, 0.f, 0.f};
    const bf16_t* ap[2]; const bf16_t* bp[4];
#pragma unroll
    for (int m = 0; m < 2; ++m) ap[m] = arow(wm * 32 + m * 16 + fr) + fq * 8;
#pragma unroll
    for (int n = 0; n < 4; ++n) bp[n] = brow(wn * 64 + n * 16 + fr) + fq * 8;
    for (int k = 0; k < K; k += 32) {
        bf16x8 a[2], b[4];
#pragma unroll
        for (int m = 0; m < 2; ++m) a[m] = *(const bf16x8*)(ap[m] + k);
#pragma unroll
        for (int n = 0; n < 4; ++n) b[n] = *(const bf16x8*)(bp[n] + k);
#pragma unroll
        for (int m = 0; m < 2; ++m)
#pragma unroll
            for (int n = 0; n < 4; ++n) acc[m][n] = __builtin_amdgcn_mfma_f32_16x16x32_bf16(b[n], a[m], acc[m][n], 0, 0, 0);
    }
#pragma unroll
    for (int m = 0; m < 2; ++m)
#pragma unroll
        for (int n = 0; n < 4; ++n) epi(wm * 32 + m * 16 + fr, wn * 64 + n * 16 + 4 * fq, acc[m][n], n);
}


namespace pg8 {
constexpr int BM = 256, BK = 64, HALF = 128, HTB = HALF * BK * 2, STAGE_BYTES = 8 * HTB, NXCD = 8, WGM = 8;
__host__ __device__ __forceinline__ int lds_byte(int r, int c) { const int st = (r >> 4) * 2 + (c >> 5), rr = r & 15, cc = c & 31, ob = rr * 64 + cc * 2; return st * 1024 + (ob ^ (((ob >> 9) & 1) << 5)); }
__host__ __device__ __forceinline__ void stage_rc(int b, int& R, int& C) { const int st = b / 1024, sb = b % 1024, swz = sb ^ (((sb >> 9) & 1) << 5); R = (st >> 1) * 16 + swz / 64; C = (st & 1) * 32 + (swz % 64) / 2; }
__host__ __device__ __forceinline__ int perm32(int rho) { const int n = rho >> 4, i = rho & 15; return 8 * (i >> 2) + 4 * n + (i & 3); }
struct Unit { const char* A; const char* B0; const char* B1; int x0, x1, x2, x3, x4; };
__device__ __forceinline__ unsigned cvt_pk_bf16(float lo, float hi) { unsigned r; asm volatile("v_cvt_pk_bf16_f32 %0, %1, %2" : "=v"(r) : "v"(lo), "v"(hi)); return r; }

__device__ __forceinline__ const char* uni_ptr(const char* p) { const unsigned long long v = (unsigned long long)p; const unsigned lo = __builtin_amdgcn_readfirstlane((unsigned)v), hi = __builtin_amdgcn_readfirstlane((unsigned)(v >> 32)); return (const char*)(((unsigned long long)hi << 32) | lo); }
__device__ __forceinline__ bool static_order(int nM, int nN, int G, int c, int i, int& pm, int& pn) {
    const int nwg = nM * nN; const long L = (long)i * G + c; if (L >= nwg) return false;
    int wgid = (int)L; { const int q = nwg / NXCD, r = nwg % NXCD, xcd = wgid % NXCD, off = wgid / NXCD; wgid = (xcd < r ? xcd * (q + 1) : r * (q + 1) + (xcd - r) * q) + off; }
    const int nig = WGM * nN, gid = wgid / nig, fm = gid * WGM, gsz = (nM - fm) < WGM ? (nM - fm) : WGM;
    pm = fm + ((wgid % nig) % gsz); pn = (wgid % nig) / gsz; return true;
}

template <class Pol>
__device__ __forceinline__ void gemm_phase(LAS unsigned char* lds, const Pol& P, const int K) {
    const int tid = threadIdx.x, wid = __builtin_amdgcn_readfirstlane(tid >> 6), lane = tid & 63, wr = wid >> 2, wc = wid & 3, fr = lane & 15, fq = lane >> 4;
    const int nt = K / BK;
    int R0, C0; stage_rc(tid * 16, R0, C0);
    const int Rb0 = Pol::PERM ? ((R0 & ~31) + perm32(R0 & 31)) : R0;
    const unsigned vB = (unsigned)(Rb0 * K + C0) * 2u;
    const size_t pstep = (size_t)64 * K * 2;
    const size_t kstep = (size_t)(BK * 2);
    const unsigned ldsw = (unsigned)wid * 1024u;
    const int aoff = lds_byte(wr * 64 + fr, fq * 8), boff = lds_byte(wc * 32 + fr, fq * 8);
#define PG8_SA(b, h) (((b) * 2 + (h)) * HTB)
#define PG8_SB(b, h) ((4 + (b) * 2 + (h)) * HTB)
#define PG8_STAGE_B(bufoff, gbase) do { _Pragma("unroll") for (int _i = 0; _i < 2; ++_i) \
        __builtin_amdgcn_global_load_lds((const unsigned*)(uni_ptr((const char*)(gbase) + _i * pstep) + vB), (LAS unsigned*)(lds + (bufoff) + ldsw + _i * 8192), 16, 0, 0); } while (0)
#define PG8_STAGE_A(bufoff, gbase, vo, h) do { _Pragma("unroll") for (int _i = 0; _i < 2; ++_i) { \
        if constexpr (Pol::GATHER) __builtin_amdgcn_global_load_lds((const unsigned*)(uni_ptr((const char*)(gbase)) + (vo)[h][_i]), (LAS unsigned*)(lds + (bufoff) + ldsw + _i * 8192), 16, 0, 0); \
        else __builtin_amdgcn_global_load_lds((const unsigned*)(uni_ptr((const char*)(gbase) + ((h) * 2 + _i) * pstep) + (vo)[0][0]), (LAS unsigned*)(lds + (bufoff) + ldsw + _i * 8192), 16, 0, 0); } } while (0)
#define PG8_LDA(dst, b, h) do { _Pragma("unroll") for (int m = 0; m < 4; ++m) _Pragma("unroll") for (int k = 0; k < 2; ++k) dst[m][k] = *(const LAS bf16x8*)(lds + PG8_SA(b, h) + aoff + m * 2048 + k * 1024); } while (0)
#define PG8_LDB(dst, b, h) do { _Pragma("unroll") for (int n = 0; n < 2; ++n) _Pragma("unroll") for (int k = 0; k < 2; ++k) dst[n][k] = *(const LAS bf16x8*)(lds + PG8_SB(b, h) + boff + n * 2048 + k * 1024); } while (0)
#define PG8_MMA(ai, bj, At, Bt) do { __builtin_amdgcn_s_setprio(1); _Pragma("unroll") for (int m = 0; m < 4; ++m) _Pragma("unroll") for (int n = 0; n < 2; ++n) _Pragma("unroll") for (int k = 0; k < 2; ++k) \
        acc[ai][bj][m][n] = __builtin_amdgcn_mfma_f32_16x16x32_bf16(Bt[n][k], At[m][k], acc[ai][bj][m][n], 0, 0, 0); __builtin_amdgcn_s_setprio(0); } while (0)
#define PG8_WAIT_V(n) asm volatile("s_waitcnt vmcnt(" #n ")" ::: "memory")
#define PG8_WAIT_L(n) asm volatile("s_waitcnt lgkmcnt(" #n ")" ::: "memory")
#define PG8_BAR __builtin_amdgcn_s_barrier()
#define PG8_SCHED __builtin_amdgcn_sched_barrier(0)
    Unit cur, nxt; int ui = 0;
    if (!P.next(0, cur)) return;
    f32x4 acc[2][2][4][2];
#pragma unroll
    for (int a = 0; a < 2; ++a)
#pragma unroll
        for (int b = 0; b < 2; ++b)
#pragma unroll
            for (int m = 0; m < 4; ++m)
#pragma unroll
                for (int n = 0; n < 2; ++n) acc[a][b][m][n] = (f32x4){0.f, 0.f, 0.f, 0.f};
    bf16x8 At[4][2], B0[2][2], B1[2][2];
    unsigned vAc[2][2], vAn[2][2];
    if constexpr (Pol::GATHER) { P.rows_issue(cur, R0, vAc); P.rows_finish(C0, K, vAc); }
    else { vAc[0][0] = (unsigned)(R0 * K + C0) * 2u; vAc[0][1] = vAc[1][0] = vAc[1][1] = 0u; }
    asm volatile("s_waitcnt vmcnt(0)" ::: "memory");
    PG8_STAGE_B(PG8_SB(0, 0), cur.B0); PG8_STAGE_B(PG8_SB(0, 1), cur.B1); PG8_STAGE_A(PG8_SA(0, 0), cur.A, vAc, 0); PG8_STAGE_A(PG8_SA(0, 1), cur.A, vAc, 1);
    if (wr == 1) PG8_BAR;
    PG8_WAIT_V(2); PG8_BAR;
    PG8_STAGE_B(PG8_SB(1, 0), cur.B0 + kstep); PG8_STAGE_A(PG8_SA(1, 0), cur.A + kstep, vAc, 0); PG8_STAGE_B(PG8_SB(1, 1), cur.B1 + kstep);
    PG8_WAIT_V(6); PG8_BAR;
    for (;;) {
        const bool has_next = P.next(ui + 1, nxt);
        if (!has_next) nxt = cur;
        for (int t = 0; t < nt; t += 2) {
            const bool last = (t == nt - 2);
            if constexpr (Pol::GATHER) {
                if (last && has_next) { P.rows_issue(nxt, R0, vAn); vAc[0][0] = (vAn[0][0] * (unsigned)K + (unsigned)C0) * 2u; vAc[0][1] = (vAn[0][1] * (unsigned)K + (unsigned)C0) * 2u; }
            }
            const char* a1 = cur.A + (size_t)(t + 1) * kstep;
            const char* a2 = last ? nxt.A : cur.A + (size_t)(t + 2) * kstep;
            const char* b20 = last ? nxt.B0 : cur.B0 + (size_t)(t + 2) * kstep; const char* b21 = last ? nxt.B1 : cur.B1 + (size_t)(t + 2) * kstep;
            const char* a3 = a2 + kstep; const char* b30 = b20 + kstep; const char* b31 = b21 + kstep;
            PG8_LDB(B0, 0, 0); PG8_LDB(B1, 0, 1); PG8_SCHED; PG8_LDA(At, 0, 0); PG8_STAGE_A(PG8_SA(1, 1), a1, vAc, 1);
            if constexpr (Pol::GATHER) { if (last && has_next) { vAc[1][0] = (vAn[1][0] * (unsigned)K + (unsigned)C0) * 2u; vAc[1][1] = (vAn[1][1] * (unsigned)K + (unsigned)C0) * 2u; } }
            PG8_WAIT_V(8); PG8_WAIT_L(0); PG8_BAR; PG8_MMA(0, 0, At, B0); PG8_MMA(0, 1, At, B1); PG8_BAR; PG8_SCHED;
            PG8_LDA(At, 0, 1); PG8_STAGE_B(PG8_SB(0, 0), b20); PG8_STAGE_B(PG8_SB(0, 1), b21); PG8_STAGE_A(PG8_SA(0, 0), a2, vAc, 0);
            PG8_WAIT_V(8); PG8_WAIT_L(0); PG8_BAR; PG8_MMA(1, 0, At, B0); PG8_MMA(1, 1, At, B1); PG8_BAR; PG8_SCHED;
            PG8_LDB(B0, 1, 0); PG8_LDB(B1, 1, 1); PG8_SCHED; PG8_LDA(At, 1, 0); PG8_STAGE_A(PG8_SA(0, 1), a2, vAc, 1);
            PG8_WAIT_V(8); PG8_WAIT_L(0); PG8_BAR; PG8_MMA(0, 0, At, B0); PG8_MMA(0, 1, At, B1); PG8_BAR; PG8_SCHED;
            PG8_LDA(At, 1, 1); PG8_STAGE_B(PG8_SB(1, 0), b30); PG8_STAGE_B(PG8_SB(1, 1), b31); PG8_STAGE_A(PG8_SA(1, 0), a3, vAc, 0);
            PG8_WAIT_V(8); PG8_WAIT_L(0); PG8_BAR; PG8_MMA(1, 0, At, B0); PG8_MMA(1, 1, At, B1); PG8_BAR; PG8_SCHED;
        }
        if (wr == 0) PG8_BAR;
        P.epi(acc, cur, wr, wc, fr, fq);
        if (!has_next) break;
#pragma unroll
        for (int a = 0; a < 2; ++a)
#pragma unroll
            for (int b = 0; b < 2; ++b)
#pragma unroll
                for (int m = 0; m < 4; ++m)
#pragma unroll
                    for (int n = 0; n < 2; ++n) acc[a][b][m][n] = (f32x4){0.f, 0.f, 0.f, 0.f};
        cur = nxt; ++ui;
        if (wr == 1) PG8_BAR;
    }
    PG8_WAIT_V(0);
    PG8_BAR;
#undef PG8_SA
#undef PG8_SB
#undef PG8_STAGE_A
#undef PG8_STAGE_B
#undef PG8_LDA
#undef PG8_LDB
#undef PG8_MMA
#undef PG8_WAIT_V
#undef PG8_WAIT_L
#undef PG8_BAR
#undef PG8_SCHED
}
}

struct PolP1 {
    static constexpr bool PERM = true, GATHER = false;
    const bf16_t* A; const bf16_t* Bt; bf16_t* PR; bf16_t* PA; const bf16_t* MB; const bf16_t* WK; bf16_t* KVM; int G, c;
    __device__ __forceinline__ bool next(int i, pg8::Unit& u) const { int pm, pn; constexpr int NMAIN = (T / 256) * (IN_WP / 256), NKV = (BATCH * NMEM / 256) * (2 * MW / 256);
        if (pg8::static_order(T / 256, IN_WP / 256, G, c, i, pm, pn)) {
            u.A = (const char*)(A + (size_t)pm * 256 * D); u.B0 = (const char*)(Bt + (size_t)pn * 256 * D); u.B1 = u.B0 + (size_t)128 * D * 2; u.x0 = pm; u.x1 = pn; u.x2 = 0; u.x3 = 0; u.x4 = 0; return true; }
        const long L = (long)i * G + c - NMAIN; if (L < 0 || L >= NKV) return false;
        pm = (int)(L >> 1); pn = (int)(L & 1);
        u.A = (const char*)(MB + (size_t)pm * 256 * D); u.B0 = (const char*)(WK + (size_t)pn * 256 * D); u.B1 = u.B0 + (size_t)128 * D * 2; u.x0 = pm; u.x1 = pn; u.x2 = 1; u.x3 = 0; u.x4 = 0; return true; }
    __device__ __forceinline__ void epi(const f32x4 (&acc)[2][2][4][2], const pg8::Unit& u, int wr, int wc, int fr, int fq) const {
        const int row0 = u.x0 * 256 + wr * 64 + fr;
#pragma unroll
        for (int bj = 0; bj < 2; ++bj) { const int col = u.x1 * 256 + bj * 128 + wc * 32 + 8 * fq;
            bf16_t* base; int pitch; float sc = 1.f;
            if (u.x2) { base = KVM + col; pitch = 2 * MW; }
            else if (col < RWKV_IN) { base = PR + col; pitch = RWKV_IN; }
            else { const int ca = col - RWKV_IN; base = PA + ca; pitch = PA_W; sc = (ca < AW || (ca >= 3 * AW && ca < 3 * AW + MW)) ? 0.125f : 1.f; }
#pragma unroll
            for (int ai = 0; ai < 2; ++ai)
#pragma unroll
                for (int m = 0; m < 4; ++m) { const f32x4 v0 = acc[ai][bj][m][0] * sc, v1 = acc[ai][bj][m][1] * sc;
                    u32x4 w; w.x = pg8::cvt_pk_bf16(v0[0], v0[1]); w.y = pg8::cvt_pk_bf16(v0[2], v0[3]); w.z = pg8::cvt_pk_bf16(v1[0], v1[1]); w.w = pg8::cvt_pk_bf16(v1[2], v1[3]);
                    *(u32x4*)(base + (size_t)(row0 + ai * 128 + m * 16) * pitch) = w; } }
    }
};
__device__ __forceinline__ void phase1(const Params& p, LAS unsigned char* lds) {
    unsigned char* ws = p.ws;
    PolP1 P{(const bf16_t*)(ws + WS_H0B), (const bf16_t*)(ws + WS_WT_IN), (bf16_t*)(ws + WS_PR), (bf16_t*)(ws + WS_PA), (const bf16_t*)(ws + WS_MEMB), (const bf16_t*)(ws + WS_WT_KV), (bf16_t*)(ws + WS_KVM), (int)gridDim.x, (int)blockIdx.x};
    pg8::gemm_phase(lds, P, D);
}

constexpr int P2_AP = 200;
__device__ __forceinline__ f32x4 p2_shift(const bf16_t* cur, int po, int no, float pm, float nm, const float* mu) {
    const u32x2 c = *(const u32x2*)cur, pv = *(const u32x2*)(cur + po), nv = *(const u32x2*)(cur + no);
    const f32x4 m = *(const f32x4*)mu;
    const f32x4 cc = {bflo(c.x), bfhi(c.x), bflo(c.y), bfhi(c.y)}, pp = {bflo(pv.x), bfhi(pv.x), bflo(pv.y), bfhi(pv.y)}, nn = {bflo(nv.x), bfhi(nv.x), bflo(nv.y), bfhi(nv.y)};
    return cc + m * (0.5f * (pp * pm + nn * nm) - cc);
}
__device__ __forceinline__ void phase2(const Params& p, LAS unsigned char* lds) {
    const int tid = threadIdx.x, lane = tid & 63, wave = tid >> 6, fr = lane & 15, fq = lane >> 4;
    unsigned char* ws = p.ws;
    const bf16_t* PR = (const bf16_t*)(ws + WS_PR);
    const float* mu = p.in[5];
    const bf16_t* WU = (const bf16_t*)(ws + WS_LORA); const bf16_t* AU = WU + 2 * RC * 32; const bf16_t* GU = AU + 2 * RC * 32;
    LAS bf16_t* ACT = (LAS bf16_t*)(lds + wave * (16 * P2_AP * 2));
    float* SSH = (float*)(ws + WS_SSH); float* SDIR = (float*)(ws + WS_SDIR);
    bf16_t* G = (bf16_t*)((unsigned char*)p.out + DO_G); float* BON = (float*)(ws + WS_BONUS);
    for (int tile = blockIdx.x * NWAVES + wave; tile < T / 16; tile += gridDim.x * NWAVES) {
        const int t0 = tile * 16;
#pragma unroll 4
        for (int i = 0; i < 12; ++i) { const int grp = lane + 64 * i, tok = grp / 48, c4 = (grp % 48) * 4, t = t0 + tok, sq = t & (SEQ - 1);
            f32x4 v = p2_shift(PR + (size_t)t * RWKV_IN + 3 * RC + c4, sq > 0 ? -RWKV_IN : 0, sq < SEQ - 1 ? RWKV_IN : 0, sq > 0 ? 1.f : 0.f, sq < SEQ - 1 ? 1.f : 0.f, mu + 3 * RC + c4);
            { const float sc = c4 < 64 ? 1.f : 2.f, mul = c4 < 64 ? 1.f : 2.f, add = c4 < 64 ? 0.f : -1.f; const bool raw = c4 >= 128;
#pragma unroll
              for (int e = 0; e < 4; ++e) { const float a = sigmoidf_(sc * v[e]) * mul + add; v[e] = raw ? v[e] : a; } }
            u32x2 o; o.x = pk2(v.x, v.y); o.y = pk2(v.z, v.w); *(LAS u32x2*)(ACT + tok * P2_AP + c4) = o; }
        asm volatile("s_waitcnt lgkmcnt(0)" ::: "memory");
        const int t = t0 + fr, sq = t & (SEQ - 1), b = t >> 11; const int po = sq > 0 ? -RWKV_IN : 0, no = sq < SEQ - 1 ? RWKV_IN : 0; const float pm = sq > 0 ? 1.f : 0.f, nm = sq < SEQ - 1 ? 1.f : 0.f;
        const bf16_t* prow = PR + (size_t)t * RWKV_IN;
        const bf16x8 bsg0 = *(const LAS bf16x8*)(ACT + fr * P2_AP + 8 * fq), bsg1 = *(const LAS bf16x8*)(ACT + fr * P2_AP + 32 + 8 * fq);
        const bf16x8 btw0 = *(const LAS bf16x8*)(ACT + fr * P2_AP + 64 + 8 * fq), btw1 = *(const LAS bf16x8*)(ACT + fr * P2_AP + 96 + 8 * fq);
        const bf16x8 bal0 = *(const LAS bf16x8*)(ACT + fr * P2_AP + 128 + 8 * fq), bal1 = *(const LAS bf16x8*)(ACT + fr * P2_AP + 160 + 8 * fq);
#pragma unroll 1
        for (int h = 0; h < RH; ++h) {
            f32x4 kp[4]; float ss = 0.f;
#pragma unroll
            for (int ct = 0; ct < 4; ++ct) { const int ch = h * 64 + 16 * ct + 4 * fq; kp[ct] = p2_shift(prow + RC + ch, po, no, pm, nm, mu + RC + ch);
                const f32x4 kkv = kp[ct] * *(const f32x4*)(p.in[11] + ch); ss += (kkv.x * kkv.x + kkv.y * kkv.y) + (kkv.z * kkv.z + kkv.w * kkv.w); }
            ss += __shfl_xor(ss, 16); ss += __shfl_xor(ss, 32);
            const float rn = 1.f / fmaxf(sqrtf(ss), 1e-12f);
            float bon = 0.f;
            unsigned char* shrec = (unsigned char*)SSH + ((size_t)(b * RH + h) * SEQ + sq) * 384;
            unsigned char* d0rec = (unsigned char*)SDIR + ((size_t)((0 * BATCH + b) * RH + h) * SEQ + sq) * 512; unsigned char* d1rec = (unsigned char*)SDIR + ((size_t)((1 * BATCH + b) * RH + h) * SEQ + sq) * 512;
#pragma unroll
            for (int ct = 0; ct < 4; ++ct) { const int ch = h * 64 + 16 * ct + 4 * fq, cl = 16 * ct + 4 * fq;
                const f32x4 r = p2_shift(prow + ch, po, no, pm, nm, mu + ch), v = p2_shift(prow + 2 * RC + ch, po, no, pm, nm, mu + 2 * RC + ch), k = kp[ct];
                const bf16_t* wrow = WU + (size_t)(h * 64 + 16 * ct + fr) * 32 + 8 * fq; const bf16_t* arow = AU + (size_t)(h * 64 + 16 * ct + fr) * 32 + 8 * fq;
                const bf16_t* grow = GU + (size_t)(h * 64 + 16 * ct + fr) * 64 + 8 * fq;
                const f32x4 z = {0.f, 0.f, 0.f, 0.f};
                const f32x4 wl0 = __builtin_amdgcn_mfma_f32_16x16x32_bf16(*(const bf16x8*)wrow, btw0, z, 0, 0, 0);
                const f32x4 wl1 = __builtin_amdgcn_mfma_f32_16x16x32_bf16(*(const bf16x8*)(wrow + RC * 32), btw1, z, 0, 0, 0);
                const f32x4 al0 = __builtin_amdgcn_mfma_f32_16x16x32_bf16(*(const bf16x8*)arow, bal0, z, 0, 0, 0);
                const f32x4 al1 = __builtin_amdgcn_mfma_f32_16x16x32_bf16(*(const bf16x8*)(arow + RC * 32), bal1, z, 0, 0, 0);
                f32x4 gg = __builtin_amdgcn_mfma_f32_16x16x32_bf16(*(const bf16x8*)grow, bsg0, z, 0, 0, 0);
                gg = __builtin_amdgcn_mfma_f32_16x16x32_bf16(*(const bf16x8*)(grow + 32), bsg1, gg, 0, 0, 0);
                const f32x4 w00 = *(const f32x4*)(p.in[6] + ch), w01 = *(const f32x4*)(p.in[6] + RC + ch), a00 = *(const f32x4*)(p.in[8] + ch), a01 = *(const f32x4*)(p.in[8] + RC + ch);
                const f32x4 kkw = *(const f32x4*)(p.in[11] + ch), kaw = *(const f32x4*)(p.in[12] + ch), rkw = *(const f32x4*)(p.in[13] + ch);
                f32x4 dec0, dec1, kd0, kd1, bb0, bb1, kkn;
#pragma unroll
                for (int e = 0; e < 4; ++e) {
                    dec0[e] = __expf(-0.6065306597126334f * sigmoidf_(w00[e] + wl0[e])); dec1[e] = __expf(-0.6065306597126334f * sigmoidf_(w01[e] + wl1[e]));
                    const float a0 = sigmoidf_(a00[e] + al0[e]), a1 = sigmoidf_(a01[e] + al1[e]);
                    kkn[e] = k[e] * kkw[e] * rn; kd0[e] = k[e] * (1.f + (a0 - 1.f) * kaw[e]); kd1[e] = k[e] * (1.f + (a1 - 1.f) * kaw[e]);
                    bb0[e] = kkn[e] * a0; bb1[e] = kkn[e] * a1; bon += r[e] * (kd0[e] + kd1[e]) * rkw[e]; }
                { u32x2 o; o.x = pk2(r.x, r.y); o.y = pk2(r.z, r.w); *(u32x2*)(shrec + cl * 2) = o; o.x = pk2(v.x, v.y); o.y = pk2(v.z, v.w); *(u32x2*)(shrec + 128 + cl * 2) = o;
                  o.x = pk2(kkn.x, kkn.y); o.y = pk2(kkn.z, kkn.w); *(u32x2*)(shrec + 256 + cl * 2) = o;
                  *(f32x4*)(d0rec + cl * 4) = dec0; o.x = pk2(kd0.x, kd0.y); o.y = pk2(kd0.z, kd0.w); *(u32x2*)(d0rec + 256 + cl * 2) = o; o.x = pk2(bb0.x, bb0.y); o.y = pk2(bb0.z, bb0.w); *(u32x2*)(d0rec + 384 + cl * 2) = o;
                  *(f32x4*)(d1rec + cl * 4) = dec1; o.x = pk2(kd1.x, kd1.y); o.y = pk2(kd1.z, kd1.w); *(u32x2*)(d1rec + 256 + cl * 2) = o; o.x = pk2(bb1.x, bb1.y); o.y = pk2(bb1.z, bb1.w); *(u32x2*)(d1rec + 384 + cl * 2) = o; }
                u32x2 go; go.x = pk2(gg.x, gg.y); go.y = pk2(gg.z, gg.w); *(u32x2*)(G + (size_t)t * RC + ch) = go;
            }
            bon += __shfl_xor(bon, 16); bon += __shfl_xor(bon, 32);
            if (fq == 0) BON[t * RH + h] = bon;
        }
    }
}

constexpr int SC_TC = 16;
constexpr int SC_STEPB = 1408;
constexpr int SC_BUFB = SC_TC * SC_STEPB;
struct ScanProd { const unsigned char* gsrc; long gstep; int ldst; int conv; };
__device__ __forceinline__ ScanProd scan_prod_init(const unsigned char* sh, const unsigned char* dr, int dir, int ptid) {
    ScanProd P; const int wi = ptid % 56, st0 = ptid / 56; const unsigned char* src; int shift = 0; bool fromsh = false;
    if (wi < 16) { src = dr + wi * 16; P.ldst = wi * 16; P.conv = 0; }
    else if (wi < 24) { src = dr + 256 + (wi - 16) * 16; P.ldst = 512 + (wi - 16) * 32; P.conv = 1; }
    else if (wi < 32) { src = dr + 384 + (wi - 24) * 16; P.ldst = 256 + (wi - 24) * 32; P.conv = 1; }
    else if (wi < 40) { src = sh + 128 + (wi - 32) * 16; P.ldst = 768 + (wi - 32) * 32; P.conv = 1; fromsh = true; }
    else if (wi < 48) { src = sh + 256 + (wi - 40) * 16; P.ldst = 1024 + (wi - 40) * 16; P.conv = 0; fromsh = true; }
    else { src = sh + (wi - 48) * 16; P.ldst = 1152 + (wi - 48) * 16; P.conv = 0; shift = 1; fromsh = true; }
    const long rec = fromsh ? 384 : 512;
    const long t0 = dir ? (long)(SEQ - 1 - (st0 - shift)) : (long)(st0 - shift);
    P.gsrc = src + t0 * rec; P.gstep = dir ? -rec : rec; P.ldst += st0 * SC_STEPB; return P;
}
__device__ __forceinline__ void scan_fetch(const ScanProd& P, int c, u32x4 (&reg)[SC_TC / 4]) {
    const unsigned char* g = P.gsrc + (long)(c * SC_TC) * P.gstep;
#pragma unroll
    for (int q = 0; q < SC_TC / 4; ++q) reg[q] = *(const u32x4*)(g + (long)(4 * q) * P.gstep);
}
__device__ __forceinline__ void scan_put(const ScanProd& P, LAS unsigned char* buf, const u32x4 (&reg)[SC_TC / 4]) {
    LAS unsigned char* d = buf + P.ldst;
    if (P.conv) {
#pragma unroll
        for (int q = 0; q < SC_TC / 4; ++q) { const u32x4 x = reg[q];
            *(LAS f32x4*)(d + 4 * q * SC_STEPB) = (f32x4){bflo(x.x), bfhi(x.x), bflo(x.y), bfhi(x.y)}; *(LAS f32x4*)(d + 4 * q * SC_STEPB + 16) = (f32x4){bflo(x.z), bfhi(x.z), bflo(x.w), bfhi(x.w)}; }
    } else {
#pragma unroll
        for (int q = 0; q < SC_TC / 4; ++q) *(LAS u32x4*)(d + 4 * q * SC_STEPB) = reg[q];
    }
}
__device__ __forceinline__ void scan_block(const Params& p, LAS unsigned char* lds, int sid) {
    const int tid = threadIdx.x, lane = tid & 63, wave = tid >> 6;
    const int dir = sid / (BATCH * RH), bh = sid % (BATCH * RH), b = bh / RH, h = bh % RH;
    const unsigned char* sh = p.ws + WS_SSH + (size_t)bh * SEQ * 384;
    const unsigned char* dr = p.ws + WS_SDIR + (size_t)(dir * BATCH * RH + bh) * SEQ * 512;
    float* Y = (float*)((unsigned char*)p.out + DO_Y) + (size_t)dir * T * RC;
    LAS unsigned char* buf0 = lds; LAS unsigned char* buf1 = lds + SC_BUFB;
    constexpr int NCH = SEQ / SC_TC;
    __syncthreads();
    for (int i = tid; i < 2 * SC_TC * 32; i += NTHR) { const int st = i >> 5, e = i & 31; *(LAS unsigned*)(lds + st * SC_STEPB + 1280 + e * 4) = 0u; }
    const ScanProd SP = scan_prod_init(sh, dr, dir, (tid - 256) & 255);
    const bool prod = wave >= 4 && tid - 256 < 224;
    u32x4 preg[SC_TC / 4];
    if (prod) { scan_fetch(SP, 0, preg); scan_put(SP, buf0, preg); scan_fetch(SP, 1, preg); }
    __syncthreads();
    const int fr = lane & 15, fq = lane >> 4, sel = (fr & 3) < 2 ? (fr & 3) : 2;
    float s[16];
#pragma unroll
    for (int j = 0; j < 16; ++j) s[j] = 0.f;
    bf16x8 sb0 = (bf16x8){0, 0, 0, 0, 0, 0, 0, 0}, sb1 = sb0;
    float* yrow = Y + (size_t)b * SEQ * RC + h * 64 + 16 * wave + fr;
    float yk = 0.f;
    for (int c = 0; c < NCH; ++c) {
        LAS unsigned char* cur = (c & 1) ? buf1 : buf0; LAS unsigned char* nxt = (c & 1) ? buf0 : buf1;
        if (wave >= 4) {
            if (prod && c + 1 < NCH) { scan_put(SP, nxt, preg); if (c + 2 < NCH) scan_fetch(SP, c + 2, preg); }
        } else {
            const LAS unsigned char* cb = cur + fq * 32;
            const LAS unsigned char* ab = cur + 1024 + 128 * sel + fq * 16;
            const LAS unsigned char* vb = cur + 768 + (16 * wave + fr) * 4;
            bf16x8 cA0, cA1, nA0, nA1; f32x4 cW[4], cK[4], cB[4], nW[4], nK[4], nB[4]; float cV, nV;
#define SC_LOAD(A0, A1, W, K, B, V, st) do { const LAS unsigned char* q_ = cb + (st) * SC_STEPB; \
                A0 = *(const LAS bf16x8*)(ab + (st) * SC_STEPB); A1 = *(const LAS bf16x8*)(ab + (st) * SC_STEPB + 64); \
                W[0] = *(const LAS f32x4*)(q_); W[1] = *(const LAS f32x4*)(q_ + 16); W[2] = *(const LAS f32x4*)(q_ + 128); W[3] = *(const LAS f32x4*)(q_ + 144); \
                K[0] = *(const LAS f32x4*)(q_ + 512); K[1] = *(const LAS f32x4*)(q_ + 528); K[2] = *(const LAS f32x4*)(q_ + 640); K[3] = *(const LAS f32x4*)(q_ + 656); \
                B[0] = *(const LAS f32x4*)(q_ + 256); B[1] = *(const LAS f32x4*)(q_ + 272); B[2] = *(const LAS f32x4*)(q_ + 384); B[3] = *(const LAS f32x4*)(q_ + 400); \
                V = *(const LAS float*)(vb + (st) * SC_STEPB); } while (0)
            SC_LOAD(cA0, cA1, cW, cK, cB, cV, 0);
#pragma unroll 1
            for (int g = 0; g < SC_TC / 4; ++g) {
#pragma unroll
                for (int u = 0; u < 4; ++u) {
                    const int st = 4 * g + u;
                    f32x4 d = (f32x4){0.f, 0.f, 0.f, 0.f};
                    d = __builtin_amdgcn_mfma_f32_16x16x32_bf16(cA0, sb0, d, 0, 0, 0);
                    d = __builtin_amdgcn_mfma_f32_16x16x32_bf16(cA1, sb1, d, 0, 0, 0);
                    if (st + 1 < SC_TC) SC_LOAD(nA0, nA1, nW, nK, nB, nV, st + 1);
#define OPQ(x) asm("" : "+v"(x))
                    float tt[16];
#pragma unroll
                    for (int j = 0; j < 16; ++j) { tt[j] = cV * cK[j >> 2][j & 3]; OPQ(tt[j]); }
#pragma unroll
                    for (int j = 0; j < 16; ++j) { tt[j] = s[j] * cW[j >> 2][j & 3] + tt[j]; OPQ(tt[j]); }
                    const float nsa = -d[0];
                    yk = (((u + 3) & 3) == fq) ? d[1] : yk;
                    if (u == 0) {
                        const int tau = c * SC_TC + 4 * g - 4 + fq;
                        if (tau >= 0) { const int t = dir ? (SEQ - 1 - tau) : tau; yrow[(size_t)t * RC] = yk; } }
#pragma unroll
                    for (int j = 0; j < 16; ++j) { s[j] = nsa * cB[j >> 2][j & 3] + tt[j]; OPQ(s[j]); }
#undef OPQ
                    u32x4 p0, p1;
                    p0.x = pg8::cvt_pk_bf16(s[0], s[1]); p0.y = pg8::cvt_pk_bf16(s[2], s[3]); p0.z = pg8::cvt_pk_bf16(s[4], s[5]); p0.w = pg8::cvt_pk_bf16(s[6], s[7]);
                    p1.x = pg8::cvt_pk_bf16(s[8], s[9]); p1.y = pg8::cvt_pk_bf16(s[10], s[11]); p1.z = pg8::cvt_pk_bf16(s[12], s[13]); p1.w = pg8::cvt_pk_bf16(s[14], s[15]);
                    sb0 = __builtin_bit_cast(bf16x8, p0); sb1 = __builtin_bit_cast(bf16x8, p1);
                    cA0 = nA0; cA1 = nA1; cV = nV;
#pragma unroll
                    for (int i = 0; i < 4; ++i) { cW[i] = nW[i]; cK[i] = nK[i]; cB[i] = nB[i]; }
                    asm volatile("" ::: "memory");
                }
            }
#undef SC_LOAD
        }
        __syncthreads();
    }
    if (wave < 4) {
        if (fq < 3) { const int tau = SEQ - 4 + fq, t = dir ? (SEQ - 1 - tau) : tau; yrow[(size_t)t * RC] = yk; }
        const int t = dir ? 0 : (SEQ - 1); const bf16_t* rr = (const bf16_t*)(sh + (size_t)t * 384);
        float acc = 0.f;
#pragma unroll
        for (int j = 0; j < 8; ++j) { acc += bf2f((unsigned)(unsigned short)sb0[j]) * bf2f(rr[8 * fq + j]); acc += bf2f((unsigned)(unsigned short)sb1[j]) * bf2f(rr[32 + 8 * fq + j]); }
        acc += __shfl_xor(acc, 16); acc += __shfl_xor(acc, 32);
        if (fq == 0) yrow[(size_t)t * RC] = acc;
    }
    __syncthreads();
}

constexpr int AT_P = 72;
constexpr int AT_KOFF = 0, AT_VOFF = 256 * AT_P * 2;
constexpr int ATT_DIL_UNITS = BATCH * AH * 48;
constexpr int ATT_MEM_UNITS = BATCH * MH * 16;
constexpr int ATT_UNITS = ATT_DIL_UNITS + ATT_MEM_UNITS;
struct AttU { const bf16_t* q; const bf16_t* k; const bf16_t* v; long qs, ks; int kind, win0, L, dil; float slope; bf16_t* o; long os; float* lse; long ls; };
__device__ __forceinline__ void att_make_unit(const Params& p, int u, AttU& U) {
    unsigned char* ws = p.ws; const bf16_t* PA = (const bf16_t*)(ws + WS_PA);
    if (u < ATT_DIL_UNITS) {
        const int bh = u / 48, x = u % 48, b = bh / AH, h = bh % AH, br = x >> 4, y = x & 15;
        const int dil = br == 0 ? 1 : (br == 1 ? 4 : 16), L = SEQ / dil, npr = L / 128, r = y / npr, np = y % npr;
        const bf16_t* base = PA + (size_t)(b * SEQ + r) * PA_W + h * 64;
        U.kind = 0; U.win0 = (2 * np - 1) * 64; U.L = L; U.dil = dil; U.slope = exp2f(-8.f * (float)(h + 1) / (float)AH);
        U.qs = (long)dil * PA_W; U.ks = U.qs;
        U.q = base + (long)(np * 128) * U.qs; U.k = base + AW; U.v = base + 2 * AW;
        const size_t tok0 = (size_t)(b * SEQ + r) + (size_t)np * 128 * dil;
        U.o = (bf16_t*)(ws + WS_ATTO) + (size_t)br * T * AW + tok0 * AW + h * 64; U.os = (long)dil * AW;
        U.lse = (float*)((unsigned char*)p.out + DO_LSE) + (size_t)br * T * AH + tok0 * AH + h; U.ls = (long)dil * AH;
    } else {
        const int v = u - ATT_DIL_UNITS, bh = v >> 4, qb = v & 15, b = bh / MH, h = bh % MH;
        const bf16_t* KVM = (const bf16_t*)(ws + WS_KVM);
        U.kind = 1; U.win0 = 0; U.L = NMEM; U.dil = 1; U.slope = 0.f;
        U.q = PA + (size_t)(b * SEQ + qb * 128) * PA_W + 3 * AW + h * 64; U.qs = PA_W;
        U.k = KVM + (size_t)(b * NMEM) * (2 * MW) + h * 64; U.v = U.k + MW; U.ks = 2 * MW;
        U.o = (bf16_t*)(ws + WS_YMIX) + (size_t)(b * SEQ + qb * 128) * D + RC + AW + h * 64; U.os = D;
        U.lse = nullptr; U.ls = 0;
    }
}
__device__ __forceinline__ void att_fetch(const AttU& U, u32x4 (&reg)[8], int tid) {
#pragma unroll
    for (int q = 0; q < 8; ++q) { const int rem = (tid + NTHR * q) & 2047, row = rem >> 3, ch = rem & 7; const int lk = U.win0 + row; const bool ok = lk >= 0 && lk < U.L;
        const bf16_t* src = (q < 4 ? U.k : U.v) + (long)(ok ? lk : 0) * U.ks + ch * 8;
        u32x4 raw = *(const u32x4*)src; if (!ok) raw = (u32x4){0u, 0u, 0u, 0u}; reg[q] = raw; }
}
__device__ __forceinline__ void att_put(LAS unsigned char* lds, const u32x4 (&reg)[8], int tid) {
#pragma unroll
    for (int q = 0; q < 8; ++q) { const int rem = (tid + NTHR * q) & 2047, row = rem >> 3, ch = rem & 7;
        *(LAS u32x4*)(lds + (q < 4 ? AT_KOFF : AT_VOFF) + row * (AT_P * 2) + ch * 16) = reg[q]; }
}
typedef short v4i16_t __attribute__((ext_vector_type(4)));
template <int NT  , bool DIL>
__device__ __forceinline__ void att_compute(const AttU& U, LAS unsigned char* lds, int w, int lane) {
    const int fr = lane & 15, fq = lane >> 4;
    const bf16_t* qp = U.q + (long)(16 * w + fr) * U.qs + fq * 8;
    const bf16x8 q0 = *(const bf16x8*)qp, q1 = *(const bf16x8*)(qp + 32);
    f32x4 sT[NT];
#pragma unroll
    for (int i = 0; i < NT; ++i) {
        if (DIL && i == 9) { sT[i] = (f32x4){-1e30f, -1e30f, -1e30f, -1e30f}; continue; }
        int tt = DIL ? w + i : i; tt = tt > 15 ? 15 : tt;
        const LAS unsigned char* kp = lds + AT_KOFF + (16 * tt + fr) * (AT_P * 2) + fq * 16;
        const bf16x8 k0 = *(const LAS bf16x8*)kp, k1 = *(const LAS bf16x8*)(kp + 64);
        f32x4 a = (f32x4){0.f, 0.f, 0.f, 0.f};
        a = __builtin_amdgcn_mfma_f32_16x16x32_bf16(k0, q0, a, 0, 0, 0);
        a = __builtin_amdgcn_mfma_f32_16x16x32_bf16(k1, q1, a, 0, 0, 0);
        sT[i] = a; if ((i & 3) == 3) asm volatile("" ::: "memory"); }
    float m = -3.0e38f;
    if (DIL) {
        const int c0 = 4 * fq - fr, lb = U.win0 + 16 * w + 4 * fq; const float sd = U.slope * (float)U.dil; const unsigned Lc = (unsigned)U.L;
#pragma unroll
        for (int i = 0; i < NT; ++i) { if (i == 9) continue;
#pragma unroll
            for (int r = 0; r < 4; ++r) { const int dl = 16 * i + r - 64 + c0, ad = dl < 0 ? -dl : dl;
                bool valid = (unsigned)(lb + 16 * i + r) < Lc; if (i == 0 || i >= 7) valid = valid && ad <= 64;
                const float sv = valid ? sT[i][r] - sd * (float)ad : -1e30f; sT[i][r] = sv; m = fmaxf(m, sv); } }
    } else {
#pragma unroll
        for (int i = 0; i < NT; ++i)
#pragma unroll
            for (int r = 0; r < 4; ++r) m = fmaxf(m, sT[i][r]);
    }
    m = fmaxf(m, __shfl_xor(m, 16)); m = fmaxf(m, __shfl_xor(m, 32));
    float l = 0.f;
#pragma unroll
    for (int i = 0; i < NT; ++i)
#pragma unroll
        for (int r = 0; r < 4; ++r) { const float e = __expf(sT[i][r] - m); sT[i][r] = e; l += e; }
    l += __shfl_xor(l, 16); l += __shfl_xor(l, 32);
    f32x4 oT[4];
#pragma unroll
    for (int dt = 0; dt < 4; ++dt) oT[dt] = (f32x4){0.f, 0.f, 0.f, 0.f};
#pragma unroll
    for (int tp = 0; tp < NT / 2; ++tp) {
        int ta = DIL ? w + 2 * tp : 2 * tp, tb = ta + 1; ta = ta > 15 ? 15 : ta; tb = tb > 15 ? 15 : tb;
        u32x4 pw; pw.x = pk2(sT[2 * tp][0], sT[2 * tp][1]); pw.y = pk2(sT[2 * tp][2], sT[2 * tp][3]); pw.z = pk2(sT[2 * tp + 1][0], sT[2 * tp + 1][1]); pw.w = pk2(sT[2 * tp + 1][2], sT[2 * tp + 1][3]);
        const bf16x8 pb = __builtin_bit_cast(bf16x8, pw);
        const LAS unsigned char* va = lds + AT_VOFF + (16 * ta + 4 * fq + (fr >> 2)) * (AT_P * 2) + 8 * (fr & 3);
        const LAS unsigned char* vb = lds + AT_VOFF + (16 * tb + 4 * fq + (fr >> 2)) * (AT_P * 2) + 8 * (fr & 3);
#pragma unroll
        for (int dt = 0; dt < 4; ++dt) {
            const v4i16_t lo = __builtin_amdgcn_ds_read_tr16_b64_v4i16((LAS v4i16_t*)(va + 32 * dt)), hi = __builtin_amdgcn_ds_read_tr16_b64_v4i16((LAS v4i16_t*)(vb + 32 * dt));
            bf16x8 vf; vf[0] = lo[0]; vf[1] = lo[1]; vf[2] = lo[2]; vf[3] = lo[3]; vf[4] = hi[0]; vf[5] = hi[1]; vf[6] = hi[2]; vf[7] = hi[3];
            oT[dt] = __builtin_amdgcn_mfma_f32_16x16x32_bf16(vf, pb, oT[dt], 0, 0, 0); }
        if (tp & 1) asm volatile("" ::: "memory");
    }
    const float inv = 1.f / l;
    bf16_t* op = U.o + (long)(16 * w + fr) * U.os;
#pragma unroll
    for (int dt = 0; dt < 4; ++dt) { u32x2 o; o.x = pk2(oT[dt][0] * inv, oT[dt][1] * inv); o.y = pk2(oT[dt][2] * inv, oT[dt][3] * inv); *(u32x2*)(op + 16 * dt + 4 * fq) = o; }
    if (DIL && fq == 0) U.lse[(long)(16 * w + fr) * U.ls] = m + __logf(l);
}
__device__ __forceinline__ void phase3(const Params& p, LAS unsigned char* lds, int rep) {
    const int tid = threadIdx.x, lane = tid & 63, wave = tid >> 6;
    unsigned* ctl = (unsigned*)(p.ws + WS_CTL);
    LAS unsigned* bc = (LAS unsigned*)(lds + 98304);
    for (;;) {
        __syncthreads();
        if (tid == 0) bc[0] = atomicAdd(ctl + CW_SCANQ + 16 * rep, 1u);
        __syncthreads();
        const unsigned sid = __builtin_amdgcn_readfirstlane(bc[0]);
        if (sid >= 2u * BATCH * RH) break;
#pragma unroll 1
        for (int tw = 0; tw < (REPEAT_PHASE == 31 ? 2 : 1); ++tw) scan_block(p, lds, (int)sid);
    }
    constexpr unsigned ATT_BATCH = 2;
    for (;;) {
        __syncthreads();
        if (tid == 0) bc[1] = atomicAdd(ctl + CW_ATTQ + 16 * rep, ATT_BATCH);
        __syncthreads();
        const unsigned ubase = __builtin_amdgcn_readfirstlane(bc[1]);
        if (ubase >= (unsigned)ATT_UNITS) break;
        const unsigned uend = ubase + ATT_BATCH < (unsigned)ATT_UNITS ? ubase + ATT_BATCH : (unsigned)ATT_UNITS;
        { AttU U; att_make_unit(p, (int)ubase, U); u32x4 reg[8]; att_fetch(U, reg, tid); att_put(lds, reg, tid); }
#pragma unroll 1
        for (unsigned ucur = ubase; ucur < uend; ++ucur) {
            __syncthreads();
            u32x4 reg[8];
            if (ucur + 1 < uend) { AttU Un; att_make_unit(p, (int)ucur + 1, Un); att_fetch(Un, reg, tid); }
            { AttU U; att_make_unit(p, (int)ucur, U);
#pragma unroll 1
              for (int tw = 0; tw < (REPEAT_PHASE == 32 ? 2 : 1); ++tw) {
                if (ucur < (unsigned)ATT_DIL_UNITS) att_compute<10, true>(U, lds, wave, lane); else att_compute<16, false>(U, lds, wave, lane); } }
            __syncthreads();
            if (ucur + 1 < uend) att_put(lds, reg, tid);
        }
    }
}

__device__ __forceinline__ void phase4(const Params& p) {
    const int tid = threadIdx.x, lane = tid & 63, wave = tid >> 6;
    const int gw = blockIdx.x * NWAVES + wave, NGW = gridDim.x * NWAVES;
    unsigned char* ws = p.ws; const unsigned char* dob = (const unsigned char*)p.out;
    const float* Yf = (const float*)(dob + DO_Y); const float* Yb = Yf + (size_t)T * RC;
    const bf16_t* G = (const bf16_t*)(dob + DO_G); const float* LSE = (const float*)(dob + DO_LSE);
    const float* BON = (const float*)(ws + WS_BONUS); const float* SSH = (const float*)(ws + WS_SSH);
    const bf16_t* AO = (const bf16_t*)(ws + WS_ATTO); bf16_t* YM = (bf16_t*)(ws + WS_YMIX);
    for (int t = gw; t < T; t += NGW) {
        const int b = t >> 11, s = t & (SEQ - 1);
        float yf[RH], yb[RH], vv[RH], bo[RH]; unsigned short gg[RH], a0[AH], a1[AH], a2[AH]; float l0[AH], l1[AH], l2[AH];
#pragma unroll
        for (int h = 0; h < RH; ++h) { const int ch = h * 64 + lane;
            yf[h] = Yf[(size_t)t * RC + ch]; yb[h] = Yb[(size_t)t * RC + ch]; gg[h] = G[(size_t)t * RC + ch];
            vv[h] = bf2f(((const bf16_t*)SSH)[((size_t)(b * RH + h) * SEQ + s) * 192 + 64 + lane]); bo[h] = BON[t * RH + h];
            a0[h] = AO[(size_t)t * AW + ch]; a1[h] = AO[(size_t)T * AW + (size_t)t * AW + ch]; a2[h] = AO[(size_t)2 * T * AW + (size_t)t * AW + ch];
            l0[h] = LSE[(size_t)t * AH + h]; l1[h] = LSE[(size_t)T * AH + (size_t)t * AH + h]; l2[h] = LSE[(size_t)2 * T * AH + (size_t)t * AH + h]; }
#pragma unroll
        for (int h = 0; h < RH; ++h) { const int ch = h * 64 + lane;
            const float y = yf[h] + yb[h];
            const float mean = wave_sum(y) * (1.f / 64.f); const float dlt = y - mean; const float var = wave_sum(dlt * dlt) * (1.f / 64.f);
            const float yn = dlt * (1.f / sqrtf(var + GN_EPS)) * p.in[14][ch] + p.in[15][ch];
            const float o = (yn + bo[h] * vv[h]) * bf2f(gg[h]);
            YM[(size_t)t * D + ch] = (bf16_t)f2bf(o); }
#pragma unroll
        for (int h = 0; h < AH; ++h) { const int ch = h * 64 + lane;
            const float mx = fmaxf(l0[h], fmaxf(l1[h], l2[h])); const float e0 = __expf(l0[h] - mx), e1 = __expf(l1[h] - mx), e2 = __expf(l2[h] - mx); const float inv = 1.f / (e0 + e1 + e2);
            const float o = (e0 * bf2f(a0[h]) + e1 * bf2f(a1[h]) + e2 * bf2f(a2[h])) * inv;
            YM[(size_t)t * D + RC + ch] = (bf16_t)f2bf(o); }
    }
}

struct PolP5 {
    static constexpr bool PERM = false, GATHER = false;
    const bf16_t* A; const bf16_t* Bt; const bf16_t* H0B; float* PRE; int G, c;
    __device__ __forceinline__ bool next(int i, pg8::Unit& u) const { int pm, pn; if (!pg8::static_order(T / 256, D / 256, G, c, i, pm, pn)) return false;
        u.A = (const char*)(A + (size_t)pm * 256 * D); u.B0 = (const char*)(Bt + (size_t)pn * 256 * D); u.B1 = u.B0 + (size_t)128 * D * 2; u.x0 = pm; u.x1 = pn; u.x2 = 0; u.x3 = 0; u.x4 = 0; return true; }
    __device__ __forceinline__ void epi(const f32x4 (&acc)[2][2][4][2], const pg8::Unit& u, int wr, int wc, int fr, int fq) const {
        const int row0 = u.x0 * 256 + wr * 64 + fr, col0 = u.x1 * 256 + wc * 32 + 4 * fq;
        u32x2 hb[2][4][2][2];
#pragma unroll
        for (int ai = 0; ai < 2; ++ai)
#pragma unroll
            for (int m = 0; m < 4; ++m)
#pragma unroll
                for (int bj = 0; bj < 2; ++bj)
#pragma unroll
                    for (int n = 0; n < 2; ++n) hb[ai][m][bj][n] = *(const u32x2*)(H0B + (size_t)(row0 + ai * 128 + m * 16) * D + col0 + bj * 128 + n * 16);
#pragma unroll
        for (int ai = 0; ai < 2; ++ai)
#pragma unroll
            for (int m = 0; m < 4; ++m) { const size_t ro = (size_t)(row0 + ai * 128 + m * 16) * D + col0;
#pragma unroll
                for (int bj = 0; bj < 2; ++bj)
#pragma unroll
                    for (int n = 0; n < 2; ++n) { const size_t off = ro + bj * 128 + n * 16; const u32x2 h2 = hb[ai][m][bj][n]; const f32x4 v = acc[ai][bj][m][n];
                        f32x4 o; o.x = v.x + ALPHA * bflo(h2.x); o.y = v.y + ALPHA * bfhi(h2.x); o.z = v.z + ALPHA * bflo(h2.y); o.w = v.w + ALPHA * bfhi(h2.y); *(f32x4*)(PRE + off) = o; } }
    }
};
__device__ __forceinline__ void phase5(const Params& p, LAS unsigned char* lds) {
    unsigned char* ws = p.ws;
    PolP5 P{(const bf16_t*)(ws + WS_YMIX), (const bf16_t*)(ws + WS_WT_OUT), (const bf16_t*)(ws + WS_H0B), p.out, (int)gridDim.x, (int)blockIdx.x};
    pg8::gemm_phase(lds, P, D);
}

constexpr int P6_TP = 1032;
constexpr int P6_TH = 0, P6_TL = 16 * P6_TP * 2, P6_PART = 2 * 16 * P6_TP * 2, P6_LC = P6_PART + 8 * 16 * 32 * 4, P6_BASE = P6_LC + 128, P6_ENT = P6_BASE + 128, P6_MAXENT = 2048;
__device__ __forceinline__ void phase6(const Params& p, LAS unsigned char* lds, int rep) {
    const int tid = threadIdx.x, lane = tid & 63, wave = tid >> 6, fr = lane & 15, fq = lane >> 4;
    unsigned char* ws = p.ws; unsigned* ctl = (unsigned*)(ws + WS_CTL);
    const bf16_t* WRH = (const bf16_t*)(ws + WS_WRT); const bf16_t* WRL = WRH + NE * D;
    LAS bf16_t* TH = (LAS bf16_t*)(lds + P6_TH); LAS bf16_t* TL = (LAS bf16_t*)(lds + P6_TL); LAS float* PART = (LAS float*)(lds + P6_PART);
    LAS int* LC = (LAS int*)(lds + P6_LC); LAS int* BASE = (LAS int*)(lds + P6_BASE); LAS int* ENT = (LAS int*)(lds + P6_ENT);
    int* LIST = (int*)(ws + WS_LIST); float* RG = (float*)(ws + WS_ROWGATE); int* SEL = (int*)(ws + WS_SEL);
    __syncthreads();
    if (tid < NE) LC[tid] = 0;
    __syncthreads();
    int it = 0;
    for (int tile = blockIdx.x; tile < T / 16; tile += gridDim.x, ++it) {
        const int t0 = tile * 16;
#pragma unroll
        for (int q = 0; q < 2; ++q) { const int tt = 2 * wave + q, t = t0 + tt;
            const f32x4* xr = (const f32x4*)(p.out + (size_t)t * D) + lane; f32x4 v[4];
#pragma unroll
            for (int j = 0; j < 4; ++j) v[j] = xr[64 * j];
            ln_row(v, p.in[18], p.in[19], lane);
            bf16_t* orow = (bf16_t*)(ws + WS_H1B) + (size_t)t * D;
#pragma unroll
            for (int j = 0; j < 4; ++j) { const unsigned h0 = f2bf(v[j].x), h1 = f2bf(v[j].y), h2 = f2bf(v[j].z), h3 = f2bf(v[j].w);
                u32x2 hi; hi.x = h0 | (h1 << 16); hi.y = h2 | (h3 << 16);
                u32x2 lo; lo.x = pk2(v[j].x - bf2f(h0), v[j].y - bf2f(h1)); lo.y = pk2(v[j].z - bf2f(h2), v[j].w - bf2f(h3));
                *(u32x2*)(orow + 4 * lane + 256 * j) = hi;
                *(LAS u32x2*)(TH + tt * P6_TP + 4 * lane + 256 * j) = hi; *(LAS u32x2*)(TL + tt * P6_TP + 4 * lane + 256 * j) = lo; } }
        __syncthreads();
        f32x4 acc0 = (f32x4){0.f, 0.f, 0.f, 0.f}, acc1 = acc0;
#pragma unroll
        for (int ks = 0; ks < 4; ++ks) { const int k0 = 128 * wave + 32 * ks + 8 * fq;
            const bf16x8 ah = *(const LAS bf16x8*)(TH + fr * P6_TP + k0), al = *(const LAS bf16x8*)(TL + fr * P6_TP + k0);
            const bf16x8 bh0 = *(const bf16x8*)(WRH + (size_t)fr * D + k0), bl0 = *(const bf16x8*)(WRL + (size_t)fr * D + k0);
            const bf16x8 bh1 = *(const bf16x8*)(WRH + (size_t)(16 + fr) * D + k0), bl1 = *(const bf16x8*)(WRL + (size_t)(16 + fr) * D + k0);
            acc0 = __builtin_amdgcn_mfma_f32_16x16x32_bf16(ah, bh0, acc0, 0, 0, 0); acc0 = __builtin_amdgcn_mfma_f32_16x16x32_bf16(ah, bl0, acc0, 0, 0, 0); acc0 = __builtin_amdgcn_mfma_f32_16x16x32_bf16(al, bh0, acc0, 0, 0, 0);
            acc1 = __builtin_amdgcn_mfma_f32_16x16x32_bf16(ah, bh1, acc1, 0, 0, 0); acc1 = __builtin_amdgcn_mfma_f32_16x16x32_bf16(ah, bl1, acc1, 0, 0, 0); acc1 = __builtin_amdgcn_mfma_f32_16x16x32_bf16(al, bh1, acc1, 0, 0, 0); }
#pragma unroll
        for (int r = 0; r < 4; ++r) { PART[(wave * 16 + 4 * fq + r) * 32 + fr] = acc0[r]; PART[(wave * 16 + 4 * fq + r) * 32 + 16 + fr] = acc1[r]; }
        __syncthreads();
        const int e = lane & 31, tt = 2 * wave + (lane >> 5), t = t0 + tt;
        float logit = p.in[21][e];
#pragma unroll
        for (int v = 0; v < 8; ++v) logit += PART[(v * 16 + tt) * 32 + e];
        float cur = logit; float tv0 = 0.f, tv1 = 0.f, tv2 = 0.f, tv3 = 0.f; int te0 = 0, te1 = 0, te2 = 0, te3 = 0;
#pragma unroll
        for (int k = 0; k < 4; ++k) { float bv = cur; int bi = e;
#pragma unroll
            for (int o = 1; o < 32; o <<= 1) { const float ov = __shfl_xor(bv, o); const int oi = __shfl_xor(bi, o); if (ov > bv || (ov == bv && oi < bi)) { bv = ov; bi = oi; } }
            if (k == 0) { tv0 = bv; te0 = bi; } if (k == 1) { tv1 = bv; te1 = bi; } if (k == 2) { tv2 = bv; te2 = bi; } if (k == 3) { tv3 = bv; te3 = bi; }
            if (e == bi) cur = -3.0e38f; }
        const float e1 = __expf(tv1 - tv0), e2 = __expf(tv2 - tv0), e3 = __expf(tv3 - tv0); const float inv = 1.f / (1.f + e1 + e2 + e3);
        if (e < 4) { int ee = te0; float gg = inv;
            if (e == 1) { ee = te1; gg = e1 * inv; } if (e == 2) { ee = te2; gg = e2 * inv; } if (e == 3) { ee = te3; gg = e3 * inv; }
            const int lr = __hip_atomic_fetch_add((int*)(LC + ee), 1, __ATOMIC_RELAXED, __HIP_MEMORY_SCOPE_WORKGROUP); const int n = (it * 16 + tt) * 4 + e;
            if (n < P6_MAXENT) { ENT[4 * n] = t * 4 + e; ENT[4 * n + 1] = ee; ENT[4 * n + 2] = lr; ENT[4 * n + 3] = __builtin_bit_cast(int, gg); } }
    }
    __syncthreads();
    if (tid < NE) BASE[tid] = (int)atomicAdd(ctl + CW_CNT + 32 * rep + tid, (unsigned)LC[tid]);
    __syncthreads();
    const int nent = it * 64 < P6_MAXENT ? it * 64 : P6_MAXENT;
    for (int n = tid; n < nent; n += NTHR) { const int tk = ENT[4 * n], ee = ENT[4 * n + 1], rank = BASE[ee] + ENT[4 * n + 2];
        LIST[(size_t)ee * T + rank] = tk >> 2; RG[(size_t)ee * T + rank] = __builtin_bit_cast(float, ENT[4 * n + 3]); SEL[(size_t)tk * 2] = ee; SEL[(size_t)tk * 2 + 1] = rank; }
}

__device__ __forceinline__ void build_expert_tables(const Params& p, LAS int* tab) {
    const unsigned* ctl = (const unsigned*)(p.ws + WS_CTL);
    __syncthreads();
    if (threadIdx.x < NE) tab[threadIdx.x] = (int)__hip_atomic_load(ctl + CW_CNT + CNT_SET + threadIdx.x, __ATOMIC_RELAXED, __HIP_MEMORY_SCOPE_AGENT);
    __syncthreads();
    if (threadIdx.x == 0) { int ps = 0, ts = 0;
        for (int e = 0; e < NE; ++e) { const int c = tab[e]; tab[32 + e] = ps; tab[64 + e] = ts; ps += (c + 255) / 256 * 256; ts += (c + 127) / 128; }
        tab[64 + NE] = ts; }
    __syncthreads();
}

constexpr int TAB_OFF = 131072, UTAB_OFF = 100, UTAB_MAX = 48;
constexpr int IDX_OFF = 131072 + 2048, IDX_UNITS = 20;
__device__ __forceinline__ void build_expert_tables256(const Params& p, LAS int* tab, int npn  ) {
    const unsigned* ctl = (const unsigned*)(p.ws + WS_CTL);
    __syncthreads();
    if (threadIdx.x < NE) tab[threadIdx.x] = (int)__hip_atomic_load(ctl + CW_CNT + CNT_SET + threadIdx.x, __ATOMIC_RELAXED, __HIP_MEMORY_SCOPE_AGENT);
    __syncthreads();
    if (threadIdx.x == 0) { int ps = 0, ts = 0;
        for (int e = 0; e < NE; ++e) { const int c = tab[e]; tab[32 + e] = ps; tab[64 + e] = ts; ps += (c + 255) / 256 * 256; ts += (c + 255) / 256; }
        tab[64 + NE] = ts;
        int e = 0, n = 0;
        if (gridDim.x == 256) { const int g = blockIdx.x & 7, sl = blockIdx.x >> 3, mpx = 32 / npn  , mround = 8 * mpx;
            for (int i = 0; n < UTAB_MAX; ++i) { const int mt_g = i * mround + g * mpx + sl / npn, pn = sl % npn; if (i * mround >= ts) break; if (mt_g >= ts) continue;
                while (e + 1 < NE && mt_g >= tab[64 + e + 1]) ++e;
                const int r0 = (mt_g - tab[64 + e]) * 256;
                tab[UTAB_OFF + 4 * n] = e; tab[UTAB_OFF + 4 * n + 1] = r0; tab[UTAB_OFF + 4 * n + 2] = pn; tab[UTAB_OFF + 4 * n + 3] = tab[32 + e] + r0; ++n; }
        } else { const int nun = ts * npn;
        for (int L = blockIdx.x; L < nun && n < UTAB_MAX; L += gridDim.x, ++n) { const int pn = L % npn, mt_g = L / npn;
            while (e + 1 < NE && mt_g >= tab[64 + e + 1]) ++e;
            const int r0 = (mt_g - tab[64 + e]) * 256;
            tab[UTAB_OFF + 4 * n] = e; tab[UTAB_OFF + 4 * n + 1] = r0; tab[UTAB_OFF + 4 * n + 2] = pn; tab[UTAB_OFF + 4 * n + 3] = tab[32 + e] + r0; } }
        tab[98] = n; }
    __syncthreads();
}
struct PolP7 {
    static constexpr bool PERM = true, GATHER = true;
    const bf16_t* H1B; const bf16_t* WG; const LAS int* IDX; bf16_t* ACT; const float* BGU; const LAS int* tab; int G, c;
    __device__ __forceinline__ bool next(int i, pg8::Unit& u) const { if (i >= __builtin_amdgcn_readfirstlane(tab[98])) return false;
        const int e = __builtin_amdgcn_readfirstlane(tab[UTAB_OFF + 4 * i]), r0 = __builtin_amdgcn_readfirstlane(tab[UTAB_OFF + 4 * i + 1]), pn = __builtin_amdgcn_readfirstlane(tab[UTAB_OFF + 4 * i + 2]);
        u.A = (const char*)H1B; u.B0 = (const char*)(WG + ((size_t)e * 2 * FF + pn * 128) * D); u.B1 = u.B0 + (size_t)FF * D * 2;
        u.x0 = e; u.x1 = i; u.x2 = pn; u.x3 = __builtin_amdgcn_readfirstlane(tab[UTAB_OFF + 4 * i + 3]); u.x4 = __builtin_amdgcn_readfirstlane(tab[e]) - r0; return true; }
    __device__ __forceinline__ void rows_issue(const pg8::Unit& u, int R0, unsigned (&raw)[2][2]) const { const LAS int* lst = IDX + u.x1 * 256 + R0;
#pragma unroll
        for (int h = 0; h < 2; ++h)
#pragma unroll
            for (int i = 0; i < 2; ++i) raw[h][i] = (unsigned)lst[h * 128 + i * 64]; }
    __device__ __forceinline__ void rows_finish(int C0, int K, unsigned (&raw)[2][2]) const {
#pragma unroll
        for (int h = 0; h < 2; ++h)
#pragma unroll
            for (int i = 0; i < 2; ++i) raw[h][i] = (raw[h][i] * (unsigned)K + (unsigned)C0) * 2u; }
    __device__ __forceinline__ void epi(const f32x4 (&acc)[2][2][4][2], const pg8::Unit& u, int wr, int wc, int fr, int fq) const {
        const int e = u.x0, f0 = u.x2 * 128 + wc * 32 + 8 * fq;
        const float* bias = BGU + (size_t)e * 2 * FF + f0;
        const f32x4 bg0 = *(const f32x4*)bias, bg1 = *(const f32x4*)(bias + 4), bu0 = *(const f32x4*)(bias + FF), bu1 = *(const f32x4*)(bias + FF + 4);
#pragma unroll
        for (int ai = 0; ai < 2; ++ai)
#pragma unroll
            for (int m = 0; m < 4; ++m) { const int r = ai * 128 + wr * 64 + m * 16 + fr;
                const f32x4 g0 = acc[ai][0][m][0] + bg0, g1 = acc[ai][0][m][1] + bg1, u0 = acc[ai][1][m][0] + bu0, u1 = acc[ai][1][m][1] + bu1;
                float a[8];
#pragma unroll
                for (int j = 0; j < 4; ++j) {
                    const float gc = fminf(g0[j], 7.f), uc = __builtin_amdgcn_fmed3f(u0[j], -7.f, 7.f);
                    a[j] = __builtin_fmaf(uc, gc, gc) * __builtin_amdgcn_rcpf(1.f + __builtin_amdgcn_exp2f(-2.4554669595930157f * gc));
                    const float gd = fminf(g1[j], 7.f), ud = __builtin_amdgcn_fmed3f(u1[j], -7.f, 7.f);
                    a[4 + j] = __builtin_fmaf(ud, gd, gd) * __builtin_amdgcn_rcpf(1.f + __builtin_amdgcn_exp2f(-2.4554669595930157f * gd)); }
                { u32x4 w; w.x = pg8::cvt_pk_bf16(a[0], a[1]); w.y = pg8::cvt_pk_bf16(a[2], a[3]); w.z = pg8::cvt_pk_bf16(a[4], a[5]); w.w = pg8::cvt_pk_bf16(a[6], a[7]);
                    *(u32x4*)(ACT + (size_t)(u.x3 + r) * FF + f0) = w; } }
    }
};
__device__ __forceinline__ void phase7(const Params& p, LAS unsigned char* lds) {
    LAS int* tab = (LAS int*)(lds + TAB_OFF); build_expert_tables256(p, tab, 8);
    unsigned char* ws = p.ws;
    LAS int* IDX = (LAS int*)(lds + IDX_OFF);
    { const int* LIST = (const int*)(ws + WS_LIST); const int nun = tab[98] < IDX_UNITS ? tab[98] : IDX_UNITS;
      for (int j = threadIdx.x; j < nun * 256; j += NTHR) { const int n = j >> 8, i = j & 255, e = tab[UTAB_OFF + 4 * n], r0 = tab[UTAB_OFF + 4 * n + 1], nval = tab[e] - r0;
          IDX[j] = LIST[(size_t)e * T + r0 + (i < nval ? i : 0)]; }
      __syncthreads(); }
    PolP7 P{(const bf16_t*)(ws + WS_H1B), (const bf16_t*)(ws + WS_WT_GU), IDX, (bf16_t*)(ws + WS_ACT), p.in[23], tab, (int)gridDim.x, (int)blockIdx.x};
    pg8::gemm_phase(lds, P, D);
}

struct PolP8 {
    static constexpr bool PERM = true, GATHER = false;
    const bf16_t* ACT; const bf16_t* WD; const float* RG; bf16_t* YR; const float* BD; const LAS int* tab; int G, c;
    __device__ __forceinline__ bool next(int i, pg8::Unit& u) const { if (i >= __builtin_amdgcn_readfirstlane(tab[98])) return false;
        const int e = __builtin_amdgcn_readfirstlane(tab[UTAB_OFF + 4 * i]), r0 = __builtin_amdgcn_readfirstlane(tab[UTAB_OFF + 4 * i + 1]), pn = __builtin_amdgcn_readfirstlane(tab[UTAB_OFF + 4 * i + 2]), prow0 = __builtin_amdgcn_readfirstlane(tab[UTAB_OFF + 4 * i + 3]);
        u.A = (const char*)(ACT + (size_t)prow0 * FF); u.B0 = (const char*)(WD + ((size_t)e * D + pn * 256) * FF); u.B1 = u.B0 + (size_t)128 * FF * 2;
        u.x4 = __builtin_amdgcn_readfirstlane(tab[e]) - r0;
        u.x0 = e; u.x1 = r0; u.x2 = pn; u.x3 = prow0; return true; }
    __device__ __forceinline__ void epi(const f32x4 (&acc)[2][2][4][2], const pg8::Unit& u, int wr, int wc, int fr, int fq) const {
        const int e = u.x0, nval = u.x4; const float* rg = RG + (size_t)e * T + u.x1;
        float gt[2][4];
#pragma unroll
        for (int ai = 0; ai < 2; ++ai)
#pragma unroll
            for (int m = 0; m < 4; ++m) { const int r = ai * 128 + wr * 64 + m * 16 + fr; gt[ai][m] = rg[r < nval ? r : 0]; }
        f32x4 bs[2][2];
#pragma unroll
        for (int bj = 0; bj < 2; ++bj) { const float* bias = BD + (size_t)e * D + u.x2 * 256 + bj * 128 + wc * 32 + 8 * fq; bs[bj][0] = *(const f32x4*)bias; bs[bj][1] = *(const f32x4*)(bias + 4); }
#pragma unroll
        for (int ai = 0; ai < 2; ++ai)
#pragma unroll
            for (int m = 0; m < 4; ++m) { const int r = ai * 128 + wr * 64 + m * 16 + fr; const float g = gt[ai][m];
#pragma unroll
                for (int bj = 0; bj < 2; ++bj) { const int col = u.x2 * 256 + bj * 128 + wc * 32 + 8 * fq;
                    const f32x4 v0 = (acc[ai][bj][m][0] + bs[bj][0]) * g, v1 = (acc[ai][bj][m][1] + bs[bj][1]) * g;
                    u32x4 w; w.x = pg8::cvt_pk_bf16(v0[0], v0[1]); w.y = pg8::cvt_pk_bf16(v0[2], v0[3]); w.z = pg8::cvt_pk_bf16(v1[0], v1[1]); w.w = pg8::cvt_pk_bf16(v1[2], v1[3]);
                    *(u32x4*)(YR + (size_t)(u.x3 + r) * D + col) = w; } }
    }
};
__device__ __forceinline__ void phase8(const Params& p, LAS unsigned char* lds) {
    LAS int* tab = (LAS int*)(lds + TAB_OFF); build_expert_tables256(p, tab, 4);
    unsigned char* ws = p.ws;
    PolP8 P{(const bf16_t*)(ws + WS_ACT), (const bf16_t*)(ws + WS_WT_DN), (const float*)(ws + WS_ROWGATE), (bf16_t*)(ws + WS_YROWS), p.in[25], tab, (int)gridDim.x, (int)blockIdx.x};
    pg8::gemm_phase(lds, P, FF);
}

__device__ __forceinline__ void phase9(const Params& p, LAS unsigned char* lds) {
    LAS int* tab = (LAS int*)lds; build_expert_tables(p, tab);
    const int tid = threadIdx.x, lane = tid & 63, wave = tid >> 6;
    const int gw = blockIdx.x * NWAVES + wave, NGW = gridDim.x * NWAVES;
    unsigned char* ws = p.ws; const bf16_t* H1B = (const bf16_t*)(ws + WS_H1B); const bf16_t* YR = (const bf16_t*)(ws + WS_YROWS); const int* SEL = (const int*)(ws + WS_SEL);
    typedef int i32x4 __attribute__((ext_vector_type(4)));
    i32x4 sa = {0, 0, 0, 0}, sb = sa;
    if (gw < T) { sa = *(const i32x4*)(SEL + (size_t)gw * 8); sb = *(const i32x4*)(SEL + (size_t)gw * 8 + 4); }
    for (int t = gw; t < T; t += NGW) {
        const i32x4 ca = sa, cb = sb;
        if (t + NGW < T) { sa = *(const i32x4*)(SEL + (size_t)(t + NGW) * 8); sb = *(const i32x4*)(SEL + (size_t)(t + NGW) * 8 + 4); }
        const bf16_t* y0 = YR + (size_t)(tab[32 + ca.x] + ca.y) * D + 4 * lane; const bf16_t* y1 = YR + (size_t)(tab[32 + ca.z] + ca.w) * D + 4 * lane;
        const bf16_t* y2 = YR + (size_t)(tab[32 + cb.x] + cb.y) * D + 4 * lane; const bf16_t* y3 = YR + (size_t)(tab[32 + cb.z] + cb.w) * D + 4 * lane;
        const bf16_t* hr = H1B + (size_t)t * D + 4 * lane;
        u32x2 hb[4], q0[4], q1[4], q2[4], q3[4];
#pragma unroll
        for (int j = 0; j < 4; ++j) { hb[j] = *(const u32x2*)(hr + 256 * j); q0[j] = *(const u32x2*)(y0 + 256 * j); q1[j] = *(const u32x2*)(y1 + 256 * j); q2[j] = *(const u32x2*)(y2 + 256 * j); q3[j] = *(const u32x2*)(y3 + 256 * j); }
        f32x4 v[4];
#pragma unroll
        for (int j = 0; j < 4; ++j) {
            v[j].x = ALPHA * bflo(hb[j].x) + ((bflo(q0[j].x) + bflo(q1[j].x)) + (bflo(q2[j].x) + bflo(q3[j].x)));
            v[j].y = ALPHA * bfhi(hb[j].x) + ((bfhi(q0[j].x) + bfhi(q1[j].x)) + (bfhi(q2[j].x) + bfhi(q3[j].x)));
            v[j].z = ALPHA * bflo(hb[j].y) + ((bflo(q0[j].y) + bflo(q1[j].y)) + (bflo(q2[j].y) + bflo(q3[j].y)));
            v[j].w = ALPHA * bfhi(hb[j].y) + ((bfhi(q0[j].y) + bfhi(q1[j].y)) + (bfhi(q2[j].y) + bfhi(q3[j].y))); }
        ln_row(v, p.in[26], p.in[27], lane);
        f32x4* orow = (f32x4*)(p.out + (size_t)t * D) + lane;
#pragma unroll
        for (int j = 0; j < 4; ++j) orow[64 * j] = v[j];
    }
}

#define XB_TMO      128
#define XB_XCNT(j)  (256  + 64 * (j))
#define XB_XSUB(j)  (1280 + 64 * (j))
#define XB_XGEN(j)  (2304 + 64 * (j))
#define XB_TOP      3328
#define XB_TOPGEN   3392
#define XCD_BAR_WORDS 3456
#define XB_SPIN_CAP (1u << 22)
__device__ __forceinline__ unsigned xb_ld(unsigned* p)              { return __hip_atomic_load(p, __ATOMIC_RELAXED, __HIP_MEMORY_SCOPE_AGENT); }
__device__ __forceinline__ unsigned xb_add(unsigned* p, unsigned v) { return __hip_atomic_fetch_add(p, v, __ATOMIC_RELAXED, __HIP_MEMORY_SCOPE_AGENT); }
__device__ __forceinline__ unsigned xb_xcc_id() { return (unsigned)__builtin_amdgcn_s_getreg((3 << 11) | 20) & 0xFu; }
#define XB_SPIN(cond, bar) do { unsigned _sp = 0; while (cond) { __builtin_amdgcn_s_sleep(1); \
    if ((++_sp & 255u) == 0u) { if (xb_ld(&(bar)[XB_TMO])) break; if (_sp > XB_SPIN_CAP) { atomicAdd(&(bar)[XB_TMO], 1u); break; } } } } while (0)
struct XcdBarrier { unsigned* bar; unsigned x; volatile LAS unsigned* st; };
__device__ __forceinline__ XcdBarrier xcd_barrier_post(unsigned* bar, volatile LAS unsigned* st) {
    XcdBarrier b; b.bar = bar; b.x = xb_xcc_id(); b.st = st;
    if (threadIdx.x == 0) (void)xb_add(&bar[XB_XCNT(b.x)], 1u);
    return b;
}
__device__ __forceinline__ void xcd_barrier_complete(unsigned* bar, unsigned x, unsigned& nloc, unsigned& nx) {
    const unsigned G = gridDim.x * gridDim.y * gridDim.z;
    unsigned sum, cnt, mine, sp = 0u;
    for (;;) {
        sum = 0u; cnt = 0u; mine = 0u;
#pragma unroll
        for (unsigned j = 0; j < 16; ++j) { const unsigned c = xb_ld(&bar[XB_XCNT(j)]); sum += c; cnt += (c > 0u) ? 1u : 0u; mine = (j == x) ? c : mine; }
        if (sum == G) break;
        __builtin_amdgcn_s_sleep(1);
        if ((++sp & 255u) == 0u) { if (xb_ld(&bar[XB_TMO])) break; if (sp > XB_SPIN_CAP) { atomicAdd(&bar[XB_TMO], 1u); break; } }
    }
    nloc = mine > 0u ? mine : 1u; nx = cnt > 0u ? cnt : 1u;
}
__device__ __forceinline__ void xcd_barrier(const XcdBarrier& b) {
    asm volatile("s_waitcnt vmcnt(0)" ::: "memory");
    __syncthreads();
    if (threadIdx.x == 0) {
        unsigned* bar = b.bar;
        __builtin_amdgcn_s_waitcnt(0);
        unsigned nloc = b.st[0], nx = b.st[1];
        if (nloc == 0u) { xcd_barrier_complete(bar, b.x, nloc, nx); b.st[0] = nloc; b.st[1] = nx; }
        const unsigned old = xb_add(&bar[XB_XSUB(b.x)], 1u);
        const unsigned gen = old / nloc;
        if (old + 1u == (gen + 1u) * nloc) {
            __builtin_amdgcn_fence(__ATOMIC_RELEASE, "agent");
            asm volatile("s_waitcnt vmcnt(0)" ::: "memory");
            const unsigned og = xb_add(&bar[XB_TOP], 1u);
            const unsigned tg = og / nx;
            if (og + 1u == (tg + 1u) * nx) xb_add(&bar[XB_TOPGEN], 1u);
            else XB_SPIN(xb_ld(&bar[XB_TOPGEN]) == tg, bar);
            __builtin_amdgcn_fence(__ATOMIC_ACQUIRE, "agent");
            xb_add(&bar[XB_XGEN(b.x)], 1u);
            asm volatile("s_waitcnt vmcnt(0)" ::: "memory");
        } else {
            XB_SPIN(xb_ld(&bar[XB_XGEN(b.x)]) == gen, bar);
            __builtin_amdgcn_fence(__ATOMIC_ACQUIRE, "agent");
            asm volatile("s_waitcnt vmcnt(0)" ::: "memory");
        }
    }
    __syncthreads();
}

constexpr int NPHASE = 10;
constexpr int LDS_BYTES = 131072 + 2048 + IDX_UNITS * 1024;
__global__ void __launch_bounds__(NTHR, 2) mk_fwd(Params p) {
    extern __shared__ __attribute__((aligned(16))) unsigned char lds_raw[];
    LAS unsigned char* lds = (LAS unsigned char*)lds_raw;
    const int lo = p.ph_lo, hi = p.ph_hi;
    volatile LAS unsigned* barst = (volatile LAS unsigned*)(lds + BARST_OFF);
    if (threadIdx.x < 2) barst[threadIdx.x] = 0u;
    __syncthreads();
    const XcdBarrier xbar = xcd_barrier_post((unsigned*)(p.ws + WS_CTL) + CW_BAR, barst);
#ifdef ONLY_PHASE
#define IN(k) ((k) == ONLY_PHASE && lo <= (k) && (k) < hi)
#else
#define IN(k) (lo <= (k) && (k) < hi)
#endif
#define SEAM(k) do { if (IN(k) && IN((k) + 1)) { if ((k) == 0) cg::this_grid().sync(); else xcd_barrier(xbar); } } while (0)
#define RUN(k, call) do { if (IN(k)) { call; if (REPEAT_PHASE == (k)) { cg::this_grid().sync(); call; } } } while (0)
    { int rep = 0;
    RUN(0, phase0(p, lds));
    SEAM(0);
    RUN(1, phase1(p, lds));
    SEAM(1);
    RUN(2, phase2(p, lds));
    SEAM(2);
    if (IN(3)) { const int nrep = (REPEAT_PHASE == 3) ? 2 : 1;
#pragma unroll 1
        for (rep = 0; rep < nrep; ++rep) { if (rep) cg::this_grid().sync(); phase3(p, lds, rep); } }
    SEAM(3);
    RUN(4, phase4(p));
    SEAM(4);
    RUN(5, phase5(p, lds));
    SEAM(5);
    rep = 0; RUN(6, (phase6(p, lds, rep), ++rep));
    SEAM(6);
    RUN(7, phase7(p, lds));
    SEAM(7);
    RUN(8, phase8(p, lds));
    SEAM(8);
    RUN(9, phase9(p, lds));
    }
#undef RUN
#undef IN
#undef SEAM
}

extern "C" void kernel_launch(void* const* d_in, const int* in_sizes, int n_in, void* d_out, int out_size, void* d_ws, size_t ws_size, hipStream_t stream) {
    static int grid = 0;
    if (grid == 0) {
        if (n_in != 28 || out_size != T * D || ws_size < WS_END) { fprintf(stderr, "kernel_launch: unexpected shapes: n_in %d out %d ws %zu (need %zu)\n", n_in, out_size, ws_size, (size_t)WS_END); grid = -1; return; }
        int dev = 0, cus = 0, per_cu = 0;
        hipGetDevice(&dev); hipDeviceGetAttribute(&cus, hipDeviceAttributeMultiprocessorCount, dev);
        hipFuncSetAttribute((const void*)mk_fwd, hipFuncAttributeMaxDynamicSharedMemorySize, LDS_BYTES);
        hipOccupancyMaxActiveBlocksPerMultiprocessor(&per_cu, (const void*)mk_fwd, NTHR, LDS_BYTES);
        (void)hipGetLastError();
        if (per_cu < 1) { fprintf(stderr, "kernel_launch: occupancy query says %d blocks per CU\n", per_cu); per_cu = 1; }
        grid = cus;
    }
    if (grid < 0) return;
    hipMemsetAsync((char*)d_ws + WS_CTL, 0, CTL_ZERO_BYTES, stream);
    Params p{};
    for (int i = 0; i < 28; ++i) p.in[i] = (const float*)d_in[i];
    p.out = (float*)d_out; p.ws = (unsigned char*)d_ws;
#if MK_ONE_LAUNCH
    p.ph_lo = 0; p.ph_hi = NPHASE;
    void* args[] = {&p};
    hipError_t e = hipLaunchCooperativeKernel((const void*)mk_fwd, dim3(grid), dim3(NTHR), args, LDS_BYTES, stream);
    if (e != hipSuccess) fprintf(stderr, "cooperative launch failed: %s (grid %d)\n", hipGetErrorString(e), grid);
#else
    for (int ph = 0; ph < NPHASE; ++ph) { p.ph_lo = ph; p.ph_hi = ph + 1; hipLaunchKernelGGL(mk_fwd, dim3(grid), dim3(NTHR), LDS_BYTES, stream, p); }
#endif
}
```

```cpp
#include <hip/hip_runtime.h>
#include <hip/hip_cooperative_groups.h>
#include <cstdio>
#include <cstdint>
namespace cg = cooperative_groups;

#ifndef REPEAT_PHASE
#define REPEAT_PHASE -1
#endif
#ifndef PROBE_TS
#define PROBE_TS -1
#endif
#ifndef PROBE_GEMM
#define PROBE_GEMM -1
#endif
#ifndef PROBE_PART
#define PROBE_PART 0
#endif
#ifndef MK_ONE_LAUNCH
#define MK_ONE_LAUNCH 1
#endif

typedef unsigned short bf16_t;
typedef short bf16x8 __attribute__((ext_vector_type(8)));
typedef short bf16x4 __attribute__((ext_vector_type(4)));
typedef float f32x4 __attribute__((ext_vector_type(4)));
typedef float f32x2 __attribute__((ext_vector_type(2)));
typedef unsigned u32x4 __attribute__((ext_vector_type(4)));
typedef unsigned u32x2 __attribute__((ext_vector_type(2)));

constexpr int D = 1024, BATCH = 16, SEQ = 2048, T = BATCH * SEQ;
constexpr int NMEM = 256, HD = 64;
constexpr int RH = 6, RC = 384;
constexpr int RWKV_IN = 1344;
constexpr int AH = 6, AW = 384, MH = 4, MW = 256;
constexpr int IN_W = 2752, IN_WP = 2816;
constexpr int PA_W = IN_WP - RWKV_IN;
constexpr int NE = 32, TOPK = 4, FF = 1024;
constexpr float LN_EPS = 1e-5f, GN_EPS = 64e-5f;
constexpr float ALPHA = 1.189207115002721f;
constexpr int NTHR = 512, NWAVES = 8;

constexpr size_t MiB = 1u << 20;
constexpr size_t WS_CTL = 0;
constexpr size_t WS_WT_IN = 1 * MiB;
constexpr size_t WS_LORA = 6 * MiB + 512 * 1024;
constexpr size_t WS_WT_OUT = 7 * MiB;
constexpr size_t WS_WT_KV = 9 * MiB;
constexpr size_t WS_KVM = 10 * MiB;
constexpr size_t WS_MEMB = 14 * MiB;
constexpr size_t WS_LIST = 22 * MiB;
constexpr size_t WS_ROWGATE = 26 * MiB;
constexpr size_t WS_SEL = 30 * MiB;
constexpr size_t WS_BONUS = 31 * MiB;
constexpr size_t WS_WRT = 31 * MiB + 800 * 1024;
constexpr size_t WS_WT_GU = 32 * MiB;
constexpr size_t WS_WT_DN = 160 * MiB;
constexpr size_t WS_H0B = 224 * MiB;
constexpr size_t WS_H1B = 288 * MiB;
constexpr size_t WS_YMIX = 352 * MiB;
constexpr size_t WS_PR = 416 * MiB;
constexpr size_t WS_ATTO = 416 * MiB;
constexpr size_t WS_PA = 500 * MiB;
constexpr size_t WS_SSH = 592 * MiB;
constexpr size_t WS_SDIR = 736 * MiB;
constexpr size_t WS_ACT = 352 * MiB;
constexpr size_t WS_YROWS = 624 * MiB;
constexpr size_t WS_END = 1024 * MiB;
constexpr size_t DO_Y = 0, DO_G = 96 * MiB, DO_LSE = 120 * MiB;
constexpr int ROWS_PAD = T * TOPK + NE * 256;

constexpr int CW_CNT = 0;
constexpr int CNT_SET = (REPEAT_PHASE == 6) ? 32 : 0;
constexpr int CW_ATTQ = 64;
constexpr int CW_SCANQ = 128;
constexpr int CW_BAR = 4096;
constexpr int CTL_ZERO_BYTES = 65536;
constexpr int BARST_OFF = 131072 + 1536;

#define LAS __attribute__((address_space(3)))

struct Params { const float* in[28]; float* out; unsigned char* ws; int ph_lo, ph_hi; };

__device__ __forceinline__ unsigned f2bf(float f) { unsigned u = __builtin_bit_cast(unsigned, f); return (u + 0x7fffu + ((u >> 16) & 1u)) >> 16; }
__device__ __forceinline__ unsigned pk2(float lo, float hi) { return f2bf(lo) | (f2bf(hi) << 16); }
__device__ __forceinline__ float bf2f(unsigned b) { return __builtin_bit_cast(float, b << 16); }
__device__ __forceinline__ float bflo(unsigned w) { return __builtin_bit_cast(float, w << 16); }
__device__ __forceinline__ float bfhi(unsigned w) { return __builtin_bit_cast(float, w & 0xffff0000u); }
template <int CTRL> __device__ __forceinline__ float dpp_mov(float v) {
    return __builtin_bit_cast(float, __builtin_amdgcn_update_dpp(0, __builtin_bit_cast(int, v), CTRL, 0xF, 0xF, true));
}
__device__ __forceinline__ float sum16(float v) {
    v += dpp_mov<0xB1>(v);
    v += dpp_mov<0x4E>(v);
    v += dpp_mov<0x141>(v);
    v += dpp_mov<0x140>(v);
    return v;
}
__device__ __forceinline__ float wave_sum(float v) {
    v = sum16(v);
    const int iv = __builtin_bit_cast(int, v);
    const float a = __builtin_bit_cast(float, __builtin_amdgcn_readlane(iv, 0)), b = __builtin_bit_cast(float, __builtin_amdgcn_readlane(iv, 16));
    const float c = __builtin_bit_cast(float, __builtin_amdgcn_readlane(iv, 32)), d = __builtin_bit_cast(float, __builtin_amdgcn_readlane(iv, 48));
    return (a + b) + (c + d);
}
__device__ __forceinline__ float sigmoidf_(float x) { return 1.f / (1.f + __expf(-x)); }

struct P0Item { const float* W; bf16_t* WT; int K, N, item; };
__device__ __forceinline__ void p0_item_load(const P0Item& I, float (&reg)[32], int lane) {
    const int nblk = I.N / 32, kb = I.item / nblk, nb = I.item % nblk, k0 = 64 * kb, n0 = 32 * nb;
    const float* src = I.W + (size_t)(k0 + (lane >> 5)) * I.N + n0 + (lane & 31);
#pragma unroll
    for (int i = 0; i < 32; ++i) reg[i] = src[(size_t)(2 * i) * I.N];
}
__device__ __forceinline__ void p0_item_store(const P0Item& I, const float (&reg)[32], LAS float* scr, int lane) {
    const int nblk = I.N / 32, kb = I.item / nblk, nb = I.item % nblk, k0 = 64 * kb, n0 = 32 * nb;
#pragma unroll
    for (int i = 0; i < 32; ++i) scr[(2 * i + (lane >> 5)) * 33 + (lane & 31)] = reg[i];
    asm volatile("s_waitcnt lgkmcnt(0)" ::: "memory");
    const int c = lane & 7;
#pragma unroll
    for (int j = 0; j < 4; ++j) { const int n = (lane >> 3) + 8 * j; const LAS float* s = scr + (8 * c) * 33 + n;
        u32x4 o; o.x = pk2(s[0 * 33], s[1 * 33]); o.y = pk2(s[2 * 33], s[3 * 33]); o.z = pk2(s[4 * 33], s[5 * 33]); o.w = pk2(s[6 * 33], s[7 * 33]);
        *(u32x4*)(I.WT + (size_t)(n0 + n) * I.K + k0 + 8 * c) = o; }
    asm volatile("s_waitcnt lgkmcnt(0)" ::: "memory");
}
__device__ __forceinline__ void ln_row(f32x4 (&v)[4], const float* __restrict__ g, const float* __restrict__ b, int lane) {
    float s = 0.f;
#pragma unroll
    for (int j = 0; j < 4; ++j) s += (v[j].x + v[j].y) + (v[j].z + v[j].w);
    const float mean = wave_sum(s) * (1.f / D); float s2 = 0.f;
#pragma unroll
    for (int j = 0; j < 4; ++j) { v[j] = v[j] - mean; s2 += (v[j].x * v[j].x + v[j].y * v[j].y) + (v[j].z * v[j].z + v[j].w * v[j].w); }
    const float rstd = 1.f / sqrtf(wave_sum(s2) * (1.f / D) + LN_EPS);
#pragma unroll
    for (int j = 0; j < 4; ++j) { const f32x4 gg = *(const f32x4*)(g + 4 * lane + 256 * j), bb = *(const f32x4*)(b + 4 * lane + 256 * j); v[j] = v[j] * rstd * gg + bb; }
}
__device__ __forceinline__ void store_row_bf16(bf16_t* orow, const f32x4 (&v)[4], int lane) {
#pragma unroll
    for (int j = 0; j < 4; ++j) { u32x2 o; o.x = pk2(v[j].x, v[j].y); o.y = pk2(v[j].z, v[j].w); *(u32x2*)(orow + 4 * lane + 256 * j) = o; }
}

__device__ __forceinline__ void phase0(const Params& p, LAS unsigned char* lds) {
    const int tid = threadIdx.x, lane = tid & 63, wave = tid >> 6;
    const int gw = blockIdx.x * NWAVES + wave, NGW = gridDim.x * NWAVES;
    LAS float* scr = (LAS float*)(lds + wave * 16384);
    unsigned char* ws = p.ws;
    constexpr int I_IN = 16 * (IN_W / 32), I_OUT = 16 * 32, I_KV = 16 * 16, I_GU = 16 * 64, I_DN = 16 * 32;
    constexpr int NITEMS = I_IN + I_OUT + I_KV + NE * I_GU + NE * I_DN;
    auto mk = [&](int it) { P0Item I; int r = it;
        if (r < I_IN) { I.W = p.in[4]; I.WT = (bf16_t*)(ws + WS_WT_IN); I.K = D; I.N = IN_W; I.item = r; return I; } r -= I_IN;
        if (r < I_OUT) { I.W = p.in[17]; I.WT = (bf16_t*)(ws + WS_WT_OUT); I.K = D; I.N = D; I.item = r; return I; } r -= I_OUT;
        if (r < I_KV) { I.W = p.in[16]; I.WT = (bf16_t*)(ws + WS_WT_KV); I.K = D; I.N = 2 * MW; I.item = r; return I; } r -= I_KV;
        if (r < NE * I_GU) { const int e = r / I_GU; I.W = p.in[22] + (size_t)e * D * 2 * FF; I.WT = (bf16_t*)(ws + WS_WT_GU) + (size_t)e * 2 * FF * D; I.K = D; I.N = 2 * FF; I.item = r % I_GU; return I; } r -= NE * I_GU;
        { const int e = r / I_DN; I.W = p.in[24] + (size_t)e * FF * D; I.WT = (bf16_t*)(ws + WS_WT_DN) + (size_t)e * D * FF; I.K = FF; I.N = D; I.item = r % I_DN; return I; } };
    { float ra[32], rb[32]; int it = gw;
      if (it < NITEMS) { const P0Item I0 = mk(it); p0_item_load(I0, ra, lane); }
      for (; it < NITEMS; it += 2 * NGW) {
          const P0Item Ia = mk(it); const bool hb = it + NGW < NITEMS; P0Item Ib = Ia;
          if (hb) { Ib = mk(it + NGW); p0_item_load(Ib, rb, lane); }
          p0_item_store(Ia, ra, scr, lane);
          if (it + 2 * NGW < NITEMS) { const P0Item Ic = mk(it + 2 * NGW); p0_item_load(Ic, ra, lane); }
          if (hb) p0_item_store(Ib, rb, scr, lane);
      } }
    { u32x4* z = (u32x4*)((bf16_t*)(ws + WS_WT_IN) + (size_t)IN_W * D); const int n16 = (IN_WP - IN_W) * D * 2 / 16;
      for (int i = blockIdx.x * NTHR + tid; i < n16; i += gridDim.x * NTHR) z[i] = (u32x4){0u, 0u, 0u, 0u}; }
    { const float* wr = p.in[20]; bf16_t* wh = (bf16_t*)(ws + WS_WRT); bf16_t* wl = wh + NE * D;
      for (int i = blockIdx.x * NTHR + tid; i < NE * D; i += gridDim.x * NTHR) { const int e = i / D, k = i % D; const float w = wr[k * NE + e]; const unsigned h = f2bf(w); wh[i] = (bf16_t)h; wl[i] = (bf16_t)f2bf(w - bf2f(h)); } }
    { bf16_t* wu = (bf16_t*)(ws + WS_LORA); bf16_t* au = wu + 2 * RC * 32; bf16_t* gu = au + 2 * RC * 32;
      for (int i = blockIdx.x * NTHR + tid; i < 2 * RC * 32; i += gridDim.x * NTHR) { const int dch = i >> 5, j = i & 31, d = dch / RC, ch = dch % RC; wu[i] = (bf16_t)f2bf(p.in[7][(size_t)(d * 32 + j) * RC + ch]); au[i] = (bf16_t)f2bf(p.in[9][(size_t)(d * 32 + j) * RC + ch]); }
      for (int i = blockIdx.x * NTHR + tid; i < RC * 64; i += gridDim.x * NTHR) { const int ch = i >> 6, j = i & 63; gu[i] = (bf16_t)f2bf(p.in[10][(size_t)j * RC + ch]); } }
    for (int m = gw; m < T; m += NGW) {
        const f32x4* xr = (const f32x4*)(p.in[0] + (size_t)m * D) + lane; f32x4 v[4];
#pragma unroll
        for (int j = 0; j < 4; ++j) v[j] = xr[64 * j];
        ln_row(v, p.in[2], p.in[3], lane);
        store_row_bf16((bf16_t*)(ws + WS_H0B) + (size_t)m * D, v, lane);
    }
    for (int m = gw; m < BATCH * NMEM; m += NGW) {
        const f32x4* xr = (const f32x4*)(p.in[1] + (size_t)m * D) + lane; f32x4 v[4];
#pragma unroll
        for (int j = 0; j < 4; ++j) v[j] = xr[64 * j];
        store_row_bf16((bf16_t*)(ws + WS_MEMB) + (size_t)m * D, v, lane);
    }
}

template <class ARow, class BRow, class Epi>
__device__ __forceinline__ void sgemm_tile(int K, ARow arow, BRow brow, Epi epi) {
    const int tid = threadIdx.x, wid = tid >> 6, lane = tid & 63, wm = wid >> 1, wn = wid & 1, fr = lane & 15, fq = lane >> 4;
    f32x4 acc[2][4];
#pragma unroll
    for (int m = 0; m < 2; ++m)
#pragma unroll
        for (int n = 0; n < 4; ++n) acc[m][n] = (f32x4){0.f, 0.f, 0.f, 0.f};
    const bf16_t* ap[2]; const bf16_t* bp[4];
#pragma unroll
    for (int m = 0; m < 2; ++m) ap[m] = arow(wm * 32 + m * 16 + fr) + fq * 8;
#pragma unroll
    for (int n = 0; n < 4; ++n) bp[n] = brow(wn * 64 + n * 16 + fr) + fq * 8;
    for (int k = 0; k < K; k += 32) {
        bf16x8 a[2], b[4];
#pragma unroll
        for (int m = 0; m < 2; ++m) a[m] = *(const bf16x8*)(ap[m] + k);
#pragma unroll
        for (int n = 0; n < 4; ++n) b[n] = *(const bf16x8*)(bp[n] + k);
#pragma unroll
        for (int m = 0; m < 2; ++m)
#pragma unroll
            for (int n = 0; n < 4; ++n) acc[m][n] = __builtin_amdgcn_mfma_f32_16x16x32_bf16(b[n], a[m], acc[m][n], 0, 0, 0);
    }
#pragma unroll
    for (int m = 0; m < 2; ++m)
#pragma unroll
        for (int n = 0; n < 4; ++n) epi(wm * 32 + m * 16 + fr, wn * 64 + n * 16 + 4 * fq, acc[m][n], n);
}


namespace pg8 {
constexpr int BM = 256, BK = 64, HALF = 128, HTB = HALF * BK * 2, STAGE_BYTES = 8 * HTB, NXCD = 8, WGM = 8;
__host__ __device__ __forceinline__ int lds_byte(int r, int c) { const int st = (r >> 4) * 2 + (c >> 5), rr = r & 15, cc = c & 31, ob = rr * 64 + cc * 2; return st * 1024 + (ob ^ (((ob >> 9) & 1) << 5)); }
__host__ __device__ __forceinline__ void stage_rc(int b, int& R, int& C) { const int st = b / 1024, sb = b % 1024, swz = sb ^ (((sb >> 9) & 1) << 5); R = (st >> 1) * 16 + swz / 64; C = (st & 1) * 32 + (swz % 64) / 2; }
__host__ __device__ __forceinline__ int perm32(int rho) { const int n = rho >> 4, i = rho & 15; return 8 * (i >> 2) + 4 * n + (i & 3); }
struct Unit { const char* A; const char* B0; const char* B1; int x0, x1, x2, x3, x4; };
__device__ __forceinline__ unsigned cvt_pk_bf16(float lo, float hi) { unsigned r; asm volatile("v_cvt_pk_bf16_f32 %0, %1, %2" : "=v"(r) : "v"(lo), "v"(hi)); return r; }

__device__ __forceinline__ const char* uni_ptr(const char* p) { const unsigned long long v = (unsigned long long)p; const unsigned lo = __builtin_amdgcn_readfirstlane((unsigned)v), hi = __builtin_amdgcn_readfirstlane((unsigned)(v >> 32)); return (const char*)(((unsigned long long)hi << 32) | lo); }
__device__ __forceinline__ bool static_order(int nM, int nN, int G, int c, int i, int& pm, int& pn) {
    const int nwg = nM * nN; const long L = (long)i * G + c; if (L >= nwg) return false;
    int wgid = (int)L; { const int q = nwg / NXCD, r = nwg % NXCD, xcd = wgid % NXCD, off = wgid / NXCD; wgid = (xcd < r ? xcd * (q + 1) : r * (q + 1) + (xcd - r) * q) + off; }
    const int nig = WGM * nN, gid = wgid / nig, fm = gid * WGM, gsz = (nM - fm) < WGM ? (nM - fm) : WGM;
    pm = fm + ((wgid % nig) % gsz); pn = (wgid % nig) / gsz; return true;
}

template <class Pol>
__device__ __forceinline__ void gemm_phase(LAS unsigned char* lds, const Pol& P, const int K, unsigned long long* stat = nullptr) {
    unsigned long long tK = 0, tE = 0, tmark = 0, tstart = stat ? __builtin_amdgcn_s_memrealtime() : 0;
    const int tid = threadIdx.x, wid = __builtin_amdgcn_readfirstlane(tid >> 6), lane = tid & 63, wr = wid >> 2, wc = wid & 3, fr = lane & 15, fq = lane >> 4;
    const int nt = K / BK;
    int R0, C0; stage_rc(tid * 16, R0, C0);
    const int Rb0 = Pol::PERM ? ((R0 & ~31) + perm32(R0 & 31)) : R0;
    const unsigned vB = (unsigned)(Rb0 * K + C0) * 2u;
    const size_t pstep = (size_t)64 * K * 2;
    const size_t kstep = (size_t)(BK * 2);
    const unsigned ldsw = (unsigned)wid * 1024u;
    const int aoff = lds_byte(wr * 64 + fr, fq * 8), boff = lds_byte(wc * 32 + fr, fq * 8);
#define PG8_SA(b, h) (((b) * 2 + (h)) * HTB)
#define PG8_SB(b, h) ((4 + (b) * 2 + (h)) * HTB)
#define PG8_STAGE_B(bufoff, gbase) do { _Pragma("unroll") for (int _i = 0; _i < 2; ++_i) \
        __builtin_amdgcn_global_load_lds((const unsigned*)(uni_ptr((const char*)(gbase) + _i * pstep) + vB), (LAS unsigned*)(lds + (bufoff) + ldsw + _i * 8192), 16, 0, 0); } while (0)
#define PG8_STAGE_A(bufoff, gbase, vo, h) do { _Pragma("unroll") for (int _i = 0; _i < 2; ++_i) { \
        if constexpr (Pol::GATHER) __builtin_amdgcn_global_load_lds((const unsigned*)(uni_ptr((const char*)(gbase)) + (vo)[h][_i]), (LAS unsigned*)(lds + (bufoff) + ldsw + _i * 8192), 16, 0, 0); \
        else __builtin_amdgcn_global_load_lds((const unsigned*)(uni_ptr((const char*)(gbase) + ((h) * 2 + _i) * pstep) + (vo)[0][0]), (LAS unsigned*)(lds + (bufoff) + ldsw + _i * 8192), 16, 0, 0); } } while (0)
#define PG8_LDA(dst, b, h) do { _Pragma("unroll") for (int m = 0; m < 4; ++m) _Pragma("unroll") for (int k = 0; k < 2; ++k) dst[m][k] = *(const LAS bf16x8*)(lds + PG8_SA(b, h) + aoff + m * 2048 + k * 1024); } while (0)
#define PG8_LDB(dst, b, h) do { _Pragma("unroll") for (int n = 0; n < 2; ++n) _Pragma("unroll") for (int k = 0; k < 2; ++k) dst[n][k] = *(const LAS bf16x8*)(lds + PG8_SB(b, h) + boff + n * 2048 + k * 1024); } while (0)
#define PG8_MMA(ai, bj, At, Bt) do { __builtin_amdgcn_s_setprio(1); _Pragma("unroll") for (int m = 0; m < 4; ++m) _Pragma("unroll") for (int n = 0; n < 2; ++n) _Pragma("unroll") for (int k = 0; k < 2; ++k) \
        acc[ai][bj][m][n] = __builtin_amdgcn_mfma_f32_16x16x32_bf16(Bt[n][k], At[m][k], acc[ai][bj][m][n], 0, 0, 0); __builtin_amdgcn_s_setprio(0); } while (0)
#define PG8_WAIT_V(n) asm volatile("s_waitcnt vmcnt(" #n ")" ::: "memory")
#define PG8_WAIT_L(n) asm volatile("s_waitcnt lgkmcnt(" #n ")" ::: "memory")
#define PG8_BAR __builtin_amdgcn_s_barrier()
#define PG8_SCHED __builtin_amdgcn_sched_barrier(0)
    Unit cur, nxt; int ui = 0;
    if (!P.next(0, cur)) return;
    f32x4 acc[2][2][4][2];
#pragma unroll
    for (int a = 0; a < 2; ++a)
#pragma unroll
        for (int b = 0; b < 2; ++b)
#pragma unroll
            for (int m = 0; m < 4; ++m)
#pragma unroll
                for (int n = 0; n < 2; ++n) acc[a][b][m][n] = (f32x4){0.f, 0.f, 0.f, 0.f};
    bf16x8 At[4][2], B0[2][2], B1[2][2];
    unsigned vAc[2][2], vAn[2][2];
    if constexpr (Pol::GATHER) { P.rows_issue(cur, R0, vAc); P.rows_finish(C0, K, vAc); }
    else { vAc[0][0] = (unsigned)(R0 * K + C0) * 2u; vAc[0][1] = vAc[1][0] = vAc[1][1] = 0u; }
    asm volatile("s_waitcnt vmcnt(0)" ::: "memory");
    PG8_STAGE_B(PG8_SB(0, 0), cur.B0); PG8_STAGE_B(PG8_SB(0, 1), cur.B1); PG8_STAGE_A(PG8_SA(0, 0), cur.A, vAc, 0); PG8_STAGE_A(PG8_SA(0, 1), cur.A, vAc, 1);
    if (wr == 1) PG8_BAR;
    PG8_WAIT_V(2); PG8_BAR;
    PG8_STAGE_B(PG8_SB(1, 0), cur.B0 + kstep); PG8_STAGE_A(PG8_SA(1, 0), cur.A + kstep, vAc, 0); PG8_STAGE_B(PG8_SB(1, 1), cur.B1 + kstep);
    PG8_WAIT_V(6); PG8_BAR;
    for (;;) {
        const bool has_next = P.next(ui + 1, nxt);
        if (!has_next) nxt = cur;
        if (stat) tmark = __builtin_amdgcn_s_memrealtime();
        for (int t = 0; t < nt; t += 2) {
            const bool last = (t == nt - 2);
            if constexpr (Pol::GATHER) {
                if (last && has_next) { P.rows_issue(nxt, R0, vAn); vAc[0][0] = (vAn[0][0] * (unsigned)K + (unsigned)C0) * 2u; vAc[0][1] = (vAn[0][1] * (unsigned)K + (unsigned)C0) * 2u; }
            }
            const char* a1 = cur.A + (size_t)(t + 1) * kstep;
            const char* a2 = last ? nxt.A : cur.A + (size_t)(t + 2) * kstep;
            const char* b20 = last ? nxt.B0 : cur.B0 + (size_t)(t + 2) * kstep; const char* b21 = last ? nxt.B1 : cur.B1 + (size_t)(t + 2) * kstep;
            const char* a3 = a2 + kstep; const char* b30 = b20 + kstep; const char* b31 = b21 + kstep;
            PG8_LDB(B0, 0, 0); PG8_LDB(B1, 0, 1); PG8_SCHED; PG8_LDA(At, 0, 0); PG8_STAGE_A(PG8_SA(1, 1), a1, vAc, 1);
            if constexpr (Pol::GATHER) { if (last && has_next) { vAc[1][0] = (vAn[1][0] * (unsigned)K + (unsigned)C0) * 2u; vAc[1][1] = (vAn[1][1] * (unsigned)K + (unsigned)C0) * 2u; } }
            PG8_WAIT_V(8); PG8_WAIT_L(0); PG8_BAR; PG8_MMA(0, 0, At, B0); PG8_MMA(0, 1, At, B1); PG8_BAR; PG8_SCHED;
            PG8_LDA(At, 0, 1); PG8_STAGE_B(PG8_SB(0, 0), b20); PG8_STAGE_B(PG8_SB(0, 1), b21); PG8_STAGE_A(PG8_SA(0, 0), a2, vAc, 0);
            PG8_WAIT_V(8); PG8_WAIT_L(0); PG8_BAR; PG8_MMA(1, 0, At, B0); PG8_MMA(1, 1, At, B1); PG8_BAR; PG8_SCHED;
            PG8_LDB(B0, 1, 0); PG8_LDB(B1, 1, 1); PG8_SCHED; PG8_LDA(At, 1, 0); PG8_STAGE_A(PG8_SA(0, 1), a2, vAc, 1);
            PG8_WAIT_V(8); PG8_WAIT_L(0); PG8_BAR; PG8_MMA(0, 0, At, B0); PG8_MMA(0, 1, At, B1); PG8_BAR; PG8_SCHED;
            PG8_LDA(At, 1, 1); PG8_STAGE_B(PG8_SB(1, 0), b30); PG8_STAGE_B(PG8_SB(1, 1), b31); PG8_STAGE_A(PG8_SA(1, 0), a3, vAc, 0);
            PG8_WAIT_V(8); PG8_WAIT_L(0); PG8_BAR; PG8_MMA(1, 0, At, B0); PG8_MMA(1, 1, At, B1); PG8_BAR; PG8_SCHED;
        }
        if (stat) { const unsigned long long n_ = __builtin_amdgcn_s_memrealtime(); tK += n_ - tmark; tmark = n_; }
        if (wr == 0) PG8_BAR;
        P.epi(acc, cur, wr, wc, fr, fq);
        if (stat) { const unsigned long long n_ = __builtin_amdgcn_s_memrealtime(); tE += n_ - tmark; }
        if (!has_next) break;
#pragma unroll
        for (int a = 0; a < 2; ++a)
#pragma unroll
            for (int b = 0; b < 2; ++b)
#pragma unroll
                for (int m = 0; m < 4; ++m)
#pragma unroll
                    for (int n = 0; n < 2; ++n) acc[a][b][m][n] = (f32x4){0.f, 0.f, 0.f, 0.f};
        cur = nxt; ++ui;
        if (wr == 1) PG8_BAR;
    }
    PG8_WAIT_V(0);
    PG8_BAR;
    if (stat && threadIdx.x == 0) { stat[0] = tK; stat[1] = tE; stat[2] = __builtin_amdgcn_s_memrealtime() - tstart; }
#undef PG8_SA
#undef PG8_SB
#undef PG8_STAGE_A
#undef PG8_STAGE_B
#undef PG8_LDA
#undef PG8_LDB
#undef PG8_MMA
#undef PG8_WAIT_V
#undef PG8_WAIT_L
#undef PG8_BAR
#undef PG8_SCHED
}
}

struct PolP1 {
    static constexpr bool PERM = true, GATHER = false;
    const bf16_t* A; const bf16_t* Bt; bf16_t* PR; bf16_t* PA; const bf16_t* MB; const bf16_t* WK; bf16_t* KVM; int G, c;
    __device__ __forceinline__ bool next(int i, pg8::Unit& u) const { int pm, pn; constexpr int NMAIN = (T / 256) * (IN_WP / 256), NKV = (BATCH * NMEM / 256) * (2 * MW / 256);
        if (pg8::static_order(T / 256, IN_WP / 256, G, c, i, pm, pn)) {
            u.A = (const char*)(A + (size_t)pm * 256 * D); u.B0 = (const char*)(Bt + (size_t)pn * 256 * D); u.B1 = u.B0 + (size_t)128 * D * 2; u.x0 = pm; u.x1 = pn; u.x2 = 0; u.x3 = 0; u.x4 = 0; return true; }
        const long L = (long)i * G + c - NMAIN; if (L < 0 || L >= NKV) return false;
        pm = (int)(L >> 1); pn = (int)(L & 1);
        u.A = (const char*)(MB + (size_t)pm * 256 * D); u.B0 = (const char*)(WK + (size_t)pn * 256 * D); u.B1 = u.B0 + (size_t)128 * D * 2; u.x0 = pm; u.x1 = pn; u.x2 = 1; u.x3 = 0; u.x4 = 0; return true; }
    __device__ __forceinline__ void epi(const f32x4 (&acc)[2][2][4][2], const pg8::Unit& u, int wr, int wc, int fr, int fq) const {
        const int row0 = u.x0 * 256 + wr * 64 + fr;
#pragma unroll
        for (int bj = 0; bj < 2; ++bj) { const int col = u.x1 * 256 + bj * 128 + wc * 32 + 8 * fq;
            bf16_t* base; int pitch; float sc = 1.f;
            if (u.x2) { base = KVM + col; pitch = 2 * MW; }
            else if (col < RWKV_IN) { base = PR + col; pitch = RWKV_IN; }
            else { const int ca = col - RWKV_IN; base = PA + ca; pitch = PA_W; sc = (ca < AW || (ca >= 3 * AW && ca < 3 * AW + MW)) ? 0.125f : 1.f; }
#pragma unroll
            for (int ai = 0; ai < 2; ++ai)
#pragma unroll
                for (int m = 0; m < 4; ++m) { const f32x4 v0 = acc[ai][bj][m][0] * sc, v1 = acc[ai][bj][m][1] * sc;
                    u32x4 w; w.x = pg8::cvt_pk_bf16(v0[0], v0[1]); w.y = pg8::cvt_pk_bf16(v0[2], v0[3]); w.z = pg8::cvt_pk_bf16(v1[0], v1[1]); w.w = pg8::cvt_pk_bf16(v1[2], v1[3]);
                    *(u32x4*)(base + (size_t)(row0 + ai * 128 + m * 16) * pitch) = w; } }
    }
};
__device__ __forceinline__ void phase1(const Params& p, LAS unsigned char* lds) {
    unsigned char* ws = p.ws;
    PolP1 P{(const bf16_t*)(ws + WS_H0B), (const bf16_t*)(ws + WS_WT_IN), (bf16_t*)(ws + WS_PR), (bf16_t*)(ws + WS_PA), (const bf16_t*)(ws + WS_MEMB), (const bf16_t*)(ws + WS_WT_KV), (bf16_t*)(ws + WS_KVM), (int)gridDim.x, (int)blockIdx.x};
    pg8::gemm_phase(lds, P, D, (PROBE_GEMM == 1 && blockIdx.x == 0) ? (unsigned long long*)(ws + WS_CTL + 32768) : nullptr);
}

constexpr int P2_AP = 200;
__device__ __forceinline__ f32x4 p2_shift(const bf16_t* cur, int po, int no, float pm, float nm, const float* mu) {
    const u32x2 c = *(const u32x2*)cur, pv = *(const u32x2*)(cur + po), nv = *(const u32x2*)(cur + no);
    const f32x4 m = *(const f32x4*)mu;
    const f32x4 cc = {bflo(c.x), bfhi(c.x), bflo(c.y), bfhi(c.y)}, pp = {bflo(pv.x), bfhi(pv.x), bflo(pv.y), bfhi(pv.y)}, nn = {bflo(nv.x), bfhi(nv.x), bflo(nv.y), bfhi(nv.y)};
    return cc + m * (0.5f * (pp * pm + nn * nm) - cc);
}
constexpr int P2_CST = 8 * 16 * P2_AP * 2;
constexpr int P2_WOFF = P2_CST + 10 * RC * 4, P2_WBUF = 24576;
struct P2Pre { u32x2 rc, rp, rn, vc, vp, vn; };
__device__ __forceinline__ f32x4 p2_lerp(u32x2 c, u32x2 pv, u32x2 nv, float pm, float nm, f32x4 m) {
    const f32x4 cc = {bflo(c.x), bfhi(c.x), bflo(c.y), bfhi(c.y)}, pp = {bflo(pv.x), bfhi(pv.x), bflo(pv.y), bfhi(pv.y)}, nn = {bflo(nv.x), bfhi(nv.x), bflo(nv.y), bfhi(nv.y)};
    return cc + m * (0.5f * (pp * pm + nn * nm) - cc);
}
__device__ __forceinline__ void p2_fetch(P2Pre& P, const bf16_t* prow, int po, int no, const bf16_t* WU, const bf16_t* AU, const bf16_t* GU, int it, int fr, int fq) {
    const int h = it >> 2, ct = it & 3, ch = h * 64 + 16 * ct + 4 * fq;
    P.rc = *(const u32x2*)(prow + ch); P.rp = *(const u32x2*)(prow + ch + po); P.rn = *(const u32x2*)(prow + ch + no);
    P.vc = *(const u32x2*)(prow + 2 * RC + ch); P.vp = *(const u32x2*)(prow + 2 * RC + ch + po); P.vn = *(const u32x2*)(prow + 2 * RC + ch + no);
}
__device__ __forceinline__ void p2_wfetch(const bf16_t* WU, const bf16_t* AU, const bf16_t* GU, int h, int tid, u32x4 (&wr)[3]) {
#pragma unroll
    for (int q = 0; q < 3; ++q) { const int idx = tid + NTHR * q; const bf16_t* src;
        if (q < 2) { const int d = (idx & 511) >> 8, row = (idx & 255) >> 2, part = idx & 3; src = (q == 0 ? WU : AU) + ((size_t)(d * RC + h * 64 + row) * 32 + part * 8); }
        else { const int row = (idx - 1024) >> 3, part = idx & 7; src = GU + ((size_t)(h * 64 + row) * 64 + part * 8); }
        wr[q] = *(const u32x4*)src; }
}
__device__ __forceinline__ void p2_wput(LAS unsigned char* wb, int tid, const u32x4 (&wr)[3]) {
#pragma unroll
    for (int q = 0; q < 3; ++q) *(LAS u32x4*)(wb + (tid + NTHR * q) * 16) = wr[q];
}
__device__ __forceinline__ void phase2(const Params& p, LAS unsigned char* lds) {
    int tid_ = threadIdx.x; asm volatile("" : "+v"(tid_)); const int tid = tid_, lane = tid & 63, wave = tid >> 6, fr = lane & 15, fq = lane >> 4;
    unsigned char* ws = p.ws;
    const bf16_t* PR = (const bf16_t*)(ws + WS_PR);
    const float* mu = p.in[5];
    const bf16_t* WU = (const bf16_t*)(ws + WS_LORA); const bf16_t* AU = WU + 2 * RC * 32; const bf16_t* GU = AU + 2 * RC * 32;
    LAS bf16_t* ACT = (LAS bf16_t*)(lds + wave * (16 * P2_AP * 2));
    LAS float* CST = (LAS float*)(lds + P2_CST);
    unsigned char* SSH = ws + WS_SSH; unsigned char* SDIR = ws + WS_SDIR;
    bf16_t* G = (bf16_t*)((unsigned char*)p.out + DO_G); float* BON = (float*)(ws + WS_BONUS);
    __syncthreads();
    for (int i = tid; i < 10 * RC; i += NTHR) { const int a = i / RC, c = i % RC; float v;
        if (a < 3) v = mu[a * RC + c]; else if (a < 5) v = p.in[6][(a - 3) * RC + c]; else if (a < 7) v = p.in[8][(a - 5) * RC + c]; else v = p.in[11 + (a - 7)][c];
        CST[i] = v; }
    u32x4 wreg[3];
    p2_wfetch(WU, AU, GU, 0, tid, wreg); p2_wput(lds + P2_WOFF, tid, wreg);
    __syncthreads();
    { const int tile = blockIdx.x * NWAVES + wave;
        const int t0 = tile * 16;
#pragma unroll 4
        for (int i = 0; i < 12; ++i) { const int grp = lane + 64 * i, tok = grp / 48, c4 = (grp % 48) * 4, t = t0 + tok, sq = t & (SEQ - 1);
            f32x4 v = p2_shift(PR + (size_t)t * RWKV_IN + 3 * RC + c4, sq > 0 ? -RWKV_IN : 0, sq < SEQ - 1 ? RWKV_IN : 0, sq > 0 ? 1.f : 0.f, sq < SEQ - 1 ? 1.f : 0.f, mu + 3 * RC + c4);
            { const float sc = c4 < 64 ? 1.f : 2.f, mul = c4 < 64 ? 1.f : 2.f, add = c4 < 64 ? 0.f : -1.f; const bool raw = c4 >= 128;
#pragma unroll
              for (int e = 0; e < 4; ++e) { const float a = sigmoidf_(sc * v[e]) * mul + add; v[e] = raw ? v[e] : a; } }
            u32x2 o; o.x = pk2(v.x, v.y); o.y = pk2(v.z, v.w); *(LAS u32x2*)(ACT + tok * P2_AP + c4) = o; }
        asm volatile("s_waitcnt lgkmcnt(0)" ::: "memory");
        const int t = t0 + fr, sq = t & (SEQ - 1), b = t >> 11; const int po = sq > 0 ? -RWKV_IN : 0, no = sq < SEQ - 1 ? RWKV_IN : 0; const float pm = sq > 0 ? 1.f : 0.f, nm = sq < SEQ - 1 ? 1.f : 0.f;
        const bf16_t* prow = PR + (size_t)t * RWKV_IN;
        const LAS bf16_t* arowp = ACT + fr * P2_AP + 8 * fq;
        u32x2 kq[4][3];
#pragma unroll
        for (int ct = 0; ct < 4; ++ct) { const int ch = RC + 16 * ct + 4 * fq; kq[ct][0] = *(const u32x2*)(prow + ch); kq[ct][1] = *(const u32x2*)(prow + ch + po); kq[ct][2] = *(const u32x2*)(prow + ch + no); }
        P2Pre cur, nxt; p2_fetch(cur, prow, po, no, WU, AU, GU, 0, fr, fq);
#pragma unroll 1
        for (int h = 0; h < RH; ++h) {
            if (h + 1 < RH) p2_wfetch(WU, AU, GU, h + 1, tid, wreg);
            const LAS unsigned char* wbuf = lds + P2_WOFF + (h & 1) * P2_WBUF;
            f32x4 kp[4]; float ss = 0.f;
#pragma unroll
            for (int ct = 0; ct < 4; ++ct) { const int ch = h * 64 + 16 * ct + 4 * fq; kp[ct] = p2_lerp(kq[ct][0], kq[ct][1], kq[ct][2], pm, nm, *(const LAS f32x4*)(CST + RC + ch));
                const f32x4 kkv = kp[ct] * *(const LAS f32x4*)(CST + 7 * RC + ch); ss += (kkv.x * kkv.x + kkv.y * kkv.y) + (kkv.z * kkv.z + kkv.w * kkv.w); }
            ss += __shfl_xor(ss, 16); ss += __shfl_xor(ss, 32);
            const float rn = 1.f / fmaxf(sqrtf(ss), 1e-12f);
            float bon = 0.f;
            unsigned char* shrec = SSH + ((size_t)(b * RH + h) * SEQ + sq) * 384;
            unsigned char* d0rec = SDIR + ((size_t)((0 * BATCH + b) * RH + h) * SEQ + sq) * 512; unsigned char* d1rec = SDIR + ((size_t)((1 * BATCH + b) * RH + h) * SEQ + sq) * 512;
#pragma unroll
            for (int ct = 0; ct < 4; ++ct) { const int ch = h * 64 + 16 * ct + 4 * fq, cl = 16 * ct + 4 * fq, it = h * 4 + ct;
                const f32x4 r = p2_lerp(cur.rc, cur.rp, cur.rn, pm, nm, *(const LAS f32x4*)(CST + ch)), v = p2_lerp(cur.vc, cur.vp, cur.vn, pm, nm, *(const LAS f32x4*)(CST + 2 * RC + ch)), k = kp[ct];
                const LAS unsigned char* wl_ = wbuf + ((16 * ct + fr) * 4 + fq) * 16;
                const bf16x8 fw0 = *(const LAS bf16x8*)wl_, fw1 = *(const LAS bf16x8*)(wl_ + 4096), fa0 = *(const LAS bf16x8*)(wl_ + 8192), fa1 = *(const LAS bf16x8*)(wl_ + 12288);
                const LAS unsigned char* gl_ = wbuf + 16384 + ((16 * ct + fr) * 8 + fq) * 16;
                const bf16x8 fg0 = *(const LAS bf16x8*)gl_, fg1 = *(const LAS bf16x8*)(gl_ + 64);
                const f32x4 z = {0.f, 0.f, 0.f, 0.f};
                const f32x4 wl0 = __builtin_amdgcn_mfma_f32_16x16x32_bf16(fw0, *(const LAS bf16x8*)(arowp + 64), z, 0, 0, 0);
                const f32x4 wl1 = __builtin_amdgcn_mfma_f32_16x16x32_bf16(fw1, *(const LAS bf16x8*)(arowp + 96), z, 0, 0, 0);
                const f32x4 al0 = __builtin_amdgcn_mfma_f32_16x16x32_bf16(fa0, *(const LAS bf16x8*)(arowp + 128), z, 0, 0, 0);
                const f32x4 al1 = __builtin_amdgcn_mfma_f32_16x16x32_bf16(fa1, *(const LAS bf16x8*)(arowp + 160), z, 0, 0, 0);
                f32x4 gg = __builtin_amdgcn_mfma_f32_16x16x32_bf16(fg0, *(const LAS bf16x8*)(arowp), z, 0, 0, 0);
                gg = __builtin_amdgcn_mfma_f32_16x16x32_bf16(fg1, *(const LAS bf16x8*)(arowp + 32), gg, 0, 0, 0);
                const f32x4 w00 = *(const LAS f32x4*)(CST + 3 * RC + ch), w01 = *(const LAS f32x4*)(CST + 4 * RC + ch), a00 = *(const LAS f32x4*)(CST + 5 * RC + ch), a01 = *(const LAS f32x4*)(CST + 6 * RC + ch);
                const f32x4 kkw = *(const LAS f32x4*)(CST + 7 * RC + ch), kaw = *(const LAS f32x4*)(CST + 8 * RC + ch), rkw = *(const LAS f32x4*)(CST + 9 * RC + ch);
                f32x4 dec0, dec1, kd0, kd1, bb0, bb1, kkn;
#pragma unroll
                for (int e = 0; e < 4; ++e) {
                    dec0[e] = __expf(-0.6065306597126334f * sigmoidf_(w00[e] + wl0[e])); dec1[e] = __expf(-0.6065306597126334f * sigmoidf_(w01[e] + wl1[e]));
                    const float a0 = sigmoidf_(a00[e] + al0[e]), a1 = sigmoidf_(a01[e] + al1[e]);
                    kkn[e] = k[e] * kkw[e] * rn; kd0[e] = k[e] * (1.f + (a0 - 1.f) * kaw[e]); kd1[e] = k[e] * (1.f + (a1 - 1.f) * kaw[e]);
                    bb0[e] = kkn[e] * a0; bb1[e] = kkn[e] * a1; bon += r[e] * (kd0[e] + kd1[e]) * rkw[e]; }
                if (it + 1 < 4 * RH) p2_fetch(nxt, prow, po, no, WU, AU, GU, it + 1, fr, fq);
                if (ct == 3 && h + 1 < RH) {
#pragma unroll
                    for (int c2 = 0; c2 < 4; ++c2) { const int chn = RC + (h + 1) * 64 + 16 * c2 + 4 * fq; kq[c2][0] = *(const u32x2*)(prow + chn); kq[c2][1] = *(const u32x2*)(prow + chn + po); kq[c2][2] = *(const u32x2*)(prow + chn + no); } }
                { u32x2 o; o.x = pk2(r.x, r.y); o.y = pk2(r.z, r.w); *(u32x2*)(shrec + cl * 2) = o; o.x = pk2(v.x, v.y); o.y = pk2(v.z, v.w); *(u32x2*)(shrec + 128 + cl * 2) = o;
                  o.x = pk2(kkn.x, kkn.y); o.y = pk2(kkn.z, kkn.w); *(u32x2*)(shrec + 256 + cl * 2) = o;
                  *(f32x4*)(d0rec + cl * 4) = dec0; o.x = pk2(kd0.x, kd0.y); o.y = pk2(kd0.z, kd0.w); *(u32x2*)(d0rec + 256 + cl * 2) = o; o.x = pk2(bb0.x, bb0.y); o.y = pk2(bb0.z, bb0.w); *(u32x2*)(d0rec + 384 + cl * 2) = o;
                  *(f32x4*)(d1rec + cl * 4) = dec1; o.x = pk2(kd1.x, kd1.y); o.y = pk2(kd1.z, kd1.w); *(u32x2*)(d1rec + 256 + cl * 2) = o; o.x = pk2(bb1.x, bb1.y); o.y = pk2(bb1.z, bb1.w); *(u32x2*)(d1rec + 384 + cl * 2) = o; }
                u32x2 go; go.x = pk2(gg.x, gg.y); go.y = pk2(gg.z, gg.w); *(u32x2*)(G + (size_t)t * RC + ch) = go;
                cur = nxt;
                asm volatile("" ::: "memory");
            }
            bon += __shfl_xor(bon, 16); bon += __shfl_xor(bon, 32);
            if (fq == 0) BON[t * RH + h] = bon;
            if (h + 1 < RH) { p2_wput(lds + P2_WOFF + ((h + 1) & 1) * P2_WBUF, tid, wreg); __syncthreads(); }
        }
    }
}

typedef float f32x2_t __attribute__((ext_vector_type(2))); typedef __bf16 bf16x2_t __attribute__((ext_vector_type(2)));
__device__ __forceinline__ unsigned cvtpk(float lo, float hi) { const f32x2_t v = {lo, hi}; const bf16x2_t b = __builtin_convertvector(v, bf16x2_t); return __builtin_bit_cast(unsigned, b); }
constexpr int SC_TC = 16;
constexpr int SC_W = 0, SC_KK = 256, SC_RP = 384, SC_Z = 512, SC_UB = 640, SC_V = 1152, SC_STEPB = 1280;
constexpr int SC_BUFB = SC_TC * SC_STEPB;
struct ScanProd { const unsigned char* g0; const unsigned char* g1; long gstep0, gstep1; int ldst; int kind; };
__device__ __forceinline__ ScanProd scan_prod_init(const unsigned char* sh, const unsigned char* dr, int dir, int ptid) {
    ScanProd P; const int wi = ptid % 48, st0 = ptid / 48; int shift = 0; bool sh0 = false;
    P.g1 = dr; P.gstep1 = 0;
    if (wi < 16) { P.g0 = dr + wi * 16; P.ldst = SC_W + wi * 16; P.kind = 0; }
    else if (wi < 24) { const int c = wi - 16, ct = c >> 1; P.g0 = dr + 256 + c * 16; P.g1 = dr + 384 + c * 16; P.ldst = SC_UB + (ct >> 1) * 256 + (c & 1) * 128 + (ct & 1) * 8; P.kind = 1; }
    else if (wi < 32) { const int c = wi - 24; P.g0 = sh + 128 + c * 16; P.ldst = SC_V + c * 16; P.kind = 0; sh0 = true; }
    else { const int c = (wi - 32) & 7; const bool isr = wi >= 40; P.g0 = sh + (isr ? 0 : 256) + c * 16; sh0 = true; shift = isr ? 1 : 0; P.kind = 2;
        const int ct = c >> 1, fqb = 2 * (c & 1), pp = 32 * (ct >> 1) + 8 * fqb + (ct & 1) * 4; P.ldst = (isr ? SC_RP : SC_KK) + pp * 2; }
    const long rec0 = sh0 ? 384 : 512;
    const long t0 = dir ? (long)(SEQ - 1 - (st0 - shift)) : (long)(st0 - shift), t1 = dir ? (long)(SEQ - 1 - st0) : (long)st0;
    P.g0 += t0 * rec0; P.gstep0 = dir ? -rec0 : rec0; P.g1 += t1 * 512; P.gstep1 = dir ? -512 : 512; P.ldst += st0 * SC_STEPB; return P;
}
__device__ __forceinline__ void scan_fetch(const ScanProd& P, int c, u32x4 (&reg)[SC_TC / 4], u32x4 (&reg2)[SC_TC / 4]) {
    const unsigned char* a = P.g0 + (long)(c * SC_TC) * P.gstep0; const unsigned char* b = P.g1 + (long)(c * SC_TC) * P.gstep1;
#pragma unroll
    for (int q = 0; q < SC_TC / 4; ++q) { reg[q] = *(const u32x4*)(a + (long)(4 * q) * P.gstep0); reg2[q] = *(const u32x4*)(b + (long)(4 * q) * P.gstep1); }
}
__device__ __forceinline__ void scan_put(const ScanProd& P, LAS unsigned char* buf, const u32x4 (&reg)[SC_TC / 4], const u32x4 (&reg2)[SC_TC / 4]) {
    LAS unsigned char* d = buf + P.ldst;
    if (P.kind == 0) {
#pragma unroll
        for (int q = 0; q < SC_TC / 4; ++q) *(LAS u32x4*)(d + 4 * q * SC_STEPB) = reg[q];
    } else if (P.kind == 1) {
#pragma unroll
        for (int q = 0; q < SC_TC / 4; ++q) { const unsigned kw[4] = {reg[q].x, reg[q].y, reg[q].z, reg[q].w}, bw[4] = {reg2[q].x, reg2[q].y, reg2[q].z, reg2[q].w};
#pragma unroll
            for (int e = 0; e < 4; ++e) { const unsigned k0 = kw[e] & 0xffffu, k1 = kw[e] >> 16, b0 = bw[e] & 0xffffu, b1 = bw[e] >> 16;
                *(LAS u32x2*)(d + 4 * q * SC_STEPB + (2 * e) * 16) = (u32x2){k0 | (b0 << 16), b0};
                *(LAS u32x2*)(d + 4 * q * SC_STEPB + (2 * e + 1) * 16) = (u32x2){k1 | (b1 << 16), b1}; } }
    } else {
#pragma unroll
        for (int q = 0; q < SC_TC / 4; ++q) { *(LAS u32x2*)(d + 4 * q * SC_STEPB) = (u32x2){reg[q].x, reg[q].y}; *(LAS u32x2*)(d + 4 * q * SC_STEPB + 16) = (u32x2){reg[q].z, reg[q].w}; }
    }
}
__device__ __forceinline__ void scan_block(const Params& p, LAS unsigned char* lds, int sid) {
    const int tid = threadIdx.x, lane = tid & 63, wave = tid >> 6;
    const int dir = sid / (BATCH * RH), bh = sid % (BATCH * RH), b = bh / RH, h = bh % RH;
    const unsigned char* sh = p.ws + WS_SSH + (size_t)bh * SEQ * 384;
    const unsigned char* dr = p.ws + WS_SDIR + (size_t)(dir * BATCH * RH + bh) * SEQ * 512;
    float* Y = (float*)((unsigned char*)p.out + DO_Y) + (size_t)dir * T * RC;
    LAS unsigned char* buf0 = lds; LAS unsigned char* buf1 = lds + SC_BUFB;
    constexpr int NCH = SEQ / SC_TC;
    __syncthreads();
    for (int i = tid; i < 2 * SC_TC * 32; i += NTHR) { const int st = i >> 5, e = i & 31; *(LAS unsigned*)(lds + st * SC_STEPB + SC_Z + e * 4) = 0u; }
    const ScanProd SP = scan_prod_init(sh, dr, dir, (tid - 256) & 255);
    const bool prod = wave >= 4 && tid - 256 < 192;
    u32x4 preg[SC_TC / 4], preg2[SC_TC / 4];
    if (prod) { scan_fetch(SP, 0, preg, preg2); scan_put(SP, buf0, preg, preg2); scan_fetch(SP, 1, preg, preg2); }
    __syncthreads();
    const int fr = lane & 15, fq = lane >> 4, sel = (fr & 3) < 2 ? (fr & 3) : 2;
    f32x4 acc[4];
#pragma unroll
    for (int ct = 0; ct < 4; ++ct) acc[ct] = (f32x4){0.f, 0.f, 0.f, 0.f};
    bf16x8 sb0 = (bf16x8){0, 0, 0, 0, 0, 0, 0, 0}, sb1 = sb0;
    float* yrow = Y + (size_t)b * SEQ * RC + h * 64 + 16 * wave + fr;
    float yk = 0.f;
    const int ubo = fq == 0 ? SC_UB + fr * 16 : SC_Z, ubs = fq == 0 ? 256 : 0;
    for (int c = 0; c < NCH; ++c) {
        LAS unsigned char* cur = (c & 1) ? buf1 : buf0; LAS unsigned char* nxt = (c & 1) ? buf0 : buf1;
        if (wave >= 4) {
            if (prod && c + 1 < NCH) { scan_put(SP, nxt, preg, preg2); if (c + 2 < NCH) scan_fetch(SP, c + 2, preg, preg2); }
        } else {
            const LAS unsigned char* ab = cur + SC_KK + 128 * sel + fq * 16;
            const LAS unsigned char* wb = cur + SC_W + fq * 16;
            const LAS unsigned char* ub = cur + ubo;
            const LAS unsigned char* vb = cur + SC_V + (16 * wave + fr) * 2;
            bf16x8 cA0, cA1, nA0, nA1; u32x4 cU[2], nU[2]; f32x4 cW[4], nW[4]; unsigned cV, nV;
#define SC_LOAD(A0, A1, W, U, V, st) do { \
                A0 = *(const LAS bf16x8*)(ab + (st) * SC_STEPB); A1 = *(const LAS bf16x8*)(ab + (st) * SC_STEPB + 64); \
                _Pragma("unroll") for (int ct_ = 0; ct_ < 4; ++ct_) W[ct_] = *(const LAS f32x4*)(wb + (st) * SC_STEPB + ct_ * 64); \
                _Pragma("unroll") for (int cp_ = 0; cp_ < 2; ++cp_) U[cp_] = *(const LAS u32x4*)(ub + (st) * SC_STEPB + cp_ * ubs); \
                V = *(const LAS unsigned short*)(vb + (st) * SC_STEPB); } while (0)
            SC_LOAD(cA0, cA1, cW, cU, cV, 0);
#pragma unroll 1
            for (int g = 0; g < SC_TC / 4; ++g) {
#pragma unroll
                for (int u = 0; u < 4; ++u) {
                    const int st = 4 * g + u;
                    if (st + 1 < SC_TC) SC_LOAD(nA0, nA1, nW, nU, nV, st + 1);
                    f32x4 d = (f32x4){0.f, 0.f, 0.f, 0.f};
                    d = __builtin_amdgcn_mfma_f32_16x16x32_bf16(cA0, sb0, d, 0, 0, 0);
                    d = __builtin_amdgcn_mfma_f32_16x16x32_bf16(cA1, sb1, d, 0, 0, 0);
                    f32x4 cc[4];
#pragma unroll
                    for (int ct = 0; ct < 4; ++ct) cc[ct] = acc[ct] * cW[ct];
                    yk = (((u + 3) & 3) == fq) ? d[1] : yk;
                    if (u == 0) {
                        const int tau = c * SC_TC + 4 * g - 4 + fq;
                        if (tau >= 0) { const int t = dir ? (SEQ - 1 - tau) : tau; yrow[(size_t)t * RC] = yk; } }
                    const float nsa = -d[0];
                    const unsigned t1 = cvtpk(nsa, nsa);
                    const float lo = nsa - __builtin_bit_cast(float, t1 & 0xffff0000u);
                    const unsigned t2 = cvtpk(lo, 0.f);
                    u32x4 bw; bw.x = cV | (t1 << 16); bw.y = t2; bw.z = 0u; bw.w = 0u;
                    const bf16x8 b2 = __builtin_bit_cast(bf16x8, bw);
#pragma unroll
                    for (int ct = 0; ct < 4; ++ct) { u32x4 aw; aw.x = (ct & 1) ? cU[ct >> 1].z : cU[ct >> 1].x; aw.y = (ct & 1) ? cU[ct >> 1].w : cU[ct >> 1].y; aw.z = 0u; aw.w = 0u;
                        acc[ct] = __builtin_amdgcn_mfma_f32_16x16x32_bf16(__builtin_bit_cast(bf16x8, aw), b2, cc[ct], 0, 0, 0); }
                    u32x4 p0, p1;
                    p0.x = cvtpk(acc[0][0], acc[0][1]); p0.y = cvtpk(acc[0][2], acc[0][3]); p0.z = cvtpk(acc[1][0], acc[1][1]); p0.w = cvtpk(acc[1][2], acc[1][3]);
                    p1.x = cvtpk(acc[2][0], acc[2][1]); p1.y = cvtpk(acc[2][2], acc[2][3]); p1.z = cvtpk(acc[3][0], acc[3][1]); p1.w = cvtpk(acc[3][2], acc[3][3]);
                    sb0 = __builtin_bit_cast(bf16x8, p0); sb1 = __builtin_bit_cast(bf16x8, p1);
                    cA0 = nA0; cA1 = nA1; cV = nV;
#pragma unroll
                    for (int i = 0; i < 4; ++i) cW[i] = nW[i];
                    cU[0] = nU[0]; cU[1] = nU[1];
                    asm volatile("" ::: "memory");
                }
            }
#undef SC_LOAD
        }
        __syncthreads();
    }
    if (wave < 4) {
        if (fq < 3) { const int tau = SEQ - 4 + fq, t = dir ? (SEQ - 1 - tau) : tau; yrow[(size_t)t * RC] = yk; }
        const int t = dir ? 0 : (SEQ - 1); const bf16_t* rr = (const bf16_t*)(sh + (size_t)t * 384);
        float accy = 0.f;
#pragma unroll
        for (int j = 0; j < 8; ++j) { accy += bf2f((unsigned)(unsigned short)sb0[j]) * bf2f(rr[16 * (j >> 2) + 4 * fq + (j & 3)]); accy += bf2f((unsigned)(unsigned short)sb1[j]) * bf2f(rr[32 + 16 * (j >> 2) + 4 * fq + (j & 3)]); }
        accy += __shfl_xor(accy, 16); accy += __shfl_xor(accy, 32);
        if (fq == 0) yrow[(size_t)t * RC] = accy;
    }
    __syncthreads();
}

constexpr int AT_P = 72;
constexpr int AT_KOFF = 0, AT_VOFF = 256 * AT_P * 2;
constexpr int ATT_DIL_UNITS = BATCH * AH * 48;
constexpr int ATT_MEM_UNITS = BATCH * MH * 16;
constexpr int ATT_UNITS = ATT_DIL_UNITS + ATT_MEM_UNITS;
struct AttU { const bf16_t* q; const bf16_t* k; const bf16_t* v; long qs, ks; int kind, win0, L, dil; float slope; bf16_t* o; long os; float* lse; long ls; };
__device__ __forceinline__ void att_make_unit(const Params& p, int u, AttU& U) {
    unsigned char* ws = p.ws; const bf16_t* PA = (const bf16_t*)(ws + WS_PA);
    if (u < ATT_DIL_UNITS) {
        const int bh = u / 48, x = u % 48, b = bh / AH, h = bh % AH, br = x >> 4, y = x & 15;
        const int dil = br == 0 ? 1 : (br == 1 ? 4 : 16), L = SEQ / dil, npr = L / 128, r = y / npr, np = y % npr;
        const bf16_t* base = PA + (size_t)(b * SEQ + r) * PA_W + h * 64;
        U.kind = 0; U.win0 = (2 * np - 1) * 64; U.L = L; U.dil = dil; U.slope = exp2f(-8.f * (float)(h + 1) / (float)AH);
        U.qs = (long)dil * PA_W; U.ks = U.qs;
        U.q = base + (long)(np * 128) * U.qs; U.k = base + AW; U.v = base + 2 * AW;
        const size_t tok0 = (size_t)(b * SEQ + r) + (size_t)np * 128 * dil;
        U.o = (bf16_t*)(ws + WS_ATTO) + (size_t)br * T * AW + tok0 * AW + h * 64; U.os = (long)dil * AW;
        U.lse = (float*)((unsigned char*)p.out + DO_LSE) + (size_t)br * T * AH + tok0 * AH + h; U.ls = (long)dil * AH;
    } else {
        const int v = u - ATT_DIL_UNITS, bh = v >> 4, qb = v & 15, b = bh / MH, h = bh % MH;
        const bf16_t* KVM = (const bf16_t*)(ws + WS_KVM);
        U.kind = 1; U.win0 = 0; U.L = NMEM; U.dil = 1; U.slope = 0.f;
        U.q = PA + (size_t)(b * SEQ + qb * 128) * PA_W + 3 * AW + h * 64; U.qs = PA_W;
        U.k = KVM + (size_t)(b * NMEM) * (2 * MW) + h * 64; U.v = U.k + MW; U.ks = 2 * MW;
        U.o = (bf16_t*)(ws + WS_YMIX) + (size_t)(b * SEQ + qb * 128) * D + RC + AW + h * 64; U.os = D;
        U.lse = nullptr; U.ls = 0;
    }
}
__device__ __forceinline__ void att_fetch(const AttU& U, u32x4 (&reg)[8], int tid) {
#pragma unroll
    for (int q = 0; q < 8; ++q) { const int rem = (tid + NTHR * q) & 2047, row = rem >> 3, ch = rem & 7; const int lk = U.win0 + row; const bool ok = lk >= 0 && lk < U.L;
        const bf16_t* src = (q < 4 ? U.k : U.v) + (long)(ok ? lk : 0) * U.ks + ch * 8;
        u32x4 raw = *(const u32x4*)src; if (!ok) raw = (u32x4){0u, 0u, 0u, 0u}; reg[q] = raw; }
}
__device__ __forceinline__ void att_put(LAS unsigned char* lds, const u32x4 (&reg)[8], int tid) {
#pragma unroll
    for (int q = 0; q < 8; ++q) { const int rem = (tid + NTHR * q) & 2047, row = rem >> 3, ch = rem & 7;
        *(LAS u32x4*)(lds + (q < 4 ? AT_KOFF : AT_VOFF) + row * (AT_P * 2) + ch * 16) = reg[q]; }
}
typedef short v4i16_t __attribute__((ext_vector_type(4)));
template <int NT  , bool DIL>
__device__ __forceinline__ void att_compute(const AttU& U, LAS unsigned char* lds, int w, int lane, const bf16x8 q0, const bf16x8 q1) {
    const int fr = lane & 15, fq = lane >> 4;
    f32x4 sT[NT];
#pragma unroll
    for (int i = 0; i < NT; ++i) {
        if (DIL && i == 9) { sT[i] = (f32x4){-1e30f, -1e30f, -1e30f, -1e30f}; continue; }
        int tt = DIL ? w + i : i; tt = tt > 15 ? 15 : tt;
        const LAS unsigned char* kp = lds + AT_KOFF + (16 * tt + fr) * (AT_P * 2) + fq * 16;
        const bf16x8 k0 = *(const LAS bf16x8*)kp, k1 = *(const LAS bf16x8*)(kp + 64);
        f32x4 a = (f32x4){0.f, 0.f, 0.f, 0.f};
        a = __builtin_amdgcn_mfma_f32_16x16x32_bf16(k0, q0, a, 0, 0, 0);
        a = __builtin_amdgcn_mfma_f32_16x16x32_bf16(k1, q1, a, 0, 0, 0);
        sT[i] = a; if ((i & 3) == 3) asm volatile("" ::: "memory"); }
    float m = -3.0e38f;
    if (DIL) {
        const int c0 = 4 * fq - fr, lb = U.win0 + 16 * w + 4 * fq; const float sd = U.slope * (float)U.dil; const unsigned Lc = (unsigned)U.L;
#pragma unroll
        for (int i = 0; i < NT; ++i) { if (i == 9) continue;
#pragma unroll
            for (int r = 0; r < 4; ++r) { const int dl = 16 * i + r - 64 + c0, ad = dl < 0 ? -dl : dl;
                bool valid = (unsigned)(lb + 16 * i + r) < Lc; if (i == 0 || i >= 7) valid = valid && ad <= 64;
                const float sv = valid ? sT[i][r] - sd * (float)ad : -1e30f; sT[i][r] = sv; m = fmaxf(m, sv); } }
    } else {
#pragma unroll
        for (int i = 0; i < NT; ++i)
#pragma unroll
            for (int r = 0; r < 4; ++r) m = fmaxf(m, sT[i][r]);
    }
    m = fmaxf(m, __shfl_xor(m, 16)); m = fmaxf(m, __shfl_xor(m, 32));
    float l = 0.f;
#pragma unroll
    for (int i = 0; i < NT; ++i)
#pragma unroll
        for (int r = 0; r < 4; ++r) { const float e = __expf(sT[i][r] - m); sT[i][r] = e; l += e; }
    l += __shfl_xor(l, 16); l += __shfl_xor(l, 32);
    f32x4 oT[4];
#pragma unroll
    for (int dt = 0; dt < 4; ++dt) oT[dt] = (f32x4){0.f, 0.f, 0.f, 0.f};
#pragma unroll
    for (int tp = 0; tp < NT / 2; ++tp) {
        int ta = DIL ? w + 2 * tp : 2 * tp, tb = ta + 1; ta = ta > 15 ? 15 : ta; tb = tb > 15 ? 15 : tb;
        u32x4 pw; pw.x = pk2(sT[2 * tp][0], sT[2 * tp][1]); pw.y = pk2(sT[2 * tp][2], sT[2 * tp][3]); pw.z = pk2(sT[2 * tp + 1][0], sT[2 * tp + 1][1]); pw.w = pk2(sT[2 * tp + 1][2], sT[2 * tp + 1][3]);
        const bf16x8 pb = __builtin_bit_cast(bf16x8, pw);
        const LAS unsigned char* va = lds + AT_VOFF + (16 * ta + 4 * fq + (fr >> 2)) * (AT_P * 2) + 8 * (fr & 3);
        const LAS unsigned char* vb = lds + AT_VOFF + (16 * tb + 4 * fq + (fr >> 2)) * (AT_P * 2) + 8 * (fr & 3);
#pragma unroll
        for (int dt = 0; dt < 4; ++dt) {
            const v4i16_t lo = __builtin_amdgcn_ds_read_tr16_b64_v4i16((LAS v4i16_t*)(va + 32 * dt)), hi = __builtin_amdgcn_ds_read_tr16_b64_v4i16((LAS v4i16_t*)(vb + 32 * dt));
            bf16x8 vf; vf[0] = lo[0]; vf[1] = lo[1]; vf[2] = lo[2]; vf[3] = lo[3]; vf[4] = hi[0]; vf[5] = hi[1]; vf[6] = hi[2]; vf[7] = hi[3];
            oT[dt] = __builtin_amdgcn_mfma_f32_16x16x32_bf16(vf, pb, oT[dt], 0, 0, 0); }
        if (tp & 1) asm volatile("" ::: "memory");
    }
    const float inv = 1.f / l;
    bf16_t* op = U.o + (long)(16 * w + fr) * U.os;
#pragma unroll
    for (int dt = 0; dt < 4; ++dt) { u32x2 o; o.x = pk2(oT[dt][0] * inv, oT[dt][1] * inv); o.y = pk2(oT[dt][2] * inv, oT[dt][3] * inv); *(u32x2*)(op + 16 * dt + 4 * fq) = o; }
    if (DIL && fq == 0) U.lse[(long)(16 * w + fr) * U.ls] = m + __logf(l);
}
__device__ __forceinline__ void phase3(const Params& p, LAS unsigned char* lds, int rep) {
    const int tid = threadIdx.x, lane = tid & 63, wave = tid >> 6;
    unsigned* ctl = (unsigned*)(p.ws + WS_CTL);
    LAS unsigned* bc = (LAS unsigned*)(lds + 98304);
    for (;;) {
        __syncthreads();
        if (tid == 0) bc[0] = atomicAdd(ctl + CW_SCANQ + 16 * rep, 1u);
        __syncthreads();
        const unsigned sid = __builtin_amdgcn_readfirstlane(bc[0]);
        if (sid >= 2u * BATCH * RH) break;
#pragma unroll 1
        for (int tw = 0; tw < (REPEAT_PHASE == 31 ? 2 : 1); ++tw) scan_block(p, lds, (int)sid);
    }
    constexpr unsigned ATT_BATCH = 2;
    for (;;) {
        __syncthreads();
        if (tid == 0) bc[1] = atomicAdd(ctl + CW_ATTQ + 16 * rep, ATT_BATCH);
        __syncthreads();
        const unsigned ubase = __builtin_amdgcn_readfirstlane(bc[1]);
        if (ubase >= (unsigned)ATT_UNITS) break;
        const unsigned uend = ubase + ATT_BATCH < (unsigned)ATT_UNITS ? ubase + ATT_BATCH : (unsigned)ATT_UNITS;
        { AttU U; att_make_unit(p, (int)ubase, U); u32x4 reg[8]; att_fetch(U, reg, tid); att_put(lds, reg, tid); }
#pragma unroll 1
        for (unsigned ucur = ubase; ucur < uend; ++ucur) {
            __syncthreads();
            u32x4 reg[8];
            { AttU U; att_make_unit(p, (int)ucur, U);
              const bf16_t* qp = U.q + (long)(16 * wave + (lane & 15)) * U.qs + (lane >> 4) * 8;
              const bf16x8 q0 = *(const bf16x8*)qp, q1 = *(const bf16x8*)(qp + 32);
              if (ucur + 1 < uend) { AttU Un; att_make_unit(p, (int)ucur + 1, Un); att_fetch(Un, reg, tid); }
#pragma unroll 1
              for (int tw = 0; tw < (REPEAT_PHASE == 32 ? 2 : 1); ++tw) {
                if (ucur < (unsigned)ATT_DIL_UNITS) att_compute<10, true>(U, lds, wave, lane, q0, q1); else att_compute<16, false>(U, lds, wave, lane, q0, q1); } }
            __syncthreads();
            if (ucur + 1 < uend) att_put(lds, reg, tid);
        }
    }
}

__device__ __forceinline__ void phase4(const Params& p) {
    const int tid = threadIdx.x, lane = tid & 63, wave = tid >> 6;
    const int gw = blockIdx.x * NWAVES + wave, NGW = gridDim.x * NWAVES;
    unsigned char* ws = p.ws; const unsigned char* dob = (const unsigned char*)p.out;
    const float* Yf = (const float*)(dob + DO_Y); const float* Yb = Yf + (size_t)T * RC;
    const bf16_t* G = (const bf16_t*)(dob + DO_G); const float* LSE = (const float*)(dob + DO_LSE);
    const float* BON = (const float*)(ws + WS_BONUS); const float* SSH = (const float*)(ws + WS_SSH);
    const bf16_t* AO = (const bf16_t*)(ws + WS_ATTO); bf16_t* YM = (bf16_t*)(ws + WS_YMIX);
    for (int t = gw; t < T; t += NGW) {
        const int b = t >> 11, s = t & (SEQ - 1);
        float yf[RH], yb[RH], vv[RH], bo[RH]; unsigned short gg[RH], a0[AH], a1[AH], a2[AH]; float l0[AH], l1[AH], l2[AH];
#pragma unroll
        for (int h = 0; h < RH; ++h) { const int ch = h * 64 + lane;
            yf[h] = Yf[(size_t)t * RC + ch]; yb[h] = Yb[(size_t)t * RC + ch]; gg[h] = G[(size_t)t * RC + ch];
            vv[h] = bf2f(((const bf16_t*)SSH)[((size_t)(b * RH + h) * SEQ + s) * 192 + 64 + lane]); bo[h] = BON[t * RH + h];
            a0[h] = AO[(size_t)t * AW + ch]; a1[h] = AO[(size_t)T * AW + (size_t)t * AW + ch]; a2[h] = AO[(size_t)2 * T * AW + (size_t)t * AW + ch];
            l0[h] = LSE[(size_t)t * AH + h]; l1[h] = LSE[(size_t)T * AH + (size_t)t * AH + h]; l2[h] = LSE[(size_t)2 * T * AH + (size_t)t * AH + h]; }
#pragma unroll
        for (int h = 0; h < RH; ++h) { const int ch = h * 64 + lane;
            const float y = yf[h] + yb[h];
            const float mean = wave_sum(y) * (1.f / 64.f); const float dlt = y - mean; const float var = wave_sum(dlt * dlt) * (1.f / 64.f);
            const float yn = dlt * (1.f / sqrtf(var + GN_EPS)) * p.in[14][ch] + p.in[15][ch];
            const float o = (yn + bo[h] * vv[h]) * bf2f(gg[h]);
            YM[(size_t)t * D + ch] = (bf16_t)f2bf(o); }
#pragma unroll
        for (int h = 0; h < AH; ++h) { const int ch = h * 64 + lane;
            const float mx = fmaxf(l0[h], fmaxf(l1[h], l2[h])); const float e0 = __expf(l0[h] - mx), e1 = __expf(l1[h] - mx), e2 = __expf(l2[h] - mx); const float inv = 1.f / (e0 + e1 + e2);
            const float o = (e0 * bf2f(a0[h]) + e1 * bf2f(a1[h]) + e2 * bf2f(a2[h])) * inv;
            YM[(size_t)t * D + RC + ch] = (bf16_t)f2bf(o); }
    }
}

struct PolP5 {
    static constexpr bool PERM = false, GATHER = false;
    const bf16_t* A; const bf16_t* Bt; const bf16_t* H0B; float* PRE; int G, c;
    __device__ __forceinline__ bool next(int i, pg8::Unit& u) const { int pm, pn; if (!pg8::static_order(T / 256, D / 256, G, c, i, pm, pn)) return false;
        u.A = (const char*)(A + (size_t)pm * 256 * D); u.B0 = (const char*)(Bt + (size_t)pn * 256 * D); u.B1 = u.B0 + (size_t)128 * D * 2; u.x0 = pm; u.x1 = pn; u.x2 = 0; u.x3 = 0; u.x4 = 0; return true; }
    __device__ __forceinline__ void epi(const f32x4 (&acc)[2][2][4][2], const pg8::Unit& u, int wr, int wc, int fr, int fq) const {
        const int row0 = u.x0 * 256 + wr * 64 + fr, col0 = u.x1 * 256 + wc * 32 + 4 * fq;
        u32x2 hb[2][4][2][2];
#pragma unroll
        for (int ai = 0; ai < 2; ++ai)
#pragma unroll
            for (int m = 0; m < 4; ++m)
#pragma unroll
                for (int bj = 0; bj < 2; ++bj)
#pragma unroll
                    for (int n = 0; n < 2; ++n) hb[ai][m][bj][n] = *(const u32x2*)(H0B + (size_t)(row0 + ai * 128 + m * 16) * D + col0 + bj * 128 + n * 16);
#pragma unroll
        for (int ai = 0; ai < 2; ++ai)
#pragma unroll
            for (int m = 0; m < 4; ++m) { const size_t ro = (size_t)(row0 + ai * 128 + m * 16) * D + col0;
#pragma unroll
                for (int bj = 0; bj < 2; ++bj)
#pragma unroll
                    for (int n = 0; n < 2; ++n) { const size_t off = ro + bj * 128 + n * 16; const u32x2 h2 = hb[ai][m][bj][n]; const f32x4 v = acc[ai][bj][m][n];
                        f32x4 o; o.x = v.x + ALPHA * bflo(h2.x); o.y = v.y + ALPHA * bfhi(h2.x); o.z = v.z + ALPHA * bflo(h2.y); o.w = v.w + ALPHA * bfhi(h2.y); *(f32x4*)(PRE + off) = o; } }
    }
};
__device__ __forceinline__ void phase5(const Params& p, LAS unsigned char* lds) {
    unsigned char* ws = p.ws;
    PolP5 P{(const bf16_t*)(ws + WS_YMIX), (const bf16_t*)(ws + WS_WT_OUT), (const bf16_t*)(ws + WS_H0B), p.out, (int)gridDim.x, (int)blockIdx.x};
    pg8::gemm_phase(lds, P, D, (PROBE_GEMM == 5 && blockIdx.x == 0) ? (unsigned long long*)(ws + WS_CTL + 32768) : nullptr);
}

constexpr int P6_TP = 1032;
constexpr int P6_TH = 0, P6_TL = 16 * P6_TP * 2, P6_PART = 2 * 16 * P6_TP * 2, P6_LC = P6_PART + 8 * 16 * 32 * 4, P6_BASE = P6_LC + 128, P6_ENT = P6_BASE + 128, P6_MAXENT = 2048;
__device__ __forceinline__ void phase6(const Params& p, LAS unsigned char* lds, int rep) {
    const int tid = threadIdx.x, lane = tid & 63, wave = tid >> 6, fr = lane & 15, fq = lane >> 4;
    unsigned char* ws = p.ws; unsigned* ctl = (unsigned*)(ws + WS_CTL);
    const bf16_t* WRH = (const bf16_t*)(ws + WS_WRT); const bf16_t* WRL = WRH + NE * D;
    LAS bf16_t* TH = (LAS bf16_t*)(lds + P6_TH); LAS bf16_t* TL = (LAS bf16_t*)(lds + P6_TL); LAS float* PART = (LAS float*)(lds + P6_PART);
    LAS int* LC = (LAS int*)(lds + P6_LC); LAS int* BASE = (LAS int*)(lds + P6_BASE); LAS int* ENT = (LAS int*)(lds + P6_ENT);
    int* LIST = (int*)(ws + WS_LIST); float* RG = (float*)(ws + WS_ROWGATE); int* SEL = (int*)(ws + WS_SEL);
    __syncthreads();
    if (tid < NE) LC[tid] = 0;
    __syncthreads();
    int it = 0;
    for (int tile = blockIdx.x; tile < T / 16; tile += gridDim.x, ++it) {
        const int t0 = tile * 16;
#pragma unroll
        for (int q = 0; q < 2; ++q) { const int tt = 2 * wave + q, t = t0 + tt;
            const f32x4* xr = (const f32x4*)(p.out + (size_t)t * D) + lane; f32x4 v[4];
#pragma unroll
            for (int j = 0; j < 4; ++j) v[j] = xr[64 * j];
            ln_row(v, p.in[18], p.in[19], lane);
            bf16_t* orow = (bf16_t*)(ws + WS_H1B) + (size_t)t * D;
#pragma unroll
            for (int j = 0; j < 4; ++j) { const unsigned h0 = f2bf(v[j].x), h1 = f2bf(v[j].y), h2 = f2bf(v[j].z), h3 = f2bf(v[j].w);
                u32x2 hi; hi.x = h0 | (h1 << 16); hi.y = h2 | (h3 << 16);
                u32x2 lo; lo.x = pk2(v[j].x - bf2f(h0), v[j].y - bf2f(h1)); lo.y = pk2(v[j].z - bf2f(h2), v[j].w - bf2f(h3));
                *(u32x2*)(orow + 4 * lane + 256 * j) = hi;
                *(LAS u32x2*)(TH + tt * P6_TP + 4 * lane + 256 * j) = hi; *(LAS u32x2*)(TL + tt * P6_TP + 4 * lane + 256 * j) = lo; } }
        __syncthreads();
        f32x4 acc0 = (f32x4){0.f, 0.f, 0.f, 0.f}, acc1 = acc0;
#pragma unroll
        for (int ks = 0; ks < 4; ++ks) { const int k0 = 128 * wave + 32 * ks + 8 * fq;
            const bf16x8 ah = *(const LAS bf16x8*)(TH + fr * P6_TP + k0), al = *(const LAS bf16x8*)(TL + fr * P6_TP + k0);
            const bf16x8 bh0 = *(const bf16x8*)(WRH + (size_t)fr * D + k0), bl0 = *(const bf16x8*)(WRL + (size_t)fr * D + k0);
            const bf16x8 bh1 = *(const bf16x8*)(WRH + (size_t)(16 + fr) * D + k0), bl1 = *(const bf16x8*)(WRL + (size_t)(16 + fr) * D + k0);
            acc0 = __builtin_amdgcn_mfma_f32_16x16x32_bf16(ah, bh0, acc0, 0, 0, 0); acc0 = __builtin_amdgcn_mfma_f32_16x16x32_bf16(ah, bl0, acc0, 0, 0, 0); acc0 = __builtin_amdgcn_mfma_f32_16x16x32_bf16(al, bh0, acc0, 0, 0, 0);
            acc1 = __builtin_amdgcn_mfma_f32_16x16x32_bf16(ah, bh1, acc1, 0, 0, 0); acc1 = __builtin_amdgcn_mfma_f32_16x16x32_bf16(ah, bl1, acc1, 0, 0, 0); acc1 = __builtin_amdgcn_mfma_f32_16x16x32_bf16(al, bh1, acc1, 0, 0, 0); }
#pragma unroll
        for (int r = 0; r < 4; ++r) { PART[(wave * 16 + 4 * fq + r) * 32 + fr] = acc0[r]; PART[(wave * 16 + 4 * fq + r) * 32 + 16 + fr] = acc1[r]; }
        __syncthreads();
        const int e = lane & 31, tt = 2 * wave + (lane >> 5), t = t0 + tt;
        float logit = p.in[21][e];
#pragma unroll
        for (int v = 0; v < 8; ++v) logit += PART[(v * 16 + tt) * 32 + e];
        float cur = logit; float tv0 = 0.f, tv1 = 0.f, tv2 = 0.f, tv3 = 0.f; int te0 = 0, te1 = 0, te2 = 0, te3 = 0;
#pragma unroll
        for (int k = 0; k < 4; ++k) { float bv = cur; int bi = e;
#pragma unroll
            for (int o = 1; o < 32; o <<= 1) { const float ov = __shfl_xor(bv, o); const int oi = __shfl_xor(bi, o); if (ov > bv || (ov == bv && oi < bi)) { bv = ov; bi = oi; } }
            if (k == 0) { tv0 = bv; te0 = bi; } if (k == 1) { tv1 = bv; te1 = bi; } if (k == 2) { tv2 = bv; te2 = bi; } if (k == 3) { tv3 = bv; te3 = bi; }
            if (e == bi) cur = -3.0e38f; }
        const float e1 = __expf(tv1 - tv0), e2 = __expf(tv2 - tv0), e3 = __expf(tv3 - tv0); const float inv = 1.f / (1.f + e1 + e2 + e3);
        if (e < 4) { int ee = te0; float gg = inv;
            if (e == 1) { ee = te1; gg = e1 * inv; } if (e == 2) { ee = te2; gg = e2 * inv; } if (e == 3) { ee = te3; gg = e3 * inv; }
            const int lr = __hip_atomic_fetch_add((int*)(LC + ee), 1, __ATOMIC_RELAXED, __HIP_MEMORY_SCOPE_WORKGROUP); const int n = (it * 16 + tt) * 4 + e;
            if (n < P6_MAXENT) { ENT[4 * n] = t * 4 + e; ENT[4 * n + 1] = ee; ENT[4 * n + 2] = lr; ENT[4 * n + 3] = __builtin_bit_cast(int, gg); } }
    }
    __syncthreads();
    if (tid < NE) BASE[tid] = (int)atomicAdd(ctl + CW_CNT + 32 * rep + tid, (unsigned)LC[tid]);
    __syncthreads();
    const int nent = it * 64 < P6_MAXENT ? it * 64 : P6_MAXENT;
    for (int n = tid; n < nent; n += NTHR) { const int tk = ENT[4 * n], ee = ENT[4 * n + 1], rank = BASE[ee] + ENT[4 * n + 2];
        LIST[(size_t)ee * T + rank] = tk >> 2; RG[(size_t)ee * T + rank] = __builtin_bit_cast(float, ENT[4 * n + 3]); SEL[(size_t)tk * 2] = ee; SEL[(size_t)tk * 2 + 1] = rank; }
}

__device__ __forceinline__ void build_expert_tables(const Params& p, LAS int* tab) {
    const unsigned* ctl = (const unsigned*)(p.ws + WS_CTL);
    __syncthreads();
    if (threadIdx.x < NE) tab[threadIdx.x] = (int)__hip_atomic_load(ctl + CW_CNT + CNT_SET + threadIdx.x, __ATOMIC_RELAXED, __HIP_MEMORY_SCOPE_AGENT);
    __syncthreads();
    if (threadIdx.x == 0) { int ps = 0, ts = 0;
        for (int e = 0; e < NE; ++e) { const int c = tab[e]; tab[32 + e] = ps; tab[64 + e] = ts; ps += (c + 255) / 256 * 256; ts += (c + 127) / 128; }
        tab[64 + NE] = ts; }
    __syncthreads();
}

constexpr int TAB_OFF = 131072, UTAB_OFF = 100, UTAB_MAX = 48;
constexpr int IDX_OFF = 131072 + 2048, IDX_UNITS = 20;
__device__ __forceinline__ void build_expert_tables256(const Params& p, LAS int* tab, int npn  ) {
    const unsigned* ctl = (const unsigned*)(p.ws + WS_CTL);
    __syncthreads();
    if (threadIdx.x < NE) tab[threadIdx.x] = (int)__hip_atomic_load(ctl + CW_CNT + CNT_SET + threadIdx.x, __ATOMIC_RELAXED, __HIP_MEMORY_SCOPE_AGENT);
    __syncthreads();
    if (threadIdx.x == 0) { int ps = 0, ts = 0;
        for (int e = 0; e < NE; ++e) { const int c = tab[e]; tab[32 + e] = ps; tab[64 + e] = ts; ps += (c + 255) / 256 * 256; ts += (c + 255) / 256; }
        tab[64 + NE] = ts;
        int e = 0, n = 0;
        if (gridDim.x == 256) { const int g = blockIdx.x & 7, sl = blockIdx.x >> 3, mpx = 32 / npn  , mround = 8 * mpx;
            for (int i = 0; n < UTAB_MAX; ++i) { const int mt_g = i * mround + g * mpx + sl / npn, pn = sl % npn; if (i * mround >= ts) break; if (mt_g >= ts) continue;
                while (e + 1 < NE && mt_g >= tab[64 + e + 1]) ++e;
                const int r0 = (mt_g - tab[64 + e]) * 256;
                tab[UTAB_OFF + 4 * n] = e; tab[UTAB_OFF + 4 * n + 1] = r0; tab[UTAB_OFF + 4 * n + 2] = pn; tab[UTAB_OFF + 4 * n + 3] = tab[32 + e] + r0; ++n; }
        } else { const int nun = ts * npn;
        for (int L = blockIdx.x; L < nun && n < UTAB_MAX; L += gridDim.x, ++n) { const int pn = L % npn, mt_g = L / npn;
            while (e + 1 < NE && mt_g >= tab[64 + e + 1]) ++e;
            const int r0 = (mt_g - tab[64 + e]) * 256;
            tab[UTAB_OFF + 4 * n] = e; tab[UTAB_OFF + 4 * n + 1] = r0; tab[UTAB_OFF + 4 * n + 2] = pn; tab[UTAB_OFF + 4 * n + 3] = tab[32 + e] + r0; } }
        tab[98] = n; }
    __syncthreads();
}
struct PolP7 {
    static constexpr bool PERM = true, GATHER = true;
    const bf16_t* H1B; const bf16_t* WG; const LAS int* IDX; bf16_t* ACT; const float* BGU; const LAS int* tab; int G, c;
    __device__ __forceinline__ bool next(int i, pg8::Unit& u) const { if (i >= __builtin_amdgcn_readfirstlane(tab[98])) return false;
        const int e = __builtin_amdgcn_readfirstlane(tab[UTAB_OFF + 4 * i]), r0 = __builtin_amdgcn_readfirstlane(tab[UTAB_OFF + 4 * i + 1]), pn = __builtin_amdgcn_readfirstlane(tab[UTAB_OFF + 4 * i + 2]);
        u.A = (const char*)H1B; u.B0 = (const char*)(WG + ((size_t)e * 2 * FF + pn * 128) * D); u.B1 = u.B0 + (size_t)FF * D * 2;
        u.x0 = e; u.x1 = i; u.x2 = pn; u.x3 = __builtin_amdgcn_readfirstlane(tab[UTAB_OFF + 4 * i + 3]); u.x4 = __builtin_amdgcn_readfirstlane(tab[e]) - r0; return true; }
    __device__ __forceinline__ void rows_issue(const pg8::Unit& u, int R0, unsigned (&raw)[2][2]) const { const LAS int* lst = IDX + u.x1 * 256 + R0;
#pragma unroll
        for (int h = 0; h < 2; ++h)
#pragma unroll
            for (int i = 0; i < 2; ++i) raw[h][i] = (unsigned)lst[h * 128 + i * 64]; }
    __device__ __forceinline__ void rows_finish(int C0, int K, unsigned (&raw)[2][2]) const {
#pragma unroll
        for (int h = 0; h < 2; ++h)
#pragma unroll
            for (int i = 0; i < 2; ++i) raw[h][i] = (raw[h][i] * (unsigned)K + (unsigned)C0) * 2u; }
    __device__ __forceinline__ void epi(const f32x4 (&acc)[2][2][4][2], const pg8::Unit& u, int wr, int wc, int fr, int fq) const {
        const int e = u.x0, f0 = u.x2 * 128 + wc * 32 + 8 * fq;
        const float* bias = BGU + (size_t)e * 2 * FF + f0;
        const f32x4 bg0 = *(const f32x4*)bias, bg1 = *(const f32x4*)(bias + 4), bu0 = *(const f32x4*)(bias + FF), bu1 = *(const f32x4*)(bias + FF + 4);
#pragma unroll
        for (int ai = 0; ai < 2; ++ai)
#pragma unroll
            for (int m = 0; m < 4; ++m) { const int r = ai * 128 + wr * 64 + m * 16 + fr;
                const f32x4 g0 = acc[ai][0][m][0] + bg0, g1 = acc[ai][0][m][1] + bg1, u0 = acc[ai][1][m][0] + bu0, u1 = acc[ai][1][m][1] + bu1;
                float a[8];
#pragma unroll
                for (int j = 0; j < 4; ++j) {
                    const float gc = fminf(g0[j], 7.f), uc = __builtin_amdgcn_fmed3f(u0[j], -7.f, 7.f);
                    a[j] = __builtin_fmaf(uc, gc, gc) * __builtin_amdgcn_rcpf(1.f + __builtin_amdgcn_exp2f(-2.4554669595930157f * gc));
                    const float gd = fminf(g1[j], 7.f), ud = __builtin_amdgcn_fmed3f(u1[j], -7.f, 7.f);
                    a[4 + j] = __builtin_fmaf(ud, gd, gd) * __builtin_amdgcn_rcpf(1.f + __builtin_amdgcn_exp2f(-2.4554669595930157f * gd)); }
                { u32x4 w; w.x = pg8::cvt_pk_bf16(a[0], a[1]); w.y = pg8::cvt_pk_bf16(a[2], a[3]); w.z = pg8::cvt_pk_bf16(a[4], a[5]); w.w = pg8::cvt_pk_bf16(a[6], a[7]);
                    *(u32x4*)(ACT + (size_t)(u.x3 + r) * FF + f0) = w; } }
    }
};
__device__ __forceinline__ void phase7(const Params& p, LAS unsigned char* lds) {
    LAS int* tab = (LAS int*)(lds + TAB_OFF); build_expert_tables256(p, tab, 8);
    unsigned char* ws = p.ws;
    LAS int* IDX = (LAS int*)(lds + IDX_OFF);
    { const int* LIST = (const int*)(ws + WS_LIST); const int nun = tab[98] < IDX_UNITS ? tab[98] : IDX_UNITS;
      for (int j = threadIdx.x; j < nun * 256; j += NTHR) { const int n = j >> 8, i = j & 255, e = tab[UTAB_OFF + 4 * n], r0 = tab[UTAB_OFF + 4 * n + 1], nval = tab[e] - r0;
          IDX[j] = LIST[(size_t)e * T + r0 + (i < nval ? i : 0)]; }
      __syncthreads(); }
    PolP7 P{(const bf16_t*)(ws + WS_H1B), (const bf16_t*)(ws + WS_WT_GU), IDX, (bf16_t*)(ws + WS_ACT), p.in[23], tab, (int)gridDim.x, (int)blockIdx.x};
    pg8::gemm_phase(lds, P, D, (PROBE_GEMM == 7 && blockIdx.x == 0) ? (unsigned long long*)(ws + WS_CTL + 32768) : nullptr);
}

struct PolP8 {
    static constexpr bool PERM = true, GATHER = false;
    const bf16_t* ACT; const bf16_t* WD; const float* RG; bf16_t* YR; const float* BD; const LAS int* tab; int G, c;
    __device__ __forceinline__ bool next(int i, pg8::Unit& u) const { if (i >= __builtin_amdgcn_readfirstlane(tab[98])) return false;
        const int e = __builtin_amdgcn_readfirstlane(tab[UTAB_OFF + 4 * i]), r0 = __builtin_amdgcn_readfirstlane(tab[UTAB_OFF + 4 * i + 1]), pn = __builtin_amdgcn_readfirstlane(tab[UTAB_OFF + 4 * i + 2]), prow0 = __builtin_amdgcn_readfirstlane(tab[UTAB_OFF + 4 * i + 3]);
        u.A = (const char*)(ACT + (size_t)prow0 * FF); u.B0 = (const char*)(WD + ((size_t)e * D + pn * 256) * FF); u.B1 = u.B0 + (size_t)128 * FF * 2;
        u.x4 = __builtin_amdgcn_readfirstlane(tab[e]) - r0;
        u.x0 = e; u.x1 = r0; u.x2 = pn; u.x3 = prow0; return true; }
    __device__ __forceinline__ void epi(const f32x4 (&acc)[2][2][4][2], const pg8::Unit& u, int wr, int wc, int fr, int fq) const {
        const int e = u.x0, nval = u.x4; const float* rg = RG + (size_t)e * T + u.x1;
        float gt[2][4];
#pragma unroll
        for (int ai = 0; ai < 2; ++ai)
#pragma unroll
            for (int m = 0; m < 4; ++m) { const int r = ai * 128 + wr * 64 + m * 16 + fr; gt[ai][m] = rg[r < nval ? r : 0]; }
        f32x4 bs[2][2];
#pragma unroll
        for (int bj = 0; bj < 2; ++bj) { const float* bias = BD + (size_t)e * D + u.x2 * 256 + bj * 128 + wc * 32 + 8 * fq; bs[bj][0] = *(const f32x4*)bias; bs[bj][1] = *(const f32x4*)(bias + 4); }
#pragma unroll
        for (int ai = 0; ai < 2; ++ai)
#pragma unroll
            for (int m = 0; m < 4; ++m) { const int r = ai * 128 + wr * 64 + m * 16 + fr; const float g = gt[ai][m];
#pragma unroll
                for (int bj = 0; bj < 2; ++bj) { const int col = u.x2 * 256 + bj * 128 + wc * 32 + 8 * fq;
                    const f32x4 v0 = (acc[ai][bj][m][0] + bs[bj][0]) * g, v1 = (acc[ai][bj][m][1] + bs[bj][1]) * g;
                    u32x4 w; w.x = pg8::cvt_pk_bf16(v0[0], v0[1]); w.y = pg8::cvt_pk_bf16(v0[2], v0[3]); w.z = pg8::cvt_pk_bf16(v1[0], v1[1]); w.w = pg8::cvt_pk_bf16(v1[2], v1[3]);
                    *(u32x4*)(YR + (size_t)(u.x3 + r) * D + col) = w; } }
    }
};
__device__ __forceinline__ void phase8(const Params& p, LAS unsigned char* lds) {
    LAS int* tab = (LAS int*)(lds + TAB_OFF); build_expert_tables256(p, tab, 4);
    unsigned char* ws = p.ws;
    PolP8 P{(const bf16_t*)(ws + WS_ACT), (const bf16_t*)(ws + WS_WT_DN), (const float*)(ws + WS_ROWGATE), (bf16_t*)(ws + WS_YROWS), p.in[25], tab, (int)gridDim.x, (int)blockIdx.x};
    pg8::gemm_phase(lds, P, FF, (PROBE_GEMM == 8 && blockIdx.x == 0) ? (unsigned long long*)(ws + WS_CTL + 32768) : nullptr);
}

__device__ __forceinline__ void phase9(const Params& p, LAS unsigned char* lds) {
    LAS int* tab = (LAS int*)lds; build_expert_tables(p, tab);
    const int tid = threadIdx.x, lane = tid & 63, wave = tid >> 6;
    const int gw = blockIdx.x * NWAVES + wave, NGW = gridDim.x * NWAVES;
    unsigned char* ws = p.ws; const bf16_t* H1B = (const bf16_t*)(ws + WS_H1B); const bf16_t* YR = (const bf16_t*)(ws + WS_YROWS); const int* SEL = (const int*)(ws + WS_SEL);
    typedef int i32x4 __attribute__((ext_vector_type(4)));
    i32x4 sa = {0, 0, 0, 0}, sb = sa;
    if (gw < T) { sa = *(const i32x4*)(SEL + (size_t)gw * 8); sb = *(const i32x4*)(SEL + (size_t)gw * 8 + 4); }
    for (int t = gw; t < T; t += NGW) {
        const i32x4 ca = sa, cb = sb;
        if (t + NGW < T) { sa = *(const i32x4*)(SEL + (size_t)(t + NGW) * 8); sb = *(const i32x4*)(SEL + (size_t)(t + NGW) * 8 + 4); }
        const bf16_t* y0 = YR + (size_t)(tab[32 + ca.x] + ca.y) * D + 4 * lane; const bf16_t* y1 = YR + (size_t)(tab[32 + ca.z] + ca.w) * D + 4 * lane;
        const bf16_t* y2 = YR + (size_t)(tab[32 + cb.x] + cb.y) * D + 4 * lane; const bf16_t* y3 = YR + (size_t)(tab[32 + cb.z] + cb.w) * D + 4 * lane;
        const bf16_t* hr = H1B + (size_t)t * D + 4 * lane;
        u32x2 hb[4], q0[4], q1[4], q2[4], q3[4];
#pragma unroll
        for (int j = 0; j < 4; ++j) { hb[j] = *(const u32x2*)(hr + 256 * j); q0[j] = *(const u32x2*)(y0 + 256 * j); q1[j] = *(const u32x2*)(y1 + 256 * j); q2[j] = *(const u32x2*)(y2 + 256 * j); q3[j] = *(const u32x2*)(y3 + 256 * j); }
        f32x4 v[4];
#pragma unroll
        for (int j = 0; j < 4; ++j) {
            v[j].x = ALPHA * bflo(hb[j].x) + ((bflo(q0[j].x) + bflo(q1[j].x)) + (bflo(q2[j].x) + bflo(q3[j].x)));
            v[j].y = ALPHA * bfhi(hb[j].x) + ((bfhi(q0[j].x) + bfhi(q1[j].x)) + (bfhi(q2[j].x) + bfhi(q3[j].x)));
            v[j].z = ALPHA * bflo(hb[j].y) + ((bflo(q0[j].y) + bflo(q1[j].y)) + (bflo(q2[j].y) + bflo(q3[j].y)));
            v[j].w = ALPHA * bfhi(hb[j].y) + ((bfhi(q0[j].y) + bfhi(q1[j].y)) + (bfhi(q2[j].y) + bfhi(q3[j].y))); }
        ln_row(v, p.in[26], p.in[27], lane);
        f32x4* orow = (f32x4*)(p.out + (size_t)t * D) + lane;
#pragma unroll
        for (int j = 0; j < 4; ++j) orow[64 * j] = v[j];
    }
}

#define XB_TMO      128
#define XB_XCNT(j)  (256  + 64 * (j))
#define XB_XSUB(j)  (1280 + 64 * (j))
#define XB_XGEN(j)  (2304 + 64 * (j))
#define XB_TOP      3328
#define XB_TOPGEN   3392
#define XCD_BAR_WORDS 3456
#define XB_SPIN_CAP (1u << 22)
__device__ __forceinline__ unsigned xb_ld(unsigned* p)              { return __hip_atomic_load(p, __ATOMIC_RELAXED, __HIP_MEMORY_SCOPE_AGENT); }
__device__ __forceinline__ unsigned xb_add(unsigned* p, unsigned v) { return __hip_atomic_fetch_add(p, v, __ATOMIC_RELAXED, __HIP_MEMORY_SCOPE_AGENT); }
__device__ __forceinline__ unsigned xb_xcc_id() { return (unsigned)__builtin_amdgcn_s_getreg((3 << 11) | 20) & 0xFu; }
#define XB_SPIN(cond, bar) do { unsigned _sp = 0; while (cond) { __builtin_amdgcn_s_sleep(1); \
    if ((++_sp & 255u) == 0u) { if (xb_ld(&(bar)[XB_TMO])) break; if (_sp > XB_SPIN_CAP) { atomicAdd(&(bar)[XB_TMO], 1u); break; } } } } while (0)
struct XcdBarrier { unsigned* bar; unsigned x; volatile LAS unsigned* st; };
__device__ __forceinline__ XcdBarrier xcd_barrier_post(unsigned* bar, volatile LAS unsigned* st) {
    XcdBarrier b; b.bar = bar; b.x = xb_xcc_id(); b.st = st;
    if (threadIdx.x == 0) (void)xb_add(&bar[XB_XCNT(b.x)], 1u);
    return b;
}
__device__ __forceinline__ void xcd_barrier_complete(unsigned* bar, unsigned x, unsigned& nloc, unsigned& nx) {
    const unsigned G = gridDim.x * gridDim.y * gridDim.z;
    unsigned sum, cnt, mine, sp = 0u;
    for (;;) {
        sum = 0u; cnt = 0u; mine = 0u;
#pragma unroll
        for (unsigned j = 0; j < 16; ++j) { const unsigned c = xb_ld(&bar[XB_XCNT(j)]); sum += c; cnt += (c > 0u) ? 1u : 0u; mine = (j == x) ? c : mine; }
        if (sum == G) break;
        __builtin_amdgcn_s_sleep(1);
        if ((++sp & 255u) == 0u) { if (xb_ld(&bar[XB_TMO])) break; if (sp > XB_SPIN_CAP) { atomicAdd(&bar[XB_TMO], 1u); break; } }
    }
    nloc = mine > 0u ? mine : 1u; nx = cnt > 0u ? cnt : 1u;
}
__device__ __forceinline__ void xcd_barrier(const XcdBarrier& b) {
    asm volatile("s_waitcnt vmcnt(0)" ::: "memory");
    __syncthreads();
    if (threadIdx.x == 0) {
        unsigned* bar = b.bar;
        __builtin_amdgcn_s_waitcnt(0);
        unsigned nloc = b.st[0], nx = b.st[1];
        if (nloc == 0u) { xcd_barrier_complete(bar, b.x, nloc, nx); b.st[0] = nloc; b.st[1] = nx; }
        const unsigned old = xb_add(&bar[XB_XSUB(b.x)], 1u);
        const unsigned gen = old / nloc;
        if (old + 1u == (gen + 1u) * nloc) {
            __builtin_amdgcn_fence(__ATOMIC_RELEASE, "agent");
            asm volatile("s_waitcnt vmcnt(0)" ::: "memory");
            const unsigned og = xb_add(&bar[XB_TOP], 1u);
            const unsigned tg = og / nx;
            if (og + 1u == (tg + 1u) * nx) xb_add(&bar[XB_TOPGEN], 1u);
            else XB_SPIN(xb_ld(&bar[XB_TOPGEN]) == tg, bar);
            __builtin_amdgcn_fence(__ATOMIC_ACQUIRE, "agent");
            xb_add(&bar[XB_XGEN(b.x)], 1u);
            asm volatile("s_waitcnt vmcnt(0)" ::: "memory");
        } else {
            XB_SPIN(xb_ld(&bar[XB_XGEN(b.x)]) == gen, bar);
            __builtin_amdgcn_fence(__ATOMIC_ACQUIRE, "agent");
            asm volatile("s_waitcnt vmcnt(0)" ::: "memory");
        }
    }
    __syncthreads();
}

constexpr int NPHASE = 10;
constexpr int LDS_BYTES = 131072 + 2048 + IDX_UNITS * 1024;
__global__ void __launch_bounds__(NTHR, 2) mk_fwd(Params p) {
    extern __shared__ __attribute__((aligned(16))) unsigned char lds_raw[];
    LAS unsigned char* lds = (LAS unsigned char*)lds_raw;
    const int lo = p.ph_lo, hi = p.ph_hi;
    volatile LAS unsigned* barst = (volatile LAS unsigned*)(lds + BARST_OFF);
    if (threadIdx.x < 2) barst[threadIdx.x] = 0u;
    __syncthreads();
    XcdBarrier xbar; xbar.bar = (unsigned*)(p.ws + WS_CTL) + CW_BAR; xbar.x = xb_xcc_id(); xbar.st = barst;
    if (MK_ONE_LAUNCH && blockIdx.x == 0 && lo == 0) { u32x4* z = (u32x4*)(p.ws + WS_CTL); for (int i = threadIdx.x; i < CTL_ZERO_BYTES / 16; i += NTHR) z[i] = (u32x4){0u, 0u, 0u, 0u}; }
#ifdef ONLY_PHASE
#define IN(k) ((k) == ONLY_PHASE && lo <= (k) && (k) < hi)
#else
#define IN(k) (lo <= (k) && (k) < hi)
#endif
#define SEAM(k) do { if (IN(k) && IN((k) + 1)) { if ((k) == 0) { cg::this_grid().sync(); if (threadIdx.x == 0) (void)xb_add(&xbar.bar[XB_XCNT(xbar.x)], 1u); } else xcd_barrier(xbar); } if (PROBE_TS == (k)) ts1 = __builtin_amdgcn_s_memrealtime(); } while (0)
#define RUN(k, call) do { if (IN(k)) { if (PROBE_TS == (k)) ts0 = __builtin_amdgcn_s_memrealtime(); call; if (REPEAT_PHASE == (k)) { cg::this_grid().sync(); call; } } } while (0)
    unsigned long long ts0 = 0, ts1 = 0;
    { int rep = 0;
    RUN(0, phase0(p, lds));
    SEAM(0);
    RUN(1, phase1(p, lds));
    SEAM(1);
    RUN(2, phase2(p, lds));
    SEAM(2);
    if (IN(3)) { const int nrep = (REPEAT_PHASE == 3) ? 2 : 1; if (PROBE_TS == 3) ts0 = __builtin_amdgcn_s_memrealtime();
#pragma unroll 1
        for (rep = 0; rep < nrep; ++rep) { if (rep) cg::this_grid().sync(); phase3(p, lds, rep); } }
    SEAM(3);
    RUN(4, phase4(p));
    SEAM(4);
    RUN(5, phase5(p, lds));
    SEAM(5);
    rep = 0; RUN(6, (phase6(p, lds, rep), ++rep));
    SEAM(6);
    RUN(7, phase7(p, lds));
    SEAM(7);
    RUN(8, phase8(p, lds));
    SEAM(8);
    RUN(9, phase9(p, lds));
    if (PROBE_TS == 9) ts1 = __builtin_amdgcn_s_memrealtime();
    if (PROBE_GEMM >= 0 && blockIdx.x == 0) { __syncthreads(); if (threadIdx.x == 0) p.out[0] += (float)(((const unsigned long long*)(p.ws + WS_CTL + 32768))[PROBE_PART]) * 1e-4f; }
    if (PROBE_TS >= 0 && blockIdx.x == 0 && threadIdx.x == 0) p.out[0] += (float)(ts1 - ts0) * 1e-4f;
    }
#undef RUN
#undef IN
#undef SEAM
}

extern "C" void kernel_launch(void* const* d_in, const int* in_sizes, int n_in, void* d_out, int out_size, void* d_ws, size_t ws_size, hipStream_t stream) {
    static int grid = 0;
    if (grid == 0) {
        if (n_in != 28 || out_size != T * D || ws_size < WS_END) { fprintf(stderr, "kernel_launch: unexpected shapes: n_in %d out %d ws %zu (need %zu)\n", n_in, out_size, ws_size, (size_t)WS_END); grid = -1; return; }
        int dev = 0, cus = 0, per_cu = 0;
        hipGetDevice(&dev); hipDeviceGetAttribute(&cus, hipDeviceAttributeMultiprocessorCount, dev);
        hipFuncSetAttribute((const void*)mk_fwd, hipFuncAttributeMaxDynamicSharedMemorySize, LDS_BYTES);
        hipOccupancyMaxActiveBlocksPerMultiprocessor(&per_cu, (const void*)mk_fwd, NTHR, LDS_BYTES);
        (void)hipGetLastError();
        if (per_cu < 1) { fprintf(stderr, "kernel_launch: occupancy query says %d blocks per CU\n", per_cu); per_cu = 1; }
        grid = cus;
    }
    if (grid < 0) return;
#if !MK_ONE_LAUNCH
    hipMemsetAsync((char*)d_ws + WS_CTL, 0, CTL_ZERO_BYTES, stream);
#endif
    Params p{};
    for (int i = 0; i < 28; ++i) p.in[i] = (const float*)d_in[i];
    p.out = (float*)d_out; p.ws = (unsigned char*)d_ws;
#if MK_ONE_LAUNCH
    p.ph_lo = 0; p.ph_hi = NPHASE;
    void* args[] = {&p};
    hipError_t e = hipLaunchCooperativeKernel((const void*)mk_fwd, dim3(grid), dim3(NTHR), args, LDS_BYTES, stream);
    if (e != hipSuccess) fprintf(stderr, "cooperative launch failed: %s (grid %d)\n", hipGetErrorString(e), grid);
#else
    for (int ph = 0; ph < NPHASE; ++ph) { p.ph_lo = ph; p.ph_hi = ph + 1; hipLaunchKernelGGL(mk_fwd, dim3(grid), dim3(NTHR), LDS_BYTES, stream, p); }
#endif
}
```

```cpp
#include <hip/hip_runtime.h>
#include <hip/hip_cooperative_groups.h>
#include <cstdio>
#include <cstdint>
namespace cg = cooperative_groups;

#ifndef REPEAT_PHASE
#define REPEAT_PHASE -1
#endif
#ifndef PROBE_TS
#define PROBE_TS -1
#endif
#ifndef PROBE_GEMM
#define PROBE_GEMM -1
#endif
#ifndef PROBE_PART
#define PROBE_PART 0
#endif
#ifndef MK_ONE_LAUNCH
#define MK_ONE_LAUNCH 1
#endif

typedef unsigned short bf16_t;
typedef short bf16x8 __attribute__((ext_vector_type(8)));
typedef short bf16x4 __attribute__((ext_vector_type(4)));
typedef float f32x4 __attribute__((ext_vector_type(4)));
typedef float f32x2 __attribute__((ext_vector_type(2)));
typedef unsigned u32x4 __attribute__((ext_vector_type(4)));
typedef unsigned u32x2 __attribute__((ext_vector_type(2)));

constexpr int D = 1024, BATCH = 16, SEQ = 2048, T = BATCH * SEQ;
constexpr int NMEM = 256, HD = 64;
constexpr int RH = 6, RC = 384;
constexpr int RWKV_IN = 1344;
constexpr int AH = 6, AW = 384, MH = 4, MW = 256;
constexpr int IN_W = 2752, IN_WP = 2816;
constexpr int PA_W = IN_WP - RWKV_IN;
constexpr int NE = 32, TOPK = 4, FF = 1024;
constexpr float LN_EPS = 1e-5f, GN_EPS = 64e-5f;
constexpr float ALPHA = 1.189207115002721f;
constexpr int NTHR = 512, NWAVES = 8;

constexpr size_t MiB = 1u << 20;
constexpr size_t WS_CTL = 0;
constexpr size_t WS_WT_IN = 1 * MiB;
constexpr size_t WS_LORA = 6 * MiB + 512 * 1024;
constexpr size_t WS_WT_OUT = 7 * MiB;
constexpr size_t WS_WT_KV = 9 * MiB;
constexpr size_t WS_KVM = 10 * MiB;
constexpr size_t WS_MEMB = 14 * MiB;
constexpr size_t WS_LIST = 22 * MiB;
constexpr size_t WS_ROWGATE = 26 * MiB;
constexpr size_t WS_SEL = 30 * MiB;
constexpr size_t WS_BONUS = 31 * MiB;
constexpr size_t WS_WRT = 31 * MiB + 800 * 1024;
constexpr size_t WS_WT_GU = 32 * MiB;
constexpr size_t WS_WT_DN = 160 * MiB;
constexpr size_t WS_H0B = 224 * MiB;
constexpr size_t WS_H1B = 288 * MiB;
constexpr size_t WS_YMIX = 352 * MiB;
constexpr size_t WS_PR = 416 * MiB;
constexpr size_t WS_ATTO = 416 * MiB;
constexpr size_t WS_PA = 500 * MiB;
constexpr size_t WS_SSH = 592 * MiB;
constexpr size_t WS_SDIR = 736 * MiB;
constexpr size_t WS_ACT = 352 * MiB;
constexpr size_t WS_YROWS = 624 * MiB;
constexpr size_t WS_END = 1024 * MiB;
constexpr size_t DO_Y = 0, DO_G = 96 * MiB, DO_LSE = 120 * MiB;
constexpr int ROWS_PAD = T * TOPK + NE * 256;

constexpr int CW_CNT = 0;
constexpr int CNT_SET = (REPEAT_PHASE == 6) ? 32 : 0;
constexpr int CW_ATTQ = 64;
constexpr int CW_SCANQ = 128;
constexpr int CW_BAR = 4096;
constexpr int CTL_ZERO_BYTES = 65536;
constexpr int BARST_OFF = 131072 + 1536;

#define LAS __attribute__((address_space(3)))

struct Params { const float* in[28]; float* out; unsigned char* ws; int ph_lo, ph_hi; };

__device__ __forceinline__ unsigned f2bf(float f) { unsigned u = __builtin_bit_cast(unsigned, f); return (u + 0x7fffu + ((u >> 16) & 1u)) >> 16; }
__device__ __forceinline__ unsigned pk2(float lo, float hi) { return f2bf(lo) | (f2bf(hi) << 16); }
__device__ __forceinline__ float bf2f(unsigned b) { return __builtin_bit_cast(float, b << 16); }
__device__ __forceinline__ float bflo(unsigned w) { return __builtin_bit_cast(float, w << 16); }
__device__ __forceinline__ float bfhi(unsigned w) { return __builtin_bit_cast(float, w & 0xffff0000u); }
template <int CTRL> __device__ __forceinline__ float dpp_mov(float v) {
    return __builtin_bit_cast(float, __builtin_amdgcn_update_dpp(0, __builtin_bit_cast(int, v), CTRL, 0xF, 0xF, true));
}
__device__ __forceinline__ float sum16(float v) {
    v += dpp_mov<0xB1>(v);
    v += dpp_mov<0x4E>(v);
    v += dpp_mov<0x141>(v);
    v += dpp_mov<0x140>(v);
    return v;
}
__device__ __forceinline__ float wave_sum(float v) {
    v = sum16(v);
    const int iv = __builtin_bit_cast(int, v);
    const float a = __builtin_bit_cast(float, __builtin_amdgcn_readlane(iv, 0)), b = __builtin_bit_cast(float, __builtin_amdgcn_readlane(iv, 16));
    const float c = __builtin_bit_cast(float, __builtin_amdgcn_readlane(iv, 32)), d = __builtin_bit_cast(float, __builtin_amdgcn_readlane(iv, 48));
    return (a + b) + (c + d);
}
__device__ __forceinline__ float sigmoidf_(float x) { return 1.f / (1.f + __expf(-x)); }

struct P0Item { const float* W; bf16_t* WT; int K, N, item; };
__device__ __forceinline__ void p0_item_load(const P0Item& I, float (&reg)[32], int lane) {
    const int nblk = I.N / 32, kb = I.item / nblk, nb = I.item % nblk, k0 = 64 * kb, n0 = 32 * nb;
    const float* src = I.W + (size_t)(k0 + (lane >> 5)) * I.N + n0 + (lane & 31);
#pragma unroll
    for (int i = 0; i < 32; ++i) reg[i] = src[(size_t)(2 * i) * I.N];
}
__device__ __forceinline__ void p0_item_store(const P0Item& I, const float (&reg)[32], LAS float* scr, int lane) {
    const int nblk = I.N / 32, kb = I.item / nblk, nb = I.item % nblk, k0 = 64 * kb, n0 = 32 * nb;
#pragma unroll
    for (int i = 0; i < 32; ++i) scr[(2 * i + (lane >> 5)) * 33 + (lane & 31)] = reg[i];
    asm volatile("s_waitcnt lgkmcnt(0)" ::: "memory");
    const int c = lane & 7;
#pragma unroll
    for (int j = 0; j < 4; ++j) { const int n = (lane >> 3) + 8 * j; const LAS float* s = scr + (8 * c) * 33 + n;
        u32x4 o; o.x = pk2(s[0 * 33], s[1 * 33]); o.y = pk2(s[2 * 33], s[3 * 33]); o.z = pk2(s[4 * 33], s[5 * 33]); o.w = pk2(s[6 * 33], s[7 * 33]);
        *(u32x4*)(I.WT + (size_t)(n0 + n) * I.K + k0 + 8 * c) = o; }
    asm volatile("s_waitcnt lgkmcnt(0)" ::: "memory");
}
__device__ __forceinline__ void ln_row(f32x4 (&v)[4], const float* __restrict__ g, const float* __restrict__ b, int lane) {
    float s = 0.f;
#pragma unroll
    for (int j = 0; j < 4; ++j) s += (v[j].x + v[j].y) + (v[j].z + v[j].w);
    const float mean = wave_sum(s) * (1.f / D); float s2 = 0.f;
#pragma unroll
    for (int j = 0; j < 4; ++j) { v[j] = v[j] - mean; s2 += (v[j].x * v[j].x + v[j].y * v[j].y) + (v[j].z * v[j].z + v[j].w * v[j].w); }
    const float rstd = 1.f / sqrtf(wave_sum(s2) * (1.f / D) + LN_EPS);
#pragma unroll
    for (int j = 0; j < 4; ++j) { const f32x4 gg = *(const f32x4*)(g + 4 * lane + 256 * j), bb = *(const f32x4*)(b + 4 * lane + 256 * j); v[j] = v[j] * rstd * gg + bb; }
}
__device__ __forceinline__ void store_row_bf16(bf16_t* orow, const f32x4 (&v)[4], int lane) {
#pragma unroll
    for (int j = 0; j < 4; ++j) { u32x2 o; o.x = pk2(v[j].x, v[j].y); o.y = pk2(v[j].z, v[j].w); *(u32x2*)(orow + 4 * lane + 256 * j) = o; }
}

__device__ __forceinline__ void phase0(const Params& p, LAS unsigned char* lds) {
    const int tid = threadIdx.x, lane = tid & 63, wave = tid >> 6;
    const int gw = blockIdx.x * NWAVES + wave, NGW = gridDim.x * NWAVES;
    LAS float* scr = (LAS float*)(lds + wave * 16384);
    unsigned char* ws = p.ws;
    constexpr int I_IN = 16 * (IN_W / 32), I_OUT = 16 * 32, I_KV = 16 * 16, I_GU = 16 * 64, I_DN = 16 * 32;
    constexpr int NITEMS = I_IN + I_OUT + I_KV + NE * I_GU + NE * I_DN;
    auto mk = [&](int it) { P0Item I; int r = it;
        if (r < I_IN) { I.W = p.in[4]; I.WT = (bf16_t*)(ws + WS_WT_IN); I.K = D; I.N = IN_W; I.item = r; return I; } r -= I_IN;
        if (r < I_OUT) { I.W = p.in[17]; I.WT = (bf16_t*)(ws + WS_WT_OUT); I.K = D; I.N = D; I.item = r; return I; } r -= I_OUT;
        if (r < I_KV) { I.W = p.in[16]; I.WT = (bf16_t*)(ws + WS_WT_KV); I.K = D; I.N = 2 * MW; I.item = r; return I; } r -= I_KV;
        if (r < NE * I_GU) { const int e = r / I_GU; I.W = p.in[22] + (size_t)e * D * 2 * FF; I.WT = (bf16_t*)(ws + WS_WT_GU) + (size_t)e * 2 * FF * D; I.K = D; I.N = 2 * FF; I.item = r % I_GU; return I; } r -= NE * I_GU;
        { const int e = r / I_DN; I.W = p.in[24] + (size_t)e * FF * D; I.WT = (bf16_t*)(ws + WS_WT_DN) + (size_t)e * D * FF; I.K = FF; I.N = D; I.item = r % I_DN; return I; } };
    { float ra[32], rb[32]; int it = gw;
      if (it < NITEMS) { const P0Item I0 = mk(it); p0_item_load(I0, ra, lane); }
      for (; it < NITEMS; it += 2 * NGW) {
          const P0Item Ia = mk(it); const bool hb = it + NGW < NITEMS; P0Item Ib = Ia;
          if (hb) { Ib = mk(it + NGW); p0_item_load(Ib, rb, lane); }
          p0_item_store(Ia, ra, scr, lane);
          if (it + 2 * NGW < NITEMS) { const P0Item Ic = mk(it + 2 * NGW); p0_item_load(Ic, ra, lane); }
          if (hb) p0_item_store(Ib, rb, scr, lane);
      } }
    { u32x4* z = (u32x4*)((bf16_t*)(ws + WS_WT_IN) + (size_t)IN_W * D); const int n16 = (IN_WP - IN_W) * D * 2 / 16;
      for (int i = blockIdx.x * NTHR + tid; i < n16; i += gridDim.x * NTHR) z[i] = (u32x4){0u, 0u, 0u, 0u}; }
    { const float* wr = p.in[20]; bf16_t* wh = (bf16_t*)(ws + WS_WRT); bf16_t* wl = wh + NE * D;
      for (int i = blockIdx.x * NTHR + tid; i < NE * D; i += gridDim.x * NTHR) { const int e = i / D, k = i % D; const float w = wr[k * NE + e]; const unsigned h = f2bf(w); wh[i] = (bf16_t)h; wl[i] = (bf16_t)f2bf(w - bf2f(h)); } }
    { bf16_t* wu = (bf16_t*)(ws + WS_LORA); bf16_t* au = wu + 2 * RC * 32; bf16_t* gu = au + 2 * RC * 32;
      for (int i = blockIdx.x * NTHR + tid; i < 2 * RC * 32; i += gridDim.x * NTHR) { const int dch = i >> 5, j = i & 31, d = dch / RC, ch = dch % RC; wu[i] = (bf16_t)f2bf(p.in[7][(size_t)(d * 32 + j) * RC + ch]); au[i] = (bf16_t)f2bf(p.in[9][(size_t)(d * 32 + j) * RC + ch]); }
      for (int i = blockIdx.x * NTHR + tid; i < RC * 64; i += gridDim.x * NTHR) { const int ch = i >> 6, j = i & 63; gu[i] = (bf16_t)f2bf(p.in[10][(size_t)j * RC + ch]); } }
    for (int m = gw; m < T; m += NGW) {
        const f32x4* xr = (const f32x4*)(p.in[0] + (size_t)m * D) + lane; f32x4 v[4];
#pragma unroll
        for (int j = 0; j < 4; ++j) v[j] = xr[64 * j];
        ln_row(v, p.in[2], p.in[3], lane);
        store_row_bf16((bf16_t*)(ws + WS_H0B) + (size_t)m * D, v, lane);
    }
    for (int m = gw; m < BATCH * NMEM; m += NGW) {
        const f32x4* xr = (const f32x4*)(p.in[1] + (size_t)m * D) + lane; f32x4 v[4];
#pragma unroll
        for (int j = 0; j < 4; ++j) v[j] = xr[64 * j];
        store_row_bf16((bf16_t*)(ws + WS_MEMB) + (size_t)m * D, v, lane);
    }
}

template <class ARow, class BRow, class Epi>
__device__ __forceinline__ void sgemm_tile(int K, ARow arow, BRow brow, Epi epi) {
    const int tid = threadIdx.x, wid = tid >> 6, lane = tid & 63, wm = wid >> 1, wn = wid & 1, fr = lane & 15, fq = lane >> 4;
    f32x4 acc[2][4];
#pragma unroll
    for (int m = 0; m < 2; ++m)
#pragma unroll
        for (int n = 0; n < 4; ++n) acc[m][n] = (f32x4){0.f, 0.f, 0.f, 0.f};
    const bf16_t* ap[2]; const bf16_t* bp[4];
#pragma unroll
    for (int m = 0; m < 2; ++m) ap[m] = arow(wm * 32 + m * 16 + fr) + fq * 8;
#pragma unroll
    for (int n = 0; n < 4; ++n) bp[n] = brow(wn * 64 + n * 16 + fr) + fq * 8;
    for (int k = 0; k < K; k += 32) {
        bf16x8 a[2], b[4];
#pragma unroll
        for (int m = 0; m < 2; ++m) a[m] = *(const bf16x8*)(ap[m] + k);
#pragma unroll
        for (int n = 0; n < 4; ++n) b[n] = *(const bf16x8*)(bp[n] + k);
#pragma unroll
        for (int m = 0; m < 2; ++m)
#pragma unroll
            for (int n = 0; n < 4; ++n) acc[m][n] = __builtin_amdgcn_mfma_f32_16x16x32_bf16(b[n], a[m], acc[m][n], 0, 0, 0);
    }
#pragma unroll
    for (int m = 0; m < 2; ++m)
#pragma unroll
        for (int n = 0; n < 4; ++n) epi(wm * 32 + m * 16 + fr, wn * 64 + n * 16 + 4 * fq, acc[m][n], n);
}


namespace pg8 {
constexpr int BM = 256, BK = 64, HALF = 128, HTB = HALF * BK * 2, STAGE_BYTES = 8 * HTB, NXCD = 8, WGM = 8;
__host__ __device__ __forceinline__ int lds_byte(int r, int c) { const int st = (r >> 4) * 2 + (c >> 5), rr = r & 15, cc = c & 31, ob = rr * 64 + cc * 2; return st * 1024 + (ob ^ (((ob >> 9) & 1) << 5)); }
__host__ __device__ __forceinline__ void stage_rc(int b, int& R, int& C) { const int st = b / 1024, sb = b % 1024, swz = sb ^ (((sb >> 9) & 1) << 5); R = (st >> 1) * 16 + swz / 64; C = (st & 1) * 32 + (swz % 64) / 2; }
__host__ __device__ __forceinline__ int perm32(int rho) { const int n = rho >> 4, i = rho & 15; return 8 * (i >> 2) + 4 * n + (i & 3); }
struct Unit { const char* A; const char* B0; const char* B1; int x0, x1, x2, x3, x4; };
__device__ __forceinline__ unsigned cvt_pk_bf16(float lo, float hi) { unsigned r; asm volatile("v_cvt_pk_bf16_f32 %0, %1, %2" : "=v"(r) : "v"(lo), "v"(hi)); return r; }

__device__ __forceinline__ const char* uni_ptr(const char* p) { const unsigned long long v = (unsigned long long)p; const unsigned lo = __builtin_amdgcn_readfirstlane((unsigned)v), hi = __builtin_amdgcn_readfirstlane((unsigned)(v >> 32)); return (const char*)(((unsigned long long)hi << 32) | lo); }
__device__ __forceinline__ bool static_order(int nM, int nN, int G, int c, int i, int& pm, int& pn) {
    const int nwg = nM * nN; const long L = (long)i * G + c; if (L >= nwg) return false;
    int wgid = (int)L; { const int q = nwg / NXCD, r = nwg % NXCD, xcd = wgid % NXCD, off = wgid / NXCD; wgid = (xcd < r ? xcd * (q + 1) : r * (q + 1) + (xcd - r) * q) + off; }
    const int nig = WGM * nN, gid = wgid / nig, fm = gid * WGM, gsz = (nM - fm) < WGM ? (nM - fm) : WGM;
    pm = fm + ((wgid % nig) % gsz); pn = (wgid % nig) / gsz; return true;
}

template <class Pol>
__device__ __forceinline__ void gemm_phase(LAS unsigned char* lds, const Pol& P, const int K, unsigned long long* stat = nullptr) {
    unsigned long long tK = 0, tE = 0, tmark = 0, tstart = stat ? __builtin_amdgcn_s_memrealtime() : 0;
    const int tid = threadIdx.x, wid = __builtin_amdgcn_readfirstlane(tid >> 6), lane = tid & 63, wr = wid >> 2, wc = wid & 3, fr = lane & 15, fq = lane >> 4;
    const int nt = K / BK;
    int R0, C0; stage_rc(tid * 16, R0, C0);
    const int Rb0 = Pol::PERM ? ((R0 & ~31) + perm32(R0 & 31)) : R0;
    const unsigned vB = (unsigned)(Rb0 * K + C0) * 2u;
    const size_t pstep = (size_t)64 * K * 2;
    const size_t kstep = (size_t)(BK * 2);
    const unsigned ldsw = (unsigned)wid * 1024u;
    const int aoff = lds_byte(wr * 64 + fr, fq * 8), boff = lds_byte(wc * 32 + fr, fq * 8);
#define PG8_SA(b, h) (((b) * 2 + (h)) * HTB)
#define PG8_SB(b, h) ((4 + (b) * 2 + (h)) * HTB)
#define PG8_STAGE_B(bufoff, gbase) do { _Pragma("unroll") for (int _i = 0; _i < 2; ++_i) \
        __builtin_amdgcn_global_load_lds((const unsigned*)(uni_ptr((const char*)(gbase) + _i * pstep) + vB), (LAS unsigned*)(lds + (bufoff) + ldsw + _i * 8192), 16, 0, 0); } while (0)
#define PG8_STAGE_A(bufoff, gbase, vo, h) do { _Pragma("unroll") for (int _i = 0; _i < 2; ++_i) { \
        if constexpr (Pol::GATHER) __builtin_amdgcn_global_load_lds((const unsigned*)(uni_ptr((const char*)(gbase)) + (vo)[h][_i]), (LAS unsigned*)(lds + (bufoff) + ldsw + _i * 8192), 16, 0, 0); \
        else __builtin_amdgcn_global_load_lds((const unsigned*)(uni_ptr((const char*)(gbase) + ((h) * 2 + _i) * pstep) + (vo)[0][0]), (LAS unsigned*)(lds + (bufoff) + ldsw + _i * 8192), 16, 0, 0); } } while (0)
#define PG8_LDA(dst, b, h) do { _Pragma("unroll") for (int m = 0; m < 4; ++m) _Pragma("unroll") for (int k = 0; k < 2; ++k) dst[m][k] = *(const LAS bf16x8*)(lds + PG8_SA(b, h) + aoff + m * 2048 + k * 1024); } while (0)
#define PG8_LDB(dst, b, h) do { _Pragma("unroll") for (int n = 0; n < 2; ++n) _Pragma("unroll") for (int k = 0; k < 2; ++k) dst[n][k] = *(const LAS bf16x8*)(lds + PG8_SB(b, h) + boff + n * 2048 + k * 1024); } while (0)
#define PG8_MMA(ai, bj, At, Bt) do { __builtin_amdgcn_s_setprio(1); _Pragma("unroll") for (int m = 0; m < 4; ++m) _Pragma("unroll") for (int n = 0; n < 2; ++n) _Pragma("unroll") for (int k = 0; k < 2; ++k) \
        acc[ai][bj][m][n] = __builtin_amdgcn_mfma_f32_16x16x32_bf16(Bt[n][k], At[m][k], acc[ai][bj][m][n], 0, 0, 0); __builtin_amdgcn_s_setprio(0); } while (0)
#define PG8_WAIT_V(n) asm volatile("s_waitcnt vmcnt(" #n ")" ::: "memory")
#define PG8_WAIT_L(n) asm volatile("s_waitcnt lgkmcnt(" #n ")" ::: "memory")
#define PG8_BAR __builtin_amdgcn_s_barrier()
#define PG8_SCHED __builtin_amdgcn_sched_barrier(0)
    Unit cur, nxt; int ui = 0;
    if (!P.next(0, cur)) return;
    f32x4 acc[2][2][4][2];
#pragma unroll
    for (int a = 0; a < 2; ++a)
#pragma unroll
        for (int b = 0; b < 2; ++b)
#pragma unroll
            for (int m = 0; m < 4; ++m)
#pragma unroll
                for (int n = 0; n < 2; ++n) acc[a][b][m][n] = (f32x4){0.f, 0.f, 0.f, 0.f};
    bf16x8 At[4][2], B0[2][2], B1[2][2];
    unsigned vAc[2][2], vAn[2][2];
    if constexpr (Pol::GATHER) { P.rows_issue(cur, R0, vAc); P.rows_finish(C0, K, vAc); }
    else { vAc[0][0] = (unsigned)(R0 * K + C0) * 2u; vAc[0][1] = vAc[1][0] = vAc[1][1] = 0u; }
    asm volatile("s_waitcnt vmcnt(0)" ::: "memory");
    PG8_STAGE_B(PG8_SB(0, 0), cur.B0); PG8_STAGE_B(PG8_SB(0, 1), cur.B1); PG8_STAGE_A(PG8_SA(0, 0), cur.A, vAc, 0); PG8_STAGE_A(PG8_SA(0, 1), cur.A, vAc, 1);
    if (wr == 1) PG8_BAR;
    PG8_WAIT_V(2); PG8_BAR;
    PG8_STAGE_B(PG8_SB(1, 0), cur.B0 + kstep); PG8_STAGE_A(PG8_SA(1, 0), cur.A + kstep, vAc, 0); PG8_STAGE_B(PG8_SB(1, 1), cur.B1 + kstep);
    PG8_WAIT_V(6); PG8_BAR;
    for (;;) {
        const bool has_next = P.next(ui + 1, nxt);
        if (!has_next) nxt = cur;
        if (stat) tmark = __builtin_amdgcn_s_memrealtime();
        for (int t = 0; t < nt; t += 2) {
            const bool last = (t == nt - 2);
            if constexpr (Pol::GATHER) {
                if (last && has_next) { P.rows_issue(nxt, R0, vAn); vAc[0][0] = (vAn[0][0] * (unsigned)K + (unsigned)C0) * 2u; vAc[0][1] = (vAn[0][1] * (unsigned)K + (unsigned)C0) * 2u; }
            }
            const char* a1 = cur.A + (size_t)(t + 1) * kstep;
            const char* a2 = last ? nxt.A : cur.A + (size_t)(t + 2) * kstep;
            const char* b20 = last ? nxt.B0 : cur.B0 + (size_t)(t + 2) * kstep; const char* b21 = last ? nxt.B1 : cur.B1 + (size_t)(t + 2) * kstep;
            const char* a3 = a2 + kstep; const char* b30 = b20 + kstep; const char* b31 = b21 + kstep;
            PG8_LDB(B0, 0, 0); PG8_LDB(B1, 0, 1); PG8_SCHED; PG8_LDA(At, 0, 0); PG8_STAGE_A(PG8_SA(1, 1), a1, vAc, 1);
            if constexpr (Pol::GATHER) { if (last && has_next) { vAc[1][0] = (vAn[1][0] * (unsigned)K + (unsigned)C0) * 2u; vAc[1][1] = (vAn[1][1] * (unsigned)K + (unsigned)C0) * 2u; } }
            PG8_WAIT_V(8); PG8_WAIT_L(0); PG8_BAR; PG8_MMA(0, 0, At, B0); PG8_MMA(0, 1, At, B1); PG8_BAR; PG8_SCHED;
            PG8_LDA(At, 0, 1); PG8_STAGE_B(PG8_SB(0, 0), b20); PG8_STAGE_B(PG8_SB(0, 1), b21); PG8_STAGE_A(PG8_SA(0, 0), a2, vAc, 0);
            PG8_WAIT_V(8); PG8_WAIT_L(0); PG8_BAR; PG8_MMA(1, 0, At, B0); PG8_MMA(1, 1, At, B1); PG8_BAR; PG8_SCHED;
            PG8_LDB(B0, 1, 0); PG8_LDB(B1, 1, 1); PG8_SCHED; PG8_LDA(At, 1, 0); PG8_STAGE_A(PG8_SA(0, 1), a2, vAc, 1);
            PG8_WAIT_V(8); PG8_WAIT_L(0); PG8_BAR; PG8_MMA(0, 0, At, B0); PG8_MMA(0, 1, At, B1); PG8_BAR; PG8_SCHED;
            PG8_LDA(At, 1, 1); PG8_STAGE_B(PG8_SB(1, 0), b30); PG8_STAGE_B(PG8_SB(1, 1), b31); PG8_STAGE_A(PG8_SA(1, 0), a3, vAc, 0);
            PG8_WAIT_V(8); PG8_WAIT_L(0); PG8_BAR; PG8_MMA(1, 0, At, B0); PG8_MMA(1, 1, At, B1); PG8_BAR; PG8_SCHED;
        }
        if (stat) { const unsigned long long n_ = __builtin_amdgcn_s_memrealtime(); tK += n_ - tmark; tmark = n_; }
        if (wr == 0) PG8_BAR;
        P.epi(acc, cur, wr, wc, fr, fq);
        if (stat) { const unsigned long long n_ = __builtin_amdgcn_s_memrealtime(); tE += n_ - tmark; }
        if (!has_next) break;
#pragma unroll
        for (int a = 0; a < 2; ++a)
#pragma unroll
            for (int b = 0; b < 2; ++b)
#pragma unroll
                for (int m = 0; m < 4; ++m)
#pragma unroll
                    for (int n = 0; n < 2; ++n) acc[a][b][m][n] = (f32x4){0.f, 0.f, 0.f, 0.f};
        cur = nxt; ++ui;
        if (wr == 1) PG8_BAR;
    }
    PG8_WAIT_V(0);
    PG8_BAR;
    if (stat && threadIdx.x == 0) { stat[0] = tK; stat[1] = tE; stat[2] = __builtin_amdgcn_s_memrealtime() - tstart; }
#undef PG8_SA
#undef PG8_SB
#undef PG8_STAGE_A
#undef PG8_STAGE_B
#undef PG8_LDA
#undef PG8_LDB
#undef PG8_MMA
#undef PG8_WAIT_V
#undef PG8_WAIT_L
#undef PG8_BAR
#undef PG8_SCHED
}
}

struct PolP1 {
    static constexpr bool PERM = true, GATHER = false;
    const bf16_t* A; const bf16_t* Bt; bf16_t* PR; bf16_t* PA; const bf16_t* MB; const bf16_t* WK; bf16_t* KVM; int G, c;
    __device__ __forceinline__ bool next(int i, pg8::Unit& u) const { int pm, pn; constexpr int NMAIN = (T / 256) * (IN_WP / 256), NKV = (BATCH * NMEM / 256) * (2 * MW / 256);
        if (pg8::static_order(T / 256, IN_WP / 256, G, c, i, pm, pn)) {
            u.A = (const char*)(A + (size_t)pm * 256 * D); u.B0 = (const char*)(Bt + (size_t)pn * 256 * D); u.B1 = u.B0 + (size_t)128 * D * 2; u.x0 = pm; u.x1 = pn; u.x2 = 0; u.x3 = 0; u.x4 = 0; return true; }
        const long L = (long)i * G + c - NMAIN; if (L < 0 || L >= NKV) return false;
        pm = (int)(L >> 1); pn = (int)(L & 1);
        u.A = (const char*)(MB + (size_t)pm * 256 * D); u.B0 = (const char*)(WK + (size_t)pn * 256 * D); u.B1 = u.B0 + (size_t)128 * D * 2; u.x0 = pm; u.x1 = pn; u.x2 = 1; u.x3 = 0; u.x4 = 0; return true; }
    __device__ __forceinline__ void epi(const f32x4 (&acc)[2][2][4][2], const pg8::Unit& u, int wr, int wc, int fr, int fq) const {
        const int row0 = u.x0 * 256 + wr * 64 + fr;
#pragma unroll
        for (int bj = 0; bj < 2; ++bj) { const int col = u.x1 * 256 + bj * 128 + wc * 32 + 8 * fq;
            bf16_t* base; int pitch; float sc = 1.f;
            if (u.x2) { base = KVM + col; pitch = 2 * MW; }
            else if (col < RWKV_IN) { base = PR + col; pitch = RWKV_IN; }
            else { const int ca = col - RWKV_IN; base = PA + ca; pitch = PA_W; sc = (ca < AW || (ca >= 3 * AW && ca < 3 * AW + MW)) ? 0.125f : 1.f; }
#pragma unroll
            for (int ai = 0; ai < 2; ++ai)
#pragma unroll
                for (int m = 0; m < 4; ++m) { const f32x4 v0 = acc[ai][bj][m][0] * sc, v1 = acc[ai][bj][m][1] * sc;
                    u32x4 w; w.x = pg8::cvt_pk_bf16(v0[0], v0[1]); w.y = pg8::cvt_pk_bf16(v0[2], v0[3]); w.z = pg8::cvt_pk_bf16(v1[0], v1[1]); w.w = pg8::cvt_pk_bf16(v1[2], v1[3]);
                    *(u32x4*)(base + (size_t)(row0 + ai * 128 + m * 16) * pitch) = w; } }
    }
};
__device__ __forceinline__ void phase1(const Params& p, LAS unsigned char* lds) {
    unsigned char* ws = p.ws;
    PolP1 P{(const bf16_t*)(ws + WS_H0B), (const bf16_t*)(ws + WS_WT_IN), (bf16_t*)(ws + WS_PR), (bf16_t*)(ws + WS_PA), (const bf16_t*)(ws + WS_MEMB), (const bf16_t*)(ws + WS_WT_KV), (bf16_t*)(ws + WS_KVM), (int)gridDim.x, (int)blockIdx.x};
    pg8::gemm_phase(lds, P, D, (PROBE_GEMM == 1 && blockIdx.x == 0) ? (unsigned long long*)(ws + WS_CTL + 32768) : nullptr);
}

constexpr int P2_AP = 200;
__device__ __forceinline__ f32x4 p2_shift(const bf16_t* cur, int po, int no, float pm, float nm, const float* mu) {
    const u32x2 c = *(const u32x2*)cur, pv = *(const u32x2*)(cur + po), nv = *(const u32x2*)(cur + no);
    const f32x4 m = *(const f32x4*)mu;
    const f32x4 cc = {bflo(c.x), bfhi(c.x), bflo(c.y), bfhi(c.y)}, pp = {bflo(pv.x), bfhi(pv.x), bflo(pv.y), bfhi(pv.y)}, nn = {bflo(nv.x), bfhi(nv.x), bflo(nv.y), bfhi(nv.y)};
    return cc + m * (0.5f * (pp * pm + nn * nm) - cc);
}
constexpr int P2_CST = 8 * 16 * P2_AP * 2;
constexpr int P2_WOFF = P2_CST + 10 * RC * 4, P2_WBUF = 24576;
struct P2Pre { u32x2 rc, rp, rn, vc, vp, vn; };
__device__ __forceinline__ f32x4 p2_lerp(u32x2 c, u32x2 pv, u32x2 nv, float pm, float nm, f32x4 m) {
    const f32x4 cc = {bflo(c.x), bfhi(c.x), bflo(c.y), bfhi(c.y)}, pp = {bflo(pv.x), bfhi(pv.x), bflo(pv.y), bfhi(pv.y)}, nn = {bflo(nv.x), bfhi(nv.x), bflo(nv.y), bfhi(nv.y)};
    return cc + m * (0.5f * (pp * pm + nn * nm) - cc);
}
__device__ __forceinline__ void p2_fetch(P2Pre& P, const bf16_t* prow, int po, int no, const bf16_t* WU, const bf16_t* AU, const bf16_t* GU, int it, int fr, int fq) {
    const int h = it >> 2, ct = it & 3, ch = h * 64 + 16 * ct + 4 * fq;
    P.rc = *(const u32x2*)(prow + ch); P.rp = *(const u32x2*)(prow + ch + po); P.rn = *(const u32x2*)(prow + ch + no);
    P.vc = *(const u32x2*)(prow + 2 * RC + ch); P.vp = *(const u32x2*)(prow + 2 * RC + ch + po); P.vn = *(const u32x2*)(prow + 2 * RC + ch + no);
}
__device__ __forceinline__ void p2_wfetch(const bf16_t* WU, const bf16_t* AU, const bf16_t* GU, int h, int tid, u32x4 (&wr)[3]) {
#pragma unroll
    for (int q = 0; q < 3; ++q) { const int idx = tid + NTHR * q; const bf16_t* src;
        if (q < 2) { const int d = (idx & 511) >> 8, row = (idx & 255) >> 2, part = idx & 3; src = (q == 0 ? WU : AU) + ((size_t)(d * RC + h * 64 + row) * 32 + part * 8); }
        else { const int row = (idx - 1024) >> 3, part = idx & 7; src = GU + ((size_t)(h * 64 + row) * 64 + part * 8); }
        wr[q] = *(const u32x4*)src; }
}
__device__ __forceinline__ void p2_wput(LAS unsigned char* wb, int tid, const u32x4 (&wr)[3]) {
#pragma unroll
    for (int q = 0; q < 3; ++q) *(LAS u32x4*)(wb + (tid + NTHR * q) * 16) = wr[q];
}
__device__ __forceinline__ void phase2(const Params& p, LAS unsigned char* lds) {
    int tid_ = threadIdx.x; asm volatile("" : "+v"(tid_)); const int tid = tid_, lane = tid & 63, wave = tid >> 6, fr = lane & 15, fq = lane >> 4;
    unsigned char* ws = p.ws;
    const bf16_t* PR = (const bf16_t*)(ws + WS_PR);
    const float* mu = p.in[5];
    const bf16_t* WU = (const bf16_t*)(ws + WS_LORA); const bf16_t* AU = WU + 2 * RC * 32; const bf16_t* GU = AU + 2 * RC * 32;
    LAS bf16_t* ACT = (LAS bf16_t*)(lds + wave * (16 * P2_AP * 2));
    LAS float* CST = (LAS float*)(lds + P2_CST);
    unsigned char* SSH = ws + WS_SSH; unsigned char* SDIR = ws + WS_SDIR;
    bf16_t* G = (bf16_t*)((unsigned char*)p.out + DO_G); float* BON = (float*)(ws + WS_BONUS);
    __syncthreads();
    for (int i = tid; i < 10 * RC; i += NTHR) { const int a = i / RC, c = i % RC; float v;
        if (a < 3) v = mu[a * RC + c]; else if (a < 5) v = p.in[6][(a - 3) * RC + c]; else if (a < 7) v = p.in[8][(a - 5) * RC + c]; else v = p.in[11 + (a - 7)][c];
        CST[i] = v; }
    u32x4 wreg[3];
    p2_wfetch(WU, AU, GU, 0, tid, wreg); p2_wput(lds + P2_WOFF, tid, wreg);
    __syncthreads();
    { const int tile = blockIdx.x * NWAVES + wave;
        const int t0 = tile * 16;
#pragma unroll 4
        for (int i = 0; i < 12; ++i) { const int grp = lane + 64 * i, tok = grp / 48, c4 = (grp % 48) * 4, t = t0 + tok, sq = t & (SEQ - 1);
            f32x4 v = p2_shift(PR + (size_t)t * RWKV_IN + 3 * RC + c4, sq > 0 ? -RWKV_IN : 0, sq < SEQ - 1 ? RWKV_IN : 0, sq > 0 ? 1.f : 0.f, sq < SEQ - 1 ? 1.f : 0.f, mu + 3 * RC + c4);
            { const float sc = c4 < 64 ? 1.f : 2.f, mul = c4 < 64 ? 1.f : 2.f, add = c4 < 64 ? 0.f : -1.f; const bool raw = c4 >= 128;
#pragma unroll
              for (int e = 0; e < 4; ++e) { const float a = sigmoidf_(sc * v[e]) * mul + add; v[e] = raw ? v[e] : a; } }
            u32x2 o; o.x = pk2(v.x, v.y); o.y = pk2(v.z, v.w); *(LAS u32x2*)(ACT + tok * P2_AP + c4) = o; }
        asm volatile("s_waitcnt lgkmcnt(0)" ::: "memory");
        const int t = t0 + fr, sq = t & (SEQ - 1), b = t >> 11; const int po = sq > 0 ? -RWKV_IN : 0, no = sq < SEQ - 1 ? RWKV_IN : 0; const float pm = sq > 0 ? 1.f : 0.f, nm = sq < SEQ - 1 ? 1.f : 0.f;
        const bf16_t* prow = PR + (size_t)t * RWKV_IN;
        const LAS bf16_t* arowp = ACT + fr * P2_AP + 8 * fq;
        u32x2 kq[4][3];
#pragma unroll
        for (int ct = 0; ct < 4; ++ct) { const int ch = RC + 16 * ct + 4 * fq; kq[ct][0] = *(const u32x2*)(prow + ch); kq[ct][1] = *(const u32x2*)(prow + ch + po); kq[ct][2] = *(const u32x2*)(prow + ch + no); }
        P2Pre cur, nxt; p2_fetch(cur, prow, po, no, WU, AU, GU, 0, fr, fq);
#pragma unroll 1
        for (int h = 0; h < RH; ++h) {
            if (h + 1 < RH) p2_wfetch(WU, AU, GU, h + 1, tid, wreg);
            const LAS unsigned char* wbuf = lds + P2_WOFF + (h & 1) * P2_WBUF;
            f32x4 kp[4]; float ss = 0.f;
#pragma unroll
            for (int ct = 0; ct < 4; ++ct) { const int ch = h * 64 + 16 * ct + 4 * fq; kp[ct] = p2_lerp(kq[ct][0], kq[ct][1], kq[ct][2], pm, nm, *(const LAS f32x4*)(CST + RC + ch));
                const f32x4 kkv = kp[ct] * *(const LAS f32x4*)(CST + 7 * RC + ch); ss += (kkv.x * kkv.x + kkv.y * kkv.y) + (kkv.z * kkv.z + kkv.w * kkv.w); }
            ss += __shfl_xor(ss, 16); ss += __shfl_xor(ss, 32);
            const float rn = 1.f / fmaxf(sqrtf(ss), 1e-12f);
            float bon = 0.f;
            unsigned char* shrec = SSH + ((size_t)(b * RH + h) * SEQ + sq) * 384;
            unsigned char* d0rec = SDIR + ((size_t)((0 * BATCH + b) * RH + h) * SEQ + sq) * 512; unsigned char* d1rec = SDIR + ((size_t)((1 * BATCH + b) * RH + h) * SEQ + sq) * 512;
#pragma unroll
            for (int ct = 0; ct < 4; ++ct) { const int ch = h * 64 + 16 * ct + 4 * fq, cl = 16 * ct + 4 * fq, it = h * 4 + ct;
                const f32x4 r = p2_lerp(cur.rc, cur.rp, cur.rn, pm, nm, *(const LAS f32x4*)(CST + ch)), v = p2_lerp(cur.vc, cur.vp, cur.vn, pm, nm, *(const LAS f32x4*)(CST + 2 * RC + ch)), k = kp[ct];
                const LAS unsigned char* wl_ = wbuf + ((16 * ct + fr) * 4 + fq) * 16;
                const bf16x8 fw0 = *(const LAS bf16x8*)wl_, fw1 = *(const LAS bf16x8*)(wl_ + 4096), fa0 = *(const LAS bf16x8*)(wl_ + 8192), fa1 = *(const LAS bf16x8*)(wl_ + 12288);
                const LAS unsigned char* gl_ = wbuf + 16384 + ((16 * ct + fr) * 8 + fq) * 16;
                const bf16x8 fg0 = *(const LAS bf16x8*)gl_, fg1 = *(const LAS bf16x8*)(gl_ + 64);
                const f32x4 z = {0.f, 0.f, 0.f, 0.f};
                const f32x4 wl0 = __builtin_amdgcn_mfma_f32_16x16x32_bf16(fw0, *(const LAS bf16x8*)(arowp + 64), z, 0, 0, 0);
                const f32x4 wl1 = __builtin_amdgcn_mfma_f32_16x16x32_bf16(fw1, *(const LAS bf16x8*)(arowp + 96), z, 0, 0, 0);
                const f32x4 al0 = __builtin_amdgcn_mfma_f32_16x16x32_bf16(fa0, *(const LAS bf16x8*)(arowp + 128), z, 0, 0, 0);
                const f32x4 al1 = __builtin_amdgcn_mfma_f32_16x16x32_bf16(fa1, *(const LAS bf16x8*)(arowp + 160), z, 0, 0, 0);
                f32x4 gg = __builtin_amdgcn_mfma_f32_16x16x32_bf16(fg0, *(const LAS bf16x8*)(arowp), z, 0, 0, 0);
                gg = __builtin_amdgcn_mfma_f32_16x16x32_bf16(fg1, *(const LAS bf16x8*)(arowp + 32), gg, 0, 0, 0);
                const f32x4 w00 = *(const LAS f32x4*)(CST + 3 * RC + ch), w01 = *(const LAS f32x4*)(CST + 4 * RC + ch), a00 = *(const LAS f32x4*)(CST + 5 * RC + ch), a01 = *(const LAS f32x4*)(CST + 6 * RC + ch);
                const f32x4 kkw = *(const LAS f32x4*)(CST + 7 * RC + ch), kaw = *(const LAS f32x4*)(CST + 8 * RC + ch), rkw = *(const LAS f32x4*)(CST + 9 * RC + ch);
                f32x4 dec0, dec1, kd0, kd1, bb0, bb1, kkn;
#pragma unroll
                for (int e = 0; e < 4; ++e) {
                    dec0[e] = __expf(-0.6065306597126334f * sigmoidf_(w00[e] + wl0[e])); dec1[e] = __expf(-0.6065306597126334f * sigmoidf_(w01[e] + wl1[e]));
                    const float a0 = sigmoidf_(a00[e] + al0[e]), a1 = sigmoidf_(a01[e] + al1[e]);
                    kkn[e] = k[e] * kkw[e] * rn; kd0[e] = k[e] * (1.f + (a0 - 1.f) * kaw[e]); kd1[e] = k[e] * (1.f + (a1 - 1.f) * kaw[e]);
                    bb0[e] = kkn[e] * a0; bb1[e] = kkn[e] * a1; bon += r[e] * (kd0[e] + kd1[e]) * rkw[e]; }
                if (it + 1 < 4 * RH) p2_fetch(nxt, prow, po, no, WU, AU, GU, it + 1, fr, fq);
                if (ct == 3 && h + 1 < RH) {
#pragma unroll
                    for (int c2 = 0; c2 < 4; ++c2) { const int chn = RC + (h + 1) * 64 + 16 * c2 + 4 * fq; kq[c2][0] = *(const u32x2*)(prow + chn); kq[c2][1] = *(const u32x2*)(prow + chn + po); kq[c2][2] = *(const u32x2*)(prow + chn + no); } }
                { u32x2 o; o.x = pk2(r.x, r.y); o.y = pk2(r.z, r.w); *(u32x2*)(shrec + cl * 2) = o; o.x = pk2(v.x, v.y); o.y = pk2(v.z, v.w); *(u32x2*)(shrec + 128 + cl * 2) = o;
                  o.x = pk2(kkn.x, kkn.y); o.y = pk2(kkn.z, kkn.w); *(u32x2*)(shrec + 256 + cl * 2) = o;
                  *(f32x4*)(d0rec + cl * 4) = dec0; o.x = pk2(kd0.x, kd0.y); o.y = pk2(kd0.z, kd0.w); *(u32x2*)(d0rec + 256 + cl * 2) = o; o.x = pk2(bb0.x, bb0.y); o.y = pk2(bb0.z, bb0.w); *(u32x2*)(d0rec + 384 + cl * 2) = o;
                  *(f32x4*)(d1rec + cl * 4) = dec1; o.x = pk2(kd1.x, kd1.y); o.y = pk2(kd1.z, kd1.w); *(u32x2*)(d1rec + 256 + cl * 2) = o; o.x = pk2(bb1.x, bb1.y); o.y = pk2(bb1.z, bb1.w); *(u32x2*)(d1rec + 384 + cl * 2) = o; }
                u32x2 go; go.x = pk2(gg.x, gg.y); go.y = pk2(gg.z, gg.w); *(u32x2*)(G + (size_t)t * RC + ch) = go;
                cur = nxt;
                asm volatile("" ::: "memory");
            }
            bon += __shfl_xor(bon, 16); bon += __shfl_xor(bon, 32);
            if (fq == 0) BON[t * RH + h] = bon;
            if (h + 1 < RH) { p2_wput(lds + P2_WOFF + ((h + 1) & 1) * P2_WBUF, tid, wreg); __syncthreads(); }
        }
    }
}

typedef float f32x2_t __attribute__((ext_vector_type(2))); typedef __bf16 bf16x2_t __attribute__((ext_vector_type(2)));
__device__ __forceinline__ unsigned cvtpk(float lo, float hi) { const f32x2_t v = {lo, hi}; const bf16x2_t b = __builtin_convertvector(v, bf16x2_t); return __builtin_bit_cast(unsigned, b); }
constexpr int SC_TC = 16;
constexpr int SC_W = 0, SC_KK = 256, SC_RP = 384, SC_Z = 512, SC_UB = 640, SC_V = 1152, SC_STEPB = 1280;
constexpr int SC_BUFB = SC_TC * SC_STEPB;
struct ScanProd { const unsigned char* g0; const unsigned char* g1; long gstep0, gstep1; int ldst; int kind; };
__device__ __forceinline__ ScanProd scan_prod_init(const unsigned char* sh, const unsigned char* dr, int dir, int ptid) {
    ScanProd P; const int wi = ptid % 48, st0 = ptid / 48; int shift = 0; bool sh0 = false;
    P.g1 = dr; P.gstep1 = 0;
    if (wi < 16) { P.g0 = dr + wi * 16; P.ldst = SC_W + wi * 16; P.kind = 0; }
    else if (wi < 24) { const int c = wi - 16, ct = c >> 1; P.g0 = dr + 256 + c * 16; P.g1 = dr + 384 + c * 16; P.ldst = SC_UB + (ct >> 1) * 256 + (c & 1) * 128 + (ct & 1) * 8; P.kind = 1; }
    else if (wi < 32) { const int c = wi - 24; P.g0 = sh + 128 + c * 16; P.ldst = SC_V + c * 16; P.kind = 0; sh0 = true; }
    else { const int c = (wi - 32) & 7; const bool isr = wi >= 40; P.g0 = sh + (isr ? 0 : 256) + c * 16; sh0 = true; shift = isr ? 1 : 0; P.kind = 2;
        const int ct = c >> 1, fqb = 2 * (c & 1), pp = 32 * (ct >> 1) + 8 * fqb + (ct & 1) * 4; P.ldst = (isr ? SC_RP : SC_KK) + pp * 2; }
    const long rec0 = sh0 ? 384 : 512;
    const long t0 = dir ? (long)(SEQ - 1 - (st0 - shift)) : (long)(st0 - shift), t1 = dir ? (long)(SEQ - 1 - st0) : (long)st0;
    P.g0 += t0 * rec0; P.gstep0 = dir ? -rec0 : rec0; P.g1 += t1 * 512; P.gstep1 = dir ? -512 : 512; P.ldst += st0 * SC_STEPB; return P;
}
__device__ __forceinline__ void scan_fetch(const ScanProd& P, int c, u32x4 (&reg)[SC_TC / 4], u32x4 (&reg2)[SC_TC / 4]) {
    const unsigned char* a = P.g0 + (long)(c * SC_TC) * P.gstep0; const unsigned char* b = P.g1 + (long)(c * SC_TC) * P.gstep1;
#pragma unroll
    for (int q = 0; q < SC_TC / 4; ++q) { reg[q] = *(const u32x4*)(a + (long)(4 * q) * P.gstep0); reg2[q] = *(const u32x4*)(b + (long)(4 * q) * P.gstep1); }
}
__device__ __forceinline__ void scan_put(const ScanProd& P, LAS unsigned char* buf, const u32x4 (&reg)[SC_TC / 4], const u32x4 (&reg2)[SC_TC / 4]) {
    LAS unsigned char* d = buf + P.ldst;
    if (P.kind == 0) {
#pragma unroll
        for (int q = 0; q < SC_TC / 4; ++q) *(LAS u32x4*)(d + 4 * q * SC_STEPB) = reg[q];
    } else if (P.kind == 1) {
#pragma unroll
        for (int q = 0; q < SC_TC / 4; ++q) { const unsigned kw[4] = {reg[q].x, reg[q].y, reg[q].z, reg[q].w}, bw[4] = {reg2[q].x, reg2[q].y, reg2[q].z, reg2[q].w};
#pragma unroll
            for (int e = 0; e < 4; ++e) { const unsigned k0 = kw[e] & 0xffffu, k1 = kw[e] >> 16, b0 = bw[e] & 0xffffu, b1 = bw[e] >> 16;
                *(LAS u32x2*)(d + 4 * q * SC_STEPB + (2 * e) * 16) = (u32x2){k0 | (b0 << 16), b0};
                *(LAS u32x2*)(d + 4 * q * SC_STEPB + (2 * e + 1) * 16) = (u32x2){k1 | (b1 << 16), b1}; } }
    } else {
#pragma unroll
        for (int q = 0; q < SC_TC / 4; ++q) { *(LAS u32x2*)(d + 4 * q * SC_STEPB) = (u32x2){reg[q].x, reg[q].y}; *(LAS u32x2*)(d + 4 * q * SC_STEPB + 16) = (u32x2){reg[q].z, reg[q].w}; }
    }
}
__device__ __forceinline__ void scan_block(const Params& p, LAS unsigned char* lds, int sid) {
    const int tid = threadIdx.x, lane = tid & 63, wave = tid >> 6;
    const int dir = sid / (BATCH * RH), bh = sid % (BATCH * RH), b = bh / RH, h = bh % RH;
    const unsigned char* sh = p.ws + WS_SSH + (size_t)bh * SEQ * 384;
    const unsigned char* dr = p.ws + WS_SDIR + (size_t)(dir * BATCH * RH + bh) * SEQ * 512;
    float* Y = (float*)((unsigned char*)p.out + DO_Y) + (size_t)dir * T * RC;
    LAS unsigned char* buf0 = lds; LAS unsigned char* buf1 = lds + SC_BUFB;
    constexpr int NCH = SEQ / SC_TC;
    __syncthreads();
    for (int i = tid; i < 2 * SC_TC * 32; i += NTHR) { const int st = i >> 5, e = i & 31; *(LAS unsigned*)(lds + st * SC_STEPB + SC_Z + e * 4) = 0u; }
    const ScanProd SP = scan_prod_init(sh, dr, dir, (tid - 256) & 255);
    const bool prod = wave >= 4 && tid - 256 < 192;
    u32x4 preg[SC_TC / 4], preg2[SC_TC / 4];
    if (prod) { scan_fetch(SP, 0, preg, preg2); scan_put(SP, buf0, preg, preg2); scan_fetch(SP, 1, preg, preg2); }
    __syncthreads();
    const int fr = lane & 15, fq = lane >> 4, sel = (fr & 3) < 2 ? (fr & 3) : 2;
    f32x4 acc[4];
#pragma unroll
    for (int ct = 0; ct < 4; ++ct) acc[ct] = (f32x4){0.f, 0.f, 0.f, 0.f};
    bf16x8 sb0 = (bf16x8){0, 0, 0, 0, 0, 0, 0, 0}, sb1 = sb0;
    float* yrow = Y + (size_t)b * SEQ * RC + h * 64 + 16 * wave + fr;
    float yk = 0.f;
    const int ubo = fq == 0 ? SC_UB + fr * 16 : SC_Z, ubs = fq == 0 ? 256 : 0;
    for (int c = 0; c < NCH; ++c) {
        LAS unsigned char* cur = (c & 1) ? buf1 : buf0; LAS unsigned char* nxt = (c & 1) ? buf0 : buf1;
        if (wave >= 4) {
            if (prod && c + 1 < NCH) { scan_put(SP, nxt, preg, preg2); if (c + 2 < NCH) scan_fetch(SP, c + 2, preg, preg2); }
        } else {
            const LAS unsigned char* ab = cur + SC_KK + 128 * sel + fq * 16;
            const LAS unsigned char* wb = cur + SC_W + fq * 16;
            const LAS unsigned char* ub = cur + ubo;
            const LAS unsigned char* vb = cur + SC_V + (16 * wave + fr) * 2;
            bf16x8 cA0, cA1, nA0, nA1; u32x4 cU[2], nU[2]; f32x4 cW[4], nW[4]; unsigned cV, nV;
#define SC_LOAD(A0, A1, W, U, V, st) do { \
                A0 = *(const LAS bf16x8*)(ab + (st) * SC_STEPB); A1 = *(const LAS bf16x8*)(ab + (st) * SC_STEPB + 64); \
                _Pragma("unroll") for (int ct_ = 0; ct_ < 4; ++ct_) W[ct_] = *(const LAS f32x4*)(wb + (st) * SC_STEPB + ct_ * 64); \
                _Pragma("unroll") for (int cp_ = 0; cp_ < 2; ++cp_) U[cp_] = *(const LAS u32x4*)(ub + (st) * SC_STEPB + cp_ * ubs); \
                V = *(const LAS unsigned short*)(vb + (st) * SC_STEPB); } while (0)
            SC_LOAD(cA0, cA1, cW, cU, cV, 0);
#pragma unroll 1
            for (int g = 0; g < SC_TC / 4; ++g) {
#pragma unroll
                for (int u = 0; u < 4; ++u) {
                    const int st = 4 * g + u;
                    if (st + 1 < SC_TC) SC_LOAD(nA0, nA1, nW, nU, nV, st + 1);
                    f32x4 d = (f32x4){0.f, 0.f, 0.f, 0.f};
                    d = __builtin_amdgcn_mfma_f32_16x16x32_bf16(cA0, sb0, d, 0, 0, 0);
                    d = __builtin_amdgcn_mfma_f32_16x16x32_bf16(cA1, sb1, d, 0, 0, 0);
                    f32x4 cc[4];
#pragma unroll
                    for (int ct = 0; ct < 4; ++ct) cc[ct] = acc[ct] * cW[ct];
                    yk = (((u + 3) & 3) == fq) ? d[1] : yk;
                    if (u == 0) {
                        const int tau = c * SC_TC + 4 * g - 4 + fq;
                        if (tau >= 0) { const int t = dir ? (SEQ - 1 - tau) : tau; yrow[(size_t)t * RC] = yk; } }
                    const float nsa = -d[0];
                    const unsigned t1 = cvtpk(nsa, nsa);
                    const float lo = nsa - __builtin_bit_cast(float, t1 & 0xffff0000u);
                    const unsigned t2 = cvtpk(lo, 0.f);
                    u32x4 bw; bw.x = cV | (t1 << 16); bw.y = t2; bw.z = 0u; bw.w = 0u;
                    const bf16x8 b2 = __builtin_bit_cast(bf16x8, bw);
#pragma unroll
                    for (int ct = 0; ct < 4; ++ct) { u32x4 aw; aw.x = (ct & 1) ? cU[ct >> 1].z : cU[ct >> 1].x; aw.y = (ct & 1) ? cU[ct >> 1].w : cU[ct >> 1].y; aw.z = 0u; aw.w = 0u;
                        acc[ct] = __builtin_amdgcn_mfma_f32_16x16x32_bf16(__builtin_bit_cast(bf16x8, aw), b2, cc[ct], 0, 0, 0); }
                    u32x4 p0, p1;
                    p0.x = cvtpk(acc[0][0], acc[0][1]); p0.y = cvtpk(acc[0][2], acc[0][3]); p0.z = cvtpk(acc[1][0], acc[1][1]); p0.w = cvtpk(acc[1][2], acc[1][3]);
                    p1.x = cvtpk(acc[2][0], acc[2][1]); p1.y = cvtpk(acc[2][2], acc[2][3]); p1.z = cvtpk(acc[3][0], acc[3][1]); p1.w = cvtpk(acc[3][2], acc[3][3]);
                    sb0 = __builtin_bit_cast(bf16x8, p0); sb1 = __builtin_bit_cast(bf16x8, p1);
                    cA0 = nA0; cA1 = nA1; cV = nV;
#pragma unroll
                    for (int i = 0; i < 4; ++i) cW[i] = nW[i];
                    cU[0] = nU[0]; cU[1] = nU[1];
                    asm volatile("" ::: "memory");
                }
            }
#undef SC_LOAD
        }
        __syncthreads();
    }
    if (wave < 4) {
        if (fq < 3) { const int tau = SEQ - 4 + fq, t = dir ? (SEQ - 1 - tau) : tau; yrow[(size_t)t * RC] = yk; }
        const int t = dir ? 0 : (SEQ - 1); const bf16_t* rr = (const bf16_t*)(sh + (size_t)t * 384);
        float accy = 0.f;
#pragma unroll
        for (int j = 0; j < 8; ++j) { accy += bf2f((unsigned)(unsigned short)sb0[j]) * bf2f(rr[16 * (j >> 2) + 4 * fq + (j & 3)]); accy += bf2f((unsigned)(unsigned short)sb1[j]) * bf2f(rr[32 + 16 * (j >> 2) + 4 * fq + (j & 3)]); }
        accy += __shfl_xor(accy, 16); accy += __shfl_xor(accy, 32);
        if (fq == 0) yrow[(size_t)t * RC] = accy;
    }
    __syncthreads();
}

constexpr int AT_P = 72;
constexpr int AT_KOFF = 0, AT_VOFF = 256 * AT_P * 2;
constexpr int ATT_DIL_UNITS = BATCH * AH * 48;
constexpr int ATT_MEM_UNITS = BATCH * MH * 16;
constexpr int ATT_UNITS = ATT_DIL_UNITS + ATT_MEM_UNITS;
struct AttU { const bf16_t* q; const bf16_t* k; const bf16_t* v; long qs, ks; int kind, win0, L, dil; float slope; bf16_t* o; long os; float* lse; long ls; };
__device__ __forceinline__ void att_make_unit(const Params& p, int u, AttU& U) {
    unsigned char* ws = p.ws; const bf16_t* PA = (const bf16_t*)(ws + WS_PA);
    if (u < ATT_DIL_UNITS) {
        const int bh = u / 48, x = u % 48, b = bh / AH, h = bh % AH, br = x >> 4, y = x & 15;
        const int dil = br == 0 ? 1 : (br == 1 ? 4 : 16), L = SEQ / dil, npr = L / 128, r = y / npr, np = y % npr;
        const bf16_t* base = PA + (size_t)(b * SEQ + r) * PA_W + h * 64;
        U.kind = 0; U.win0 = (2 * np - 1) * 64; U.L = L; U.dil = dil; U.slope = exp2f(-8.f * (float)(h + 1) / (float)AH);
        U.qs = (long)dil * PA_W; U.ks = U.qs;
        U.q = base + (long)(np * 128) * U.qs; U.k = base + AW; U.v = base + 2 * AW;
        const size_t tok0 = (size_t)(b * SEQ + r) + (size_t)np * 128 * dil;
        U.o = (bf16_t*)(ws + WS_ATTO) + (size_t)br * T * AW + tok0 * AW + h * 64; U.os = (long)dil * AW;
        U.lse = (float*)((unsigned char*)p.out + DO_LSE) + (size_t)br * T * AH + tok0 * AH + h; U.ls = (long)dil * AH;
    } else {
        const int v = u - ATT_DIL_UNITS, bh = v >> 4, qb = v & 15, b = bh / MH, h = bh % MH;
        const bf16_t* KVM = (const bf16_t*)(ws + WS_KVM);
        U.kind = 1; U.win0 = 0; U.L = NMEM; U.dil = 1; U.slope = 0.f;
        U.q = PA + (size_t)(b * SEQ + qb * 128) * PA_W + 3 * AW + h * 64; U.qs = PA_W;
        U.k = KVM + (size_t)(b * NMEM) * (2 * MW) + h * 64; U.v = U.k + MW; U.ks = 2 * MW;
        U.o = (bf16_t*)(ws + WS_YMIX) + (size_t)(b * SEQ + qb * 128) * D + RC + AW + h * 64; U.os = D;
        U.lse = nullptr; U.ls = 0;
    }
}
__device__ __forceinline__ void att_fetch(const AttU& U, u32x4 (&reg)[8], int tid) {
#pragma unroll
    for (int q = 0; q < 8; ++q) { const int rem = (tid + NTHR * q) & 2047, row = rem >> 3, ch = rem & 7; const int lk = U.win0 + row; const bool ok = lk >= 0 && lk < U.L;
        const bf16_t* src = (q < 4 ? U.k : U.v) + (long)(ok ? lk : 0) * U.ks + ch * 8;
        u32x4 raw = *(const u32x4*)src; if (!ok) raw = (u32x4){0u, 0u, 0u, 0u}; reg[q] = raw; }
}
__device__ __forceinline__ void att_put(LAS unsigned char* lds, const u32x4 (&reg)[8], int tid) {
#pragma unroll
    for (int q = 0; q < 8; ++q) { const int rem = (tid + NTHR * q) & 2047, row = rem >> 3, ch = rem & 7;
        *(LAS u32x4*)(lds + (q < 4 ? AT_KOFF : AT_VOFF) + row * (AT_P * 2) + ch * 16) = reg[q]; }
}
typedef short v4i16_t __attribute__((ext_vector_type(4)));
template <int NT  , bool DIL>
__device__ __forceinline__ void att_compute(const AttU& U, LAS unsigned char* lds, int w, int lane) {
    const int fr = lane & 15, fq = lane >> 4;
    const bf16_t* qp = U.q + (long)(16 * w + fr) * U.qs + fq * 8;
    const bf16x8 q0 = *(const bf16x8*)qp, q1 = *(const bf16x8*)(qp + 32);
    f32x4 sT[NT];
#pragma unroll
    for (int i = 0; i < NT; ++i) {
        if (DIL && i == 9) { sT[i] = (f32x4){-1e30f, -1e30f, -1e30f, -1e30f}; continue; }
        int tt = DIL ? w + i : i; tt = tt > 15 ? 15 : tt;
        const LAS unsigned char* kp = lds + AT_KOFF + (16 * tt + fr) * (AT_P * 2) + fq * 16;
        const bf16x8 k0 = *(const LAS bf16x8*)kp, k1 = *(const LAS bf16x8*)(kp + 64);
        f32x4 a = (f32x4){0.f, 0.f, 0.f, 0.f};
        a = __builtin_amdgcn_mfma_f32_16x16x32_bf16(k0, q0, a, 0, 0, 0);
        a = __builtin_amdgcn_mfma_f32_16x16x32_bf16(k1, q1, a, 0, 0, 0);
        sT[i] = a; if ((i & 3) == 3) asm volatile("" ::: "memory"); }
    float m = -3.0e38f;
    if (DIL) {
        const int c0 = 4 * fq - fr, lb = U.win0 + 16 * w + 4 * fq; const float sd = U.slope * (float)U.dil; const unsigned Lc = (unsigned)U.L;
#pragma unroll
        for (int i = 0; i < NT; ++i) { if (i == 9) continue;
#pragma unroll
            for (int r = 0; r < 4; ++r) { const int dl = 16 * i + r - 64 + c0, ad = dl < 0 ? -dl : dl;
                bool valid = (unsigned)(lb + 16 * i + r) < Lc; if (i == 0 || i >= 7) valid = valid && ad <= 64;
                const float sv = valid ? sT[i][r] - sd * (float)ad : -1e30f; sT[i][r] = sv; m = fmaxf(m, sv); } }
    } else {
#pragma unroll
        for (int i = 0; i < NT; ++i)
#pragma unroll
            for (int r = 0; r < 4; ++r) m = fmaxf(m, sT[i][r]);
    }
    m = fmaxf(m, __shfl_xor(m, 16)); m = fmaxf(m, __shfl_xor(m, 32));
    float l = 0.f;
#pragma unroll
    for (int i = 0; i < NT; ++i)
#pragma unroll
        for (int r = 0; r < 4; ++r) { const float e = __expf(sT[i][r] - m); sT[i][r] = e; l += e; }
    l += __shfl_xor(l, 16); l += __shfl_xor(l, 32);
    f32x4 oT[4];
#pragma unroll
    for (int dt = 0; dt < 4; ++dt) oT[dt] = (f32x4){0.f, 0.f, 0.f, 0.f};
#pragma unroll
    for (int tp = 0; tp < NT / 2; ++tp) {
        int ta = DIL ? w + 2 * tp : 2 * tp, tb = ta + 1; ta = ta > 15 ? 15 : ta; tb = tb > 15 ? 15 : tb;
        u32x4 pw; pw.x = pk2(sT[2 * tp][0], sT[2 * tp][1]); pw.y = pk2(sT[2 * tp][2], sT[2 * tp][3]); pw.z = pk2(sT[2 * tp + 1][0], sT[2 * tp + 1][1]); pw.w = pk2(sT[2 * tp + 1][2], sT[2 * tp + 1][3]);
        const bf16x8 pb = __builtin_bit_cast(bf16x8, pw);
        const LAS unsigned char* va = lds + AT_VOFF + (16 * ta + 4 * fq + (fr >> 2)) * (AT_P * 2) + 8 * (fr & 3);
        const LAS unsigned char* vb = lds + AT_VOFF + (16 * tb + 4 * fq + (fr >> 2)) * (AT_P * 2) + 8 * (fr & 3);
#pragma unroll
        for (int dt = 0; dt < 4; ++dt) {
            const v4i16_t lo = __builtin_amdgcn_ds_read_tr16_b64_v4i16((LAS v4i16_t*)(va + 32 * dt)), hi = __builtin_amdgcn_ds_read_tr16_b64_v4i16((LAS v4i16_t*)(vb + 32 * dt));
            bf16x8 vf; vf[0] = lo[0]; vf[1] = lo[1]; vf[2] = lo[2]; vf[3] = lo[3]; vf[4] = hi[0]; vf[5] = hi[1]; vf[6] = hi[2]; vf[7] = hi[3];
            oT[dt] = __builtin_amdgcn_mfma_f32_16x16x32_bf16(vf, pb, oT[dt], 0, 0, 0); }
        if (tp & 1) asm volatile("" ::: "memory");
    }
    const float inv = 1.f / l;
    bf16_t* op = U.o + (long)(16 * w + fr) * U.os;
#pragma unroll
    for (int dt = 0; dt < 4; ++dt) { u32x2 o; o.x = pk2(oT[dt][0] * inv, oT[dt][1] * inv); o.y = pk2(oT[dt][2] * inv, oT[dt][3] * inv); *(u32x2*)(op + 16 * dt + 4 * fq) = o; }
    if (DIL && fq == 0) U.lse[(long)(16 * w + fr) * U.ls] = m + __logf(l);
}
__device__ __forceinline__ void phase3(const Params& p, LAS unsigned char* lds, int rep) {
    const int tid = threadIdx.x, lane = tid & 63, wave = tid >> 6;
    unsigned* ctl = (unsigned*)(p.ws + WS_CTL);
    LAS unsigned* bc = (LAS unsigned*)(lds + 98304);
    for (;;) {
        __syncthreads();
        if (tid == 0) bc[0] = atomicAdd(ctl + CW_SCANQ + 16 * rep, 1u);
        __syncthreads();
        const unsigned sid = __builtin_amdgcn_readfirstlane(bc[0]);
        if (sid >= 2u * BATCH * RH) break;
#pragma unroll 1
        for (int tw = 0; tw < (REPEAT_PHASE == 31 ? 2 : 1); ++tw) scan_block(p, lds, (int)sid);
    }
    constexpr unsigned ATT_BATCH = 2;
    for (;;) {
        __syncthreads();
        if (tid == 0) bc[1] = atomicAdd(ctl + CW_ATTQ + 16 * rep, ATT_BATCH);
        __syncthreads();
        const unsigned ubase = __builtin_amdgcn_readfirstlane(bc[1]);
        if (ubase >= (unsigned)ATT_UNITS) break;
        const unsigned uend = ubase + ATT_BATCH < (unsigned)ATT_UNITS ? ubase + ATT_BATCH : (unsigned)ATT_UNITS;
        { AttU U; att_make_unit(p, (int)ubase, U); u32x4 reg[8]; att_fetch(U, reg, tid); att_put(lds, reg, tid); }
#pragma unroll 1
        for (unsigned ucur = ubase; ucur < uend; ++ucur) {
            __syncthreads();
            u32x4 reg[8];
            if (ucur + 1 < uend) { AttU Un; att_make_unit(p, (int)ucur + 1, Un); att_fetch(Un, reg, tid); }
            { AttU U; att_make_unit(p, (int)ucur, U);
#pragma unroll 1
              for (int tw = 0; tw < (REPEAT_PHASE == 32 ? 2 : 1); ++tw) {
                if (ucur < (unsigned)ATT_DIL_UNITS) att_compute<10, true>(U, lds, wave, lane); else att_compute<16, false>(U, lds, wave, lane); } }
            __syncthreads();
            if (ucur + 1 < uend) att_put(lds, reg, tid);
        }
    }
}

__device__ __forceinline__ void phase4(const Params& p) {
    const int tid = threadIdx.x, lane = tid & 63, wave = tid >> 6;
    const int gw = blockIdx.x * NWAVES + wave, NGW = gridDim.x * NWAVES;
    unsigned char* ws = p.ws; const unsigned char* dob = (const unsigned char*)p.out;
    const float* Yf = (const float*)(dob + DO_Y); const float* Yb = Yf + (size_t)T * RC;
    const bf16_t* G = (const bf16_t*)(dob + DO_G); const float* LSE = (const float*)(dob + DO_LSE);
    const float* BON = (const float*)(ws + WS_BONUS); const float* SSH = (const float*)(ws + WS_SSH);
    const bf16_t* AO = (const bf16_t*)(ws + WS_ATTO); bf16_t* YM = (bf16_t*)(ws + WS_YMIX);
    for (int t = gw; t < T; t += NGW) {
        const int b = t >> 11, s = t & (SEQ - 1);
        float yf[RH], yb[RH], vv[RH], bo[RH]; unsigned short gg[RH], a0[AH], a1[AH], a2[AH]; float l0[AH], l1[AH], l2[AH];
#pragma unroll
        for (int h = 0; h < RH; ++h) { const int ch = h * 64 + lane;
            yf[h] = Yf[(size_t)t * RC + ch]; yb[h] = Yb[(size_t)t * RC + ch]; gg[h] = G[(size_t)t * RC + ch];
            vv[h] = bf2f(((const bf16_t*)SSH)[((size_t)(b * RH + h) * SEQ + s) * 192 + 64 + lane]); bo[h] = BON[t * RH + h];
            a0[h] = AO[(size_t)t * AW + ch]; a1[h] = AO[(size_t)T * AW + (size_t)t * AW + ch]; a2[h] = AO[(size_t)2 * T * AW + (size_t)t * AW + ch];
            l0[h] = LSE[(size_t)t * AH + h]; l1[h] = LSE[(size_t)T * AH + (size_t)t * AH + h]; l2[h] = LSE[(size_t)2 * T * AH + (size_t)t * AH + h]; }
#pragma unroll
        for (int h = 0; h < RH; ++h) { const int ch = h * 64 + lane;
            const float y = yf[h] + yb[h];
            const float mean = wave_sum(y) * (1.f / 64.f); const float dlt = y - mean; const float var = wave_sum(dlt * dlt) * (1.f / 64.f);
            const float yn = dlt * (1.f / sqrtf(var + GN_EPS)) * p.in[14][ch] + p.in[15][ch];
            const float o = (yn + bo[h] * vv[h]) * bf2f(gg[h]);
            YM[(size_t)t * D + ch] = (bf16_t)f2bf(o); }
#pragma unroll
        for (int h = 0; h < AH; ++h) { const int ch = h * 64 + lane;
            const float mx = fmaxf(l0[h], fmaxf(l1[h], l2[h])); const float e0 = __expf(l0[h] - mx), e1 = __expf(l1[h] - mx), e2 = __expf(l2[h] - mx); const float inv = 1.f / (e0 + e1 + e2);
            const float o = (e0 * bf2f(a0[h]) + e1 * bf2f(a1[h]) + e2 * bf2f(a2[h])) * inv;
            YM[(size_t)t * D + RC + ch] = (bf16_t)f2bf(o); }
    }
}

struct PolP5 {
    static constexpr bool PERM = false, GATHER = false;
    const bf16_t* A; const bf16_t* Bt; const bf16_t* H0B; float* PRE; int G, c;
    __device__ __forceinline__ bool next(int i, pg8::Unit& u) const { int pm, pn; if (!pg8::static_order(T / 256, D / 256, G, c, i, pm, pn)) return false;
        u.A = (const char*)(A + (size_t)pm * 256 * D); u.B0 = (const char*)(Bt + (size_t)pn * 256 * D); u.B1 = u.B0 + (size_t)128 * D * 2; u.x0 = pm; u.x1 = pn; u.x2 = 0; u.x3 = 0; u.x4 = 0; return true; }
    __device__ __forceinline__ void epi(const f32x4 (&acc)[2][2][4][2], const pg8::Unit& u, int wr, int wc, int fr, int fq) const {
        const int row0 = u.x0 * 256 + wr * 64 + fr, col0 = u.x1 * 256 + wc * 32 + 4 * fq;
        u32x2 hb[2][4][2][2];
#pragma unroll
        for (int ai = 0; ai < 2; ++ai)
#pragma unroll
            for (int m = 0; m < 4; ++m)
#pragma unroll
                for (int bj = 0; bj < 2; ++bj)
#pragma unroll
                    for (int n = 0; n < 2; ++n) hb[ai][m][bj][n] = *(const u32x2*)(H0B + (size_t)(row0 + ai * 128 + m * 16) * D + col0 + bj * 128 + n * 16);
#pragma unroll
        for (int ai = 0; ai < 2; ++ai)
#pragma unroll
            for (int m = 0; m < 4; ++m) { const size_t ro = (size_t)(row0 + ai * 128 + m * 16) * D + col0;
#pragma unroll
                for (int bj = 0; bj < 2; ++bj)
#pragma unroll
                    for (int n = 0; n < 2; ++n) { const size_t off = ro + bj * 128 + n * 16; const u32x2 h2 = hb[ai][m][bj][n]; const f32x4 v = acc[ai][bj][m][n];
                        f32x4 o; o.x = v.x + ALPHA * bflo(h2.x); o.y = v.y + ALPHA * bfhi(h2.x); o.z = v.z + ALPHA * bflo(h2.y); o.w = v.w + ALPHA * bfhi(h2.y); *(f32x4*)(PRE + off) = o; } }
    }
};
__device__ __forceinline__ void phase5(const Params& p, LAS unsigned char* lds) {
    unsigned char* ws = p.ws;
    PolP5 P{(const bf16_t*)(ws + WS_YMIX), (const bf16_t*)(ws + WS_WT_OUT), (const bf16_t*)(ws + WS_H0B), p.out, (int)gridDim.x, (int)blockIdx.x};
    pg8::gemm_phase(lds, P, D, (PROBE_GEMM == 5 && blockIdx.x == 0) ? (unsigned long long*)(ws + WS_CTL + 32768) : nullptr);
}

constexpr int P6_TP = 1032;
constexpr int P6_TH = 0, P6_TL = 16 * P6_TP * 2, P6_PART = 2 * 16 * P6_TP * 2, P6_LC = P6_PART + 8 * 16 * 32 * 4, P6_BASE = P6_LC + 128, P6_ENT = P6_BASE + 128, P6_MAXENT = 2048;
__device__ __forceinline__ void phase6(const Params& p, LAS unsigned char* lds, int rep) {
    const int tid = threadIdx.x, lane = tid & 63, wave = tid >> 6, fr = lane & 15, fq = lane >> 4;
    unsigned char* ws = p.ws; unsigned* ctl = (unsigned*)(ws + WS_CTL);
    const bf16_t* WRH = (const bf16_t*)(ws + WS_WRT); const bf16_t* WRL = WRH + NE * D;
    LAS bf16_t* TH = (LAS bf16_t*)(lds + P6_TH); LAS bf16_t* TL = (LAS bf16_t*)(lds + P6_TL); LAS float* PART = (LAS float*)(lds + P6_PART);
    LAS int* LC = (LAS int*)(lds + P6_LC); LAS int* BASE = (LAS int*)(lds + P6_BASE); LAS int* ENT = (LAS int*)(lds + P6_ENT);
    int* LIST = (int*)(ws + WS_LIST); float* RG = (float*)(ws + WS_ROWGATE); int* SEL = (int*)(ws + WS_SEL);
    __syncthreads();
    if (tid < NE) LC[tid] = 0;
    __syncthreads();
    int it = 0;
    for (int tile = blockIdx.x; tile < T / 16; tile += gridDim.x, ++it) {
        const int t0 = tile * 16;
#pragma unroll
        for (int q = 0; q < 2; ++q) { const int tt = 2 * wave + q, t = t0 + tt;
            const f32x4* xr = (const f32x4*)(p.out + (size_t)t * D) + lane; f32x4 v[4];
#pragma unroll
            for (int j = 0; j < 4; ++j) v[j] = xr[64 * j];
            ln_row(v, p.in[18], p.in[19], lane);
            bf16_t* orow = (bf16_t*)(ws + WS_H1B) + (size_t)t * D;
#pragma unroll
            for (int j = 0; j < 4; ++j) { const unsigned h0 = f2bf(v[j].x), h1 = f2bf(v[j].y), h2 = f2bf(v[j].z), h3 = f2bf(v[j].w);
                u32x2 hi; hi.x = h0 | (h1 << 16); hi.y = h2 | (h3 << 16);
                u32x2 lo; lo.x = pk2(v[j].x - bf2f(h0), v[j].y - bf2f(h1)); lo.y = pk2(v[j].z - bf2f(h2), v[j].w - bf2f(h3));
                *(u32x2*)(orow + 4 * lane + 256 * j) = hi;
                *(LAS u32x2*)(TH + tt * P6_TP + 4 * lane + 256 * j) = hi; *(LAS u32x2*)(TL + tt * P6_TP + 4 * lane + 256 * j) = lo; } }
        __syncthreads();
        f32x4 acc0 = (f32x4){0.f, 0.f, 0.f, 0.f}, acc1 = acc0;
#pragma unroll
        for (int ks = 0; ks < 4; ++ks) { const int k0 = 128 * wave + 32 * ks + 8 * fq;
            const bf16x8 ah = *(const LAS bf16x8*)(TH + fr * P6_TP + k0), al = *(const LAS bf16x8*)(TL + fr * P6_TP + k0);
            const bf16x8 bh0 = *(const bf16x8*)(WRH + (size_t)fr * D + k0), bl0 = *(const bf16x8*)(WRL + (size_t)fr * D + k0);
            const bf16x8 bh1 = *(const bf16x8*)(WRH + (size_t)(16 + fr) * D + k0), bl1 = *(const bf16x8*)(WRL + (size_t)(16 + fr) * D + k0);
            acc0 = __builtin_amdgcn_mfma_f32_16x16x32_bf16(ah, bh0, acc0, 0, 0, 0); acc0 = __builtin_amdgcn_mfma_f32_16x16x32_bf16(ah, bl0, acc0, 0, 0, 0); acc0 = __builtin_amdgcn_mfma_f32_16x16x32_bf16(al, bh0, acc0, 0, 0, 0);
            acc1 = __builtin_amdgcn_mfma_f32_16x16x32_bf16(ah, bh1, acc1, 0, 0, 0); acc1 = __builtin_amdgcn_mfma_f32_16x16x32_bf16(ah, bl1, acc1, 0, 0, 0); acc1 = __builtin_amdgcn_mfma_f32_16x16x32_bf16(al, bh1, acc1, 0, 0, 0); }
#pragma unroll
        for (int r = 0; r < 4; ++r) { PART[(wave * 16 + 4 * fq + r) * 32 + fr] = acc0[r]; PART[(wave * 16 + 4 * fq + r) * 32 + 16 + fr] = acc1[r]; }
        __syncthreads();
        const int e = lane & 31, tt = 2 * wave + (lane >> 5), t = t0 + tt;
        float logit = p.in[21][e];
#pragma unroll
        for (int v = 0; v < 8; ++v) logit += PART[(v * 16 + tt) * 32 + e];
        float cur = logit; float tv0 = 0.f, tv1 = 0.f, tv2 = 0.f, tv3 = 0.f; int te0 = 0, te1 = 0, te2 = 0, te3 = 0;
#pragma unroll
        for (int k = 0; k < 4; ++k) { float bv = cur; int bi = e;
#pragma unroll
            for (int o = 1; o < 32; o <<= 1) { const float ov = __shfl_xor(bv, o); const int oi = __shfl_xor(bi, o); if (ov > bv || (ov == bv && oi < bi)) { bv = ov; bi = oi; } }
            if (k == 0) { tv0 = bv; te0 = bi; } if (k == 1) { tv1 = bv; te1 = bi; } if (k == 2) { tv2 = bv; te2 = bi; } if (k == 3) { tv3 = bv; te3 = bi; }
            if (e == bi) cur = -3.0e38f; }
        const float e1 = __expf(tv1 - tv0), e2 = __expf(tv2 - tv0), e3 = __expf(tv3 - tv0); const float inv = 1.f / (1.f + e1 + e2 + e3);
        if (e < 4) { int ee = te0; float gg = inv;
            if (e == 1) { ee = te1; gg = e1 * inv; } if (e == 2) { ee = te2; gg = e2 * inv; } if (e == 3) { ee = te3; gg = e3 * inv; }
            const int lr = __hip_atomic_fetch_add((int*)(LC + ee), 1, __ATOMIC_RELAXED, __HIP_MEMORY_SCOPE_WORKGROUP); const int n = (it * 16 + tt) * 4 + e;
            if (n < P6_MAXENT) { ENT[4 * n] = t * 4 + e; ENT[4 * n + 1] = ee; ENT[4 * n + 2] = lr; ENT[4 * n + 3] = __builtin_bit_cast(int, gg); } }
    }
    __syncthreads();
    if (tid < NE) BASE[tid] = (int)atomicAdd(ctl + CW_CNT + 32 * rep + tid, (unsigned)LC[tid]);
    __syncthreads();
    const int nent = it * 64 < P6_MAXENT ? it * 64 : P6_MAXENT;
    for (int n = tid; n < nent; n += NTHR) { const int tk = ENT[4 * n], ee = ENT[4 * n + 1], rank = BASE[ee] + ENT[4 * n + 2];
        LIST[(size_t)ee * T + rank] = tk >> 2; RG[(size_t)ee * T + rank] = __builtin_bit_cast(float, ENT[4 * n + 3]); SEL[(size_t)tk * 2] = ee; SEL[(size_t)tk * 2 + 1] = rank; }
}

__device__ __forceinline__ void build_expert_tables(const Params& p, LAS int* tab) {
    const unsigned* ctl = (const unsigned*)(p.ws + WS_CTL);
    __syncthreads();
    if (threadIdx.x < NE) tab[threadIdx.x] = (int)__hip_atomic_load(ctl + CW_CNT + CNT_SET + threadIdx.x, __ATOMIC_RELAXED, __HIP_MEMORY_SCOPE_AGENT);
    __syncthreads();
    if (threadIdx.x == 0) { int ps = 0, ts = 0;
        for (int e = 0; e < NE; ++e) { const int c = tab[e]; tab[32 + e] = ps; tab[64 + e] = ts; ps += (c + 255) / 256 * 256; ts += (c + 127) / 128; }
        tab[64 + NE] = ts; }
    __syncthreads();
}

constexpr int TAB_OFF = 131072, UTAB_OFF = 100, UTAB_MAX = 48;
constexpr int IDX_OFF = 131072 + 2048, IDX_UNITS = 20;
__device__ __forceinline__ void build_expert_tables256(const Params& p, LAS int* tab, int npn  ) {
    const unsigned* ctl = (const unsigned*)(p.ws + WS_CTL);
    __syncthreads();
    if (threadIdx.x < NE) tab[threadIdx.x] = (int)__hip_atomic_load(ctl + CW_CNT + CNT_SET + threadIdx.x, __ATOMIC_RELAXED, __HIP_MEMORY_SCOPE_AGENT);
    __syncthreads();
    if (threadIdx.x == 0) { int ps = 0, ts = 0;
        for (int e = 0; e < NE; ++e) { const int c = tab[e]; tab[32 + e] = ps; tab[64 + e] = ts; ps += (c + 255) / 256 * 256; ts += (c + 255) / 256; }
        tab[64 + NE] = ts;
        int e = 0, n = 0;
        if (gridDim.x == 256) { const int g = blockIdx.x & 7, sl = blockIdx.x >> 3, mpx = 32 / npn  , mround = 8 * mpx;
            for (int i = 0; n < UTAB_MAX; ++i) { const int mt_g = i * mround + g * mpx + sl / npn, pn = sl % npn; if (i * mround >= ts) break; if (mt_g >= ts) continue;
                while (e + 1 < NE && mt_g >= tab[64 + e + 1]) ++e;
                const int r0 = (mt_g - tab[64 + e]) * 256;
                tab[UTAB_OFF + 4 * n] = e; tab[UTAB_OFF + 4 * n + 1] = r0; tab[UTAB_OFF + 4 * n + 2] = pn; tab[UTAB_OFF + 4 * n + 3] = tab[32 + e] + r0; ++n; }
        } else { const int nun = ts * npn;
        for (int L = blockIdx.x; L < nun && n < UTAB_MAX; L += gridDim.x, ++n) { const int pn = L % npn, mt_g = L / npn;
            while (e + 1 < NE && mt_g >= tab[64 + e + 1]) ++e;
            const int r0 = (mt_g - tab[64 + e]) * 256;
            tab[UTAB_OFF + 4 * n] = e; tab[UTAB_OFF + 4 * n + 1] = r0; tab[UTAB_OFF + 4 * n + 2] = pn; tab[UTAB_OFF + 4 * n + 3] = tab[32 + e] + r0; } }
        tab[98] = n; }
    __syncthreads();
}
struct PolP7 {
    static constexpr bool PERM = true, GATHER = true;
    const bf16_t* H1B; const bf16_t* WG; const LAS int* IDX; bf16_t* ACT; const float* BGU; const LAS int* tab; int G, c;
    __device__ __forceinline__ bool next(int i, pg8::Unit& u) const { if (i >= __builtin_amdgcn_readfirstlane(tab[98])) return false;
        const int e = __builtin_amdgcn_readfirstlane(tab[UTAB_OFF + 4 * i]), r0 = __builtin_amdgcn_readfirstlane(tab[UTAB_OFF + 4 * i + 1]), pn = __builtin_amdgcn_readfirstlane(tab[UTAB_OFF + 4 * i + 2]);
        u.A = (const char*)H1B; u.B0 = (const char*)(WG + ((size_t)e * 2 * FF + pn * 128) * D); u.B1 = u.B0 + (size_t)FF * D * 2;
        u.x0 = e; u.x1 = i; u.x2 = pn; u.x3 = __builtin_amdgcn_readfirstlane(tab[UTAB_OFF + 4 * i + 3]); u.x4 = __builtin_amdgcn_readfirstlane(tab[e]) - r0; return true; }
    __device__ __forceinline__ void rows_issue(const pg8::Unit& u, int R0, unsigned (&raw)[2][2]) const { const LAS int* lst = IDX + u.x1 * 256 + R0;
#pragma unroll
        for (int h = 0; h < 2; ++h)
#pragma unroll
            for (int i = 0; i < 2; ++i) raw[h][i] = (unsigned)lst[h * 128 + i * 64]; }
    __device__ __forceinline__ void rows_finish(int C0, int K, unsigned (&raw)[2][2]) const {
#pragma unroll
        for (int h = 0; h < 2; ++h)
#pragma unroll
            for (int i = 0; i < 2; ++i) raw[h][i] = (raw[h][i] * (unsigned)K + (unsigned)C0) * 2u; }
    __device__ __forceinline__ void epi(const f32x4 (&acc)[2][2][4][2], const pg8::Unit& u, int wr, int wc, int fr, int fq) const {
        const int e = u.x0, f0 = u.x2 * 128 + wc * 32 + 8 * fq;
        const float* bias = BGU + (size_t)e * 2 * FF + f0;
        const f32x4 bg0 = *(const f32x4*)bias, bg1 = *(const f32x4*)(bias + 4), bu0 = *(const f32x4*)(bias + FF), bu1 = *(const f32x4*)(bias + FF + 4);
#pragma unroll
        for (int ai = 0; ai < 2; ++ai)
#pragma unroll
            for (int m = 0; m < 4; ++m) { const int r = ai * 128 + wr * 64 + m * 16 + fr;
                const f32x4 g0 = acc[ai][0][m][0] + bg0, g1 = acc[ai][0][m][1] + bg1, u0 = acc[ai][1][m][0] + bu0, u1 = acc[ai][1][m][1] + bu1;
                float a[8];
#pragma unroll
                for (int j = 0; j < 4; ++j) {
                    const float gc = fminf(g0[j], 7.f), uc = __builtin_amdgcn_fmed3f(u0[j], -7.f, 7.f);
                    a[j] = __builtin_fmaf(uc, gc, gc) * __builtin_amdgcn_rcpf(1.f + __builtin_amdgcn_exp2f(-2.4554669595930157f * gc));
                    const float gd = fminf(g1[j], 7.f), ud = __builtin_amdgcn_fmed3f(u1[j], -7.f, 7.f);
                    a[4 + j] = __builtin_fmaf(ud, gd, gd) * __builtin_amdgcn_rcpf(1.f + __builtin_amdgcn_exp2f(-2.4554669595930157f * gd)); }
                { u32x4 w; w.x = pg8::cvt_pk_bf16(a[0], a[1]); w.y = pg8::cvt_pk_bf16(a[2], a[3]); w.z = pg8::cvt_pk_bf16(a[4], a[5]); w.w = pg8::cvt_pk_bf16(a[6], a[7]);
                    *(u32x4*)(ACT + (size_t)(u.x3 + r) * FF + f0) = w; } }
    }
};
__device__ __forceinline__ void phase7(const Params& p, LAS unsigned char* lds) {
    LAS int* tab = (LAS int*)(lds + TAB_OFF); build_expert_tables256(p, tab, 8);
    unsigned char* ws = p.ws;
    LAS int* IDX = (LAS int*)(lds + IDX_OFF);
    { const int* LIST = (const int*)(ws + WS_LIST); const int nun = tab[98] < IDX_UNITS ? tab[98] : IDX_UNITS;
      for (int j = threadIdx.x; j < nun * 256; j += NTHR) { const int n = j >> 8, i = j & 255, e = tab[UTAB_OFF + 4 * n], r0 = tab[UTAB_OFF + 4 * n + 1], nval = tab[e] - r0;
          IDX[j] = LIST[(size_t)e * T + r0 + (i < nval ? i : 0)]; }
      __syncthreads(); }
    PolP7 P{(const bf16_t*)(ws + WS_H1B), (const bf16_t*)(ws + WS_WT_GU), IDX, (bf16_t*)(ws + WS_ACT), p.in[23], tab, (int)gridDim.x, (int)blockIdx.x};
    pg8::gemm_phase(lds, P, D, (PROBE_GEMM == 7 && blockIdx.x == 0) ? (unsigned long long*)(ws + WS_CTL + 32768) : nullptr);
}

struct PolP8 {
    static constexpr bool PERM = true, GATHER = false;
    const bf16_t* ACT; const bf16_t* WD; const float* RG; bf16_t* YR; const float* BD; const LAS int* tab; int G, c;
    __device__ __forceinline__ bool next(int i, pg8::Unit& u) const { if (i >= __builtin_amdgcn_readfirstlane(tab[98])) return false;
        const int e = __builtin_amdgcn_readfirstlane(tab[UTAB_OFF + 4 * i]), r0 = __builtin_amdgcn_readfirstlane(tab[UTAB_OFF + 4 * i + 1]), pn = __builtin_amdgcn_readfirstlane(tab[UTAB_OFF + 4 * i + 2]), prow0 = __builtin_amdgcn_readfirstlane(tab[UTAB_OFF + 4 * i + 3]);
        u.A = (const char*)(ACT + (size_t)prow0 * FF); u.B0 = (const char*)(WD + ((size_t)e * D + pn * 256) * FF); u.B1 = u.B0 + (size_t)128 * FF * 2;
        u.x4 = __builtin_amdgcn_readfirstlane(tab[e]) - r0;
        u.x0 = e; u.x1 = r0; u.x2 = pn; u.x3 = prow0; return true; }
    __device__ __forceinline__ void epi(const f32x4 (&acc)[2][2][4][2], const pg8::Unit& u, int wr, int wc, int fr, int fq) const {
        const int e = u.x0, nval = u.x4; const float* rg = RG + (size_t)e * T + u.x1;
        float gt[2][4];
#pragma unroll
        for (int ai = 0; ai < 2; ++ai)
#pragma unroll
            for (int m = 0; m < 4; ++m) { const int r = ai * 128 + wr * 64 + m * 16 + fr; gt[ai][m] = rg[r < nval ? r : 0]; }
        f32x4 bs[2][2];
#pragma unroll
        for (int bj = 0; bj < 2; ++bj) { const float* bias = BD + (size_t)e * D + u.x2 * 256 + bj * 128 + wc * 32 + 8 * fq; bs[bj][0] = *(const f32x4*)bias; bs[bj][1] = *(const f32x4*)(bias + 4); }
#pragma unroll
        for (int ai = 0; ai < 2; ++ai)
#pragma unroll
            for (int m = 0; m < 4; ++m) { const int r = ai * 128 + wr * 64 + m * 16 + fr; const float g = gt[ai][m];
#pragma unroll
                for (int bj = 0; bj < 2; ++bj) { const int col = u.x2 * 256 + bj * 128 + wc * 32 + 8 * fq;
                    const f32x4 v0 = (acc[ai][bj][m][0] + bs[bj][0]) * g, v1 = (acc[ai][bj][m][1] + bs[bj][1]) * g;
                    u32x4 w; w.x = pg8::cvt_pk_bf16(v0[0], v0[1]); w.y = pg8::cvt_pk_bf16(v0[2], v0[3]); w.z = pg8::cvt_pk_bf16(v1[0], v1[1]); w.w = pg8::cvt_pk_bf16(v1[2], v1[3]);
                    *(u32x4*)(YR + (size_t)(u.x3 + r) * D + col) = w; } }
    }
};
__device__ __forceinline__ void phase8(const Params& p, LAS unsigned char* lds) {
    LAS int* tab = (LAS int*)(lds + TAB_OFF); build_expert_tables256(p, tab, 4);
    unsigned char* ws = p.ws;
    PolP8 P{(const bf16_t*)(ws + WS_ACT), (const bf16_t*)(ws + WS_WT_DN), (const float*)(ws + WS_ROWGATE), (bf16_t*)(ws + WS_YROWS), p.in[25], tab, (int)gridDim.x, (int)blockIdx.x};
    pg8::gemm_phase(lds, P, FF, (PROBE_GEMM == 8 && blockIdx.x == 0) ? (unsigned long long*)(ws + WS_CTL + 32768) : nullptr);
}

__device__ __forceinline__ void phase9(const Params& p, LAS unsigned char* lds) {
    LAS int* tab = (LAS int*)lds; build_expert_tables(p, tab);
    const int tid = threadIdx.x, lane = tid & 63, wave = tid >> 6;
    const int gw = blockIdx.x * NWAVES + wave, NGW = gridDim.x * NWAVES;
    unsigned char* ws = p.ws; const bf16_t* H1B = (const bf16_t*)(ws + WS_H1B); const bf16_t* YR = (const bf16_t*)(ws + WS_YROWS); const int* SEL = (const int*)(ws + WS_SEL);
    typedef int i32x4 __attribute__((ext_vector_type(4)));
    i32x4 sa = {0, 0, 0, 0}, sb = sa;
    if (gw < T) { sa = *(const i32x4*)(SEL + (size_t)gw * 8); sb = *(const i32x4*)(SEL + (size_t)gw * 8 + 4); }
    for (int t = gw; t < T; t += NGW) {
        const i32x4 ca = sa, cb = sb;
        if (t + NGW < T) { sa = *(const i32x4*)(SEL + (size_t)(t + NGW) * 8); sb = *(const i32x4*)(SEL + (size_t)(t + NGW) * 8 + 4); }
        const bf16_t* y0 = YR + (size_t)(tab[32 + ca.x] + ca.y) * D + 4 * lane; const bf16_t* y1 = YR + (size_t)(tab[32 + ca.z] + ca.w) * D + 4 * lane;
        const bf16_t* y2 = YR + (size_t)(tab[32 + cb.x] + cb.y) * D + 4 * lane; const bf16_t* y3 = YR + (size_t)(tab[32 + cb.z] + cb.w) * D + 4 * lane;
        const bf16_t* hr = H1B + (size_t)t * D + 4 * lane;
        u32x2 hb[4], q0[4], q1[4], q2[4], q3[4];
#pragma unroll
        for (int j = 0; j < 4; ++j) { hb[j] = *(const u32x2*)(hr + 256 * j); q0[j] = *(const u32x2*)(y0 + 256 * j); q1[j] = *(const u32x2*)(y1 + 256 * j); q2[j] = *(const u32x2*)(y2 + 256 * j); q3[j] = *(const u32x2*)(y3 + 256 * j); }
        f32x4 v[4];
#pragma unroll
        for (int j = 0; j < 4; ++j) {
            v[j].x = ALPHA * bflo(hb[j].x) + ((bflo(q0[j].x) + bflo(q1[j].x)) + (bflo(q2[j].x) + bflo(q3[j].x)));
            v[j].y = ALPHA * bfhi(hb[j].x) + ((bfhi(q0[j].x) + bfhi(q1[j].x)) + (bfhi(q2[j].x) + bfhi(q3[j].x)));
            v[j].z = ALPHA * bflo(hb[j].y) + ((bflo(q0[j].y) + bflo(q1[j].y)) + (bflo(q2[j].y) + bflo(q3[j].y)));
            v[j].w = ALPHA * bfhi(hb[j].y) + ((bfhi(q0[j].y) + bfhi(q1[j].y)) + (bfhi(q2[j].y) + bfhi(q3[j].y))); }
        ln_row(v, p.in[26], p.in[27], lane);
        f32x4* orow = (f32x4*)(p.out + (size_t)t * D) + lane;
#pragma unroll
        for (int j = 0; j < 4; ++j) orow[64 * j] = v[j];
    }
}

#define XB_TMO      128
#define XB_XCNT(j)  (256  + 64 * (j))
#define XB_XSUB(j)  (1280 + 64 * (j))
#define XB_XGEN(j)  (2304 + 64 * (j))
#define XB_TOP      3328
#define XB_TOPGEN   3392
#define XCD_BAR_WORDS 3456
#define XB_SPIN_CAP (1u << 22)
__device__ __forceinline__ unsigned xb_ld(unsigned* p)              { return __hip_atomic_load(p, __ATOMIC_RELAXED, __HIP_MEMORY_SCOPE_AGENT); }
__device__ __forceinline__ unsigned xb_add(unsigned* p, unsigned v) { return __hip_atomic_fetch_add(p, v, __ATOMIC_RELAXED, __HIP_MEMORY_SCOPE_AGENT); }
__device__ __forceinline__ unsigned xb_xcc_id() { return (unsigned)__builtin_amdgcn_s_getreg((3 << 11) | 20) & 0xFu; }
#define XB_SPIN(cond, bar) do { unsigned _sp = 0; while (cond) { __builtin_amdgcn_s_sleep(1); \
    if ((++_sp & 255u) == 0u) { if (xb_ld(&(bar)[XB_TMO])) break; if (_sp > XB_SPIN_CAP) { atomicAdd(&(bar)[XB_TMO], 1u); break; } } } } while (0)
struct XcdBarrier { unsigned* bar; unsigned x; volatile LAS unsigned* st; };
__device__ __forceinline__ XcdBarrier xcd_barrier_post(unsigned* bar, volatile LAS unsigned* st) {
    XcdBarrier b; b.bar = bar; b.x = xb_xcc_id(); b.st = st;
    if (threadIdx.x == 0) (void)xb_add(&bar[XB_XCNT(b.x)], 1u);
    return b;
}
__device__ __forceinline__ void xcd_barrier_complete(unsigned* bar, unsigned x, unsigned& nloc, unsigned& nx) {
    const unsigned G = gridDim.x * gridDim.y * gridDim.z;
    unsigned sum, cnt, mine, sp = 0u;
    for (;;) {
        sum = 0u; cnt = 0u; mine = 0u;
#pragma unroll
        for (unsigned j = 0; j < 16; ++j) { const unsigned c = xb_ld(&bar[XB_XCNT(j)]); sum += c; cnt += (c > 0u) ? 1u : 0u; mine = (j == x) ? c : mine; }
        if (sum == G) break;
        __builtin_amdgcn_s_sleep(1);
        if ((++sp & 255u) == 0u) { if (xb_ld(&bar[XB_TMO])) break; if (sp > XB_SPIN_CAP) { atomicAdd(&bar[XB_TMO], 1u); break; } }
    }
    nloc = mine > 0u ? mine : 1u; nx = cnt > 0u ? cnt : 1u;
}
__device__ __forceinline__ void xcd_barrier(const XcdBarrier& b) {
    asm volatile("s_waitcnt vmcnt(0)" ::: "memory");
    __syncthreads();
    if (threadIdx.x == 0) {
        unsigned* bar = b.bar;
        __builtin_amdgcn_s_waitcnt(0);
        unsigned nloc = b.st[0], nx = b.st[1];
        if (nloc == 0u) { xcd_barrier_complete(bar, b.x, nloc, nx); b.st[0] = nloc; b.st[1] = nx; }
        const unsigned old = xb_add(&bar[XB_XSUB(b.x)], 1u);
        const unsigned gen = old / nloc;
        if (old + 1u == (gen + 1u) * nloc) {
            __builtin_amdgcn_fence(__ATOMIC_RELEASE, "agent");
            asm volatile("s_waitcnt vmcnt(0)" ::: "memory");
            const unsigned og = xb_add(&bar[XB_TOP], 1u);
            const unsigned tg = og / nx;
            if (og + 1u == (tg + 1u) * nx) xb_add(&bar[XB_TOPGEN], 1u);
            else XB_SPIN(xb_ld(&bar[XB_TOPGEN]) == tg, bar);
            __builtin_amdgcn_fence(__ATOMIC_ACQUIRE, "agent");
            xb_add(&bar[XB_XGEN(b.x)], 1u);
            asm volatile("s_waitcnt vmcnt(0)" ::: "memory");
        } else {
            XB_SPIN(xb_ld(&bar[XB_XGEN(b.x)]) == gen, bar);
            __builtin_amdgcn_fence(__ATOMIC_ACQUIRE, "agent");
            asm volatile("s_waitcnt vmcnt(0)" ::: "memory");
        }
    }
    __syncthreads();
}

constexpr int NPHASE = 10;
constexpr int LDS_BYTES = 131072 + 2048 + IDX_UNITS * 1024;
__global__ void __launch_bounds__(NTHR, 2) mk_fwd(Params p) {
    extern __shared__ __attribute__((aligned(16))) unsigned char lds_raw[];
    LAS unsigned char* lds = (LAS unsigned char*)lds_raw;
    const int lo = p.ph_lo, hi = p.ph_hi;
    volatile LAS unsigned* barst = (volatile LAS unsigned*)(lds + BARST_OFF);
    if (threadIdx.x < 2) barst[threadIdx.x] = 0u;
    __syncthreads();
    XcdBarrier xbar; xbar.bar = (unsigned*)(p.ws + WS_CTL) + CW_BAR; xbar.x = xb_xcc_id(); xbar.st = barst;
    if (MK_ONE_LAUNCH && blockIdx.x == 0 && lo == 0) { u32x4* z = (u32x4*)(p.ws + WS_CTL); for (int i = threadIdx.x; i < CTL_ZERO_BYTES / 16; i += NTHR) z[i] = (u32x4){0u, 0u, 0u, 0u}; }
#ifdef ONLY_PHASE
#define IN(k) ((k) == ONLY_PHASE && lo <= (k) && (k) < hi)
#else
#define IN(k) (lo <= (k) && (k) < hi)
#endif
#define SEAM(k) do { if (IN(k) && IN((k) + 1)) { if ((k) == 0) { cg::this_grid().sync(); if (threadIdx.x == 0) (void)xb_add(&xbar.bar[XB_XCNT(xbar.x)], 1u); } else xcd_barrier(xbar); } if (PROBE_TS == (k)) ts1 = __builtin_amdgcn_s_memrealtime(); } while (0)
#define RUN(k, call) do { if (IN(k)) { if (PROBE_TS == (k)) ts0 = __builtin_amdgcn_s_memrealtime(); call; if (REPEAT_PHASE == (k)) { cg::this_grid().sync(); call; } } } while (0)
    unsigned long long ts0 = 0, ts1 = 0;
    { int rep = 0;
    RUN(0, phase0(p, lds));
    SEAM(0);
    RUN(1, phase1(p, lds));
    SEAM(1);
    RUN(2, phase2(p, lds));
    SEAM(2);
    if (IN(3)) { const int nrep = (REPEAT_PHASE == 3) ? 2 : 1; if (PROBE_TS == 3) ts0 = __builtin_amdgcn_s_memrealtime();
#pragma unroll 1
        for (rep = 0; rep < nrep; ++rep) { if (rep) cg::this_grid().sync(); phase3(p, lds, rep); } }
    SEAM(3);
    RUN(4, phase4(p));
    SEAM(4);
    RUN(5, phase5(p, lds));
    SEAM(5);
    rep = 0; RUN(6, (phase6(p, lds, rep), ++rep));
    SEAM(6);
    RUN(7, phase7(p, lds));
    SEAM(7);
    RUN(8, phase8(p, lds));
    SEAM(8);
    RUN(9, phase9(p, lds));
    if (PROBE_TS == 9) ts1 = __builtin_amdgcn_s_memrealtime();
    if (PROBE_GEMM >= 0 && blockIdx.x == 0) { __syncthreads(); if (threadIdx.x == 0) p.out[0] += (float)(((const unsigned long long*)(p.ws + WS_CTL + 32768))[PROBE_PART]) * 1e-4f; }
    if (PROBE_TS >= 0 && blockIdx.x == 0 && threadIdx.x == 0) p.out[0] += (float)(ts1 - ts0) * 1e-4f;
    }
#undef RUN
#undef IN
#undef SEAM
}

extern "C" void kernel_launch(void* const* d_in, const int* in_sizes, int n_in, void* d_out, int out_size, void* d_ws, size_t ws_size, hipStream_t stream) {
    static int grid = 0;
    if (grid == 0) {
        if (n_in != 28 || out_size != T * D || ws_size < WS_END) { fprintf(stderr, "kernel_launch: unexpected shapes: n_in %d out %d ws %zu (need %zu)\n", n_in, out_size, ws_size, (size_t)WS_END); grid = -1; return; }
        int dev = 0, cus = 0, per_cu = 0;
        hipGetDevice(&dev); hipDeviceGetAttribute(&cus, hipDeviceAttributeMultiprocessorCount, dev);
        hipFuncSetAttribute((const void*)mk_fwd, hipFuncAttributeMaxDynamicSharedMemorySize, LDS_BYTES);
        hipOccupancyMaxActiveBlocksPerMultiprocessor(&per_cu, (const void*)mk_fwd, NTHR, LDS_BYTES);
        (void)hipGetLastError();
        if (per_cu < 1) { fprintf(stderr, "kernel_launch: occupancy query says %d blocks per CU\n", per_cu); per_cu = 1; }
        grid = cus;
    }
    if (grid < 0) return;
#if !MK_ONE_LAUNCH
    hipMemsetAsync((char*)d_ws + WS_CTL, 0, CTL_ZERO_BYTES, stream);
#endif
    Params p{};
    for (int i = 0; i < 28; ++i) p.in[i] = (const float*)d_in[i];
    p.out = (float*)d_out; p.ws = (unsigned char*)d_ws;
#if MK_ONE_LAUNCH
    p.ph_lo = 0; p.ph_hi = NPHASE;
    void* args[] = {&p};
    hipError_t e = hipLaunchCooperativeKernel((const void*)mk_fwd, dim3(grid), dim3(NTHR), args, LDS_BYTES, stream);
    if (e != hipSuccess) fprintf(stderr, "cooperative launch failed: %s (grid %d)\n", hipGetErrorString(e), grid);
#else
    for (int ph = 0; ph < NPHASE; ++ph) { p.ph_lo = ph; p.ph_hi = ph + 1; hipLaunchKernelGGL(mk_fwd, dim3(grid), dim3(NTHR), LDS_BYTES, stream, p); }
#endif
}
```

```cpp
#include <hip/hip_runtime.h>
#include <hip/hip_cooperative_groups.h>
#include <cstdio>
#include <cstdint>
namespace cg = cooperative_groups;

#ifndef REPEAT_PHASE
#define REPEAT_PHASE -1
#endif
#ifndef PROBE_TS
#define PROBE_TS -1
#endif
#ifndef PROBE_GEMM
#define PROBE_GEMM -1
#endif
#ifndef PROBE_PART
#define PROBE_PART 0
#endif
#ifndef MK_ONE_LAUNCH
#define MK_ONE_LAUNCH 1
#endif

typedef unsigned short bf16_t;
typedef short bf16x8 __attribute__((ext_vector_type(8)));
typedef short bf16x4 __attribute__((ext_vector_type(4)));
typedef float f32x4 __attribute__((ext_vector_type(4)));
typedef float f32x2 __attribute__((ext_vector_type(2)));
typedef unsigned u32x4 __attribute__((ext_vector_type(4)));
typedef unsigned u32x2 __attribute__((ext_vector_type(2)));

constexpr int D = 1024, BATCH = 16, SEQ = 2048, T = BATCH * SEQ;
constexpr int NMEM = 256, HD = 64;
constexpr int RH = 6, RC = 384;
constexpr int RWKV_IN = 1344;
constexpr int AH = 6, AW = 384, MH = 4, MW = 256;
constexpr int IN_W = 2752, IN_WP = 2816;
constexpr int PA_W = IN_WP - RWKV_IN;
constexpr int NE = 32, TOPK = 4, FF = 1024;
constexpr float LN_EPS = 1e-5f, GN_EPS = 64e-5f;
constexpr float ALPHA = 1.189207115002721f;
constexpr int NTHR = 512, NWAVES = 8;

constexpr size_t MiB = 1u << 20;
constexpr size_t WS_CTL = 0;
constexpr size_t WS_WT_IN = 1 * MiB;
constexpr size_t WS_LORA = 6 * MiB + 512 * 1024;
constexpr size_t WS_WT_OUT = 7 * MiB;
constexpr size_t WS_WT_KV = 9 * MiB;
constexpr size_t WS_KVM = 10 * MiB;
constexpr size_t WS_MEMB = 14 * MiB;
constexpr size_t WS_LIST = 22 * MiB;
constexpr size_t WS_ROWGATE = 26 * MiB;
constexpr size_t WS_SEL = 30 * MiB;
constexpr size_t WS_BONUS = 31 * MiB;
constexpr size_t WS_WRT = 31 * MiB + 800 * 1024;
constexpr size_t WS_WT_GU = 32 * MiB;
constexpr size_t WS_WT_DN = 160 * MiB;
constexpr size_t WS_H0B = 224 * MiB;
constexpr size_t WS_H1B = 288 * MiB;
constexpr size_t WS_YMIX = 352 * MiB;
constexpr size_t WS_PR = 416 * MiB;
constexpr size_t WS_ATTO = 416 * MiB;
constexpr size_t WS_PA = 500 * MiB;
constexpr size_t WS_SSH = 592 * MiB;
constexpr size_t WS_SDIR = 736 * MiB;
constexpr size_t WS_ACT = 352 * MiB;
constexpr size_t WS_YROWS = 624 * MiB;
constexpr size_t WS_END = 1024 * MiB;
constexpr size_t DO_Y = 0, DO_G = 96 * MiB, DO_LSE = 120 * MiB;
constexpr int ROWS_PAD = T * TOPK + NE * 256;

constexpr int CW_CNT = 0;
constexpr int CNT_SET = (REPEAT_PHASE == 6) ? 32 : 0;
constexpr int CW_ATTQ = 64;
constexpr int CW_SCANQ = 128;
constexpr int CW_BAR = 4096;
constexpr int CTL_ZERO_BYTES = 65536;
constexpr int BARST_OFF = 131072 + 1536;

#define LAS __attribute__((address_space(3)))

struct Params { const float* in[28]; float* out; unsigned char* ws; int ph_lo, ph_hi; };

__device__ __forceinline__ unsigned f2bf(float f) { unsigned u = __builtin_bit_cast(unsigned, f); return (u + 0x7fffu + ((u >> 16) & 1u)) >> 16; }
__device__ __forceinline__ unsigned pk2(float lo, float hi) { return f2bf(lo) | (f2bf(hi) << 16); }
__device__ __forceinline__ float bf2f(unsigned b) { return __builtin_bit_cast(float, b << 16); }
__device__ __forceinline__ float bflo(unsigned w) { return __builtin_bit_cast(float, w << 16); }
__device__ __forceinline__ float bfhi(unsigned w) { return __builtin_bit_cast(float, w & 0xffff0000u); }
template <int CTRL> __device__ __forceinline__ float dpp_mov(float v) {
    return __builtin_bit_cast(float, __builtin_amdgcn_update_dpp(0, __builtin_bit_cast(int, v), CTRL, 0xF, 0xF, true));
}
__device__ __forceinline__ float sum16(float v) {
    v += dpp_mov<0xB1>(v);
    v += dpp_mov<0x4E>(v);
    v += dpp_mov<0x141>(v);
    v += dpp_mov<0x140>(v);
    return v;
}
__device__ __forceinline__ float wave_sum(float v) {
    v = sum16(v);
    const int iv = __builtin_bit_cast(int, v);
    const float a = __builtin_bit_cast(float, __builtin_amdgcn_readlane(iv, 0)), b = __builtin_bit_cast(float, __builtin_amdgcn_readlane(iv, 16));
    const float c = __builtin_bit_cast(float, __builtin_amdgcn_readlane(iv, 32)), d = __builtin_bit_cast(float, __builtin_amdgcn_readlane(iv, 48));
    return (a + b) + (c + d);
}
__device__ __forceinline__ float sigmoidf_(float x) { return 1.f / (1.f + __expf(-x)); }

struct P0Item { const float* W; bf16_t* WT; int K, N, item; };
__device__ __forceinline__ void p0_item_load(const P0Item& I, float (&reg)[32], int lane) {
    const int nblk = I.N / 32, kb = I.item / nblk, nb = I.item % nblk, k0 = 64 * kb, n0 = 32 * nb;
    const float* src = I.W + (size_t)(k0 + (lane >> 5)) * I.N + n0 + (lane & 31);
#pragma unroll
    for (int i = 0; i < 32; ++i) reg[i] = src[(size_t)(2 * i) * I.N];
}
__device__ __forceinline__ void p0_item_store(const P0Item& I, const float (&reg)[32], LAS float* scr, int lane) {
    const int nblk = I.N / 32, kb = I.item / nblk, nb = I.item % nblk, k0 = 64 * kb, n0 = 32 * nb;
#pragma unroll
    for (int i = 0; i < 32; ++i) scr[(2 * i + (lane >> 5)) * 33 + (lane & 31)] = reg[i];
    asm volatile("s_waitcnt lgkmcnt(0)" ::: "memory");
    const int c = lane & 7;
#pragma unroll
    for (int j = 0; j < 4; ++j) { const int n = (lane >> 3) + 8 * j; const LAS float* s = scr + (8 * c) * 33 + n;
        u32x4 o; o.x = pk2(s[0 * 33], s[1 * 33]); o.y = pk2(s[2 * 33], s[3 * 33]); o.z = pk2(s[4 * 33], s[5 * 33]); o.w = pk2(s[6 * 33], s[7 * 33]);
        *(u32x4*)(I.WT + (size_t)(n0 + n) * I.K + k0 + 8 * c) = o; }
    asm volatile("s_waitcnt lgkmcnt(0)" ::: "memory");
}
__device__ __forceinline__ void ln_row(f32x4 (&v)[4], const float* __restrict__ g, const float* __restrict__ b, int lane) {
    float s = 0.f;
#pragma unroll
    for (int j = 0; j < 4; ++j) s += (v[j].x + v[j].y) + (v[j].z + v[j].w);
    const float mean = wave_sum(s) * (1.f / D); float s2 = 0.f;
#pragma unroll
    for (int j = 0; j < 4; ++j) { v[j] = v[j] - mean; s2 += (v[j].x * v[j].x + v[j].y * v[j].y) + (v[j].z * v[j].z + v[j].w * v[j].w); }
    const float rstd = 1.f / sqrtf(wave_sum(s2) * (1.f / D) + LN_EPS);
#pragma unroll
    for (int j = 0; j < 4; ++j) { const f32x4 gg = *(const f32x4*)(g + 4 * lane + 256 * j), bb = *(const f32x4*)(b + 4 * lane + 256 * j); v[j] = v[j] * rstd * gg + bb; }
}
__device__ __forceinline__ void store_row_bf16(bf16_t* orow, const f32x4 (&v)[4], int lane) {
#pragma unroll
    for (int j = 0; j < 4; ++j) { u32x2 o; o.x = pk2(v[j].x, v[j].y); o.y = pk2(v[j].z, v[j].w); *(u32x2*)(orow + 4 * lane + 256 * j) = o; }
}

__device__ __forceinline__ void phase0(const Params& p, LAS unsigned char* lds) {
    const int tid = threadIdx.x, lane = tid & 63, wave = tid >> 6;
    const int gw = blockIdx.x * NWAVES + wave, NGW = gridDim.x * NWAVES;
    LAS float* scr = (LAS float*)(lds + wave * 16384);
    unsigned char* ws = p.ws;
    constexpr int I_IN = 16 * (IN_W / 32), I_OUT = 16 * 32, I_KV = 16 * 16, I_GU = 16 * 64, I_DN = 16 * 32;
    constexpr int NITEMS = I_IN + I_OUT + I_KV + NE * I_GU + NE * I_DN;
    auto mk = [&](int it) { P0Item I; int r = it;
        if (r < I_IN) { I.W = p.in[4]; I.WT = (bf16_t*)(ws + WS_WT_IN); I.K = D; I.N = IN_W; I.item = r; return I; } r -= I_IN;
        if (r < I_OUT) { I.W = p.in[17]; I.WT = (bf16_t*)(ws + WS_WT_OUT); I.K = D; I.N = D; I.item = r; return I; } r -= I_OUT;
        if (r < I_KV) { I.W = p.in[16]; I.WT = (bf16_t*)(ws + WS_WT_KV); I.K = D; I.N = 2 * MW; I.item = r; return I; } r -= I_KV;
        if (r < NE * I_GU) { const int e = r / I_GU; I.W = p.in[22] + (size_t)e * D * 2 * FF; I.WT = (bf16_t*)(ws + WS_WT_GU) + (size_t)e * 2 * FF * D; I.K = D; I.N = 2 * FF; I.item = r % I_GU; return I; } r -= NE * I_GU;
        { const int e = r / I_DN; I.W = p.in[24] + (size_t)e * FF * D; I.WT = (bf16_t*)(ws + WS_WT_DN) + (size_t)e * D * FF; I.K = FF; I.N = D; I.item = r % I_DN; return I; } };
    { float ra[32], rb[32]; int it = gw;
      if (it < NITEMS) { const P0Item I0 = mk(it); p0_item_load(I0, ra, lane); }
      for (; it < NITEMS; it += 2 * NGW) {
          const P0Item Ia = mk(it); const bool hb = it + NGW < NITEMS; P0Item Ib = Ia;
          if (hb) { Ib = mk(it + NGW); p0_item_load(Ib, rb, lane); }
          p0_item_store(Ia, ra, scr, lane);
          if (it + 2 * NGW < NITEMS) { const P0Item Ic = mk(it + 2 * NGW); p0_item_load(Ic, ra, lane); }
          if (hb) p0_item_store(Ib, rb, scr, lane);
      } }
    { u32x4* z = (u32x4*)((bf16_t*)(ws + WS_WT_IN) + (size_t)IN_W * D); const int n16 = (IN_WP - IN_W) * D * 2 / 16;
      for (int i = blockIdx.x * NTHR + tid; i < n16; i += gridDim.x * NTHR) z[i] = (u32x4){0u, 0u, 0u, 0u}; }
    { const float* wr = p.in[20]; bf16_t* wh = (bf16_t*)(ws + WS_WRT); bf16_t* wl = wh + NE * D;
      for (int i = blockIdx.x * NTHR + tid; i < NE * D; i += gridDim.x * NTHR) { const int e = i / D, k = i % D; const float w = wr[k * NE + e]; const unsigned h = f2bf(w); wh[i] = (bf16_t)h; wl[i] = (bf16_t)f2bf(w - bf2f(h)); } }
    { bf16_t* wu = (bf16_t*)(ws + WS_LORA); bf16_t* au = wu + 2 * RC * 32; bf16_t* gu = au + 2 * RC * 32;
      for (int i = blockIdx.x * NTHR + tid; i < 2 * RC * 32; i += gridDim.x * NTHR) { const int dch = i >> 5, j = i & 31, d = dch / RC, ch = dch % RC; wu[i] = (bf16_t)f2bf(p.in[7][(size_t)(d * 32 + j) * RC + ch]); au[i] = (bf16_t)f2bf(p.in[9][(size_t)(d * 32 + j) * RC + ch]); }
      for (int i = blockIdx.x * NTHR + tid; i < RC * 64; i += gridDim.x * NTHR) { const int ch = i >> 6, j = i & 63; gu[i] = (bf16_t)f2bf(p.in[10][(size_t)j * RC + ch]); } }
    for (int m = gw; m < T; m += NGW) {
        const f32x4* xr = (const f32x4*)(p.in[0] + (size_t)m * D) + lane; f32x4 v[4];
#pragma unroll
        for (int j = 0; j < 4; ++j) v[j] = xr[64 * j];
        ln_row(v, p.in[2], p.in[3], lane);
        store_row_bf16((bf16_t*)(ws + WS_H0B) + (size_t)m * D, v, lane);
    }
    for (int m = gw; m < BATCH * NMEM; m += NGW) {
        const f32x4* xr = (const f32x4*)(p.in[1] + (size_t)m * D) + lane; f32x4 v[4];
#pragma unroll
        for (int j = 0; j < 4; ++j) v[j] = xr[64 * j];
        store_row_bf16((bf16_t*)(ws + WS_MEMB) + (size_t)m * D, v, lane);
    }
}

template <class ARow, class BRow, class Epi>
__device__ __forceinline__ void sgemm_tile(int K, ARow arow, BRow brow, Epi epi) {
    const int tid = threadIdx.x, wid = tid >> 6, lane = tid & 63, wm = wid >> 1, wn = wid & 1, fr = lane & 15, fq = lane >> 4;
    f32x4 acc[2][4];
#pragma unroll
    for (int m = 0; m < 2; ++m)
#pragma unroll
        for (int n = 0; n < 4; ++n) acc[m][n] = (f32x4){0.f, 0.f, 0.f, 0.f};
    const bf16_t* ap[2]; const bf16_t* bp[4];
#pragma unroll
    for (int m = 0; m < 2; ++m) ap[m] = arow(wm * 32 + m * 16 + fr) + fq * 8;
#pragma unroll
    for (int n = 0; n < 4; ++n) bp[n] = brow(wn * 64 + n * 16 + fr) + fq * 8;
    for (int k = 0; k < K; k += 32) {
        bf16x8 a[2], b[4];
#pragma unroll
        for (int m = 0; m < 2; ++m) a[m] = *(const bf16x8*)(ap[m] + k);
#pragma unroll
        for (int n = 0; n < 4; ++n) b[n] = *(const bf16x8*)(bp[n] + k);
#pragma unroll
        for (int m = 0; m < 2; ++m)
#pragma unroll
            for (int n = 0; n < 4; ++n) acc[m][n] = __builtin_amdgcn_mfma_f32_16x16x32_bf16(b[n], a[m], acc[m][n], 0, 0, 0);
    }
#pragma unroll
    for (int m = 0; m < 2; ++m)
#pragma unroll
        for (int n = 0; n < 4; ++n) epi(wm * 32 + m * 16 + fr, wn * 64 + n * 16 + 4 * fq, acc[m][n], n);
}


namespace pg8 {
constexpr int BM = 256, BK = 64, HALF = 128, HTB = HALF * BK * 2, STAGE_BYTES = 8 * HTB, NXCD = 8, WGM = 8;
__host__ __device__ __forceinline__ int lds_byte(int r, int c) { const int st = (r >> 4) * 2 + (c >> 5), rr = r & 15, cc = c & 31, ob = rr * 64 + cc * 2; return st * 1024 + (ob ^ (((ob >> 9) & 1) << 5)); }
__host__ __device__ __forceinline__ void stage_rc(int b, int& R, int& C) { const int st = b / 1024, sb = b % 1024, swz = sb ^ (((sb >> 9) & 1) << 5); R = (st >> 1) * 16 + swz / 64; C = (st & 1) * 32 + (swz % 64) / 2; }
__host__ __device__ __forceinline__ int perm32(int rho) { const int n = rho >> 4, i = rho & 15; return 8 * (i >> 2) + 4 * n + (i & 3); }
struct Unit { const char* A; const char* B0; const char* B1; int x0, x1, x2, x3, x4; };
__device__ __forceinline__ unsigned cvt_pk_bf16(float lo, float hi) { unsigned r; asm volatile("v_cvt_pk_bf16_f32 %0, %1, %2" : "=v"(r) : "v"(lo), "v"(hi)); return r; }

__device__ __forceinline__ const char* uni_ptr(const char* p) { const unsigned long long v = (unsigned long long)p; const unsigned lo = __builtin_amdgcn_readfirstlane((unsigned)v), hi = __builtin_amdgcn_readfirstlane((unsigned)(v >> 32)); return (const char*)(((unsigned long long)hi << 32) | lo); }
__device__ __forceinline__ bool static_order(int nM, int nN, int G, int c, int i, int& pm, int& pn) {
    const int nwg = nM * nN; const long L = (long)i * G + c; if (L >= nwg) return false;
    int wgid = (int)L; { const int q = nwg / NXCD, r = nwg % NXCD, xcd = wgid % NXCD, off = wgid / NXCD; wgid = (xcd < r ? xcd * (q + 1) : r * (q + 1) + (xcd - r) * q) + off; }
    const int nig = WGM * nN, gid = wgid / nig, fm = gid * WGM, gsz = (nM - fm) < WGM ? (nM - fm) : WGM;
    pm = fm + ((wgid % nig) % gsz); pn = (wgid % nig) / gsz; return true;
}

template <class Pol>
__device__ __forceinline__ void gemm_phase(LAS unsigned char* lds, const Pol& P, const int K, unsigned long long* stat = nullptr) {
    unsigned long long tK = 0, tE = 0, tmark = 0, tstart = stat ? __builtin_amdgcn_s_memrealtime() : 0;
    const int tid = threadIdx.x, wid = __builtin_amdgcn_readfirstlane(tid >> 6), lane = tid & 63, wr = wid >> 2, wc = wid & 3, fr = lane & 15, fq = lane >> 4;
    const int nt = K / BK;
    int R0, C0; stage_rc(tid * 16, R0, C0);
    const int Rb0 = Pol::PERM ? ((R0 & ~31) + perm32(R0 & 31)) : R0;
    const unsigned vB = (unsigned)(Rb0 * K + C0) * 2u;
    const size_t pstep = (size_t)64 * K * 2;
    const size_t kstep = (size_t)(BK * 2);
    const unsigned ldsw = (unsigned)wid * 1024u;
    const int aoff = lds_byte(wr * 64 + fr, fq * 8), boff = lds_byte(wc * 32 + fr, fq * 8);
#define PG8_SA(b, h) (((b) * 2 + (h)) * HTB)
#define PG8_SB(b, h) ((4 + (b) * 2 + (h)) * HTB)
#define PG8_STAGE_B(bufoff, gbase) do { _Pragma("unroll") for (int _i = 0; _i < 2; ++_i) \
        __builtin_amdgcn_global_load_lds((const unsigned*)(uni_ptr((const char*)(gbase) + _i * pstep) + vB), (LAS unsigned*)(lds + (bufoff) + ldsw + _i * 8192), 16, 0, 0); } while (0)
#define PG8_STAGE_A(bufoff, gbase, vo, h) do { _Pragma("unroll") for (int _i = 0; _i < 2; ++_i) { \
        if constexpr (Pol::GATHER) __builtin_amdgcn_global_load_lds((const unsigned*)(uni_ptr((const char*)(gbase)) + (vo)[h][_i]), (LAS unsigned*)(lds + (bufoff) + ldsw + _i * 8192), 16, 0, 0); \
        else __builtin_amdgcn_global_load_lds((const unsigned*)(uni_ptr((const char*)(gbase) + ((h) * 2 + _i) * pstep) + (vo)[0][0]), (LAS unsigned*)(lds + (bufoff) + ldsw + _i * 8192), 16, 0, 0); } } while (0)
#define PG8_LDA(dst, b, h) do { _Pragma("unroll") for (int m = 0; m < 4; ++m) _Pragma("unroll") for (int k = 0; k < 2; ++k) dst[m][k] = *(const LAS bf16x8*)(lds + PG8_SA(b, h) + aoff + m * 2048 + k * 1024); } while (0)
#define PG8_LDB(dst, b, h) do { _Pragma("unroll") for (int n = 0; n < 2; ++n) _Pragma("unroll") for (int k = 0; k < 2; ++k) dst[n][k] = *(const LAS bf16x8*)(lds + PG8_SB(b, h) + boff + n * 2048 + k * 1024); } while (0)
#define PG8_MMA(ai, bj, At, Bt) do { __builtin_amdgcn_s_setprio(1); _Pragma("unroll") for (int m = 0; m < 4; ++m) _Pragma("unroll") for (int n = 0; n < 2; ++n) _Pragma("unroll") for (int k = 0; k < 2; ++k) \
        acc[ai][bj][m][n] = __builtin_amdgcn_mfma_f32_16x16x32_bf16(Bt[n][k], At[m][k], acc[ai][bj][m][n], 0, 0, 0); __builtin_amdgcn_s_setprio(0); } while (0)
#define PG8_WAIT_V(n) asm volatile("s_waitcnt vmcnt(" #n ")" ::: "memory")
#define PG8_WAIT_L(n) asm volatile("s_waitcnt lgkmcnt(" #n ")" ::: "memory")
#define PG8_BAR __builtin_amdgcn_s_barrier()
#define PG8_SCHED __builtin_amdgcn_sched_barrier(0)
    Unit cur, nxt; int ui = 0;
    if (!P.next(0, cur)) return;
    f32x4 acc[2][2][4][2];
#pragma unroll
    for (int a = 0; a < 2; ++a)
#pragma unroll
        for (int b = 0; b < 2; ++b)
#pragma unroll
            for (int m = 0; m < 4; ++m)
#pragma unroll
                for (int n = 0; n < 2; ++n) acc[a][b][m][n] = (f32x4){0.f, 0.f, 0.f, 0.f};
    bf16x8 At[4][2], B0[2][2], B1[2][2];
    unsigned vAc[2][2], vAn[2][2];
    if constexpr (Pol::GATHER) { P.rows_issue(cur, R0, vAc); P.rows_finish(C0, K, vAc); }
    else { vAc[0][0] = (unsigned)(R0 * K + C0) * 2u; vAc[0][1] = vAc[1][0] = vAc[1][1] = 0u; }
    asm volatile("s_waitcnt vmcnt(0)" ::: "memory");
    PG8_STAGE_B(PG8_SB(0, 0), cur.B0); PG8_STAGE_B(PG8_SB(0, 1), cur.B1); PG8_STAGE_A(PG8_SA(0, 0), cur.A, vAc, 0); PG8_STAGE_A(PG8_SA(0, 1), cur.A, vAc, 1);
    if (wr == 1) PG8_BAR;
    PG8_WAIT_V(2); PG8_BAR;
    PG8_STAGE_B(PG8_SB(1, 0), cur.B0 + kstep); PG8_STAGE_A(PG8_SA(1, 0), cur.A + kstep, vAc, 0); PG8_STAGE_B(PG8_SB(1, 1), cur.B1 + kstep);
    PG8_WAIT_V(6); PG8_BAR;
    for (;;) {
        const bool has_next = P.next(ui + 1, nxt);
        if (!has_next) nxt = cur;
        if (stat) tmark = __builtin_amdgcn_s_memrealtime();
        for (int t = 0; t < nt; t += 2) {
            const bool last = (t == nt - 2);
            if constexpr (Pol::GATHER) {
                if (last && has_next) { P.rows_issue(nxt, R0, vAn); vAc[0][0] = (vAn[0][0] * (unsigned)K + (unsigned)C0) * 2u; vAc[0][1] = (vAn[0][1] * (unsigned)K + (unsigned)C0) * 2u; }
            }
            const char* a1 = cur.A + (size_t)(t + 1) * kstep;
            const char* a2 = last ? nxt.A : cur.A + (size_t)(t + 2) * kstep;
            const char* b20 = last ? nxt.B0 : cur.B0 + (size_t)(t + 2) * kstep; const char* b21 = last ? nxt.B1 : cur.B1 + (size_t)(t + 2) * kstep;
            const char* a3 = a2 + kstep; const char* b30 = b20 + kstep; const char* b31 = b21 + kstep;
            PG8_LDB(B0, 0, 0); PG8_LDB(B1, 0, 1); PG8_SCHED; PG8_LDA(At, 0, 0); PG8_STAGE_A(PG8_SA(1, 1), a1, vAc, 1);
            if constexpr (Pol::GATHER) { if (last && has_next) { vAc[1][0] = (vAn[1][0] * (unsigned)K + (unsigned)C0) * 2u; vAc[1][1] = (vAn[1][1] * (unsigned)K + (unsigned)C0) * 2u; } }
            PG8_WAIT_V(8); PG8_WAIT_L(0); PG8_BAR; PG8_MMA(0, 0, At, B0); PG8_MMA(0, 1, At, B1); PG8_BAR; PG8_SCHED;
            PG8_LDA(At, 0, 1); PG8_STAGE_B(PG8_SB(0, 0), b20); PG8_STAGE_B(PG8_SB(0, 1), b21); PG8_STAGE_A(PG8_SA(0, 0), a2, vAc, 0);
            PG8_WAIT_V(8); PG8_WAIT_L(0); PG8_BAR; PG8_MMA(1, 0, At, B0); PG8_MMA(1, 1, At, B1); PG8_BAR; PG8_SCHED;
            PG8_LDB(B0, 1, 0); PG8_LDB(B1, 1, 1); PG8_SCHED; PG8_LDA(At, 1, 0); PG8_STAGE_A(PG8_SA(0, 1), a2, vAc, 1);
            PG8_WAIT_V(8); PG8_WAIT_L(0); PG8_BAR; PG8_MMA(0, 0, At, B0); PG8_MMA(0, 1, At, B1); PG8_BAR; PG8_SCHED;
            PG8_LDA(At, 1, 1); PG8_STAGE_B(PG8_SB(1, 0), b30); PG8_STAGE_B(PG8_SB(1, 1), b31); PG8_STAGE_A(PG8_SA(1, 0), a3, vAc, 0);
            PG8_WAIT_V(8); PG8_WAIT_L(0); PG8_BAR; PG8_MMA(1, 0, At, B0); PG8_MMA(1, 1, At, B1); PG8_BAR; PG8_SCHED;
        }
        if (stat) { const unsigned long long n_ = __builtin_amdgcn_s_memrealtime(); tK += n_ - tmark; tmark = n_; }
        if (wr == 0) PG8_BAR;
        P.epi(acc, cur, wr, wc, fr, fq);
        if (stat) { const unsigned long long n_ = __builtin_amdgcn_s_memrealtime(); tE += n_ - tmark; }
        if (!has_next) break;
#pragma unroll
        for (int a = 0; a < 2; ++a)
#pragma unroll
            for (int b = 0; b < 2; ++b)
#pragma unroll
                for (int m = 0; m < 4; ++m)
#pragma unroll
                    for (int n = 0; n < 2; ++n) acc[a][b][m][n] = (f32x4){0.f, 0.f, 0.f, 0.f};
        cur = nxt; ++ui;
        if (wr == 1) PG8_BAR;
    }
    PG8_WAIT_V(0);
    PG8_BAR;
    if (stat && threadIdx.x == 0) { stat[0] = tK; stat[1] = tE; stat[2] = __builtin_amdgcn_s_memrealtime() - tstart; }
#undef PG8_SA
#undef PG8_SB
#undef PG8_STAGE_A
#undef PG8_STAGE_B
#undef PG8_LDA
#undef PG8_LDB
#undef PG8_MMA
#undef PG8_WAIT_V
#undef PG8_WAIT_L
#undef PG8_BAR
#undef PG8_SCHED
}
}

struct PolP1 {
    static constexpr bool PERM = true, GATHER = false;
    const bf16_t* A; const bf16_t* Bt; bf16_t* PR; bf16_t* PA; const bf16_t* MB; const bf16_t* WK; bf16_t* KVM; int G, c;
    __device__ __forceinline__ bool next(int i, pg8::Unit& u) const { int pm, pn; constexpr int NMAIN = (T / 256) * (IN_WP / 256), NKV = (BATCH * NMEM / 256) * (2 * MW / 256);
        if (pg8::static_order(T / 256, IN_WP / 256, G, c, i, pm, pn)) {
            u.A = (const char*)(A + (size_t)pm * 256 * D); u.B0 = (const char*)(Bt + (size_t)pn * 256 * D); u.B1 = u.B0 + (size_t)128 * D * 2; u.x0 = pm; u.x1 = pn; u.x2 = 0; u.x3 = 0; u.x4 = 0; return true; }
        const long L = (long)i * G + c - NMAIN; if (L < 0 || L >= NKV) return false;
        pm = (int)(L >> 1); pn = (int)(L & 1);
        u.A = (const char*)(MB + (size_t)pm * 256 * D); u.B0 = (const char*)(WK + (size_t)pn * 256 * D); u.B1 = u.B0 + (size_t)128 * D * 2; u.x0 = pm; u.x1 = pn; u.x2 = 1; u.x3 = 0; u.x4 = 0; return true; }
    __device__ __forceinline__ void epi(const f32x4 (&acc)[2][2][4][2], const pg8::Unit& u, int wr, int wc, int fr, int fq) const {
        const int row0 = u.x0 * 256 + wr * 64 + fr;
#pragma unroll
        for (int bj = 0; bj < 2; ++bj) { const int col = u.x1 * 256 + bj * 128 + wc * 32 + 8 * fq;
            bf16_t* base; int pitch; float sc = 1.f;
            if (u.x2) { base = KVM + col; pitch = 2 * MW; }
            else if (col < RWKV_IN) { base = PR + col; pitch = RWKV_IN; }
            else { const int ca = col - RWKV_IN; base = PA + ca; pitch = PA_W; sc = (ca < AW || (ca >= 3 * AW && ca < 3 * AW + MW)) ? 0.125f : 1.f; }
#pragma unroll
            for (int ai = 0; ai < 2; ++ai)
#pragma unroll
                for (int m = 0; m < 4; ++m) { const f32x4 v0 = acc[ai][bj][m][0] * sc, v1 = acc[ai][bj][m][1] * sc;
                    u32x4 w; w.x = pg8::cvt_pk_bf16(v0[0], v0[1]); w.y = pg8::cvt_pk_bf16(v0[2], v0[3]); w.z = pg8::cvt_pk_bf16(v1[0], v1[1]); w.w = pg8::cvt_pk_bf16(v1[2], v1[3]);
                    *(u32x4*)(base + (size_t)(row0 + ai * 128 + m * 16) * pitch) = w; } }
    }
};
__device__ __forceinline__ void phase1(const Params& p, LAS unsigned char* lds) {
    unsigned char* ws = p.ws;
    PolP1 P{(const bf16_t*)(ws + WS_H0B), (const bf16_t*)(ws + WS_WT_IN), (bf16_t*)(ws + WS_PR), (bf16_t*)(ws + WS_PA), (const bf16_t*)(ws + WS_MEMB), (const bf16_t*)(ws + WS_WT_KV), (bf16_t*)(ws + WS_KVM), (int)gridDim.x, (int)blockIdx.x};
    pg8::gemm_phase(lds, P, D, (PROBE_GEMM == 1 && blockIdx.x == 0) ? (unsigned long long*)(ws + WS_CTL + 32768) : nullptr);
}

constexpr int P2_AP = 200;
__device__ __forceinline__ f32x4 p2_shift(const bf16_t* cur, int po, int no, float pm, float nm, const float* mu) {
    const u32x2 c = *(const u32x2*)cur, pv = *(const u32x2*)(cur + po), nv = *(const u32x2*)(cur + no);
    const f32x4 m = *(const f32x4*)mu;
    const f32x4 cc = {bflo(c.x), bfhi(c.x), bflo(c.y), bfhi(c.y)}, pp = {bflo(pv.x), bfhi(pv.x), bflo(pv.y), bfhi(pv.y)}, nn = {bflo(nv.x), bfhi(nv.x), bflo(nv.y), bfhi(nv.y)};
    return cc + m * (0.5f * (pp * pm + nn * nm) - cc);
}
constexpr int P2_CST = 8 * 16 * P2_AP * 2;
constexpr int P2_WOFF = P2_CST + 10 * RC * 4, P2_WBUF = 24576;
struct P2Pre { u32x2 rc, rp, rn, vc, vp, vn; };
__device__ __forceinline__ f32x4 p2_lerp(u32x2 c, u32x2 pv, u32x2 nv, float pm, float nm, f32x4 m) {
    const f32x4 cc = {bflo(c.x), bfhi(c.x), bflo(c.y), bfhi(c.y)}, pp = {bflo(pv.x), bfhi(pv.x), bflo(pv.y), bfhi(pv.y)}, nn = {bflo(nv.x), bfhi(nv.x), bflo(nv.y), bfhi(nv.y)};
    return cc + m * (0.5f * (pp * pm + nn * nm) - cc);
}
__device__ __forceinline__ void p2_fetch(P2Pre& P, const bf16_t* prow, int po, int no, const bf16_t* WU, const bf16_t* AU, const bf16_t* GU, int it, int fr, int fq) {
    const int h = it >> 2, ct = it & 3, ch = h * 64 + 16 * ct + 4 * fq;
    P.rc = *(const u32x2*)(prow + ch); P.rp = *(const u32x2*)(prow + ch + po); P.rn = *(const u32x2*)(prow + ch + no);
    P.vc = *(const u32x2*)(prow + 2 * RC + ch); P.vp = *(const u32x2*)(prow + 2 * RC + ch + po); P.vn = *(const u32x2*)(prow + 2 * RC + ch + no);
}
__device__ __forceinline__ void p2_wfetch(const bf16_t* WU, const bf16_t* AU, const bf16_t* GU, int h, int tid, u32x4 (&wr)[3]) {
#pragma unroll
    for (int q = 0; q < 3; ++q) { const int idx = tid + NTHR * q; const bf16_t* src;
        if (q < 2) { const int d = (idx & 511) >> 8, row = (idx & 255) >> 2, part = idx & 3; src = (q == 0 ? WU : AU) + ((size_t)(d * RC + h * 64 + row) * 32 + part * 8); }
        else { const int row = (idx - 1024) >> 3, part = idx & 7; src = GU + ((size_t)(h * 64 + row) * 64 + part * 8); }
        wr[q] = *(const u32x4*)src; }
}
__device__ __forceinline__ void p2_wput(LAS unsigned char* wb, int tid, const u32x4 (&wr)[3]) {
#pragma unroll
    for (int q = 0; q < 3; ++q) *(LAS u32x4*)(wb + (tid + NTHR * q) * 16) = wr[q];
}
__device__ __forceinline__ void phase2(const Params& p, LAS unsigned char* lds) {
    int tid_ = threadIdx.x; asm volatile("" : "+v"(tid_)); const int tid = tid_, lane = tid & 63, wave = tid >> 6, fr = lane & 15, fq = lane >> 4;
    unsigned char* ws = p.ws;
    const bf16_t* PR = (const bf16_t*)(ws + WS_PR);
    const float* mu = p.in[5];
    const bf16_t* WU = (const bf16_t*)(ws + WS_LORA); const bf16_t* AU = WU + 2 * RC * 32; const bf16_t* GU = AU + 2 * RC * 32;
    LAS bf16_t* ACT = (LAS bf16_t*)(lds + wave * (16 * P2_AP * 2));
    LAS float* CST = (LAS float*)(lds + P2_CST);
    unsigned char* SSH = ws + WS_SSH; unsigned char* SDIR = ws + WS_SDIR;
    bf16_t* G = (bf16_t*)((unsigned char*)p.out + DO_G); float* BON = (float*)(ws + WS_BONUS);
    __syncthreads();
    for (int i = tid; i < 10 * RC; i += NTHR) { const int a = i / RC, c = i % RC; float v;
        if (a < 3) v = mu[a * RC + c]; else if (a < 5) v = p.in[6][(a - 3) * RC + c]; else if (a < 7) v = p.in[8][(a - 5) * RC + c]; else v = p.in[11 + (a - 7)][c];
        CST[i] = v; }
    u32x4 wreg[3];
    p2_wfetch(WU, AU, GU, 0, tid, wreg); p2_wput(lds + P2_WOFF, tid, wreg);
    __syncthreads();
    { const int tile = blockIdx.x * NWAVES + wave;
        const int t0 = tile * 16;
#pragma unroll 4
        for (int i = 0; i < 12; ++i) { const int grp = lane + 64 * i, tok = grp / 48, c4 = (grp % 48) * 4, t = t0 + tok, sq = t & (SEQ - 1);
            f32x4 v = p2_shift(PR + (size_t)t * RWKV_IN + 3 * RC + c4, sq > 0 ? -RWKV_IN : 0, sq < SEQ - 1 ? RWKV_IN : 0, sq > 0 ? 1.f : 0.f, sq < SEQ - 1 ? 1.f : 0.f, mu + 3 * RC + c4);
            { const float sc = c4 < 64 ? 1.f : 2.f, mul = c4 < 64 ? 1.f : 2.f, add = c4 < 64 ? 0.f : -1.f; const bool raw = c4 >= 128;
#pragma unroll
              for (int e = 0; e < 4; ++e) { const float a = sigmoidf_(sc * v[e]) * mul + add; v[e] = raw ? v[e] : a; } }
            u32x2 o; o.x = pk2(v.x, v.y); o.y = pk2(v.z, v.w); *(LAS u32x2*)(ACT + tok * P2_AP + c4) = o; }
        asm volatile("s_waitcnt lgkmcnt(0)" ::: "memory");
        const int t = t0 + fr, sq = t & (SEQ - 1), b = t >> 11; const int po = sq > 0 ? -RWKV_IN : 0, no = sq < SEQ - 1 ? RWKV_IN : 0; const float pm = sq > 0 ? 1.f : 0.f, nm = sq < SEQ - 1 ? 1.f : 0.f;
        const bf16_t* prow = PR + (size_t)t * RWKV_IN;
        const LAS bf16_t* arowp = ACT + fr * P2_AP + 8 * fq;
        u32x2 kq[4][3];
#pragma unroll
        for (int ct = 0; ct < 4; ++ct) { const int ch = RC + 16 * ct + 4 * fq; kq[ct][0] = *(const u32x2*)(prow + ch); kq[ct][1] = *(const u32x2*)(prow + ch + po); kq[ct][2] = *(const u32x2*)(prow + ch + no); }
        P2Pre cur, nxt; p2_fetch(cur, prow, po, no, WU, AU, GU, 0, fr, fq);
#pragma unroll 1
        for (int h = 0; h < RH; ++h) {
            if (h + 1 < RH) p2_wfetch(WU, AU, GU, h + 1, tid, wreg);
            const LAS unsigned char* wbuf = lds + P2_WOFF + (h & 1) * P2_WBUF;
            f32x4 kp[4]; float ss = 0.f;
#pragma unroll
            for (int ct = 0; ct < 4; ++ct) { const int ch = h * 64 + 16 * ct + 4 * fq; kp[ct] = p2_lerp(kq[ct][0], kq[ct][1], kq[ct][2], pm, nm, *(const LAS f32x4*)(CST + RC + ch));
                const f32x4 kkv = kp[ct] * *(const LAS f32x4*)(CST + 7 * RC + ch); ss += (kkv.x * kkv.x + kkv.y * kkv.y) + (kkv.z * kkv.z + kkv.w * kkv.w); }
            ss += __shfl_xor(ss, 16); ss += __shfl_xor(ss, 32);
            const float rn = 1.f / fmaxf(sqrtf(ss), 1e-12f);
            float bon = 0.f;
            unsigned char* shrec = SSH + ((size_t)(b * RH + h) * SEQ + sq) * 384;
            unsigned char* d0rec = SDIR + ((size_t)((0 * BATCH + b) * RH + h) * SEQ + sq) * 512; unsigned char* d1rec = SDIR + ((size_t)((1 * BATCH + b) * RH + h) * SEQ + sq) * 512;
#pragma unroll
            for (int ct = 0; ct < 4; ++ct) { const int ch = h * 64 + 16 * ct + 4 * fq, cl = 16 * ct + 4 * fq, it = h * 4 + ct;
                const f32x4 r = p2_lerp(cur.rc, cur.rp, cur.rn, pm, nm, *(const LAS f32x4*)(CST + ch)), v = p2_lerp(cur.vc, cur.vp, cur.vn, pm, nm, *(const LAS f32x4*)(CST + 2 * RC + ch)), k = kp[ct];
                const LAS unsigned char* wl_ = wbuf + ((16 * ct + fr) * 4 + fq) * 16;
                const bf16x8 fw0 = *(const LAS bf16x8*)wl_, fw1 = *(const LAS bf16x8*)(wl_ + 4096), fa0 = *(const LAS bf16x8*)(wl_ + 8192), fa1 = *(const LAS bf16x8*)(wl_ + 12288);
                const LAS unsigned char* gl_ = wbuf + 16384 + ((16 * ct + fr) * 8 + fq) * 16;
                const bf16x8 fg0 = *(const LAS bf16x8*)gl_, fg1 = *(const LAS bf16x8*)(gl_ + 64);
                const f32x4 z = {0.f, 0.f, 0.f, 0.f};
                const f32x4 wl0 = __builtin_amdgcn_mfma_f32_16x16x32_bf16(fw0, *(const LAS bf16x8*)(arowp + 64), z, 0, 0, 0);
                const f32x4 wl1 = __builtin_amdgcn_mfma_f32_16x16x32_bf16(fw1, *(const LAS bf16x8*)(arowp + 96), z, 0, 0, 0);
                const f32x4 al0 = __builtin_amdgcn_mfma_f32_16x16x32_bf16(fa0, *(const LAS bf16x8*)(arowp + 128), z, 0, 0, 0);
                const f32x4 al1 = __builtin_amdgcn_mfma_f32_16x16x32_bf16(fa1, *(const LAS bf16x8*)(arowp + 160), z, 0, 0, 0);
                f32x4 gg = __builtin_amdgcn_mfma_f32_16x16x32_bf16(fg0, *(const LAS bf16x8*)(arowp), z, 0, 0, 0);
                gg = __builtin_amdgcn_mfma_f32_16x16x32_bf16(fg1, *(const LAS bf16x8*)(arowp + 32), gg, 0, 0, 0);
                const f32x4 w00 = *(const LAS f32x4*)(CST + 3 * RC + ch), w01 = *(const LAS f32x4*)(CST + 4 * RC + ch), a00 = *(const LAS f32x4*)(CST + 5 * RC + ch), a01 = *(const LAS f32x4*)(CST + 6 * RC + ch);
                const f32x4 kkw = *(const LAS f32x4*)(CST + 7 * RC + ch), kaw = *(const LAS f32x4*)(CST + 8 * RC + ch), rkw = *(const LAS f32x4*)(CST + 9 * RC + ch);
                f32x4 dec0, dec1, kd0, kd1, bb0, bb1, kkn;
#pragma unroll
                for (int e = 0; e < 4; ++e) {
                    dec0[e] = __expf(-0.6065306597126334f * sigmoidf_(w00[e] + wl0[e])); dec1[e] = __expf(-0.6065306597126334f * sigmoidf_(w01[e] + wl1[e]));
                    const float a0 = sigmoidf_(a00[e] + al0[e]), a1 = sigmoidf_(a01[e] + al1[e]);
                    kkn[e] = k[e] * kkw[e] * rn; kd0[e] = k[e] * (1.f + (a0 - 1.f) * kaw[e]); kd1[e] = k[e] * (1.f + (a1 - 1.f) * kaw[e]);
                    bb0[e] = kkn[e] * a0; bb1[e] = kkn[e] * a1; bon += r[e] * (kd0[e] + kd1[e]) * rkw[e]; }
                if (it + 1 < 4 * RH) p2_fetch(nxt, prow, po, no, WU, AU, GU, it + 1, fr, fq);
                if (ct == 3 && h + 1 < RH) {
#pragma unroll
                    for (int c2 = 0; c2 < 4; ++c2) { const int chn = RC + (h + 1) * 64 + 16 * c2 + 4 * fq; kq[c2][0] = *(const u32x2*)(prow + chn); kq[c2][1] = *(const u32x2*)(prow + chn + po); kq[c2][2] = *(const u32x2*)(prow + chn + no); } }
                { u32x2 o; o.x = pk2(r.x, r.y); o.y = pk2(r.z, r.w); *(u32x2*)(shrec + cl * 2) = o; o.x = pk2(v.x, v.y); o.y = pk2(v.z, v.w); *(u32x2*)(shrec + 128 + cl * 2) = o;
                  o.x = pk2(kkn.x, kkn.y); o.y = pk2(kkn.z, kkn.w); *(u32x2*)(shrec + 256 + cl * 2) = o;
                  *(f32x4*)(d0rec + cl * 4) = dec0; o.x = pk2(kd0.x, kd0.y); o.y = pk2(kd0.z, kd0.w); *(u32x2*)(d0rec + 256 + cl * 2) = o; o.x = pk2(bb0.x, bb0.y); o.y = pk2(bb0.z, bb0.w); *(u32x2*)(d0rec + 384 + cl * 2) = o;
                  *(f32x4*)(d1rec + cl * 4) = dec1; o.x = pk2(kd1.x, kd1.y); o.y = pk2(kd1.z, kd1.w); *(u32x2*)(d1rec + 256 + cl * 2) = o; o.x = pk2(bb1.x, bb1.y); o.y = pk2(bb1.z, bb1.w); *(u32x2*)(d1rec + 384 + cl * 2) = o; }
                u32x2 go; go.x = pk2(gg.x, gg.y); go.y = pk2(gg.z, gg.w); *(u32x2*)(G + (size_t)t * RC + ch) = go;
                cur = nxt;
                asm volatile("" ::: "memory");
            }
            bon += __shfl_xor(bon, 16); bon += __shfl_xor(bon, 32);
            if (fq == 0) BON[t * RH + h] = bon;
            if (h + 1 < RH) { p2_wput(lds + P2_WOFF + ((h + 1) & 1) * P2_WBUF, tid, wreg); __syncthreads(); }
        }
    }
}

typedef float f32x2_t __attribute__((ext_vector_type(2))); typedef __bf16 bf16x2_t __attribute__((ext_vector_type(2)));
__device__ __forceinline__ unsigned cvtpk(float lo, float hi) { const f32x2_t v = {lo, hi}; const bf16x2_t b = __builtin_convertvector(v, bf16x2_t); return __builtin_bit_cast(unsigned, b); }
constexpr int SC_TC = 32;
constexpr int SC_W = 0, SC_KK = 256, SC_RP = 384, SC_Z = 512, SC_UB = 640, SC_V = 1152, SC_STEPB = 1280;
constexpr int SC_BUFB = SC_TC * SC_STEPB;
struct ScanProd { const unsigned char* g0; const unsigned char* g1; long gstep0, gstep1; int ldst; int kind; };
__device__ __forceinline__ ScanProd scan_prod_init(const unsigned char* sh, const unsigned char* dr, int dir, int ptid) {
    ScanProd P; const int wi = ptid % 48, st0 = ptid / 48; int shift = 0; bool sh0 = false;
    P.g1 = dr; P.gstep1 = 0;
    if (wi < 16) { P.g0 = dr + wi * 16; P.ldst = SC_W + wi * 16; P.kind = 0; }
    else if (wi < 24) { const int c = wi - 16, ct = c >> 1; P.g0 = dr + 256 + c * 16; P.g1 = dr + 384 + c * 16; P.ldst = SC_UB + (ct >> 1) * 256 + (c & 1) * 128 + (ct & 1) * 8; P.kind = 1; }
    else if (wi < 32) { const int c = wi - 24; P.g0 = sh + 128 + c * 16; P.ldst = SC_V + c * 16; P.kind = 0; sh0 = true; }
    else { const int c = (wi - 32) & 7; const bool isr = wi >= 40; P.g0 = sh + (isr ? 0 : 256) + c * 16; sh0 = true; shift = isr ? 1 : 0; P.kind = 2;
        const int ct = c >> 1, fqb = 2 * (c & 1), pp = 32 * (ct >> 1) + 8 * fqb + (ct & 1) * 4; P.ldst = (isr ? SC_RP : SC_KK) + pp * 2; }
    const long rec0 = sh0 ? 384 : 512;
    const long t0 = dir ? (long)(SEQ - 1 - (st0 - shift)) : (long)(st0 - shift), t1 = dir ? (long)(SEQ - 1 - st0) : (long)st0;
    P.g0 += t0 * rec0; P.gstep0 = dir ? -rec0 : rec0; P.g1 += t1 * 512; P.gstep1 = dir ? -512 : 512; P.ldst += st0 * SC_STEPB; return P;
}
__device__ __forceinline__ void scan_fetch(const ScanProd& P, int c, u32x4 (&reg)[SC_TC / 4], u32x4 (&reg2)[SC_TC / 4]) {
    const unsigned char* a = P.g0 + (long)(c * SC_TC) * P.gstep0; const unsigned char* b = P.g1 + (long)(c * SC_TC) * P.gstep1;
#pragma unroll
    for (int q = 0; q < SC_TC / 4; ++q) { reg[q] = *(const u32x4*)(a + (long)(4 * q) * P.gstep0); reg2[q] = *(const u32x4*)(b + (long)(4 * q) * P.gstep1); }
}
__device__ __forceinline__ void scan_put(const ScanProd& P, LAS unsigned char* buf, const u32x4 (&reg)[SC_TC / 4], const u32x4 (&reg2)[SC_TC / 4]) {
    LAS unsigned char* d = buf + P.ldst;
    if (P.kind == 0) {
#pragma unroll
        for (int q = 0; q < SC_TC / 4; ++q) *(LAS u32x4*)(d + 4 * q * SC_STEPB) = reg[q];
    } else if (P.kind == 1) {
#pragma unroll
        for (int q = 0; q < SC_TC / 4; ++q) { const unsigned kw[4] = {reg[q].x, reg[q].y, reg[q].z, reg[q].w}, bw[4] = {reg2[q].x, reg2[q].y, reg2[q].z, reg2[q].w};
#pragma unroll
            for (int e = 0; e < 4; ++e) { const unsigned k0 = kw[e] & 0xffffu, k1 = kw[e] >> 16, b0 = bw[e] & 0xffffu, b1 = bw[e] >> 16;
                *(LAS u32x2*)(d + 4 * q * SC_STEPB + (2 * e) * 16) = (u32x2){k0 | (b0 << 16), b0};
                *(LAS u32x2*)(d + 4 * q * SC_STEPB + (2 * e + 1) * 16) = (u32x2){k1 | (b1 << 16), b1}; } }
    } else {
#pragma unroll
        for (int q = 0; q < SC_TC / 4; ++q) { *(LAS u32x2*)(d + 4 * q * SC_STEPB) = (u32x2){reg[q].x, reg[q].y}; *(LAS u32x2*)(d + 4 * q * SC_STEPB + 16) = (u32x2){reg[q].z, reg[q].w}; }
    }
}
__device__ __forceinline__ void scan_block(const Params& p, LAS unsigned char* lds, int sid) {
    const int tid = threadIdx.x, lane = tid & 63, wave = tid >> 6;
    const int dir = sid / (BATCH * RH), bh = sid % (BATCH * RH), b = bh / RH, h = bh % RH;
    const unsigned char* sh = p.ws + WS_SSH + (size_t)bh * SEQ * 384;
    const unsigned char* dr = p.ws + WS_SDIR + (size_t)(dir * BATCH * RH + bh) * SEQ * 512;
    float* Y = (float*)((unsigned char*)p.out + DO_Y) + (size_t)dir * T * RC;
    LAS unsigned char* buf0 = lds; LAS unsigned char* buf1 = lds + SC_BUFB;
    constexpr int NCH = SEQ / SC_TC;
    __syncthreads();
    for (int i = tid; i < 2 * SC_TC * 32; i += NTHR) { const int st = i >> 5, e = i & 31; *(LAS unsigned*)(lds + st * SC_STEPB + SC_Z + e * 4) = 0u; }
    const ScanProd SP = scan_prod_init(sh, dr, dir, (tid - 256) & 255);
    const bool prod = wave >= 4 && tid - 256 < 192;
    u32x4 preg[SC_TC / 4], preg2[SC_TC / 4];
    if (prod) { scan_fetch(SP, 0, preg, preg2); scan_put(SP, buf0, preg, preg2); scan_fetch(SP, 1, preg, preg2); }
    __syncthreads();
    const int fr = lane & 15, fq = lane >> 4, sel = (fr & 3) < 2 ? (fr & 3) : 2;
    f32x4 acc[4];
#pragma unroll
    for (int ct = 0; ct < 4; ++ct) acc[ct] = (f32x4){0.f, 0.f, 0.f, 0.f};
    bf16x8 sb0 = (bf16x8){0, 0, 0, 0, 0, 0, 0, 0}, sb1 = sb0;
    float* yrow = Y + (size_t)b * SEQ * RC + h * 64 + 16 * wave + fr;
    float yk = 0.f;
    const int ubo = fq == 0 ? SC_UB + fr * 16 : SC_Z, ubs = fq == 0 ? 256 : 0;
    for (int c = 0; c < NCH; ++c) {
        LAS unsigned char* cur = (c & 1) ? buf1 : buf0; LAS unsigned char* nxt = (c & 1) ? buf0 : buf1;
        if (wave >= 4) {
            if (prod && c + 1 < NCH) { scan_put(SP, nxt, preg, preg2); if (c + 2 < NCH) scan_fetch(SP, c + 2, preg, preg2); }
        } else {
            const LAS unsigned char* ab = cur + SC_KK + 128 * sel + fq * 16;
            const LAS unsigned char* wb = cur + SC_W + fq * 16;
            const LAS unsigned char* ub = cur + ubo;
            const LAS unsigned char* vb = cur + SC_V + (16 * wave + fr) * 2;
            bf16x8 cA0, cA1, nA0, nA1; u32x4 cU[2], nU[2]; f32x4 cW[4], nW[4]; unsigned cV, nV;
#define SC_LOAD(A0, A1, W, U, V, st) do { \
                A0 = *(const LAS bf16x8*)(ab + (st) * SC_STEPB); A1 = *(const LAS bf16x8*)(ab + (st) * SC_STEPB + 64); \
                _Pragma("unroll") for (int ct_ = 0; ct_ < 4; ++ct_) W[ct_] = *(const LAS f32x4*)(wb + (st) * SC_STEPB + ct_ * 64); \
                _Pragma("unroll") for (int cp_ = 0; cp_ < 2; ++cp_) U[cp_] = *(const LAS u32x4*)(ub + (st) * SC_STEPB + cp_ * ubs); \
                V = *(const LAS unsigned short*)(vb + (st) * SC_STEPB); } while (0)
            SC_LOAD(cA0, cA1, cW, cU, cV, 0);
#pragma unroll 1
            for (int g = 0; g < SC_TC / 4; ++g) {
#pragma unroll
                for (int u = 0; u < 4; ++u) {
                    const int st = 4 * g + u;
                    if (st + 1 < SC_TC) SC_LOAD(nA0, nA1, nW, nU, nV, st + 1);
                    f32x4 d = (f32x4){0.f, 0.f, 0.f, 0.f};
                    d = __builtin_amdgcn_mfma_f32_16x16x32_bf16(cA0, sb0, d, 0, 0, 0);
                    d = __builtin_amdgcn_mfma_f32_16x16x32_bf16(cA1, sb1, d, 0, 0, 0);
                    f32x4 cc[4];
#pragma unroll
                    for (int ct = 0; ct < 4; ++ct) cc[ct] = acc[ct] * cW[ct];
                    yk = (((u + 3) & 3) == fq) ? d[1] : yk;
                    if (u == 0) {
                        const int tau = c * SC_TC + 4 * g - 4 + fq;
                        if (tau >= 0) { const int t = dir ? (SEQ - 1 - tau) : tau; yrow[(size_t)t * RC] = yk; } }
                    const float nsa = -d[0];
                    const unsigned t1 = cvtpk(nsa, nsa);
                    const float lo = nsa - __builtin_bit_cast(float, t1 & 0xffff0000u);
                    const unsigned t2 = cvtpk(lo, 0.f);
                    u32x4 bw; bw.x = cV | (t1 << 16); bw.y = t2; bw.z = 0u; bw.w = 0u;
                    const bf16x8 b2 = __builtin_bit_cast(bf16x8, bw);
#pragma unroll
                    for (int ct = 0; ct < 4; ++ct) { u32x4 aw; aw.x = (ct & 1) ? cU[ct >> 1].z : cU[ct >> 1].x; aw.y = (ct & 1) ? cU[ct >> 1].w : cU[ct >> 1].y; aw.z = 0u; aw.w = 0u;
                        acc[ct] = __builtin_amdgcn_mfma_f32_16x16x32_bf16(__builtin_bit_cast(bf16x8, aw), b2, cc[ct], 0, 0, 0); }
                    u32x4 p0, p1;
                    p0.x = cvtpk(acc[0][0], acc[0][1]); p0.y = cvtpk(acc[0][2], acc[0][3]); p0.z = cvtpk(acc[1][0], acc[1][1]); p0.w = cvtpk(acc[1][2], acc[1][3]);
                    p1.x = cvtpk(acc[2][0], acc[2][1]); p1.y = cvtpk(acc[2][2], acc[2][3]); p1.z = cvtpk(acc[3][0], acc[3][1]); p1.w = cvtpk(acc[3][2], acc[3][3]);
                    sb0 = __builtin_bit_cast(bf16x8, p0); sb1 = __builtin_bit_cast(bf16x8, p1);
                    cA0 = nA0; cA1 = nA1; cV = nV;
#pragma unroll
                    for (int i = 0; i < 4; ++i) cW[i] = nW[i];
                    cU[0] = nU[0]; cU[1] = nU[1];
                    asm volatile("" ::: "memory");
                }
            }
#undef SC_LOAD
        }
        __syncthreads();
    }
    if (wave < 4) {
        if (fq < 3) { const int tau = SEQ - 4 + fq, t = dir ? (SEQ - 1 - tau) : tau; yrow[(size_t)t * RC] = yk; }
        const int t = dir ? 0 : (SEQ - 1); const bf16_t* rr = (const bf16_t*)(sh + (size_t)t * 384);
        float accy = 0.f;
#pragma unroll
        for (int j = 0; j < 8; ++j) { accy += bf2f((unsigned)(unsigned short)sb0[j]) * bf2f(rr[16 * (j >> 2) + 4 * fq + (j & 3)]); accy += bf2f((unsigned)(unsigned short)sb1[j]) * bf2f(rr[32 + 16 * (j >> 2) + 4 * fq + (j & 3)]); }
        accy += __shfl_xor(accy, 16); accy += __shfl_xor(accy, 32);
        if (fq == 0) yrow[(size_t)t * RC] = accy;
    }
    __syncthreads();
}

constexpr int AT_P = 72;
constexpr int AT_KOFF = 0, AT_VOFF = 256 * AT_P * 2;
constexpr int ATT_DIL_UNITS = BATCH * AH * 48;
constexpr int ATT_MEM_UNITS = BATCH * MH * 16;
constexpr int ATT_UNITS = ATT_DIL_UNITS + ATT_MEM_UNITS;
struct AttU { const bf16_t* q; const bf16_t* k; const bf16_t* v; long qs, ks; int kind, win0, L, dil; float slope; bf16_t* o; long os; float* lse; long ls; };
__device__ __forceinline__ void att_make_unit(const Params& p, int u, AttU& U) {
    unsigned char* ws = p.ws; const bf16_t* PA = (const bf16_t*)(ws + WS_PA);
    if (u < ATT_DIL_UNITS) {
        const int bh = u / 48, x = u % 48, b = bh / AH, h = bh % AH, br = x >> 4, y = x & 15;
        const int dil = br == 0 ? 1 : (br == 1 ? 4 : 16), L = SEQ / dil, npr = L / 128, r = y / npr, np = y % npr;
        const bf16_t* base = PA + (size_t)(b * SEQ + r) * PA_W + h * 64;
        U.kind = 0; U.win0 = (2 * np - 1) * 64; U.L = L; U.dil = dil; U.slope = exp2f(-8.f * (float)(h + 1) / (float)AH);
        U.qs = (long)dil * PA_W; U.ks = U.qs;
        U.q = base + (long)(np * 128) * U.qs; U.k = base + AW; U.v = base + 2 * AW;
        const size_t tok0 = (size_t)(b * SEQ + r) + (size_t)np * 128 * dil;
        U.o = (bf16_t*)(ws + WS_ATTO) + (size_t)br * T * AW + tok0 * AW + h * 64; U.os = (long)dil * AW;
        U.lse = (float*)((unsigned char*)p.out + DO_LSE) + (size_t)br * T * AH + tok0 * AH + h; U.ls = (long)dil * AH;
    } else {
        const int v = u - ATT_DIL_UNITS, bh = v >> 4, qb = v & 15, b = bh / MH, h = bh % MH;
        const bf16_t* KVM = (const bf16_t*)(ws + WS_KVM);
        U.kind = 1; U.win0 = 0; U.L = NMEM; U.dil = 1; U.slope = 0.f;
        U.q = PA + (size_t)(b * SEQ + qb * 128) * PA_W + 3 * AW + h * 64; U.qs = PA_W;
        U.k = KVM + (size_t)(b * NMEM) * (2 * MW) + h * 64; U.v = U.k + MW; U.ks = 2 * MW;
        U.o = (bf16_t*)(ws + WS_YMIX) + (size_t)(b * SEQ + qb * 128) * D + RC + AW + h * 64; U.os = D;
        U.lse = nullptr; U.ls = 0;
    }
}
__device__ __forceinline__ void att_fetch(const AttU& U, u32x4 (&reg)[8], int tid) {
#pragma unroll
    for (int q = 0; q < 8; ++q) { const int rem = (tid + NTHR * q) & 2047, row = rem >> 3, ch = rem & 7; const int lk = U.win0 + row; const bool ok = lk >= 0 && lk < U.L;
        const bf16_t* src = (q < 4 ? U.k : U.v) + (long)(ok ? lk : 0) * U.ks + ch * 8;
        u32x4 raw = *(const u32x4*)src; if (!ok) raw = (u32x4){0u, 0u, 0u, 0u}; reg[q] = raw; }
}
__device__ __forceinline__ void att_put(LAS unsigned char* lds, const u32x4 (&reg)[8], int tid) {
#pragma unroll
    for (int q = 0; q < 8; ++q) { const int rem = (tid + NTHR * q) & 2047, row = rem >> 3, ch = rem & 7;
        *(LAS u32x4*)(lds + (q < 4 ? AT_KOFF : AT_VOFF) + row * (AT_P * 2) + ch * 16) = reg[q]; }
}
typedef short v4i16_t __attribute__((ext_vector_type(4)));
template <int NT  , bool DIL>
__device__ __forceinline__ void att_compute(const AttU& U, LAS unsigned char* lds, int w, int lane) {
    const int fr = lane & 15, fq = lane >> 4;
    const bf16_t* qp = U.q + (long)(16 * w + fr) * U.qs + fq * 8;
    const bf16x8 q0 = *(const bf16x8*)qp, q1 = *(const bf16x8*)(qp + 32);
    f32x4 sT[NT];
#pragma unroll
    for (int i = 0; i < NT; ++i) {
        if (DIL && i == 9) { sT[i] = (f32x4){-1e30f, -1e30f, -1e30f, -1e30f}; continue; }
        int tt = DIL ? w + i : i; tt = tt > 15 ? 15 : tt;
        const LAS unsigned char* kp = lds + AT_KOFF + (16 * tt + fr) * (AT_P * 2) + fq * 16;
        const bf16x8 k0 = *(const LAS bf16x8*)kp, k1 = *(const LAS bf16x8*)(kp + 64);
        f32x4 a = (f32x4){0.f, 0.f, 0.f, 0.f};
        a = __builtin_amdgcn_mfma_f32_16x16x32_bf16(k0, q0, a, 0, 0, 0);
        a = __builtin_amdgcn_mfma_f32_16x16x32_bf16(k1, q1, a, 0, 0, 0);
        sT[i] = a; if ((i & 3) == 3) asm volatile("" ::: "memory"); }
    float m = -3.0e38f;
    if (DIL) {
        const int c0 = 4 * fq - fr, lb = U.win0 + 16 * w + 4 * fq; const float sd = U.slope * (float)U.dil; const unsigned Lc = (unsigned)U.L;
#pragma unroll
        for (int i = 0; i < NT; ++i) { if (i == 9) continue;
#pragma unroll
            for (int r = 0; r < 4; ++r) { const int dl = 16 * i + r - 64 + c0, ad = dl < 0 ? -dl : dl;
                bool valid = (unsigned)(lb + 16 * i + r) < Lc; if (i == 0 || i >= 7) valid = valid && ad <= 64;
                const float sv = valid ? sT[i][r] - sd * (float)ad : -1e30f; sT[i][r] = sv; m = fmaxf(m, sv); } }
    } else {
#pragma unroll
        for (int i = 0; i < NT; ++i)
#pragma unroll
            for (int r = 0; r < 4; ++r) m = fmaxf(m, sT[i][r]);
    }
    m = fmaxf(m, __shfl_xor(m, 16)); m = fmaxf(m, __shfl_xor(m, 32));
    float l = 0.f;
#pragma unroll
    for (int i = 0; i < NT; ++i)
#pragma unroll
        for (int r = 0; r < 4; ++r) { const float e = __expf(sT[i][r] - m); sT[i][r] = e; l += e; }
    l += __shfl_xor(l, 16); l += __shfl_xor(l, 32);
    f32x4 oT[4];
#pragma unroll
    for (int dt = 0; dt < 4; ++dt) oT[dt] = (f32x4){0.f, 0.f, 0.f, 0.f};
#pragma unroll
    for (int tp = 0; tp < NT / 2; ++tp) {
        int ta = DIL ? w + 2 * tp : 2 * tp, tb = ta + 1; ta = ta > 15 ? 15 : ta; tb = tb > 15 ? 15 : tb;
        u32x4 pw; pw.x = pk2(sT[2 * tp][0], sT[2 * tp][1]); pw.y = pk2(sT[2 * tp][2], sT[2 * tp][3]); pw.z = pk2(sT[2 * tp + 1][0], sT[2 * tp + 1][1]); pw.w = pk2(sT[2 * tp + 1][2], sT[2 * tp + 1][3]);
        const bf16x8 pb = __builtin_bit_cast(bf16x8, pw);
        const LAS unsigned char* va = lds + AT_VOFF + (16 * ta + 4 * fq + (fr >> 2)) * (AT_P * 2) + 8 * (fr & 3);
        const LAS unsigned char* vb = lds + AT_VOFF + (16 * tb + 4 * fq + (fr >> 2)) * (AT_P * 2) + 8 * (fr & 3);
#pragma unroll
        for (int dt = 0; dt < 4; ++dt) {
            const v4i16_t lo = __builtin_amdgcn_ds_read_tr16_b64_v4i16((LAS v4i16_t*)(va + 32 * dt)), hi = __builtin_amdgcn_ds_read_tr16_b64_v4i16((LAS v4i16_t*)(vb + 32 * dt));
            bf16x8 vf; vf[0] = lo[0]; vf[1] = lo[1]; vf[2] = lo[2]; vf[3] = lo[3]; vf[4] = hi[0]; vf[5] = hi[1]; vf[6] = hi[2]; vf[7] = hi[3];
            oT[dt] = __builtin_amdgcn_mfma_f32_16x16x32_bf16(vf, pb, oT[dt], 0, 0, 0); }
        if (tp & 1) asm volatile("" ::: "memory");
    }
    const float inv = 1.f / l;
    bf16_t* op = U.o + (long)(16 * w + fr) * U.os;
#pragma unroll
    for (int dt = 0; dt < 4; ++dt) { u32x2 o; o.x = pk2(oT[dt][0] * inv, oT[dt][1] * inv); o.y = pk2(oT[dt][2] * inv, oT[dt][3] * inv); *(u32x2*)(op + 16 * dt + 4 * fq) = o; }
    if (DIL && fq == 0) U.lse[(long)(16 * w + fr) * U.ls] = m + __logf(l);
}
__device__ __forceinline__ void phase3(const Params& p, LAS unsigned char* lds, int rep) {
    const int tid = threadIdx.x, lane = tid & 63, wave = tid >> 6;
    unsigned* ctl = (unsigned*)(p.ws + WS_CTL);
    LAS unsigned* bc = (LAS unsigned*)(lds + 98304);
    for (;;) {
        __syncthreads();
        if (tid == 0) bc[0] = atomicAdd(ctl + CW_SCANQ + 16 * rep, 1u);
        __syncthreads();
        const unsigned sid = __builtin_amdgcn_readfirstlane(bc[0]);
        if (sid >= 2u * BATCH * RH) break;
#pragma unroll 1
        for (int tw = 0; tw < (REPEAT_PHASE == 31 ? 2 : 1); ++tw) scan_block(p, lds, (int)sid);
    }
    constexpr unsigned ATT_BATCH = 2;
    for (;;) {
        __syncthreads();
        if (tid == 0) bc[1] = atomicAdd(ctl + CW_ATTQ + 16 * rep, ATT_BATCH);
        __syncthreads();
        const unsigned ubase = __builtin_amdgcn_readfirstlane(bc[1]);
        if (ubase >= (unsigned)ATT_UNITS) break;
        const unsigned uend = ubase + ATT_BATCH < (unsigned)ATT_UNITS ? ubase + ATT_BATCH : (unsigned)ATT_UNITS;
        { AttU U; att_make_unit(p, (int)ubase, U); u32x4 reg[8]; att_fetch(U, reg, tid); att_put(lds, reg, tid); }
#pragma unroll 1
        for (unsigned ucur = ubase; ucur < uend; ++ucur) {
            __syncthreads();
            u32x4 reg[8];
            if (ucur + 1 < uend) { AttU Un; att_make_unit(p, (int)ucur + 1, Un); att_fetch(Un, reg, tid); }
            { AttU U; att_make_unit(p, (int)ucur, U);
#pragma unroll 1
              for (int tw = 0; tw < (REPEAT_PHASE == 32 ? 2 : 1); ++tw) {
                if (ucur < (unsigned)ATT_DIL_UNITS) att_compute<10, true>(U, lds, wave, lane); else att_compute<16, false>(U, lds, wave, lane); } }
            __syncthreads();
            if (ucur + 1 < uend) att_put(lds, reg, tid);
        }
    }
}

__device__ __forceinline__ void phase4(const Params& p) {
    const int tid = threadIdx.x, lane = tid & 63, wave = tid >> 6;
    const int gw = blockIdx.x * NWAVES + wave, NGW = gridDim.x * NWAVES;
    unsigned char* ws = p.ws; const unsigned char* dob = (const unsigned char*)p.out;
    const float* Yf = (const float*)(dob + DO_Y); const float* Yb = Yf + (size_t)T * RC;
    const bf16_t* G = (const bf16_t*)(dob + DO_G); const float* LSE = (const float*)(dob + DO_LSE);
    const float* BON = (const float*)(ws + WS_BONUS); const float* SSH = (const float*)(ws + WS_SSH);
    const bf16_t* AO = (const bf16_t*)(ws + WS_ATTO); bf16_t* YM = (bf16_t*)(ws + WS_YMIX);
    for (int t = gw; t < T; t += NGW) {
        const int b = t >> 11, s = t & (SEQ - 1);
        float yf[RH], yb[RH], vv[RH], bo[RH]; unsigned short gg[RH], a0[AH], a1[AH], a2[AH]; float l0[AH], l1[AH], l2[AH];
#pragma unroll
        for (int h = 0; h < RH; ++h) { const int ch = h * 64 + lane;
            yf[h] = Yf[(size_t)t * RC + ch]; yb[h] = Yb[(size_t)t * RC + ch]; gg[h] = G[(size_t)t * RC + ch];
            vv[h] = bf2f(((const bf16_t*)SSH)[((size_t)(b * RH + h) * SEQ + s) * 192 + 64 + lane]); bo[h] = BON[t * RH + h];
            a0[h] = AO[(size_t)t * AW + ch]; a1[h] = AO[(size_t)T * AW + (size_t)t * AW + ch]; a2[h] = AO[(size_t)2 * T * AW + (size_t)t * AW + ch];
            l0[h] = LSE[(size_t)t * AH + h]; l1[h] = LSE[(size_t)T * AH + (size_t)t * AH + h]; l2[h] = LSE[(size_t)2 * T * AH + (size_t)t * AH + h]; }
#pragma unroll
        for (int h = 0; h < RH; ++h) { const int ch = h * 64 + lane;
            const float y = yf[h] + yb[h];
            const float mean = wave_sum(y) * (1.f / 64.f); const float dlt = y - mean; const float var = wave_sum(dlt * dlt) * (1.f / 64.f);
            const float yn = dlt * (1.f / sqrtf(var + GN_EPS)) * p.in[14][ch] + p.in[15][ch];
            const float o = (yn + bo[h] * vv[h]) * bf2f(gg[h]);
            YM[(size_t)t * D + ch] = (bf16_t)f2bf(o); }
#pragma unroll
        for (int h = 0; h < AH; ++h) { const int ch = h * 64 + lane;
            const float mx = fmaxf(l0[h], fmaxf(l1[h], l2[h])); const float e0 = __expf(l0[h] - mx), e1 = __expf(l1[h] - mx), e2 = __expf(l2[h] - mx); const float inv = 1.f / (e0 + e1 + e2);
            const float o = (e0 * bf2f(a0[h]) + e1 * bf2f(a1[h]) + e2 * bf2f(a2[h])) * inv;
            YM[(size_t)t * D + RC + ch] = (bf16_t)f2bf(o); }
    }
}

struct PolP5 {
    static constexpr bool PERM = false, GATHER = false;
    const bf16_t* A; const bf16_t* Bt; const bf16_t* H0B; float* PRE; int G, c;
    __device__ __forceinline__ bool next(int i, pg8::Unit& u) const { int pm, pn; if (!pg8::static_order(T / 256, D / 256, G, c, i, pm, pn)) return false;
        u.A = (const char*)(A + (size_t)pm * 256 * D); u.B0 = (const char*)(Bt + (size_t)pn * 256 * D); u.B1 = u.B0 + (size_t)128 * D * 2; u.x0 = pm; u.x1 = pn; u.x2 = 0; u.x3 = 0; u.x4 = 0; return true; }
    __device__ __forceinline__ void epi(const f32x4 (&acc)[2][2][4][2], const pg8::Unit& u, int wr, int wc, int fr, int fq) const {
        const int row0 = u.x0 * 256 + wr * 64 + fr, col0 = u.x1 * 256 + wc * 32 + 4 * fq;
        u32x2 hb[2][4][2][2];
#pragma unroll
        for (int ai = 0; ai < 2; ++ai)
#pragma unroll
            for (int m = 0; m < 4; ++m)
#pragma unroll
                for (int bj = 0; bj < 2; ++bj)
#pragma unroll
                    for (int n = 0; n < 2; ++n) hb[ai][m][bj][n] = *(const u32x2*)(H0B + (size_t)(row0 + ai * 128 + m * 16) * D + col0 + bj * 128 + n * 16);
#pragma unroll
        for (int ai = 0; ai < 2; ++ai)
#pragma unroll
            for (int m = 0; m < 4; ++m) { const size_t ro = (size_t)(row0 + ai * 128 + m * 16) * D + col0;
#pragma unroll
                for (int bj = 0; bj < 2; ++bj)
#pragma unroll
                    for (int n = 0; n < 2; ++n) { const size_t off = ro + bj * 128 + n * 16; const u32x2 h2 = hb[ai][m][bj][n]; const f32x4 v = acc[ai][bj][m][n];
                        f32x4 o; o.x = v.x + ALPHA * bflo(h2.x); o.y = v.y + ALPHA * bfhi(h2.x); o.z = v.z + ALPHA * bflo(h2.y); o.w = v.w + ALPHA * bfhi(h2.y); *(f32x4*)(PRE + off) = o; } }
    }
};
__device__ __forceinline__ void phase5(const Params& p, LAS unsigned char* lds) {
    unsigned char* ws = p.ws;
    PolP5 P{(const bf16_t*)(ws + WS_YMIX), (const bf16_t*)(ws + WS_WT_OUT), (const bf16_t*)(ws + WS_H0B), p.out, (int)gridDim.x, (int)blockIdx.x};
    pg8::gemm_phase(lds, P, D, (PROBE_GEMM == 5 && blockIdx.x == 0) ? (unsigned long long*)(ws + WS_CTL + 32768) : nullptr);
}

constexpr int P6_TP = 1032;
constexpr int P6_TH = 0, P6_TL = 16 * P6_TP * 2, P6_PART = 2 * 16 * P6_TP * 2, P6_LC = P6_PART + 8 * 16 * 32 * 4, P6_BASE = P6_LC + 128, P6_ENT = P6_BASE + 128, P6_MAXENT = 2048;
__device__ __forceinline__ void phase6(const Params& p, LAS unsigned char* lds, int rep) {
    const int tid = threadIdx.x, lane = tid & 63, wave = tid >> 6, fr = lane & 15, fq = lane >> 4;
    unsigned char* ws = p.ws; unsigned* ctl = (unsigned*)(ws + WS_CTL);
    const bf16_t* WRH = (const bf16_t*)(ws + WS_WRT); const bf16_t* WRL = WRH + NE * D;
    LAS bf16_t* TH = (LAS bf16_t*)(lds + P6_TH); LAS bf16_t* TL = (LAS bf16_t*)(lds + P6_TL); LAS float* PART = (LAS float*)(lds + P6_PART);
    LAS int* LC = (LAS int*)(lds + P6_LC); LAS int* BASE = (LAS int*)(lds + P6_BASE); LAS int* ENT = (LAS int*)(lds + P6_ENT);
    int* LIST = (int*)(ws + WS_LIST); float* RG = (float*)(ws + WS_ROWGATE); int* SEL = (int*)(ws + WS_SEL);
    __syncthreads();
    if (tid < NE) LC[tid] = 0;
    __syncthreads();
    int it = 0;
    for (int tile = blockIdx.x; tile < T / 16; tile += gridDim.x, ++it) {
        const int t0 = tile * 16;
#pragma unroll
        for (int q = 0; q < 2; ++q) { const int tt = 2 * wave + q, t = t0 + tt;
            const f32x4* xr = (const f32x4*)(p.out + (size_t)t * D) + lane; f32x4 v[4];
#pragma unroll
            for (int j = 0; j < 4; ++j) v[j] = xr[64 * j];
            ln_row(v, p.in[18], p.in[19], lane);
            bf16_t* orow = (bf16_t*)(ws + WS_H1B) + (size_t)t * D;
#pragma unroll
            for (int j = 0; j < 4; ++j) { const unsigned h0 = f2bf(v[j].x), h1 = f2bf(v[j].y), h2 = f2bf(v[j].z), h3 = f2bf(v[j].w);
                u32x2 hi; hi.x = h0 | (h1 << 16); hi.y = h2 | (h3 << 16);
                u32x2 lo; lo.x = pk2(v[j].x - bf2f(h0), v[j].y - bf2f(h1)); lo.y = pk2(v[j].z - bf2f(h2), v[j].w - bf2f(h3));
                *(u32x2*)(orow + 4 * lane + 256 * j) = hi;
                *(LAS u32x2*)(TH + tt * P6_TP + 4 * lane + 256 * j) = hi; *(LAS u32x2*)(TL + tt * P6_TP + 4 * lane + 256 * j) = lo; } }
        __syncthreads();
        f32x4 acc0 = (f32x4){0.f, 0.f, 0.f, 0.f}, acc1 = acc0;
#pragma unroll
        for (int ks = 0; ks < 4; ++ks) { const int k0 = 128 * wave + 32 * ks + 8 * fq;
            const bf16x8 ah = *(const LAS bf16x8*)(TH + fr * P6_TP + k0), al = *(const LAS bf16x8*)(TL + fr * P6_TP + k0);
            const bf16x8 bh0 = *(const bf16x8*)(WRH + (size_t)fr * D + k0), bl0 = *(const bf16x8*)(WRL + (size_t)fr * D + k0);
            const bf16x8 bh1 = *(const bf16x8*)(WRH + (size_t)(16 + fr) * D + k0), bl1 = *(const bf16x8*)(WRL + (size_t)(16 + fr) * D + k0);
            acc0 = __builtin_amdgcn_mfma_f32_16x16x32_bf16(ah, bh0, acc0, 0, 0, 0); acc0 = __builtin_amdgcn_mfma_f32_16x16x32_bf16(ah, bl0, acc0, 0, 0, 0); acc0 = __builtin_amdgcn_mfma_f32_16x16x32_bf16(al, bh0, acc0, 0, 0, 0);
            acc1 = __builtin_amdgcn_mfma_f32_16x16x32_bf16(ah, bh1, acc1, 0, 0, 0); acc1 = __builtin_amdgcn_mfma_f32_16x16x32_bf16(ah, bl1, acc1, 0, 0, 0); acc1 = __builtin_amdgcn_mfma_f32_16x16x32_bf16(al, bh1, acc1, 0, 0, 0); }
#pragma unroll
        for (int r = 0; r < 4; ++r) { PART[(wave * 16 + 4 * fq + r) * 32 + fr] = acc0[r]; PART[(wave * 16 + 4 * fq + r) * 32 + 16 + fr] = acc1[r]; }
        __syncthreads();
        const int e = lane & 31, tt = 2 * wave + (lane >> 5), t = t0 + tt;
        float logit = p.in[21][e];
#pragma unroll
        for (int v = 0; v < 8; ++v) logit += PART[(v * 16 + tt) * 32 + e];
        float cur = logit; float tv0 = 0.f, tv1 = 0.f, tv2 = 0.f, tv3 = 0.f; int te0 = 0, te1 = 0, te2 = 0, te3 = 0;
#pragma unroll
        for (int k = 0; k < 4; ++k) { float bv = cur; int bi = e;
#pragma unroll
            for (int o = 1; o < 32; o <<= 1) { const float ov = __shfl_xor(bv, o); const int oi = __shfl_xor(bi, o); if (ov > bv || (ov == bv && oi < bi)) { bv = ov; bi = oi; } }
            if (k == 0) { tv0 = bv; te0 = bi; } if (k == 1) { tv1 = bv; te1 = bi; } if (k == 2) { tv2 = bv; te2 = bi; } if (k == 3) { tv3 = bv; te3 = bi; }
            if (e == bi) cur = -3.0e38f; }
        const float e1 = __expf(tv1 - tv0), e2 = __expf(tv2 - tv0), e3 = __expf(tv3 - tv0); const float inv = 1.f / (1.f + e1 + e2 + e3);
        if (e < 4) { int ee = te0; float gg = inv;
            if (e == 1) { ee = te1; gg = e1 * inv; } if (e == 2) { ee = te2; gg = e2 * inv; } if (e == 3) { ee = te3; gg = e3 * inv; }
            const int lr = __hip_atomic_fetch_add((int*)(LC + ee), 1, __ATOMIC_RELAXED, __HIP_MEMORY_SCOPE_WORKGROUP); const int n = (it * 16 + tt) * 4 + e;
            if (n < P6_MAXENT) { ENT[4 * n] = t * 4 + e; ENT[4 * n + 1] = ee; ENT[4 * n + 2] = lr; ENT[4 * n + 3] = __builtin_bit_cast(int, gg); } }
    }
    __syncthreads();
    if (tid < NE) BASE[tid] = (int)atomicAdd(ctl + CW_CNT + 32 * rep + tid, (unsigned)LC[tid]);
    __syncthreads();
    const int nent = it * 64 < P6_MAXENT ? it * 64 : P6_MAXENT;
    for (int n = tid; n < nent; n += NTHR) { const int tk = ENT[4 * n], ee = ENT[4 * n + 1], rank = BASE[ee] + ENT[4 * n + 2];
        LIST[(size_t)ee * T + rank] = tk >> 2; RG[(size_t)ee * T + rank] = __builtin_bit_cast(float, ENT[4 * n + 3]); SEL[(size_t)tk * 2] = ee; SEL[(size_t)tk * 2 + 1] = rank; }
}

__device__ __forceinline__ void build_expert_tables(const Params& p, LAS int* tab) {
    const unsigned* ctl = (const unsigned*)(p.ws + WS_CTL);
    __syncthreads();
    if (threadIdx.x < NE) tab[threadIdx.x] = (int)__hip_atomic_load(ctl + CW_CNT + CNT_SET + threadIdx.x, __ATOMIC_RELAXED, __HIP_MEMORY_SCOPE_AGENT);
    __syncthreads();
    if (threadIdx.x == 0) { int ps = 0, ts = 0;
        for (int e = 0; e < NE; ++e) { const int c = tab[e]; tab[32 + e] = ps; tab[64 + e] = ts; ps += (c + 255) / 256 * 256; ts += (c + 127) / 128; }
        tab[64 + NE] = ts; }
    __syncthreads();
}

constexpr int TAB_OFF = 131072, UTAB_OFF = 100, UTAB_MAX = 48;
constexpr int IDX_OFF = 131072 + 2048, IDX_UNITS = 20;
__device__ __forceinline__ void build_expert_tables256(const Params& p, LAS int* tab, int npn  ) {
    const unsigned* ctl = (const unsigned*)(p.ws + WS_CTL);
    __syncthreads();
    if (threadIdx.x < NE) tab[threadIdx.x] = (int)__hip_atomic_load(ctl + CW_CNT + CNT_SET + threadIdx.x, __ATOMIC_RELAXED, __HIP_MEMORY_SCOPE_AGENT);
    __syncthreads();
    if (threadIdx.x == 0) { int ps = 0, ts = 0;
        for (int e = 0; e < NE; ++e) { const int c = tab[e]; tab[32 + e] = ps; tab[64 + e] = ts; ps += (c + 255) / 256 * 256; ts += (c + 255) / 256; }
        tab[64 + NE] = ts;
        int e = 0, n = 0;
        if (gridDim.x == 256) { const int g = blockIdx.x & 7, sl = blockIdx.x >> 3, mpx = 32 / npn  , mround = 8 * mpx;
            for (int i = 0; n < UTAB_MAX; ++i) { const int mt_g = i * mround + g * mpx + sl / npn, pn = sl % npn; if (i * mround >= ts) break; if (mt_g >= ts) continue;
                while (e + 1 < NE && mt_g >= tab[64 + e + 1]) ++e;
                const int r0 = (mt_g - tab[64 + e]) * 256;
                tab[UTAB_OFF + 4 * n] = e; tab[UTAB_OFF + 4 * n + 1] = r0; tab[UTAB_OFF + 4 * n + 2] = pn; tab[UTAB_OFF + 4 * n + 3] = tab[32 + e] + r0; ++n; }
        } else { const int nun = ts * npn;
        for (int L = blockIdx.x; L < nun && n < UTAB_MAX; L += gridDim.x, ++n) { const int pn = L % npn, mt_g = L / npn;
            while (e + 1 < NE && mt_g >= tab[64 + e + 1]) ++e;
            const int r0 = (mt_g - tab[64 + e]) * 256;
            tab[UTAB_OFF + 4 * n] = e; tab[UTAB_OFF + 4 * n + 1] = r0; tab[UTAB_OFF + 4 * n + 2] = pn; tab[UTAB_OFF + 4 * n + 3] = tab[32 + e] + r0; } }
        tab[98] = n; }
    __syncthreads();
}
struct PolP7 {
    static constexpr bool PERM = true, GATHER = true;
    const bf16_t* H1B; const bf16_t* WG; const LAS int* IDX; bf16_t* ACT; const float* BGU; const LAS int* tab; int G, c;
    __device__ __forceinline__ bool next(int i, pg8::Unit& u) const { if (i >= __builtin_amdgcn_readfirstlane(tab[98])) return false;
        const int e = __builtin_amdgcn_readfirstlane(tab[UTAB_OFF + 4 * i]), r0 = __builtin_amdgcn_readfirstlane(tab[UTAB_OFF + 4 * i + 1]), pn = __builtin_amdgcn_readfirstlane(tab[UTAB_OFF + 4 * i + 2]);
        u.A = (const char*)H1B; u.B0 = (const char*)(WG + ((size_t)e * 2 * FF + pn * 128) * D); u.B1 = u.B0 + (size_t)FF * D * 2;
        u.x0 = e; u.x1 = i; u.x2 = pn; u.x3 = __builtin_amdgcn_readfirstlane(tab[UTAB_OFF + 4 * i + 3]); u.x4 = __builtin_amdgcn_readfirstlane(tab[e]) - r0; return true; }
    __device__ __forceinline__ void rows_issue(const pg8::Unit& u, int R0, unsigned (&raw)[2][2]) const { const LAS int* lst = IDX + u.x1 * 256 + R0;
#pragma unroll
        for (int h = 0; h < 2; ++h)
#pragma unroll
            for (int i = 0; i < 2; ++i) raw[h][i] = (unsigned)lst[h * 128 + i * 64]; }
    __device__ __forceinline__ void rows_finish(int C0, int K, unsigned (&raw)[2][2]) const {
#pragma unroll
        for (int h = 0; h < 2; ++h)
#pragma unroll
            for (int i = 0; i < 2; ++i) raw[h][i] = (raw[h][i] * (unsigned)K + (unsigned)C0) * 2u; }
    __device__ __forceinline__ void epi(const f32x4 (&acc)[2][2][4][2], const pg8::Unit& u, int wr, int wc, int fr, int fq) const {
        const int e = u.x0, f0 = u.x2 * 128 + wc * 32 + 8 * fq;
        const float* bias = BGU + (size_t)e * 2 * FF + f0;
        const f32x4 bg0 = *(const f32x4*)bias, bg1 = *(const f32x4*)(bias + 4), bu0 = *(const f32x4*)(bias + FF), bu1 = *(const f32x4*)(bias + FF + 4);
#pragma unroll
        for (int ai = 0; ai < 2; ++ai)
#pragma unroll
            for (int m = 0; m < 4; ++m) { const int r = ai * 128 + wr * 64 + m * 16 + fr;
                const f32x4 g0 = acc[ai][0][m][0] + bg0, g1 = acc[ai][0][m][1] + bg1, u0 = acc[ai][1][m][0] + bu0, u1 = acc[ai][1][m][1] + bu1;
                float a[8];
#pragma unroll
                for (int j = 0; j < 4; ++j) {
                    const float gc = fminf(g0[j], 7.f), uc = __builtin_amdgcn_fmed3f(u0[j], -7.f, 7.f);
                    a[j] = __builtin_fmaf(uc, gc, gc) * __builtin_amdgcn_rcpf(1.f + __builtin_amdgcn_exp2f(-2.4554669595930157f * gc));
                    const float gd = fminf(g1[j], 7.f), ud = __builtin_amdgcn_fmed3f(u1[j], -7.f, 7.f);
                    a[4 + j] = __builtin_fmaf(ud, gd, gd) * __builtin_amdgcn_rcpf(1.f + __builtin_amdgcn_exp2f(-2.4554669595930157f * gd)); }
                { u32x4 w; w.x = pg8::cvt_pk_bf16(a[0], a[1]); w.y = pg8::cvt_pk_bf16(a[2], a[3]); w.z = pg8::cvt_pk_bf16(a[4], a[5]); w.w = pg8::cvt_pk_bf16(a[6], a[7]);
                    *(u32x4*)(ACT + (size_t)(u.x3 + r) * FF + f0) = w; } }
    }
};
__device__ __forceinline__ void phase7(const Params& p, LAS unsigned char* lds) {
    LAS int* tab = (LAS int*)(lds + TAB_OFF); build_expert_tables256(p, tab, 8);
    unsigned char* ws = p.ws;
    LAS int* IDX = (LAS int*)(lds + IDX_OFF);
    { const int* LIST = (const int*)(ws + WS_LIST); const int nun = tab[98] < IDX_UNITS ? tab[98] : IDX_UNITS;
      for (int j = threadIdx.x; j < nun * 256; j += NTHR) { const int n = j >> 8, i = j & 255, e = tab[UTAB_OFF + 4 * n], r0 = tab[UTAB_OFF + 4 * n + 1], nval = tab[e] - r0;
          IDX[j] = LIST[(size_t)e * T + r0 + (i < nval ? i : 0)]; }
      __syncthreads(); }
    PolP7 P{(const bf16_t*)(ws + WS_H1B), (const bf16_t*)(ws + WS_WT_GU), IDX, (bf16_t*)(ws + WS_ACT), p.in[23], tab, (int)gridDim.x, (int)blockIdx.x};
    pg8::gemm_phase(lds, P, D, (PROBE_GEMM == 7 && blockIdx.x == 0) ? (unsigned long long*)(ws + WS_CTL + 32768) : nullptr);
}

struct PolP8 {
    static constexpr bool PERM = true, GATHER = false;
    const bf16_t* ACT; const bf16_t* WD; const float* RG; bf16_t* YR; const float* BD; const LAS int* tab; int G, c;
    __device__ __forceinline__ bool next(int i, pg8::Unit& u) const { if (i >= __builtin_amdgcn_readfirstlane(tab[98])) return false;
        const int e = __builtin_amdgcn_readfirstlane(tab[UTAB_OFF + 4 * i]), r0 = __builtin_amdgcn_readfirstlane(tab[UTAB_OFF + 4 * i + 1]), pn = __builtin_amdgcn_readfirstlane(tab[UTAB_OFF + 4 * i + 2]), prow0 = __builtin_amdgcn_readfirstlane(tab[UTAB_OFF + 4 * i + 3]);
        u.A = (const char*)(ACT + (size_t)prow0 * FF); u.B0 = (const char*)(WD + ((size_t)e * D + pn * 256) * FF); u.B1 = u.B0 + (size_t)128 * FF * 2;
        u.x4 = __builtin_amdgcn_readfirstlane(tab[e]) - r0;
        u.x0 = e; u.x1 = r0; u.x2 = pn; u.x3 = prow0; return true; }
    __device__ __forceinline__ void epi(const f32x4 (&acc)[2][2][4][2], const pg8::Unit& u, int wr, int wc, int fr, int fq) const {
        const int e = u.x0, nval = u.x4; const float* rg = RG + (size_t)e * T + u.x1;
        float gt[2][4];
#pragma unroll
        for (int ai = 0; ai < 2; ++ai)
#pragma unroll
            for (int m = 0; m < 4; ++m) { const int r = ai * 128 + wr * 64 + m * 16 + fr; gt[ai][m] = rg[r < nval ? r : 0]; }
        f32x4 bs[2][2];
#pragma unroll
        for (int bj = 0; bj < 2; ++bj) { const float* bias = BD + (size_t)e * D + u.x2 * 256 + bj * 128 + wc * 32 + 8 * fq; bs[bj][0] = *(const f32x4*)bias; bs[bj][1] = *(const f32x4*)(bias + 4); }
#pragma unroll
        for (int ai = 0; ai < 2; ++ai)
#pragma unroll
            for (int m = 0; m < 4; ++m) { const int r = ai * 128 + wr * 64 + m * 16 + fr; const float g = gt[ai][m];
#pragma unroll
                for (int bj = 0; bj < 2; ++bj) { const int col = u.x2 * 256 + bj * 128 + wc * 32 + 8 * fq;
                    const f32x4 v0 = (acc[ai][bj][m][0] + bs[bj][0]) * g, v1 = (acc[ai][bj][m][1] + bs[bj][1]) * g;
                    u32x4 w; w.x = pg8::cvt_pk_bf16(v0[0], v0[1]); w.y = pg8::cvt_pk_bf16(v0[2], v0[3]); w.z = pg8::cvt_pk_bf16(v1[0], v1[1]); w.w = pg8::cvt_pk_bf16(v1[2], v1[3]);
                    *(u32x4*)(YR + (size_t)(u.x3 + r) * D + col) = w; } }
    }
};
__device__ __forceinline__ void phase8(const Params& p, LAS unsigned char* lds) {
    LAS int* tab = (LAS int*)(lds + TAB_OFF); build_expert_tables256(p, tab, 4);
    unsigned char* ws = p.ws;
    PolP8 P{(const bf16_t*)(ws + WS_ACT), (const bf16_t*)(ws + WS_WT_DN), (const float*)(ws + WS_ROWGATE), (bf16_t*)(ws + WS_YROWS), p.in[25], tab, (int)gridDim.x, (int)blockIdx.x};
    pg8::gemm_phase(lds, P, FF, (PROBE_GEMM == 8 && blockIdx.x == 0) ? (unsigned long long*)(ws + WS_CTL + 32768) : nullptr);
}

__device__ __forceinline__ void phase9(const Params& p, LAS unsigned char* lds) {
    LAS int* tab = (LAS int*)lds; build_expert_tables(p, tab);
    const int tid = threadIdx.x, lane = tid & 63, wave = tid >> 6;
    const int gw = blockIdx.x * NWAVES + wave, NGW = gridDim.x * NWAVES;
    unsigned char* ws = p.ws; const bf16_t* H1B = (const bf16_t*)(ws + WS_H1B); const bf16_t* YR = (const bf16_t*)(ws + WS_YROWS); const int* SEL = (const int*)(ws + WS_SEL);
    typedef int i32x4 __attribute__((ext_vector_type(4)));
    i32x4 sa = {0, 0, 0, 0}, sb = sa;
    if (gw < T) { sa = *(const i32x4*)(SEL + (size_t)gw * 8); sb = *(const i32x4*)(SEL + (size_t)gw * 8 + 4); }
    for (int t = gw; t < T; t += NGW) {
        const i32x4 ca = sa, cb = sb;
        if (t + NGW < T) { sa = *(const i32x4*)(SEL + (size_t)(t + NGW) * 8); sb = *(const i32x4*)(SEL + (size_t)(t + NGW) * 8 + 4); }
        const bf16_t* y0 = YR + (size_t)(tab[32 + ca.x] + ca.y) * D + 4 * lane; const bf16_t* y1 = YR + (size_t)(tab[32 + ca.z] + ca.w) * D + 4 * lane;
        const bf16_t* y2 = YR + (size_t)(tab[32 + cb.x] + cb.y) * D + 4 * lane; const bf16_t* y3 = YR + (size_t)(tab[32 + cb.z] + cb.w) * D + 4 * lane;
        const bf16_t* hr = H1B + (size_t)t * D + 4 * lane;
        u32x2 hb[4], q0[4], q1[4], q2[4], q3[4];
#pragma unroll
        for (int j = 0; j < 4; ++j) { hb[j] = *(const u32x2*)(hr + 256 * j); q0[j] = *(const u32x2*)(y0 + 256 * j); q1[j] = *(const u32x2*)(y1 + 256 * j); q2[j] = *(const u32x2*)(y2 + 256 * j); q3[j] = *(const u32x2*)(y3 + 256 * j); }
        f32x4 v[4];
#pragma unroll
        for (int j = 0; j < 4; ++j) {
            v[j].x = ALPHA * bflo(hb[j].x) + ((bflo(q0[j].x) + bflo(q1[j].x)) + (bflo(q2[j].x) + bflo(q3[j].x)));
            v[j].y = ALPHA * bfhi(hb[j].x) + ((bfhi(q0[j].x) + bfhi(q1[j].x)) + (bfhi(q2[j].x) + bfhi(q3[j].x)));
            v[j].z = ALPHA * bflo(hb[j].y) + ((bflo(q0[j].y) + bflo(q1[j].y)) + (bflo(q2[j].y) + bflo(q3[j].y)));
            v[j].w = ALPHA * bfhi(hb[j].y) + ((bfhi(q0[j].y) + bfhi(q1[j].y)) + (bfhi(q2[j].y) + bfhi(q3[j].y))); }
        ln_row(v, p.in[26], p.in[27], lane);
        f32x4* orow = (f32x4*)(p.out + (size_t)t * D) + lane;
#pragma unroll
        for (int j = 0; j < 4; ++j) orow[64 * j] = v[j];
    }
}

#define XB_TMO      128
#define XB_XCNT(j)  (256  + 64 * (j))
#define XB_XSUB(j)  (1280 + 64 * (j))
#define XB_XGEN(j)  (2304 + 64 * (j))
#define XB_TOP      3328
#define XB_TOPGEN   3392
#define XCD_BAR_WORDS 3456
#define XB_SPIN_CAP (1u << 22)
__device__ __forceinline__ unsigned xb_ld(unsigned* p)              { return __hip_atomic_load(p, __ATOMIC_RELAXED, __HIP_MEMORY_SCOPE_AGENT); }
__device__ __forceinline__ unsigned xb_add(unsigned* p, unsigned v) { return __hip_atomic_fetch_add(p, v, __ATOMIC_RELAXED, __HIP_MEMORY_SCOPE_AGENT); }
__device__ __forceinline__ unsigned xb_xcc_id() { return (unsigned)__builtin_amdgcn_s_getreg((3 << 11) | 20) & 0xFu; }
#define XB_SPIN(cond, bar) do { unsigned _sp = 0; while (cond) { __builtin_amdgcn_s_sleep(1); \
    if ((++_sp & 255u) == 0u) { if (xb_ld(&(bar)[XB_TMO])) break; if (_sp > XB_SPIN_CAP) { atomicAdd(&(bar)[XB_TMO], 1u); break; } } } } while (0)
struct XcdBarrier { unsigned* bar; unsigned x; volatile LAS unsigned* st; };
__device__ __forceinline__ XcdBarrier xcd_barrier_post(unsigned* bar, volatile LAS unsigned* st) {
    XcdBarrier b; b.bar = bar; b.x = xb_xcc_id(); b.st = st;
    if (threadIdx.x == 0) (void)xb_add(&bar[XB_XCNT(b.x)], 1u);
    return b;
}
__device__ __forceinline__ void xcd_barrier_complete(unsigned* bar, unsigned x, unsigned& nloc, unsigned& nx) {
    const unsigned G = gridDim.x * gridDim.y * gridDim.z;
    unsigned sum, cnt, mine, sp = 0u;
    for (;;) {
        sum = 0u; cnt = 0u; mine = 0u;
#pragma unroll
        for (unsigned j = 0; j < 16; ++j) { const unsigned c = xb_ld(&bar[XB_XCNT(j)]); sum += c; cnt += (c > 0u) ? 1u : 0u; mine = (j == x) ? c : mine; }
        if (sum == G) break;
        __builtin_amdgcn_s_sleep(1);
        if ((++sp & 255u) == 0u) { if (xb_ld(&bar[XB_TMO])) break; if (sp > XB_SPIN_CAP) { atomicAdd(&bar[XB_TMO], 1u); break; } }
    }
    nloc = mine > 0u ? mine : 1u; nx = cnt > 0u ? cnt : 1u;
}
__device__ __forceinline__ void xcd_barrier(const XcdBarrier& b) {
    asm volatile("s_waitcnt vmcnt(0)" ::: "memory");
    __syncthreads();
    if (threadIdx.x == 0) {
        unsigned* bar = b.bar;
        __builtin_amdgcn_s_waitcnt(0);
        unsigned nloc = b.st[0], nx = b.st[1];
        if (nloc == 0u) { xcd_barrier_complete(bar, b.x, nloc, nx); b.st[0] = nloc; b.st[1] = nx; }
        const unsigned old = xb_add(&bar[XB_XSUB(b.x)], 1u);
        const unsigned gen = old / nloc;
        if (old + 1u == (gen + 1u) * nloc) {
            __builtin_amdgcn_fence(__ATOMIC_RELEASE, "agent");
            asm volatile("s_waitcnt vmcnt(0)" ::: "memory");
            const unsigned og = xb_add(&bar[XB_TOP], 1u);
            const unsigned tg = og / nx;
            if (og + 1u == (tg + 1u) * nx) xb_add(&bar[XB_TOPGEN], 1u);
            else XB_SPIN(xb_ld(&bar[XB_TOPGEN]) == tg, bar);
            __builtin_amdgcn_fence(__ATOMIC_ACQUIRE, "agent");
            xb_add(&bar[XB_XGEN(b.x)], 1u);
            asm volatile("s_waitcnt vmcnt(0)" ::: "memory");
        } else {
            XB_SPIN(xb_ld(&bar[XB_XGEN(b.x)]) == gen, bar);
            __builtin_amdgcn_fence(__ATOMIC_ACQUIRE, "agent");
            asm volatile("s_waitcnt vmcnt(0)" ::: "memory");
        }
    }
    __syncthreads();
}

constexpr int NPHASE = 10;
constexpr int LDS_BYTES = 131072 + 2048 + IDX_UNITS * 1024;
__global__ void __launch_bounds__(NTHR, 2) mk_fwd(Params p) {
    extern __shared__ __attribute__((aligned(16))) unsigned char lds_raw[];
    LAS unsigned char* lds = (LAS unsigned char*)lds_raw;
    const int lo = p.ph_lo, hi = p.ph_hi;
    volatile LAS unsigned* barst = (volatile LAS unsigned*)(lds + BARST_OFF);
    if (threadIdx.x < 2) barst[threadIdx.x] = 0u;
    __syncthreads();
    XcdBarrier xbar; xbar.bar = (unsigned*)(p.ws + WS_CTL) + CW_BAR; xbar.x = xb_xcc_id(); xbar.st = barst;
    if (MK_ONE_LAUNCH && blockIdx.x == 0 && lo == 0) { u32x4* z = (u32x4*)(p.ws + WS_CTL); for (int i = threadIdx.x; i < CTL_ZERO_BYTES / 16; i += NTHR) z[i] = (u32x4){0u, 0u, 0u, 0u}; }
#ifdef ONLY_PHASE
#define IN(k) ((k) == ONLY_PHASE && lo <= (k) && (k) < hi)
#else
#define IN(k) (lo <= (k) && (k) < hi)
#endif
#define SEAM(k) do { if (IN(k) && IN((k) + 1)) { if ((k) == 0) { cg::this_grid().sync(); if (threadIdx.x == 0) (void)xb_add(&xbar.bar[XB_XCNT(xbar.x)], 1u); } else xcd_barrier(xbar); } if (PROBE_TS == (k)) ts1 = __builtin_amdgcn_s_memrealtime(); } while (0)
#define RUN(k, call) do { if (IN(k)) { if (PROBE_TS == (k)) ts0 = __builtin_amdgcn_s_memrealtime(); call; if (REPEAT_PHASE == (k)) { cg::this_grid().sync(); call; } } } while (0)
    unsigned long long ts0 = 0, ts1 = 0;
    { int rep = 0;
    RUN(0, phase0(p, lds));
    SEAM(0);
    RUN(1, phase1(p, lds));
    SEAM(1);
    RUN(2, phase2(p, lds));
    SEAM(2);
    if (IN(3)) { const int nrep = (REPEAT_PHASE == 3) ? 2 : 1; if (PROBE_TS == 3) ts0 = __builtin_amdgcn_s_memrealtime();
#pragma unroll 1
        for (rep = 0; rep < nrep; ++rep) { if (rep) cg::this_grid().sync(); phase3(p, lds, rep); } }
    SEAM(3);
    RUN(4, phase4(p));
    SEAM(4);
    RUN(5, phase5(p, lds));
    SEAM(5);
    rep = 0; RUN(6, (phase6(p, lds, rep), ++rep));
    SEAM(6);
    RUN(7, phase7(p, lds));
    SEAM(7);
    RUN(8, phase8(p, lds));
    SEAM(8);
    RUN(9, phase9(p, lds));
    if (PROBE_TS == 9) ts1 = __builtin_amdgcn_s_memrealtime();
    if (PROBE_GEMM >= 0 && blockIdx.x == 0) { __syncthreads(); if (threadIdx.x == 0) p.out[0] += (float)(((const unsigned long long*)(p.ws + WS_CTL + 32768))[PROBE_PART]) * 1e-4f; }
    if (PROBE_TS >= 0 && blockIdx.x == 0 && threadIdx.x == 0) p.out[0] += (float)(ts1 - ts0) * 1e-4f;
    }
#undef RUN
#undef IN
#undef SEAM
}

extern "C" void kernel_launch(void* const* d_in, const int* in_sizes, int n_in, void* d_out, int out_size, void* d_ws, size_t ws_size, hipStream_t stream) {
    static int grid = 0;
    if (grid == 0) {
        if (n_in != 28 || out_size != T * D || ws_size < WS_END) { fprintf(stderr, "kernel_launch: unexpected shapes: n_in %d out %d ws %zu (need %zu)\n", n_in, out_size, ws_size, (size_t)WS_END); grid = -1; return; }
        int dev = 0, cus = 0, per_cu = 0;
        hipGetDevice(&dev); hipDeviceGetAttribute(&cus, hipDeviceAttributeMultiprocessorCount, dev);
        hipFuncSetAttribute((const void*)mk_fwd, hipFuncAttributeMaxDynamicSharedMemorySize, LDS_BYTES);
        hipOccupancyMaxActiveBlocksPerMultiprocessor(&per_cu, (const void*)mk_fwd, NTHR, LDS_BYTES);
        (void)hipGetLastError();
        if (per_cu < 1) { fprintf(stderr, "kernel_launch: occupancy query says %d blocks per CU\n", per_cu); per_cu = 1; }
        grid = cus;
    }
    if (grid < 0) return;
#if !MK_ONE_LAUNCH
    hipMemsetAsync((char*)d_ws + WS_CTL, 0, CTL_ZERO_BYTES, stream);
#endif
    Params p{};
    for (int i = 0; i < 28; ++i) p.in[i] = (const float*)d_in[i];
    p.out = (float*)d_out; p.ws = (unsigned char*)d_ws;
#if MK_ONE_LAUNCH
    p.ph_lo = 0; p.ph_hi = NPHASE;
    void* args[] = {&p};
    hipError_t e = hipLaunchCooperativeKernel((const void*)mk_fwd, dim3(grid), dim3(NTHR), args, LDS_BYTES, stream);
    if (e != hipSuccess) fprintf(stderr, "cooperative launch failed: %s (grid %d)\n", hipGetErrorString(e), grid);
#else
    for (int ph = 0; ph < NPHASE; ++ph) { p.ph_lo = ph; p.ph_hi = ph + 1; hipLaunchKernelGGL(mk_fwd, dim3(grid), dim3(NTHR), LDS_BYTES, stream, p); }
#endif
}
```

```cpp
#include <hip/hip_runtime.h>
#include <hip/hip_cooperative_groups.h>
#include <cstdio>
#include <cstdint>
namespace cg = cooperative_groups;

#ifndef REPEAT_PHASE
#define REPEAT_PHASE -1
#endif
#ifndef PROBE_TS
#define PROBE_TS -1
#endif
#ifndef PROBE_GEMM
#define PROBE_GEMM -1
#endif
#ifndef PROBE_PART
#define PROBE_PART 0
#endif
#ifndef MK_ONE_LAUNCH
#define MK_ONE_LAUNCH 1
#endif

typedef unsigned short bf16_t;
typedef short bf16x8 __attribute__((ext_vector_type(8)));
typedef short bf16x4 __attribute__((ext_vector_type(4)));
typedef float f32x4 __attribute__((ext_vector_type(4)));
typedef float f32x2 __attribute__((ext_vector_type(2)));
typedef unsigned u32x4 __attribute__((ext_vector_type(4)));
typedef unsigned u32x2 __attribute__((ext_vector_type(2)));

constexpr int D = 1024, BATCH = 16, SEQ = 2048, T = BATCH * SEQ;
constexpr int NMEM = 256, HD = 64;
constexpr int RH = 6, RC = 384;
constexpr int RWKV_IN = 1344;
constexpr int AH = 6, AW = 384, MH = 4, MW = 256;
constexpr int IN_W = 2752, IN_WP = 2816;
constexpr int PA_W = IN_WP - RWKV_IN;
constexpr int NE = 32, TOPK = 4, FF = 1024;
constexpr float LN_EPS = 1e-5f, GN_EPS = 64e-5f;
constexpr float ALPHA = 1.189207115002721f;
constexpr int NTHR = 512, NWAVES = 8;

constexpr size_t MiB = 1u << 20;
constexpr size_t WS_CTL = 0;
constexpr size_t WS_WT_IN = 1 * MiB;
constexpr size_t WS_LORA = 6 * MiB + 512 * 1024;
constexpr size_t WS_WT_OUT = 7 * MiB;
constexpr size_t WS_WT_KV = 9 * MiB;
constexpr size_t WS_KVM = 10 * MiB;
constexpr size_t WS_MEMB = 14 * MiB;
constexpr size_t WS_LIST = 22 * MiB;
constexpr size_t WS_ROWGATE = 26 * MiB;
constexpr size_t WS_SEL = 30 * MiB;
constexpr size_t WS_BONUS = 31 * MiB;
constexpr size_t WS_WRT = 31 * MiB + 800 * 1024;
constexpr size_t WS_WT_GU = 32 * MiB;
constexpr size_t WS_WT_DN = 160 * MiB;
constexpr size_t WS_H0B = 224 * MiB;
constexpr size_t WS_H1B = 288 * MiB;
constexpr size_t WS_YMIX = 352 * MiB;
constexpr size_t WS_PR = 416 * MiB;
constexpr size_t WS_ATTO = 416 * MiB;
constexpr size_t WS_PA = 500 * MiB;
constexpr size_t WS_SSH = 592 * MiB;
constexpr size_t WS_SDIR = 736 * MiB;
constexpr size_t WS_ACT = 352 * MiB;
constexpr size_t WS_YROWS = 624 * MiB;
constexpr size_t WS_END = 1024 * MiB;
constexpr size_t DO_Y = 0, DO_G = 96 * MiB, DO_LSE = 120 * MiB;
constexpr int ROWS_PAD = T * TOPK + NE * 256;

constexpr int CW_CNT = 0;
constexpr int CNT_SET = (REPEAT_PHASE == 6) ? 32 : 0;
constexpr int CW_ATTQ = 64;
constexpr int CW_SCANQ = 128;
constexpr int CW_BAR = 4096;
constexpr int CTL_ZERO_BYTES = 65536;
constexpr int BARST_OFF = 131072 + 1536;

#define LAS __attribute__((address_space(3)))

struct Params { const float* in[28]; float* out; unsigned char* ws; int ph_lo, ph_hi; };

__device__ __forceinline__ unsigned f2bf(float f) { unsigned u = __builtin_bit_cast(unsigned, f); return (u + 0x7fffu + ((u >> 16) & 1u)) >> 16; }
__device__ __forceinline__ unsigned pk2(float lo, float hi) { return f2bf(lo) | (f2bf(hi) << 16); }
__device__ __forceinline__ float bf2f(unsigned b) { return __builtin_bit_cast(float, b << 16); }
__device__ __forceinline__ float bflo(unsigned w) { return __builtin_bit_cast(float, w << 16); }
__device__ __forceinline__ float bfhi(unsigned w) { return __builtin_bit_cast(float, w & 0xffff0000u); }
template <int CTRL> __device__ __forceinline__ float dpp_mov(float v) {
    return __builtin_bit_cast(float, __builtin_amdgcn_update_dpp(0, __builtin_bit_cast(int, v), CTRL, 0xF, 0xF, true));
}
__device__ __forceinline__ float sum16(float v) {
    v += dpp_mov<0xB1>(v);
    v += dpp_mov<0x4E>(v);
    v += dpp_mov<0x141>(v);
    v += dpp_mov<0x140>(v);
    return v;
}
__device__ __forceinline__ float wave_sum(float v) {
    v = sum16(v);
    const int iv = __builtin_bit_cast(int, v);
    const float a = __builtin_bit_cast(float, __builtin_amdgcn_readlane(iv, 0)), b = __builtin_bit_cast(float, __builtin_amdgcn_readlane(iv, 16));
    const float c = __builtin_bit_cast(float, __builtin_amdgcn_readlane(iv, 32)), d = __builtin_bit_cast(float, __builtin_amdgcn_readlane(iv, 48));
    return (a + b) + (c + d);
}
__device__ __forceinline__ float sigmoidf_(float x) { return 1.f / (1.f + __expf(-x)); }

struct P0Item { const float* W; bf16_t* WT; int K, N, item; };
__device__ __forceinline__ void p0_item_load(const P0Item& I, float (&reg)[32], int lane) {
    const int nblk = I.N / 32, kb = I.item / nblk, nb = I.item % nblk, k0 = 64 * kb, n0 = 32 * nb;
    const float* src = I.W + (size_t)(k0 + (lane >> 5)) * I.N + n0 + (lane & 31);
#pragma unroll
    for (int i = 0; i < 32; ++i) reg[i] = src[(size_t)(2 * i) * I.N];
}
__device__ __forceinline__ void p0_item_store(const P0Item& I, const float (&reg)[32], LAS float* scr, int lane) {
    const int nblk = I.N / 32, kb = I.item / nblk, nb = I.item % nblk, k0 = 64 * kb, n0 = 32 * nb;
#pragma unroll
    for (int i = 0; i < 32; ++i) scr[(2 * i + (lane >> 5)) * 33 + (lane & 31)] = reg[i];
    asm volatile("s_waitcnt lgkmcnt(0)" ::: "memory");
    const int c = lane & 7;
#pragma unroll
    for (int j = 0; j < 4; ++j) { const int n = (lane >> 3) + 8 * j; const LAS float* s = scr + (8 * c) * 33 + n;
        u32x4 o; o.x = pk2(s[0 * 33], s[1 * 33]); o.y = pk2(s[2 * 33], s[3 * 33]); o.z = pk2(s[4 * 33], s[5 * 33]); o.w = pk2(s[6 * 33], s[7 * 33]);
        *(u32x4*)(I.WT + (size_t)(n0 + n) * I.K + k0 + 8 * c) = o; }
    asm volatile("s_waitcnt lgkmcnt(0)" ::: "memory");
}
__device__ __forceinline__ void ln_row(f32x4 (&v)[4], const float* __restrict__ g, const float* __restrict__ b, int lane) {
    float s = 0.f;
#pragma unroll
    for (int j = 0; j < 4; ++j) s += (v[j].x + v[j].y) + (v[j].z + v[j].w);
    const float mean = wave_sum(s) * (1.f / D); float s2 = 0.f;
#pragma unroll
    for (int j = 0; j < 4; ++j) { v[j] = v[j] - mean; s2 += (v[j].x * v[j].x + v[j].y * v[j].y) + (v[j].z * v[j].z + v[j].w * v[j].w); }
    const float rstd = 1.f / sqrtf(wave_sum(s2) * (1.f / D) + LN_EPS);
#pragma unroll
    for (int j = 0; j < 4; ++j) { const f32x4 gg = *(const f32x4*)(g + 4 * lane + 256 * j), bb = *(const f32x4*)(b + 4 * lane + 256 * j); v[j] = v[j] * rstd * gg + bb; }
}
__device__ __forceinline__ void store_row_bf16(bf16_t* orow, const f32x4 (&v)[4], int lane) {
#pragma unroll
    for (int j = 0; j < 4; ++j) { u32x2 o; o.x = pk2(v[j].x, v[j].y); o.y = pk2(v[j].z, v[j].w); *(u32x2*)(orow + 4 * lane + 256 * j) = o; }
}

constexpr int P0_I_IN = 16 * (IN_W / 32), P0_I_OUT = 16 * 32, P0_I_KV = 16 * 16, P0_I_GU = 16 * 64, P0_I_DN = 16 * 32;
constexpr int P0_NSMALL = P0_I_IN + P0_I_OUT + P0_I_KV;
constexpr int P0_NMOE = NE * P0_I_GU + NE * P0_I_DN;
__device__ __forceinline__ P0Item p0_make_small_item(const float* w_in, const float* w_out, const float* w_kv, unsigned char* ws, int it) { P0Item I; int r = it;
    if (r < P0_I_IN) { I.W = w_in; I.WT = (bf16_t*)(ws + WS_WT_IN); I.K = D; I.N = IN_W; I.item = r; return I; } r -= P0_I_IN;
    if (r < P0_I_OUT) { I.W = w_out; I.WT = (bf16_t*)(ws + WS_WT_OUT); I.K = D; I.N = D; I.item = r; return I; } r -= P0_I_OUT;
    { I.W = w_kv; I.WT = (bf16_t*)(ws + WS_WT_KV); I.K = D; I.N = 2 * MW; I.item = r; return I; } }
__device__ __forceinline__ P0Item p0_make_moe_item(const float* wgu, const float* wdn, unsigned char* ws, int r) { P0Item I;
    const bool gu = r < NE * P0_I_GU; const int r2 = gu ? r : r - NE * P0_I_GU; const int per = gu ? P0_I_GU : P0_I_DN; const int e = r2 / per;
    I.W = (gu ? wgu : wdn) + (size_t)e * D * 2 * FF * (gu ? 1 : 0) + (size_t)e * FF * D * (gu ? 0 : 1);
    I.WT = (bf16_t*)(ws + (gu ? WS_WT_GU : WS_WT_DN)) + (size_t)e * (gu ? 2 * FF * D : D * FF);
    I.K = gu ? D : FF; I.N = gu ? 2 * FF : D; I.item = r2 % per; return I; }
__device__ __forceinline__ void phase0(const Params& p, LAS unsigned char* lds) {
    const int tid = threadIdx.x, lane = tid & 63, wave = tid >> 6;
    const int gw = blockIdx.x * NWAVES + wave, NGW = gridDim.x * NWAVES;
    LAS float* scr = (LAS float*)(lds + wave * 16384);
    unsigned char* ws = p.ws;
    constexpr int NITEMS = P0_NSMALL;
    const float* w_in = p.in[4]; const float* w_out = p.in[17]; const float* w_kv = p.in[16];
    asm volatile("" : "+s"(w_in), "+s"(w_out), "+s"(w_kv));
    auto mk = [&](int it) { return p0_make_small_item(w_in, w_out, w_kv, ws, it); };
    { float ra[32], rb[32]; int it = gw;
      if (it < NITEMS) { const P0Item I0 = mk(it); p0_item_load(I0, ra, lane); }
      for (; it < NITEMS; it += 2 * NGW) {
          const P0Item Ia = mk(it); const bool hb = it + NGW < NITEMS; P0Item Ib = Ia;
          if (hb) { Ib = mk(it + NGW); p0_item_load(Ib, rb, lane); }
          p0_item_store(Ia, ra, scr, lane);
          if (it + 2 * NGW < NITEMS) { const P0Item Ic = mk(it + 2 * NGW); p0_item_load(Ic, ra, lane); }
          if (hb) p0_item_store(Ib, rb, scr, lane);
      } }
    { u32x4* z = (u32x4*)((bf16_t*)(ws + WS_WT_IN) + (size_t)IN_W * D); const int n16 = (IN_WP - IN_W) * D * 2 / 16;
      for (int i = blockIdx.x * NTHR + tid; i < n16; i += gridDim.x * NTHR) z[i] = (u32x4){0u, 0u, 0u, 0u}; }
    { const float* wr = p.in[20]; bf16_t* wh = (bf16_t*)(ws + WS_WRT); bf16_t* wl = wh + NE * D;
      for (int i = blockIdx.x * NTHR + tid; i < NE * D; i += gridDim.x * NTHR) { const int e = i / D, k = i % D; const float w = wr[k * NE + e]; const unsigned h = f2bf(w); wh[i] = (bf16_t)h; wl[i] = (bf16_t)f2bf(w - bf2f(h)); } }
    { bf16_t* wu = (bf16_t*)(ws + WS_LORA); bf16_t* au = wu + 2 * RC * 32; bf16_t* gu = au + 2 * RC * 32;
      for (int i = blockIdx.x * NTHR + tid; i < 2 * RC * 32; i += gridDim.x * NTHR) { const int dch = i >> 5, j = i & 31, d = dch / RC, ch = dch % RC; wu[i] = (bf16_t)f2bf(p.in[7][(size_t)(d * 32 + j) * RC + ch]); au[i] = (bf16_t)f2bf(p.in[9][(size_t)(d * 32 + j) * RC + ch]); }
      for (int i = blockIdx.x * NTHR + tid; i < RC * 64; i += gridDim.x * NTHR) { const int ch = i >> 6, j = i & 63; gu[i] = (bf16_t)f2bf(p.in[10][(size_t)j * RC + ch]); } }
    for (int m = gw; m < T; m += NGW) {
        const f32x4* xr = (const f32x4*)(p.in[0] + (size_t)m * D) + lane; f32x4 v[4];
#pragma unroll
        for (int j = 0; j < 4; ++j) v[j] = xr[64 * j];
        ln_row(v, p.in[2], p.in[3], lane);
        store_row_bf16((bf16_t*)(ws + WS_H0B) + (size_t)m * D, v, lane);
    }
    for (int m = gw; m < BATCH * NMEM; m += NGW) {
        const f32x4* xr = (const f32x4*)(p.in[1] + (size_t)m * D) + lane; f32x4 v[4];
#pragma unroll
        for (int j = 0; j < 4; ++j) v[j] = xr[64 * j];
        store_row_bf16((bf16_t*)(ws + WS_MEMB) + (size_t)m * D, v, lane);
    }
}

template <class ARow, class BRow, class Epi>
__device__ __forceinline__ void sgemm_tile(int K, ARow arow, BRow brow, Epi epi) {
    const int tid = threadIdx.x, wid = tid >> 6, lane = tid & 63, wm = wid >> 1, wn = wid & 1, fr = lane & 15, fq = lane >> 4;
    f32x4 acc[2][4];
#pragma unroll
    for (int m = 0; m < 2; ++m)
#pragma unroll
        for (int n = 0; n < 4; ++n) acc[m][n] = (f32x4){0.f, 0.f, 0.f, 0.f};
    const bf16_t* ap[2]; const bf16_t* bp[4];
#pragma unroll
    for (int m = 0; m < 2; ++m) ap[m] = arow(wm * 32 + m * 16 + fr) + fq * 8;
#pragma unroll
    for (int n = 0; n < 4; ++n) bp[n] = brow(wn * 64 + n * 16 + fr) + fq * 8;
    for (int k = 0; k < K; k += 32) {
        bf16x8 a[2], b[4];
#pragma unroll
        for (int m = 0; m < 2; ++m) a[m] = *(const bf16x8*)(ap[m] + k);
#pragma unroll
        for (int n = 0; n < 4; ++n) b[n] = *(const bf16x8*)(bp[n] + k);
#pragma unroll
        for (int m = 0; m < 2; ++m)
#pragma unroll
            for (int n = 0; n < 4; ++n) acc[m][n] = __builtin_amdgcn_mfma_f32_16x16x32_bf16(b[n], a[m], acc[m][n], 0, 0, 0);
    }
#pragma unroll
    for (int m = 0; m < 2; ++m)
#pragma unroll
        for (int n = 0; n < 4; ++n) epi(wm * 32 + m * 16 + fr, wn * 64 + n * 16 + 4 * fq, acc[m][n], n);
}


namespace pg8 {
constexpr int BM = 256, BK = 64, HALF = 128, HTB = HALF * BK * 2, STAGE_BYTES = 8 * HTB, NXCD = 8, WGM = 8;
__host__ __device__ __forceinline__ int lds_byte(int r, int c) { const int st = (r >> 4) * 2 + (c >> 5), rr = r & 15, cc = c & 31, ob = rr * 64 + cc * 2; return st * 1024 + (ob ^ (((ob >> 9) & 1) << 5)); }
__host__ __device__ __forceinline__ void stage_rc(int b, int& R, int& C) { const int st = b / 1024, sb = b % 1024, swz = sb ^ (((sb >> 9) & 1) << 5); R = (st >> 1) * 16 + swz / 64; C = (st & 1) * 32 + (swz % 64) / 2; }
__host__ __device__ __forceinline__ int perm32(int rho) { const int n = rho >> 4, i = rho & 15; return 8 * (i >> 2) + 4 * n + (i & 3); }
struct Unit { const char* A; const char* B0; const char* B1; int x0, x1, x2, x3, x4; };
__device__ __forceinline__ unsigned cvt_pk_bf16(float lo, float hi) { unsigned r; asm volatile("v_cvt_pk_bf16_f32 %0, %1, %2" : "=v"(r) : "v"(lo), "v"(hi)); return r; }

__device__ __forceinline__ const char* uni_ptr(const char* p) { const unsigned long long v = (unsigned long long)p; const unsigned lo = __builtin_amdgcn_readfirstlane((unsigned)v), hi = __builtin_amdgcn_readfirstlane((unsigned)(v >> 32)); return (const char*)(((unsigned long long)hi << 32) | lo); }
__device__ __forceinline__ bool static_order(int nM, int nN, int G, int c, int i, int& pm, int& pn) {
    const int nwg = nM * nN; const long L = (long)i * G + c; if (L >= nwg) return false;
    int wgid = (int)L; { const int q = nwg / NXCD, r = nwg % NXCD, xcd = wgid % NXCD, off = wgid / NXCD; wgid = (xcd < r ? xcd * (q + 1) : r * (q + 1) + (xcd - r) * q) + off; }
    const int nig = WGM * nN, gid = wgid / nig, fm = gid * WGM, gsz = (nM - fm) < WGM ? (nM - fm) : WGM;
    pm = fm + ((wgid % nig) % gsz); pn = (wgid % nig) / gsz; return true;
}

template <class Pol>
__device__ __forceinline__ void gemm_phase(LAS unsigned char* lds, const Pol& P, const int K, unsigned long long* stat = nullptr) {
    unsigned long long tK = 0, tE = 0, tmark = 0, tstart = stat ? __builtin_amdgcn_s_memrealtime() : 0;
    const int tid = threadIdx.x, wid = __builtin_amdgcn_readfirstlane(tid >> 6), lane = tid & 63, wr = wid >> 2, wc = wid & 3, fr = lane & 15, fq = lane >> 4;
    const int nt = K / BK;
    int R0, C0; stage_rc(tid * 16, R0, C0);
    const int Rb0 = Pol::PERM ? ((R0 & ~31) + perm32(R0 & 31)) : R0;
    const unsigned vB = (unsigned)(Rb0 * K + C0) * 2u;
    const size_t pstep = (size_t)64 * K * 2;
    const size_t kstep = (size_t)(BK * 2);
    const unsigned ldsw = (unsigned)wid * 1024u;
    const int aoff = lds_byte(wr * 64 + fr, fq * 8), boff = lds_byte(wc * 32 + fr, fq * 8);
#define PG8_SA(b, h) (((b) * 2 + (h)) * HTB)
#define PG8_SB(b, h) ((4 + (b) * 2 + (h)) * HTB)
#define PG8_STAGE_B(bufoff, gbase) do { _Pragma("unroll") for (int _i = 0; _i < 2; ++_i) \
        __builtin_amdgcn_global_load_lds((const unsigned*)(uni_ptr((const char*)(gbase) + _i * pstep) + vB), (LAS unsigned*)(lds + (bufoff) + ldsw + _i * 8192), 16, 0, 0); } while (0)
#define PG8_STAGE_A(bufoff, gbase, vo, h) do { _Pragma("unroll") for (int _i = 0; _i < 2; ++_i) { \
        if constexpr (Pol::GATHER) __builtin_amdgcn_global_load_lds((const unsigned*)(uni_ptr((const char*)(gbase)) + (vo)[h][_i]), (LAS unsigned*)(lds + (bufoff) + ldsw + _i * 8192), 16, 0, 0); \
        else __builtin_amdgcn_global_load_lds((const unsigned*)(uni_ptr((const char*)(gbase) + ((h) * 2 + _i) * pstep) + (vo)[0][0]), (LAS unsigned*)(lds + (bufoff) + ldsw + _i * 8192), 16, 0, 0); } } while (0)
#define PG8_LDA(dst, b, h) do { _Pragma("unroll") for (int m = 0; m < 4; ++m) _Pragma("unroll") for (int k = 0; k < 2; ++k) dst[m][k] = *(const LAS bf16x8*)(lds + PG8_SA(b, h) + aoff + m * 2048 + k * 1024); } while (0)
#define PG8_LDB(dst, b, h) do { _Pragma("unroll") for (int n = 0; n < 2; ++n) _Pragma("unroll") for (int k = 0; k < 2; ++k) dst[n][k] = *(const LAS bf16x8*)(lds + PG8_SB(b, h) + boff + n * 2048 + k * 1024); } while (0)
#define PG8_MMA(ai, bj, At, Bt) do { __builtin_amdgcn_s_setprio(1); _Pragma("unroll") for (int m = 0; m < 4; ++m) _Pragma("unroll") for (int n = 0; n < 2; ++n) _Pragma("unroll") for (int k = 0; k < 2; ++k) \
        acc[ai][bj][m][n] = __builtin_amdgcn_mfma_f32_16x16x32_bf16(Bt[n][k], At[m][k], acc[ai][bj][m][n], 0, 0, 0); __builtin_amdgcn_s_setprio(0); } while (0)
#define PG8_WAIT_V(n) asm volatile("s_waitcnt vmcnt(" #n ")" ::: "memory")
#define PG8_WAIT_L(n) asm volatile("s_waitcnt lgkmcnt(" #n ")" ::: "memory")
#define PG8_BAR __builtin_amdgcn_s_barrier()
#define PG8_SCHED __builtin_amdgcn_sched_barrier(0)
    Unit cur, nxt; int ui = 0;
    if (!P.next(0, cur)) return;
    f32x4 acc[2][2][4][2];
#pragma unroll
    for (int a = 0; a < 2; ++a)
#pragma unroll
        for (int b = 0; b < 2; ++b)
#pragma unroll
            for (int m = 0; m < 4; ++m)
#pragma unroll
                for (int n = 0; n < 2; ++n) acc[a][b][m][n] = (f32x4){0.f, 0.f, 0.f, 0.f};
    bf16x8 At[4][2], B0[2][2], B1[2][2];
    unsigned vAc[2][2], vAn[2][2];
    if constexpr (Pol::GATHER) { P.rows_issue(cur, R0, vAc); P.rows_finish(C0, K, vAc); }
    else { vAc[0][0] = (unsigned)(R0 * K + C0) * 2u; vAc[0][1] = vAc[1][0] = vAc[1][1] = 0u; }
    asm volatile("s_waitcnt vmcnt(0)" ::: "memory");
    PG8_STAGE_B(PG8_SB(0, 0), cur.B0); PG8_STAGE_B(PG8_SB(0, 1), cur.B1); PG8_STAGE_A(PG8_SA(0, 0), cur.A, vAc, 0); PG8_STAGE_A(PG8_SA(0, 1), cur.A, vAc, 1);
    if (wr == 1) PG8_BAR;
    PG8_WAIT_V(2); PG8_BAR;
    PG8_STAGE_B(PG8_SB(1, 0), cur.B0 + kstep); PG8_STAGE_A(PG8_SA(1, 0), cur.A + kstep, vAc, 0); PG8_STAGE_B(PG8_SB(1, 1), cur.B1 + kstep);
    PG8_WAIT_V(6); PG8_BAR;
    for (;;) {
        const bool has_next = P.next(ui + 1, nxt);
        if (!has_next) nxt = cur;
        if (stat) tmark = __builtin_amdgcn_s_memrealtime();
        for (int t = 0; t < nt; t += 2) {
            const bool last = (t == nt - 2);
            if constexpr (Pol::GATHER) {
                if (last && has_next) { P.rows_issue(nxt, R0, vAn); vAc[0][0] = (vAn[0][0] * (unsigned)K + (unsigned)C0) * 2u; vAc[0][1] = (vAn[0][1] * (unsigned)K + (unsigned)C0) * 2u; }
            }
            const char* a1 = cur.A + (size_t)(t + 1) * kstep;
            const char* a2 = last ? nxt.A : cur.A + (size_t)(t + 2) * kstep;
            const char* b20 = last ? nxt.B0 : cur.B0 + (size_t)(t + 2) * kstep; const char* b21 = last ? nxt.B1 : cur.B1 + (size_t)(t + 2) * kstep;
            const char* a3 = a2 + kstep; const char* b30 = b20 + kstep; const char* b31 = b21 + kstep;
            PG8_LDB(B0, 0, 0); PG8_LDB(B1, 0, 1); PG8_SCHED; PG8_LDA(At, 0, 0); PG8_STAGE_A(PG8_SA(1, 1), a1, vAc, 1);
            if constexpr (Pol::GATHER) { if (last && has_next) { vAc[1][0] = (vAn[1][0] * (unsigned)K + (unsigned)C0) * 2u; vAc[1][1] = (vAn[1][1] * (unsigned)K + (unsigned)C0) * 2u; } }
            PG8_WAIT_V(8); PG8_WAIT_L(0); PG8_BAR; PG8_MMA(0, 0, At, B0); PG8_MMA(0, 1, At, B1); PG8_BAR; PG8_SCHED;
            PG8_LDA(At, 0, 1); PG8_STAGE_B(PG8_SB(0, 0), b20); PG8_STAGE_B(PG8_SB(0, 1), b21); PG8_STAGE_A(PG8_SA(0, 0), a2, vAc, 0);
            PG8_WAIT_V(8); PG8_WAIT_L(0); PG8_BAR; PG8_MMA(1, 0, At, B0); PG8_MMA(1, 1, At, B1); PG8_BAR; PG8_SCHED;
            PG8_LDB(B0, 1, 0); PG8_LDB(B1, 1, 1); PG8_SCHED; PG8_LDA(At, 1, 0); PG8_STAGE_A(PG8_SA(0, 1), a2, vAc, 1);
            PG8_WAIT_V(8); PG8_WAIT_L(0); PG8_BAR; PG8_MMA(0, 0, At, B0); PG8_MMA(0, 1, At, B1); PG8_BAR; PG8_SCHED;
            PG8_LDA(At, 1, 1); PG8_STAGE_B(PG8_SB(1, 0), b30); PG8_STAGE_B(PG8_SB(1, 1), b31); PG8_STAGE_A(PG8_SA(1, 0), a3, vAc, 0);
            PG8_WAIT_V(8); PG8_WAIT_L(0); PG8_BAR; PG8_MMA(1, 0, At, B0); PG8_MMA(1, 1, At, B1); PG8_BAR; PG8_SCHED;
        }
        if (stat) { const unsigned long long n_ = __builtin_amdgcn_s_memrealtime(); tK += n_ - tmark; tmark = n_; }
        if (wr == 0) PG8_BAR;
        P.epi(acc, cur, wr, wc, fr, fq);
        if (stat) { const unsigned long long n_ = __builtin_amdgcn_s_memrealtime(); tE += n_ - tmark; }
        if (!has_next) break;
#pragma unroll
        for (int a = 0; a < 2; ++a)
#pragma unroll
            for (int b = 0; b < 2; ++b)
#pragma unroll
                for (int m = 0; m < 4; ++m)
#pragma unroll
                    for (int n = 0; n < 2; ++n) acc[a][b][m][n] = (f32x4){0.f, 0.f, 0.f, 0.f};
        cur = nxt; ++ui;
        if (wr == 1) PG8_BAR;
    }
    PG8_WAIT_V(0);
    PG8_BAR;
    if (stat && threadIdx.x == 0) { stat[0] = tK; stat[1] = tE; stat[2] = __builtin_amdgcn_s_memrealtime() - tstart; }
#undef PG8_SA
#undef PG8_SB
#undef PG8_STAGE_A
#undef PG8_STAGE_B
#undef PG8_LDA
#undef PG8_LDB
#undef PG8_MMA
#undef PG8_WAIT_V
#undef PG8_WAIT_L
#undef PG8_BAR
#undef PG8_SCHED
}
}

struct PolP1 {
    static constexpr bool PERM = true, GATHER = false;
    const bf16_t* A; const bf16_t* Bt; bf16_t* PR; bf16_t* PA; const bf16_t* MB; const bf16_t* WK; bf16_t* KVM; int G, c;
    __device__ __forceinline__ bool next(int i, pg8::Unit& u) const { int pm, pn; constexpr int NMAIN = (T / 256) * (IN_WP / 256), NKV = (BATCH * NMEM / 256) * (2 * MW / 256);
        if (pg8::static_order(T / 256, IN_WP / 256, G, c, i, pm, pn)) {
            u.A = (const char*)(A + (size_t)pm * 256 * D); u.B0 = (const char*)(Bt + (size_t)pn * 256 * D); u.B1 = u.B0 + (size_t)128 * D * 2; u.x0 = pm; u.x1 = pn; u.x2 = 0; u.x3 = 0; u.x4 = 0; return true; }
        const long L = (long)i * G + c - NMAIN; if (L < 0 || L >= NKV) return false;
        pm = (int)(L >> 1); pn = (int)(L & 1);
        u.A = (const char*)(MB + (size_t)pm * 256 * D); u.B0 = (const char*)(WK + (size_t)pn * 256 * D); u.B1 = u.B0 + (size_t)128 * D * 2; u.x0 = pm; u.x1 = pn; u.x2 = 1; u.x3 = 0; u.x4 = 0; return true; }
    __device__ __forceinline__ void epi(const f32x4 (&acc)[2][2][4][2], const pg8::Unit& u, int wr, int wc, int fr, int fq) const {
        const int row0 = u.x0 * 256 + wr * 64 + fr;
#pragma unroll
        for (int bj = 0; bj < 2; ++bj) { const int col = u.x1 * 256 + bj * 128 + wc * 32 + 8 * fq;
            bf16_t* base; int pitch; float sc = 1.f;
            if (u.x2) { base = KVM + col; pitch = 2 * MW; }
            else if (col < RWKV_IN) { base = PR + col; pitch = RWKV_IN; }
            else { const int ca = col - RWKV_IN; base = PA + ca; pitch = PA_W; sc = (ca < AW || (ca >= 3 * AW && ca < 3 * AW + MW)) ? 0.125f : 1.f; }
#pragma unroll
            for (int ai = 0; ai < 2; ++ai)
#pragma unroll
                for (int m = 0; m < 4; ++m) { const f32x4 v0 = acc[ai][bj][m][0] * sc, v1 = acc[ai][bj][m][1] * sc;
                    u32x4 w; w.x = pg8::cvt_pk_bf16(v0[0], v0[1]); w.y = pg8::cvt_pk_bf16(v0[2], v0[3]); w.z = pg8::cvt_pk_bf16(v1[0], v1[1]); w.w = pg8::cvt_pk_bf16(v1[2], v1[3]);
                    *(u32x4*)(base + (size_t)(row0 + ai * 128 + m * 16) * pitch) = w; } }
    }
};
__device__ __forceinline__ void phase1(const Params& p, LAS unsigned char* lds) {
    unsigned char* ws = p.ws;
    PolP1 P{(const bf16_t*)(ws + WS_H0B), (const bf16_t*)(ws + WS_WT_IN), (bf16_t*)(ws + WS_PR), (bf16_t*)(ws + WS_PA), (const bf16_t*)(ws + WS_MEMB), (const bf16_t*)(ws + WS_WT_KV), (bf16_t*)(ws + WS_KVM), (int)gridDim.x, (int)blockIdx.x};
    pg8::gemm_phase(lds, P, D, (PROBE_GEMM == 1 && blockIdx.x == 0) ? (unsigned long long*)(ws + WS_CTL + 32768) : nullptr);
}

constexpr int P2_AP = 200;
__device__ __forceinline__ f32x4 p2_shift(const bf16_t* cur, int po, int no, float pm, float nm, const float* mu) {
    const u32x2 c = *(const u32x2*)cur, pv = *(const u32x2*)(cur + po), nv = *(const u32x2*)(cur + no);
    const f32x4 m = *(const f32x4*)mu;
    const f32x4 cc = {bflo(c.x), bfhi(c.x), bflo(c.y), bfhi(c.y)}, pp = {bflo(pv.x), bfhi(pv.x), bflo(pv.y), bfhi(pv.y)}, nn = {bflo(nv.x), bfhi(nv.x), bflo(nv.y), bfhi(nv.y)};
    return cc + m * (0.5f * (pp * pm + nn * nm) - cc);
}
constexpr int P2_CST = 8 * 16 * P2_AP * 2;
constexpr int P2_WOFF = P2_CST + 10 * RC * 4, P2_WBUF = 24576;
struct P2Pre { u32x2 rc, rp, rn, vc, vp, vn; };
__device__ __forceinline__ f32x4 p2_lerp(u32x2 c, u32x2 pv, u32x2 nv, float pm, float nm, f32x4 m) {
    const f32x4 cc = {bflo(c.x), bfhi(c.x), bflo(c.y), bfhi(c.y)}, pp = {bflo(pv.x), bfhi(pv.x), bflo(pv.y), bfhi(pv.y)}, nn = {bflo(nv.x), bfhi(nv.x), bflo(nv.y), bfhi(nv.y)};
    return cc + m * (0.5f * (pp * pm + nn * nm) - cc);
}
__device__ __forceinline__ void p2_fetch(P2Pre& P, const bf16_t* prow, int po, int no, const bf16_t* WU, const bf16_t* AU, const bf16_t* GU, int it, int fr, int fq) {
    const int h = it >> 2, ct = it & 3, ch = h * 64 + 16 * ct + 4 * fq;
    P.rc = *(const u32x2*)(prow + ch); P.rp = *(const u32x2*)(prow + ch + po); P.rn = *(const u32x2*)(prow + ch + no);
    P.vc = *(const u32x2*)(prow + 2 * RC + ch); P.vp = *(const u32x2*)(prow + 2 * RC + ch + po); P.vn = *(const u32x2*)(prow + 2 * RC + ch + no);
}
__device__ __forceinline__ void p2_wfetch(const bf16_t* WU, const bf16_t* AU, const bf16_t* GU, int h, int tid, u32x4 (&wr)[3]) {
#pragma unroll
    for (int q = 0; q < 3; ++q) { const int idx = tid + NTHR * q; const bf16_t* src;
        if (q < 2) { const int d = (idx & 511) >> 8, row = (idx & 255) >> 2, part = idx & 3; src = (q == 0 ? WU : AU) + ((size_t)(d * RC + h * 64 + row) * 32 + part * 8); }
        else { const int row = (idx - 1024) >> 3, part = idx & 7; src = GU + ((size_t)(h * 64 + row) * 64 + part * 8); }
        wr[q] = *(const u32x4*)src; }
}
__device__ __forceinline__ void p2_wput(LAS unsigned char* wb, int tid, const u32x4 (&wr)[3]) {
#pragma unroll
    for (int q = 0; q < 3; ++q) *(LAS u32x4*)(wb + (tid + NTHR * q) * 16) = wr[q];
}
__device__ __forceinline__ void phase2(const Params& p, LAS unsigned char* lds) {
    int tid_ = threadIdx.x; asm volatile("" : "+v"(tid_)); const int tid = tid_, lane = tid & 63, wave = tid >> 6, fr = lane & 15, fq = lane >> 4;
    unsigned char* ws = p.ws;
    const bf16_t* PR = (const bf16_t*)(ws + WS_PR);
    const float* mu = p.in[5];
    const bf16_t* WU = (const bf16_t*)(ws + WS_LORA); const bf16_t* AU = WU + 2 * RC * 32; const bf16_t* GU = AU + 2 * RC * 32;
    LAS bf16_t* ACT = (LAS bf16_t*)(lds + wave * (16 * P2_AP * 2));
    LAS float* CST = (LAS float*)(lds + P2_CST);
    unsigned char* SSH = ws + WS_SSH; unsigned char* SDIR = ws + WS_SDIR;
    bf16_t* G = (bf16_t*)((unsigned char*)p.out + DO_G); float* BON = (float*)(ws + WS_BONUS);
    __syncthreads();
    for (int i = tid; i < 10 * RC; i += NTHR) { const int a = i / RC, c = i % RC; float v;
        if (a < 3) v = mu[a * RC + c]; else if (a < 5) v = p.in[6][(a - 3) * RC + c]; else if (a < 7) v = p.in[8][(a - 5) * RC + c]; else v = p.in[11 + (a - 7)][c];
        CST[i] = v; }
    u32x4 wreg[3];
    p2_wfetch(WU, AU, GU, 0, tid, wreg); p2_wput(lds + P2_WOFF, tid, wreg);
    __syncthreads();
    { const int tile = blockIdx.x * NWAVES + wave;
        const int t0 = tile * 16;
#pragma unroll 4
        for (int i = 0; i < 12; ++i) { const int grp = lane + 64 * i, tok = grp / 48, c4 = (grp % 48) * 4, t = t0 + tok, sq = t & (SEQ - 1);
            f32x4 v = p2_shift(PR + (size_t)t * RWKV_IN + 3 * RC + c4, sq > 0 ? -RWKV_IN : 0, sq < SEQ - 1 ? RWKV_IN : 0, sq > 0 ? 1.f : 0.f, sq < SEQ - 1 ? 1.f : 0.f, mu + 3 * RC + c4);
            { const float sc = c4 < 64 ? 1.f : 2.f, mul = c4 < 64 ? 1.f : 2.f, add = c4 < 64 ? 0.f : -1.f; const bool raw = c4 >= 128;
#pragma unroll
              for (int e = 0; e < 4; ++e) { const float a = sigmoidf_(sc * v[e]) * mul + add; v[e] = raw ? v[e] : a; } }
            u32x2 o; o.x = pk2(v.x, v.y); o.y = pk2(v.z, v.w); *(LAS u32x2*)(ACT + tok * P2_AP + c4) = o; }
        asm volatile("s_waitcnt lgkmcnt(0)" ::: "memory");
        const int t = t0 + fr, sq = t & (SEQ - 1), b = t >> 11; const int po = sq > 0 ? -RWKV_IN : 0, no = sq < SEQ - 1 ? RWKV_IN : 0; const float pm = sq > 0 ? 1.f : 0.f, nm = sq < SEQ - 1 ? 1.f : 0.f;
        const bf16_t* prow = PR + (size_t)t * RWKV_IN;
        const LAS bf16_t* arowp = ACT + fr * P2_AP + 8 * fq;
        u32x2 kq[4][3];
#pragma unroll
        for (int ct = 0; ct < 4; ++ct) { const int ch = RC + 16 * ct + 4 * fq; kq[ct][0] = *(const u32x2*)(prow + ch); kq[ct][1] = *(const u32x2*)(prow + ch + po); kq[ct][2] = *(const u32x2*)(prow + ch + no); }
        P2Pre cur, nxt; p2_fetch(cur, prow, po, no, WU, AU, GU, 0, fr, fq);
#pragma unroll 1
        for (int h = 0; h < RH; ++h) {
            if (h + 1 < RH) p2_wfetch(WU, AU, GU, h + 1, tid, wreg);
            const LAS unsigned char* wbuf = lds + P2_WOFF + (h & 1) * P2_WBUF;
            f32x4 kp[4]; float ss = 0.f;
#pragma unroll
            for (int ct = 0; ct < 4; ++ct) { const int ch = h * 64 + 16 * ct + 4 * fq; kp[ct] = p2_lerp(kq[ct][0], kq[ct][1], kq[ct][2], pm, nm, *(const LAS f32x4*)(CST + RC + ch));
                const f32x4 kkv = kp[ct] * *(const LAS f32x4*)(CST + 7 * RC + ch); ss += (kkv.x * kkv.x + kkv.y * kkv.y) + (kkv.z * kkv.z + kkv.w * kkv.w); }
            ss += __shfl_xor(ss, 16); ss += __shfl_xor(ss, 32);
            const float rn = 1.f / fmaxf(sqrtf(ss), 1e-12f);
            float bon = 0.f;
            unsigned char* shrec = SSH + ((size_t)(b * RH + h) * SEQ + sq) * 384;
            unsigned char* d0rec = SDIR + ((size_t)((0 * BATCH + b) * RH + h) * SEQ + sq) * 512; unsigned char* d1rec = SDIR + ((size_t)((1 * BATCH + b) * RH + h) * SEQ + sq) * 512;
#pragma unroll
            for (int ct = 0; ct < 4; ++ct) { const int ch = h * 64 + 16 * ct + 4 * fq, cl = 16 * ct + 4 * fq, it = h * 4 + ct;
                const f32x4 r = p2_lerp(cur.rc, cur.rp, cur.rn, pm, nm, *(const LAS f32x4*)(CST + ch)), v = p2_lerp(cur.vc, cur.vp, cur.vn, pm, nm, *(const LAS f32x4*)(CST + 2 * RC + ch)), k = kp[ct];
                const LAS unsigned char* wl_ = wbuf + ((16 * ct + fr) * 4 + fq) * 16;
                const bf16x8 fw0 = *(const LAS bf16x8*)wl_, fw1 = *(const LAS bf16x8*)(wl_ + 4096), fa0 = *(const LAS bf16x8*)(wl_ + 8192), fa1 = *(const LAS bf16x8*)(wl_ + 12288);
                const LAS unsigned char* gl_ = wbuf + 16384 + ((16 * ct + fr) * 8 + fq) * 16;
                const bf16x8 fg0 = *(const LAS bf16x8*)gl_, fg1 = *(const LAS bf16x8*)(gl_ + 64);
                const f32x4 z = {0.f, 0.f, 0.f, 0.f};
                const f32x4 wl0 = __builtin_amdgcn_mfma_f32_16x16x32_bf16(fw0, *(const LAS bf16x8*)(arowp + 64), z, 0, 0, 0);
                const f32x4 wl1 = __builtin_amdgcn_mfma_f32_16x16x32_bf16(fw1, *(const LAS bf16x8*)(arowp + 96), z, 0, 0, 0);
                const f32x4 al0 = __builtin_amdgcn_mfma_f32_16x16x32_bf16(fa0, *(const LAS bf16x8*)(arowp + 128), z, 0, 0, 0);
                const f32x4 al1 = __builtin_amdgcn_mfma_f32_16x16x32_bf16(fa1, *(const LAS bf16x8*)(arowp + 160), z, 0, 0, 0);
                f32x4 gg = __builtin_amdgcn_mfma_f32_16x16x32_bf16(fg0, *(const LAS bf16x8*)(arowp), z, 0, 0, 0);
                gg = __builtin_amdgcn_mfma_f32_16x16x32_bf16(fg1, *(const LAS bf16x8*)(arowp + 32), gg, 0, 0, 0);
                const f32x4 w00 = *(const LAS f32x4*)(CST + 3 * RC + ch), w01 = *(const LAS f32x4*)(CST + 4 * RC + ch), a00 = *(const LAS f32x4*)(CST + 5 * RC + ch), a01 = *(const LAS f32x4*)(CST + 6 * RC + ch);
                const f32x4 kkw = *(const LAS f32x4*)(CST + 7 * RC + ch), kaw = *(const LAS f32x4*)(CST + 8 * RC + ch), rkw = *(const LAS f32x4*)(CST + 9 * RC + ch);
                f32x4 dec0, dec1, kd0, kd1, bb0, bb1, kkn;
#pragma unroll
                for (int e = 0; e < 4; ++e) {
                    dec0[e] = __expf(-0.6065306597126334f * sigmoidf_(w00[e] + wl0[e])); dec1[e] = __expf(-0.6065306597126334f * sigmoidf_(w01[e] + wl1[e]));
                    const float a0 = sigmoidf_(a00[e] + al0[e]), a1 = sigmoidf_(a01[e] + al1[e]);
                    kkn[e] = k[e] * kkw[e] * rn; kd0[e] = k[e] * (1.f + (a0 - 1.f) * kaw[e]); kd1[e] = k[e] * (1.f + (a1 - 1.f) * kaw[e]);
                    bb0[e] = kkn[e] * a0; bb1[e] = kkn[e] * a1; bon += r[e] * (kd0[e] + kd1[e]) * rkw[e]; }
                if (it + 1 < 4 * RH) p2_fetch(nxt, prow, po, no, WU, AU, GU, it + 1, fr, fq);
                if (ct == 3 && h + 1 < RH) {
#pragma unroll
                    for (int c2 = 0; c2 < 4; ++c2) { const int chn = RC + (h + 1) * 64 + 16 * c2 + 4 * fq; kq[c2][0] = *(const u32x2*)(prow + chn); kq[c2][1] = *(const u32x2*)(prow + chn + po); kq[c2][2] = *(const u32x2*)(prow + chn + no); } }
                { u32x2 o; o.x = pk2(r.x, r.y); o.y = pk2(r.z, r.w); *(u32x2*)(shrec + cl * 2) = o; o.x = pk2(v.x, v.y); o.y = pk2(v.z, v.w); *(u32x2*)(shrec + 128 + cl * 2) = o;
                  o.x = pk2(kkn.x, kkn.y); o.y = pk2(kkn.z, kkn.w); *(u32x2*)(shrec + 256 + cl * 2) = o;
                  *(f32x4*)(d0rec + cl * 4) = dec0; o.x = pk2(kd0.x, kd0.y); o.y = pk2(kd0.z, kd0.w); *(u32x2*)(d0rec + 256 + cl * 2) = o; o.x = pk2(bb0.x, bb0.y); o.y = pk2(bb0.z, bb0.w); *(u32x2*)(d0rec + 384 + cl * 2) = o;
                  *(f32x4*)(d1rec + cl * 4) = dec1; o.x = pk2(kd1.x, kd1.y); o.y = pk2(kd1.z, kd1.w); *(u32x2*)(d1rec + 256 + cl * 2) = o; o.x = pk2(bb1.x, bb1.y); o.y = pk2(bb1.z, bb1.w); *(u32x2*)(d1rec + 384 + cl * 2) = o; }
                u32x2 go; go.x = pk2(gg.x, gg.y); go.y = pk2(gg.z, gg.w); *(u32x2*)(G + (size_t)t * RC + ch) = go;
                cur = nxt;
                asm volatile("" ::: "memory");
            }
            bon += __shfl_xor(bon, 16); bon += __shfl_xor(bon, 32);
            if (fq == 0) BON[t * RH + h] = bon;
            if (h + 1 < RH) { p2_wput(lds + P2_WOFF + ((h + 1) & 1) * P2_WBUF, tid, wreg); __syncthreads(); }
        }
    }
}

typedef float f32x2_t __attribute__((ext_vector_type(2))); typedef __bf16 bf16x2_t __attribute__((ext_vector_type(2)));
__device__ __forceinline__ unsigned cvtpk(float lo, float hi) { const f32x2_t v = {lo, hi}; const bf16x2_t b = __builtin_convertvector(v, bf16x2_t); return __builtin_bit_cast(unsigned, b); }
constexpr int SC_TC = 32;
constexpr int SC_W = 0, SC_KK = 256, SC_RP = 384, SC_Z = 512, SC_UB = 640, SC_V = 1152, SC_STEPB = 1280;
constexpr int SC_BUFB = SC_TC * SC_STEPB;
struct ScanProd { const unsigned char* g0; const unsigned char* g1; long gstep0, gstep1; int ldst; int kind; };
__device__ __forceinline__ ScanProd scan_prod_init(const unsigned char* sh, const unsigned char* dr, int dir, int ptid) {
    ScanProd P; const int wi = ptid % 48, st0 = ptid / 48; int shift = 0; bool sh0 = false;
    P.g1 = dr; P.gstep1 = 0;
    if (wi < 16) { P.g0 = dr + wi * 16; P.ldst = SC_W + wi * 16; P.kind = 0; }
    else if (wi < 24) { const int c = wi - 16, ct = c >> 1; P.g0 = dr + 256 + c * 16; P.g1 = dr + 384 + c * 16; P.ldst = SC_UB + (ct >> 1) * 256 + (c & 1) * 128 + (ct & 1) * 8; P.kind = 1; }
    else if (wi < 32) { const int c = wi - 24; P.g0 = sh + 128 + c * 16; P.ldst = SC_V + c * 16; P.kind = 0; sh0 = true; }
    else { const int c = (wi - 32) & 7; const bool isr = wi >= 40; P.g0 = sh + (isr ? 0 : 256) + c * 16; sh0 = true; shift = isr ? 1 : 0; P.kind = 2;
        const int ct = c >> 1, fqb = 2 * (c & 1), pp = 32 * (ct >> 1) + 8 * fqb + (ct & 1) * 4; P.ldst = (isr ? SC_RP : SC_KK) + pp * 2; }
    const long rec0 = sh0 ? 384 : 512;
    const long t0 = dir ? (long)(SEQ - 1 - (st0 - shift)) : (long)(st0 - shift), t1 = dir ? (long)(SEQ - 1 - st0) : (long)st0;
    P.g0 += t0 * rec0; P.gstep0 = dir ? -rec0 : rec0; P.g1 += t1 * 512; P.gstep1 = dir ? -512 : 512; P.ldst += st0 * SC_STEPB; return P;
}
__device__ __forceinline__ void scan_fetch(const ScanProd& P, int c, u32x4 (&reg)[SC_TC / 4], u32x4 (&reg2)[SC_TC / 4]) {
    const unsigned char* a = P.g0 + (long)(c * SC_TC) * P.gstep0; const unsigned char* b = P.g1 + (long)(c * SC_TC) * P.gstep1;
#pragma unroll
    for (int q = 0; q < SC_TC / 4; ++q) { reg[q] = *(const u32x4*)(a + (long)(4 * q) * P.gstep0); reg2[q] = *(const u32x4*)(b + (long)(4 * q) * P.gstep1); }
}
__device__ __forceinline__ void scan_put(const ScanProd& P, LAS unsigned char* buf, const u32x4 (&reg)[SC_TC / 4], const u32x4 (&reg2)[SC_TC / 4]) {
    LAS unsigned char* d = buf + P.ldst;
    if (P.kind == 0) {
#pragma unroll
        for (int q = 0; q < SC_TC / 4; ++q) *(LAS u32x4*)(d + 4 * q * SC_STEPB) = reg[q];
    } else if (P.kind == 1) {
#pragma unroll
        for (int q = 0; q < SC_TC / 4; ++q) { const unsigned kw[4] = {reg[q].x, reg[q].y, reg[q].z, reg[q].w}, bw[4] = {reg2[q].x, reg2[q].y, reg2[q].z, reg2[q].w};
#pragma unroll
            for (int e = 0; e < 4; ++e) { const unsigned k0 = kw[e] & 0xffffu, k1 = kw[e] >> 16, b0 = bw[e] & 0xffffu, b1 = bw[e] >> 16;
                *(LAS u32x2*)(d + 4 * q * SC_STEPB + (2 * e) * 16) = (u32x2){k0 | (b0 << 16), b0};
                *(LAS u32x2*)(d + 4 * q * SC_STEPB + (2 * e + 1) * 16) = (u32x2){k1 | (b1 << 16), b1}; } }
    } else {
#pragma unroll
        for (int q = 0; q < SC_TC / 4; ++q) { *(LAS u32x2*)(d + 4 * q * SC_STEPB) = (u32x2){reg[q].x, reg[q].y}; *(LAS u32x2*)(d + 4 * q * SC_STEPB + 16) = (u32x2){reg[q].z, reg[q].w}; }
    }
}
__device__ __forceinline__ void scan_block(const Params& p, LAS unsigned char* lds, int sid) {
    const int tid = threadIdx.x, lane = tid & 63, wave = tid >> 6;
    const int dir = sid / (BATCH * RH), bh = sid % (BATCH * RH), b = bh / RH, h = bh % RH;
    const unsigned char* sh = p.ws + WS_SSH + (size_t)bh * SEQ * 384;
    const unsigned char* dr = p.ws + WS_SDIR + (size_t)(dir * BATCH * RH + bh) * SEQ * 512;
    float* Y = (float*)((unsigned char*)p.out + DO_Y) + (size_t)dir * T * RC;
    LAS unsigned char* buf0 = lds; LAS unsigned char* buf1 = lds + SC_BUFB;
    constexpr int NCH = SEQ / SC_TC;
    __syncthreads();
    for (int i = tid; i < 2 * SC_TC * 32; i += NTHR) { const int st = i >> 5, e = i & 31; *(LAS unsigned*)(lds + st * SC_STEPB + SC_Z + e * 4) = 0u; }
    const ScanProd SP = scan_prod_init(sh, dr, dir, (tid - 256) & 255);
    const bool prod = wave >= 4 && tid - 256 < 192;
    u32x4 preg[SC_TC / 4], preg2[SC_TC / 4];
    if (prod) { scan_fetch(SP, 0, preg, preg2); scan_put(SP, buf0, preg, preg2); scan_fetch(SP, 1, preg, preg2); }
    constexpr int CPI = 2 * BATCH * RH * 4 * (SEQ / SC_TC) / P0_NMOE;
    static_assert(P0_NMOE * CPI == 2 * BATCH * RH * 4 * (SEQ / SC_TC), "one conversion item per (scan, producer wave, CPI chunks)");
    const int cbase = __builtin_amdgcn_readfirstlane((sid * 4 + (wave - 4)) * (SEQ / SC_TC / CPI));
    const float* wgu = p.in[22]; const float* wdn = p.in[24];
    LAS float* cscr = (LAS float*)(lds + 2 * SC_BUFB + (wave & 3) * 8448);
    __syncthreads();
    const int fr = lane & 15, fq = lane >> 4, sel = (fr & 3) < 2 ? (fr & 3) : 2;
    f32x4 acc[4];
#pragma unroll
    for (int ct = 0; ct < 4; ++ct) acc[ct] = (f32x4){0.f, 0.f, 0.f, 0.f};
    bf16x8 sb0 = (bf16x8){0, 0, 0, 0, 0, 0, 0, 0}, sb1 = sb0;
    float* yrow = Y + (size_t)b * SEQ * RC + h * 64 + 16 * wave + fr;
    float yk = 0.f;
    const int ubo = fq == 0 ? SC_UB + fr * 16 : SC_Z, ubs = fq == 0 ? 256 : 0;
    for (int c = 0; c < NCH; ++c) {
        LAS unsigned char* cur = (c & 1) ? buf1 : buf0; LAS unsigned char* nxt = (c & 1) ? buf0 : buf1;
        if (wave >= 4) {
            if (prod && c + 1 < NCH) { scan_put(SP, nxt, preg, preg2); if (c + 2 < NCH) scan_fetch(SP, c + 2, preg, preg2); }
            if (c % CPI == 0) { float creg[32]; const P0Item Ic = p0_make_moe_item(wgu, wdn, p.ws, cbase + c / CPI); p0_item_load(Ic, creg, lane); p0_item_store(Ic, creg, cscr, lane); }
        } else {
            const LAS unsigned char* ab = cur + SC_KK + 128 * sel + fq * 16;
            const LAS unsigned char* wb = cur + SC_W + fq * 16;
            const LAS unsigned char* ub = cur + ubo;
            const LAS unsigned char* vb = cur + SC_V + (16 * wave + fr) * 2;
            bf16x8 cA0, cA1, nA0, nA1; u32x4 cU[2], nU[2]; f32x4 cW[4], nW[4]; unsigned cV, nV;
#define SC_LOAD(A0, A1, W, U, V, st) do { \
                A0 = *(const LAS bf16x8*)(ab + (st) * SC_STEPB); A1 = *(const LAS bf16x8*)(ab + (st) * SC_STEPB + 64); \
                _Pragma("unroll") for (int ct_ = 0; ct_ < 4; ++ct_) W[ct_] = *(const LAS f32x4*)(wb + (st) * SC_STEPB + ct_ * 64); \
                _Pragma("unroll") for (int cp_ = 0; cp_ < 2; ++cp_) U[cp_] = *(const LAS u32x4*)(ub + (st) * SC_STEPB + cp_ * ubs); \
                V = *(const LAS unsigned short*)(vb + (st) * SC_STEPB); } while (0)
            SC_LOAD(cA0, cA1, cW, cU, cV, 0);
#pragma unroll 1
            for (int g = 0; g < SC_TC / 4; ++g) {
#pragma unroll
                for (int u = 0; u < 4; ++u) {
                    const int st = 4 * g + u;
                    if (st + 1 < SC_TC) SC_LOAD(nA0, nA1, nW, nU, nV, st + 1);
                    f32x4 d = (f32x4){0.f, 0.f, 0.f, 0.f};
                    d = __builtin_amdgcn_mfma_f32_16x16x32_bf16(cA0, sb0, d, 0, 0, 0);
                    d = __builtin_amdgcn_mfma_f32_16x16x32_bf16(cA1, sb1, d, 0, 0, 0);
                    f32x4 cc[4];
#pragma unroll
                    for (int ct = 0; ct < 4; ++ct) cc[ct] = acc[ct] * cW[ct];
                    yk = (((u + 3) & 3) == fq) ? d[1] : yk;
                    if (u == 0) {
                        const int tau = c * SC_TC + 4 * g - 4 + fq;
                        if (tau >= 0) { const int t = dir ? (SEQ - 1 - tau) : tau; yrow[(size_t)t * RC] = yk; } }
                    const float nsa = -d[0];
                    const unsigned t1 = cvtpk(nsa, nsa);
                    const float lo = nsa - __builtin_bit_cast(float, t1 & 0xffff0000u);
                    const unsigned t2 = cvtpk(lo, 0.f);
                    u32x4 bw; bw.x = cV | (t1 << 16); bw.y = t2; bw.z = 0u; bw.w = 0u;
                    const bf16x8 b2 = __builtin_bit_cast(bf16x8, bw);
#pragma unroll
                    for (int ct = 0; ct < 4; ++ct) { u32x4 aw; aw.x = (ct & 1) ? cU[ct >> 1].z : cU[ct >> 1].x; aw.y = (ct & 1) ? cU[ct >> 1].w : cU[ct >> 1].y; aw.z = 0u; aw.w = 0u;
                        acc[ct] = __builtin_amdgcn_mfma_f32_16x16x32_bf16(__builtin_bit_cast(bf16x8, aw), b2, cc[ct], 0, 0, 0); }
                    u32x4 p0, p1;
                    p0.x = cvtpk(acc[0][0], acc[0][1]); p0.y = cvtpk(acc[0][2], acc[0][3]); p0.z = cvtpk(acc[1][0], acc[1][1]); p0.w = cvtpk(acc[1][2], acc[1][3]);
                    p1.x = cvtpk(acc[2][0], acc[2][1]); p1.y = cvtpk(acc[2][2], acc[2][3]); p1.z = cvtpk(acc[3][0], acc[3][1]); p1.w = cvtpk(acc[3][2], acc[3][3]);
                    sb0 = __builtin_bit_cast(bf16x8, p0); sb1 = __builtin_bit_cast(bf16x8, p1);
                    cA0 = nA0; cA1 = nA1; cV = nV;
#pragma unroll
                    for (int i = 0; i < 4; ++i) cW[i] = nW[i];
                    cU[0] = nU[0]; cU[1] = nU[1];
                    asm volatile("" ::: "memory");
                }
            }
#undef SC_LOAD
        }
        __syncthreads();
    }
    if (wave < 4) {
        if (fq < 3) { const int tau = SEQ - 4 + fq, t = dir ? (SEQ - 1 - tau) : tau; yrow[(size_t)t * RC] = yk; }
        const int t = dir ? 0 : (SEQ - 1); const bf16_t* rr = (const bf16_t*)(sh + (size_t)t * 384);
        float accy = 0.f;
#pragma unroll
        for (int j = 0; j < 8; ++j) { accy += bf2f((unsigned)(unsigned short)sb0[j]) * bf2f(rr[16 * (j >> 2) + 4 * fq + (j & 3)]); accy += bf2f((unsigned)(unsigned short)sb1[j]) * bf2f(rr[32 + 16 * (j >> 2) + 4 * fq + (j & 3)]); }
        accy += __shfl_xor(accy, 16); accy += __shfl_xor(accy, 32);
        if (fq == 0) yrow[(size_t)t * RC] = accy;
    }
    __syncthreads();
}

constexpr int AT_P = 72;
constexpr int AT_KOFF = 0, AT_VOFF = 256 * AT_P * 2;
constexpr int ATT_DIL_UNITS = BATCH * AH * 48;
constexpr int ATT_MEM_UNITS = BATCH * MH * 16;
constexpr int ATT_UNITS = ATT_DIL_UNITS + ATT_MEM_UNITS;
struct AttU { const bf16_t* q; const bf16_t* k; const bf16_t* v; long qs, ks; int kind, win0, L, dil; float slope; bf16_t* o; long os; float* lse; long ls; };
__device__ __forceinline__ void att_make_unit(const Params& p, int u, AttU& U) {
    unsigned char* ws = p.ws; const bf16_t* PA = (const bf16_t*)(ws + WS_PA);
    if (u < ATT_DIL_UNITS) {
        const int bh = u / 48, x = u % 48, b = bh / AH, h = bh % AH, br = x >> 4, y = x & 15;
        const int dil = br == 0 ? 1 : (br == 1 ? 4 : 16), L = SEQ / dil, npr = L / 128, r = y / npr, np = y % npr;
        const bf16_t* base = PA + (size_t)(b * SEQ + r) * PA_W + h * 64;
        U.kind = 0; U.win0 = (2 * np - 1) * 64; U.L = L; U.dil = dil; U.slope = exp2f(-8.f * (float)(h + 1) / (float)AH);
        U.qs = (long)dil * PA_W; U.ks = U.qs;
        U.q = base + (long)(np * 128) * U.qs; U.k = base + AW; U.v = base + 2 * AW;
        const size_t tok0 = (size_t)(b * SEQ + r) + (size_t)np * 128 * dil;
        U.o = (bf16_t*)(ws + WS_ATTO) + (size_t)br * T * AW + tok0 * AW + h * 64; U.os = (long)dil * AW;
        U.lse = (float*)((unsigned char*)p.out + DO_LSE) + (size_t)br * T * AH + tok0 * AH + h; U.ls = (long)dil * AH;
    } else {
        const int v = u - ATT_DIL_UNITS, bh = v >> 4, qb = v & 15, b = bh / MH, h = bh % MH;
        const bf16_t* KVM = (const bf16_t*)(ws + WS_KVM);
        U.kind = 1; U.win0 = 0; U.L = NMEM; U.dil = 1; U.slope = 0.f;
        U.q = PA + (size_t)(b * SEQ + qb * 128) * PA_W + 3 * AW + h * 64; U.qs = PA_W;
        U.k = KVM + (size_t)(b * NMEM) * (2 * MW) + h * 64; U.v = U.k + MW; U.ks = 2 * MW;
        U.o = (bf16_t*)(ws + WS_YMIX) + (size_t)(b * SEQ + qb * 128) * D + RC + AW + h * 64; U.os = D;
        U.lse = nullptr; U.ls = 0;
    }
}
__device__ __forceinline__ void att_fetch(const AttU& U, u32x4 (&reg)[8], int tid) {
#pragma unroll
    for (int q = 0; q < 8; ++q) { const int rem = (tid + NTHR * q) & 2047, row = rem >> 3, ch = rem & 7; const int lk = U.win0 + row; const bool ok = lk >= 0 && lk < U.L;
        const bf16_t* src = (q < 4 ? U.k : U.v) + (long)(ok ? lk : 0) * U.ks + ch * 8;
        u32x4 raw = *(const u32x4*)src; if (!ok) raw = (u32x4){0u, 0u, 0u, 0u}; reg[q] = raw; }
}
__device__ __forceinline__ void att_put(LAS unsigned char* lds, const u32x4 (&reg)[8], int tid) {
#pragma unroll
    for (int q = 0; q < 8; ++q) { const int rem = (tid + NTHR * q) & 2047, row = rem >> 3, ch = rem & 7;
        *(LAS u32x4*)(lds + (q < 4 ? AT_KOFF : AT_VOFF) + row * (AT_P * 2) + ch * 16) = reg[q]; }
}
typedef short v4i16_t __attribute__((ext_vector_type(4)));
template <int NT  , bool DIL>
__device__ __forceinline__ void att_compute(const AttU& U, LAS unsigned char* lds, int w, int lane) {
    const int fr = lane & 15, fq = lane >> 4;
    const bf16_t* qp = U.q + (long)(16 * w + fr) * U.qs + fq * 8;
    const bf16x8 q0 = *(const bf16x8*)qp, q1 = *(const bf16x8*)(qp + 32);
    f32x4 sT[NT];
#pragma unroll
    for (int i = 0; i < NT; ++i) {
        if (DIL && i == 9) { sT[i] = (f32x4){-1e30f, -1e30f, -1e30f, -1e30f}; continue; }
        int tt = DIL ? w + i : i; tt = tt > 15 ? 15 : tt;
        const LAS unsigned char* kp = lds + AT_KOFF + (16 * tt + fr) * (AT_P * 2) + fq * 16;
        const bf16x8 k0 = *(const LAS bf16x8*)kp, k1 = *(const LAS bf16x8*)(kp + 64);
        f32x4 a = (f32x4){0.f, 0.f, 0.f, 0.f};
        a = __builtin_amdgcn_mfma_f32_16x16x32_bf16(k0, q0, a, 0, 0, 0);
        a = __builtin_amdgcn_mfma_f32_16x16x32_bf16(k1, q1, a, 0, 0, 0);
        sT[i] = a; if ((i & 3) == 3) asm volatile("" ::: "memory"); }
    float m = -3.0e38f;
    if (DIL) {
        const int c0 = 4 * fq - fr, lb = U.win0 + 16 * w + 4 * fq; const float sd = U.slope * (float)U.dil; const unsigned Lc = (unsigned)U.L;
#pragma unroll
        for (int i = 0; i < NT; ++i) { if (i == 9) continue;
#pragma unroll
            for (int r = 0; r < 4; ++r) { const int dl = 16 * i + r - 64 + c0, ad = dl < 0 ? -dl : dl;
                bool valid = (unsigned)(lb + 16 * i + r) < Lc; if (i == 0 || i >= 7) valid = valid && ad <= 64;
                const float sv = valid ? sT[i][r] - sd * (float)ad : -1e30f; sT[i][r] = sv; m = fmaxf(m, sv); } }
    } else {
#pragma unroll
        for (int i = 0; i < NT; ++i)
#pragma unroll
            for (int r = 0; r < 4; ++r) m = fmaxf(m, sT[i][r]);
    }
    m = fmaxf(m, __shfl_xor(m, 16)); m = fmaxf(m, __shfl_xor(m, 32));
    float l = 0.f;
#pragma unroll
    for (int i = 0; i < NT; ++i)
#pragma unroll
        for (int r = 0; r < 4; ++r) { const float e = __expf(sT[i][r] - m); sT[i][r] = e; l += e; }
    l += __shfl_xor(l, 16); l += __shfl_xor(l, 32);
    f32x4 oT[4];
#pragma unroll
    for (int dt = 0; dt < 4; ++dt) oT[dt] = (f32x4){0.f, 0.f, 0.f, 0.f};
#pragma unroll
    for (int tp = 0; tp < NT / 2; ++tp) {
        int ta = DIL ? w + 2 * tp : 2 * tp, tb = ta + 1; ta = ta > 15 ? 15 : ta; tb = tb > 15 ? 15 : tb;
        u32x4 pw; pw.x = pk2(sT[2 * tp][0], sT[2 * tp][1]); pw.y = pk2(sT[2 * tp][2], sT[2 * tp][3]); pw.z = pk2(sT[2 * tp + 1][0], sT[2 * tp + 1][1]); pw.w = pk2(sT[2 * tp + 1][2], sT[2 * tp + 1][3]);
        const bf16x8 pb = __builtin_bit_cast(bf16x8, pw);
        const LAS unsigned char* va = lds + AT_VOFF + (16 * ta + 4 * fq + (fr >> 2)) * (AT_P * 2) + 8 * (fr & 3);
        const LAS unsigned char* vb = lds + AT_VOFF + (16 * tb + 4 * fq + (fr >> 2)) * (AT_P * 2) + 8 * (fr & 3);
#pragma unroll
        for (int dt = 0; dt < 4; ++dt) {
            const v4i16_t lo = __builtin_amdgcn_ds_read_tr16_b64_v4i16((LAS v4i16_t*)(va + 32 * dt)), hi = __builtin_amdgcn_ds_read_tr16_b64_v4i16((LAS v4i16_t*)(vb + 32 * dt));
            bf16x8 vf; vf[0] = lo[0]; vf[1] = lo[1]; vf[2] = lo[2]; vf[3] = lo[3]; vf[4] = hi[0]; vf[5] = hi[1]; vf[6] = hi[2]; vf[7] = hi[3];
            oT[dt] = __builtin_amdgcn_mfma_f32_16x16x32_bf16(vf, pb, oT[dt], 0, 0, 0); }
        if (tp & 1) asm volatile("" ::: "memory");
    }
    const float inv = 1.f / l;
    bf16_t* op = U.o + (long)(16 * w + fr) * U.os;
#pragma unroll
    for (int dt = 0; dt < 4; ++dt) { u32x2 o; o.x = pk2(oT[dt][0] * inv, oT[dt][1] * inv); o.y = pk2(oT[dt][2] * inv, oT[dt][3] * inv); *(u32x2*)(op + 16 * dt + 4 * fq) = o; }
    if (DIL && fq == 0) U.lse[(long)(16 * w + fr) * U.ls] = m + __logf(l);
}
__device__ __forceinline__ void phase3(const Params& p, LAS unsigned char* lds, int rep) {
    const int tid = threadIdx.x, lane = tid & 63, wave = tid >> 6;
    unsigned* ctl = (unsigned*)(p.ws + WS_CTL);
    LAS unsigned* bc = (LAS unsigned*)(lds + 131072 + 1280);
    for (;;) {
        __syncthreads();
        if (tid == 0) bc[0] = atomicAdd(ctl + CW_SCANQ + 16 * rep, 1u);
        __syncthreads();
        const unsigned sid = __builtin_amdgcn_readfirstlane(bc[0]);
        if (sid >= 2u * BATCH * RH) break;
#pragma unroll 1
        for (int tw = 0; tw < (REPEAT_PHASE == 31 ? 2 : 1); ++tw) scan_block(p, lds, (int)sid);
    }
    constexpr unsigned ATT_BATCH = 2;
    for (;;) {
        __syncthreads();
        if (tid == 0) bc[1] = atomicAdd(ctl + CW_ATTQ + 16 * rep, ATT_BATCH);
        __syncthreads();
        const unsigned ubase = __builtin_amdgcn_readfirstlane(bc[1]);
        if (ubase >= (unsigned)ATT_UNITS) break;
        const unsigned uend = ubase + ATT_BATCH < (unsigned)ATT_UNITS ? ubase + ATT_BATCH : (unsigned)ATT_UNITS;
        { AttU U; att_make_unit(p, (int)ubase, U); u32x4 reg[8]; att_fetch(U, reg, tid); att_put(lds, reg, tid); }
#pragma unroll 1
        for (unsigned ucur = ubase; ucur < uend; ++ucur) {
            __syncthreads();
            u32x4 reg[8];
            if (ucur + 1 < uend) { AttU Un; att_make_unit(p, (int)ucur + 1, Un); att_fetch(Un, reg, tid); }
            { AttU U; att_make_unit(p, (int)ucur, U);
#pragma unroll 1
              for (int tw = 0; tw < (REPEAT_PHASE == 32 ? 2 : 1); ++tw) {
                if (ucur < (unsigned)ATT_DIL_UNITS) att_compute<10, true>(U, lds, wave, lane); else att_compute<16, false>(U, lds, wave, lane); } }
            __syncthreads();
            if (ucur + 1 < uend) att_put(lds, reg, tid);
        }
    }
}

__device__ __forceinline__ void phase4(const Params& p) {
    const int tid = threadIdx.x, lane = tid & 63, wave = tid >> 6;
    const int gw = blockIdx.x * NWAVES + wave, NGW = gridDim.x * NWAVES;
    unsigned char* ws = p.ws; const unsigned char* dob = (const unsigned char*)p.out;
    const float* Yf = (const float*)(dob + DO_Y); const float* Yb = Yf + (size_t)T * RC;
    const bf16_t* G = (const bf16_t*)(dob + DO_G); const float* LSE = (const float*)(dob + DO_LSE);
    const float* BON = (const float*)(ws + WS_BONUS); const float* SSH = (const float*)(ws + WS_SSH);
    const bf16_t* AO = (const bf16_t*)(ws + WS_ATTO); bf16_t* YM = (bf16_t*)(ws + WS_YMIX);
    for (int t = gw; t < T; t += NGW) {
        const int b = t >> 11, s = t & (SEQ - 1);
        float yf[RH], yb[RH], vv[RH], bo[RH]; unsigned short gg[RH], a0[AH], a1[AH], a2[AH]; float l0[AH], l1[AH], l2[AH];
#pragma unroll
        for (int h = 0; h < RH; ++h) { const int ch = h * 64 + lane;
            yf[h] = Yf[(size_t)t * RC + ch]; yb[h] = Yb[(size_t)t * RC + ch]; gg[h] = G[(size_t)t * RC + ch];
            vv[h] = bf2f(((const bf16_t*)SSH)[((size_t)(b * RH + h) * SEQ + s) * 192 + 64 + lane]); bo[h] = BON[t * RH + h];
            a0[h] = AO[(size_t)t * AW + ch]; a1[h] = AO[(size_t)T * AW + (size_t)t * AW + ch]; a2[h] = AO[(size_t)2 * T * AW + (size_t)t * AW + ch];
            l0[h] = LSE[(size_t)t * AH + h]; l1[h] = LSE[(size_t)T * AH + (size_t)t * AH + h]; l2[h] = LSE[(size_t)2 * T * AH + (size_t)t * AH + h]; }
#pragma unroll
        for (int h = 0; h < RH; ++h) { const int ch = h * 64 + lane;
            const float y = yf[h] + yb[h];
            const float mean = wave_sum(y) * (1.f / 64.f); const float dlt = y - mean; const float var = wave_sum(dlt * dlt) * (1.f / 64.f);
            const float yn = dlt * (1.f / sqrtf(var + GN_EPS)) * p.in[14][ch] + p.in[15][ch];
            const float o = (yn + bo[h] * vv[h]) * bf2f(gg[h]);
            YM[(size_t)t * D + ch] = (bf16_t)f2bf(o); }
#pragma unroll
        for (int h = 0; h < AH; ++h) { const int ch = h * 64 + lane;
            const float mx = fmaxf(l0[h], fmaxf(l1[h], l2[h])); const float e0 = __expf(l0[h] - mx), e1 = __expf(l1[h] - mx), e2 = __expf(l2[h] - mx); const float inv = 1.f / (e0 + e1 + e2);
            const float o = (e0 * bf2f(a0[h]) + e1 * bf2f(a1[h]) + e2 * bf2f(a2[h])) * inv;
            YM[(size_t)t * D + RC + ch] = (bf16_t)f2bf(o); }
    }
}

struct PolP5 {
    static constexpr bool PERM = false, GATHER = false;
    const bf16_t* A; const bf16_t* Bt; const bf16_t* H0B; float* PRE; int G, c;
    __device__ __forceinline__ bool next(int i, pg8::Unit& u) const { int pm, pn; if (!pg8::static_order(T / 256, D / 256, G, c, i, pm, pn)) return false;
        u.A = (const char*)(A + (size_t)pm * 256 * D); u.B0 = (const char*)(Bt + (size_t)pn * 256 * D); u.B1 = u.B0 + (size_t)128 * D * 2; u.x0 = pm; u.x1 = pn; u.x2 = 0; u.x3 = 0; u.x4 = 0; return true; }
    __device__ __forceinline__ void epi(const f32x4 (&acc)[2][2][4][2], const pg8::Unit& u, int wr, int wc, int fr, int fq) const {
        const int row0 = u.x0 * 256 + wr * 64 + fr, col0 = u.x1 * 256 + wc * 32 + 4 * fq;
        u32x2 hb[2][4][2][2];
#pragma unroll
        for (int ai = 0; ai < 2; ++ai)
#pragma unroll
            for (int m = 0; m < 4; ++m)
#pragma unroll
                for (int bj = 0; bj < 2; ++bj)
#pragma unroll
                    for (int n = 0; n < 2; ++n) hb[ai][m][bj][n] = *(const u32x2*)(H0B + (size_t)(row0 + ai * 128 + m * 16) * D + col0 + bj * 128 + n * 16);
#pragma unroll
        for (int ai = 0; ai < 2; ++ai)
#pragma unroll
            for (int m = 0; m < 4; ++m) { const size_t ro = (size_t)(row0 + ai * 128 + m * 16) * D + col0;
#pragma unroll
                for (int bj = 0; bj < 2; ++bj)
#pragma unroll
                    for (int n = 0; n < 2; ++n) { const size_t off = ro + bj * 128 + n * 16; const u32x2 h2 = hb[ai][m][bj][n]; const f32x4 v = acc[ai][bj][m][n];
                        f32x4 o; o.x = v.x + ALPHA * bflo(h2.x); o.y = v.y + ALPHA * bfhi(h2.x); o.z = v.z + ALPHA * bflo(h2.y); o.w = v.w + ALPHA * bfhi(h2.y); *(f32x4*)(PRE + off) = o; } }
    }
};
__device__ __forceinline__ void phase5(const Params& p, LAS unsigned char* lds) {
    unsigned char* ws = p.ws;
    PolP5 P{(const bf16_t*)(ws + WS_YMIX), (const bf16_t*)(ws + WS_WT_OUT), (const bf16_t*)(ws + WS_H0B), p.out, (int)gridDim.x, (int)blockIdx.x};
    pg8::gemm_phase(lds, P, D, (PROBE_GEMM == 5 && blockIdx.x == 0) ? (unsigned long long*)(ws + WS_CTL + 32768) : nullptr);
}

constexpr int P6_TP = 1032;
constexpr int P6_TH = 0, P6_TL = 16 * P6_TP * 2, P6_PART = 2 * 16 * P6_TP * 2, P6_LC = P6_PART + 8 * 16 * 32 * 4, P6_BASE = P6_LC + 128, P6_ENT = P6_BASE + 128, P6_MAXENT = 2048;
__device__ __forceinline__ void phase6(const Params& p, LAS unsigned char* lds, int rep) {
    const int tid = threadIdx.x, lane = tid & 63, wave = tid >> 6, fr = lane & 15, fq = lane >> 4;
    unsigned char* ws = p.ws; unsigned* ctl = (unsigned*)(ws + WS_CTL);
    const bf16_t* WRH = (const bf16_t*)(ws + WS_WRT); const bf16_t* WRL = WRH + NE * D;
    LAS bf16_t* TH = (LAS bf16_t*)(lds + P6_TH); LAS bf16_t* TL = (LAS bf16_t*)(lds + P6_TL); LAS float* PART = (LAS float*)(lds + P6_PART);
    LAS int* LC = (LAS int*)(lds + P6_LC); LAS int* BASE = (LAS int*)(lds + P6_BASE); LAS int* ENT = (LAS int*)(lds + P6_ENT);
    int* LIST = (int*)(ws + WS_LIST); float* RG = (float*)(ws + WS_ROWGATE); int* SEL = (int*)(ws + WS_SEL);
    __syncthreads();
    if (tid < NE) LC[tid] = 0;
    __syncthreads();
    int it = 0;
    for (int tile = blockIdx.x; tile < T / 16; tile += gridDim.x, ++it) {
        const int t0 = tile * 16;
#pragma unroll
        for (int q = 0; q < 2; ++q) { const int tt = 2 * wave + q, t = t0 + tt;
            const f32x4* xr = (const f32x4*)(p.out + (size_t)t * D) + lane; f32x4 v[4];
#pragma unroll
            for (int j = 0; j < 4; ++j) v[j] = xr[64 * j];
            ln_row(v, p.in[18], p.in[19], lane);
            bf16_t* orow = (bf16_t*)(ws + WS_H1B) + (size_t)t * D;
#pragma unroll
            for (int j = 0; j < 4; ++j) { const unsigned h0 = f2bf(v[j].x), h1 = f2bf(v[j].y), h2 = f2bf(v[j].z), h3 = f2bf(v[j].w);
                u32x2 hi; hi.x = h0 | (h1 << 16); hi.y = h2 | (h3 << 16);
                u32x2 lo; lo.x = pk2(v[j].x - bf2f(h0), v[j].y - bf2f(h1)); lo.y = pk2(v[j].z - bf2f(h2), v[j].w - bf2f(h3));
                *(u32x2*)(orow + 4 * lane + 256 * j) = hi;
                *(LAS u32x2*)(TH + tt * P6_TP + 4 * lane + 256 * j) = hi; *(LAS u32x2*)(TL + tt * P6_TP + 4 * lane + 256 * j) = lo; } }
        __syncthreads();
        f32x4 acc0 = (f32x4){0.f, 0.f, 0.f, 0.f}, acc1 = acc0;
#pragma unroll
        for (int ks = 0; ks < 4; ++ks) { const int k0 = 128 * wave + 32 * ks + 8 * fq;
            const bf16x8 ah = *(const LAS bf16x8*)(TH + fr * P6_TP + k0), al = *(const LAS bf16x8*)(TL + fr * P6_TP + k0);
            const bf16x8 bh0 = *(const bf16x8*)(WRH + (size_t)fr * D + k0), bl0 = *(const bf16x8*)(WRL + (size_t)fr * D + k0);
            const bf16x8 bh1 = *(const bf16x8*)(WRH + (size_t)(16 + fr) * D + k0), bl1 = *(const bf16x8*)(WRL + (size_t)(16 + fr) * D + k0);
            acc0 = __builtin_amdgcn_mfma_f32_16x16x32_bf16(ah, bh0, acc0, 0, 0, 0); acc0 = __builtin_amdgcn_mfma_f32_16x16x32_bf16(ah, bl0, acc0, 0, 0, 0); acc0 = __builtin_amdgcn_mfma_f32_16x16x32_bf16(al, bh0, acc0, 0, 0, 0);
            acc1 = __builtin_amdgcn_mfma_f32_16x16x32_bf16(ah, bh1, acc1, 0, 0, 0); acc1 = __builtin_amdgcn_mfma_f32_16x16x32_bf16(ah, bl1, acc1, 0, 0, 0); acc1 = __builtin_amdgcn_mfma_f32_16x16x32_bf16(al, bh1, acc1, 0, 0, 0); }
#pragma unroll
        for (int r = 0; r < 4; ++r) { PART[(wave * 16 + 4 * fq + r) * 32 + fr] = acc0[r]; PART[(wave * 16 + 4 * fq + r) * 32 + 16 + fr] = acc1[r]; }
        __syncthreads();
        const int e = lane & 31, tt = 2 * wave + (lane >> 5), t = t0 + tt;
        float logit = p.in[21][e];
#pragma unroll
        for (int v = 0; v < 8; ++v) logit += PART[(v * 16 + tt) * 32 + e];
        float cur = logit; float tv0 = 0.f, tv1 = 0.f, tv2 = 0.f, tv3 = 0.f; int te0 = 0, te1 = 0, te2 = 0, te3 = 0;
#pragma unroll
        for (int k = 0; k < 4; ++k) { float bv = cur; int bi = e;
#pragma unroll
            for (int o = 1; o < 32; o <<= 1) { const float ov = __shfl_xor(bv, o); const int oi = __shfl_xor(bi, o); if (ov > bv || (ov == bv && oi < bi)) { bv = ov; bi = oi; } }
            if (k == 0) { tv0 = bv; te0 = bi; } if (k == 1) { tv1 = bv; te1 = bi; } if (k == 2) { tv2 = bv; te2 = bi; } if (k == 3) { tv3 = bv; te3 = bi; }
            if (e == bi) cur = -3.0e38f; }
        const float e1 = __expf(tv1 - tv0), e2 = __expf(tv2 - tv0), e3 = __expf(tv3 - tv0); const float inv = 1.f / (1.f + e1 + e2 + e3);
        if (e < 4) { int ee = te0; float gg = inv;
            if (e == 1) { ee = te1; gg = e1 * inv; } if (e == 2) { ee = te2; gg = e2 * inv; } if (e == 3) { ee = te3; gg = e3 * inv; }
            const int lr = __hip_atomic_fetch_add((int*)(LC + ee), 1, __ATOMIC_RELAXED, __HIP_MEMORY_SCOPE_WORKGROUP); const int n = (it * 16 + tt) * 4 + e;
            if (n < P6_MAXENT) { ENT[4 * n] = t * 4 + e; ENT[4 * n + 1] = ee; ENT[4 * n + 2] = lr; ENT[4 * n + 3] = __builtin_bit_cast(int, gg); } }
    }
    __syncthreads();
    if (tid < NE) BASE[tid] = (int)atomicAdd(ctl + CW_CNT + 32 * rep + tid, (unsigned)LC[tid]);
    __syncthreads();
    const int nent = it * 64 < P6_MAXENT ? it * 64 : P6_MAXENT;
    for (int n = tid; n < nent; n += NTHR) { const int tk = ENT[4 * n], ee = ENT[4 * n + 1], rank = BASE[ee] + ENT[4 * n + 2];
        LIST[(size_t)ee * T + rank] = tk >> 2; RG[(size_t)ee * T + rank] = __builtin_bit_cast(float, ENT[4 * n + 3]); SEL[(size_t)tk * 2] = ee; SEL[(size_t)tk * 2 + 1] = rank; }
}

__device__ __forceinline__ void build_expert_tables(const Params& p, LAS int* tab) {
    const unsigned* ctl = (const unsigned*)(p.ws + WS_CTL);
    __syncthreads();
    if (threadIdx.x < NE) tab[threadIdx.x] = (int)__hip_atomic_load(ctl + CW_CNT + CNT_SET + threadIdx.x, __ATOMIC_RELAXED, __HIP_MEMORY_SCOPE_AGENT);
    __syncthreads();
    if (threadIdx.x == 0) { int ps = 0, ts = 0;
        for (int e = 0; e < NE; ++e) { const int c = tab[e]; tab[32 + e] = ps; tab[64 + e] = ts; ps += (c + 255) / 256 * 256; ts += (c + 127) / 128; }
        tab[64 + NE] = ts; }
    __syncthreads();
}

constexpr int TAB_OFF = 131072, UTAB_OFF = 100, UTAB_MAX = 48;
constexpr int IDX_OFF = 131072 + 2048, IDX_UNITS = 20;
__device__ __forceinline__ void build_expert_tables256(const Params& p, LAS int* tab, int npn  ) {
    const unsigned* ctl = (const unsigned*)(p.ws + WS_CTL);
    __syncthreads();
    if (threadIdx.x < NE) tab[threadIdx.x] = (int)__hip_atomic_load(ctl + CW_CNT + CNT_SET + threadIdx.x, __ATOMIC_RELAXED, __HIP_MEMORY_SCOPE_AGENT);
    __syncthreads();
    if (threadIdx.x == 0) { int ps = 0, ts = 0;
        for (int e = 0; e < NE; ++e) { const int c = tab[e]; tab[32 + e] = ps; tab[64 + e] = ts; ps += (c + 255) / 256 * 256; ts += (c + 255) / 256; }
        tab[64 + NE] = ts;
        int e = 0, n = 0;
        if (gridDim.x == 256) { const int g = blockIdx.x & 7, sl = blockIdx.x >> 3, mpx = 32 / npn  , mround = 8 * mpx;
            for (int i = 0; n < UTAB_MAX; ++i) { const int mt_g = i * mround + g * mpx + sl / npn, pn = sl % npn; if (i * mround >= ts) break; if (mt_g >= ts) continue;
                while (e + 1 < NE && mt_g >= tab[64 + e + 1]) ++e;
                const int r0 = (mt_g - tab[64 + e]) * 256;
                tab[UTAB_OFF + 4 * n] = e; tab[UTAB_OFF + 4 * n + 1] = r0; tab[UTAB_OFF + 4 * n + 2] = pn; tab[UTAB_OFF + 4 * n + 3] = tab[32 + e] + r0; ++n; }
        } else { const int nun = ts * npn;
        for (int L = blockIdx.x; L < nun && n < UTAB_MAX; L += gridDim.x, ++n) { const int pn = L % npn, mt_g = L / npn;
            while (e + 1 < NE && mt_g >= tab[64 + e + 1]) ++e;
            const int r0 = (mt_g - tab[64 + e]) * 256;
            tab[UTAB_OFF + 4 * n] = e; tab[UTAB_OFF + 4 * n + 1] = r0; tab[UTAB_OFF + 4 * n + 2] = pn; tab[UTAB_OFF + 4 * n + 3] = tab[32 + e] + r0; } }
        tab[98] = n; }
    __syncthreads();
}
struct PolP7 {
    static constexpr bool PERM = true, GATHER = true;
    const bf16_t* H1B; const bf16_t* WG; const LAS int* IDX; bf16_t* ACT; const float* BGU; const LAS int* tab; int G, c;
    __device__ __forceinline__ bool next(int i, pg8::Unit& u) const { if (i >= __builtin_amdgcn_readfirstlane(tab[98])) return false;
        const int e = __builtin_amdgcn_readfirstlane(tab[UTAB_OFF + 4 * i]), r0 = __builtin_amdgcn_readfirstlane(tab[UTAB_OFF + 4 * i + 1]), pn = __builtin_amdgcn_readfirstlane(tab[UTAB_OFF + 4 * i + 2]);
        u.A = (const char*)H1B; u.B0 = (const char*)(WG + ((size_t)e * 2 * FF + pn * 128) * D); u.B1 = u.B0 + (size_t)FF * D * 2;
        u.x0 = e; u.x1 = i; u.x2 = pn; u.x3 = __builtin_amdgcn_readfirstlane(tab[UTAB_OFF + 4 * i + 3]); u.x4 = __builtin_amdgcn_readfirstlane(tab[e]) - r0; return true; }
    __device__ __forceinline__ void rows_issue(const pg8::Unit& u, int R0, unsigned (&raw)[2][2]) const { const LAS int* lst = IDX + u.x1 * 256 + R0;
#pragma unroll
        for (int h = 0; h < 2; ++h)
#pragma unroll
            for (int i = 0; i < 2; ++i) raw[h][i] = (unsigned)lst[h * 128 + i * 64]; }
    __device__ __forceinline__ void rows_finish(int C0, int K, unsigned (&raw)[2][2]) const {
#pragma unroll
        for (int h = 0; h < 2; ++h)
#pragma unroll
            for (int i = 0; i < 2; ++i) raw[h][i] = (raw[h][i] * (unsigned)K + (unsigned)C0) * 2u; }
    __device__ __forceinline__ void epi(const f32x4 (&acc)[2][2][4][2], const pg8::Unit& u, int wr, int wc, int fr, int fq) const {
        const int e = u.x0, f0 = u.x2 * 128 + wc * 32 + 8 * fq;
        const float* bias = BGU + (size_t)e * 2 * FF + f0;
        const f32x4 bg0 = *(const f32x4*)bias, bg1 = *(const f32x4*)(bias + 4), bu0 = *(const f32x4*)(bias + FF), bu1 = *(const f32x4*)(bias + FF + 4);
#pragma unroll
        for (int ai = 0; ai < 2; ++ai)
#pragma unroll
            for (int m = 0; m < 4; ++m) { const int r = ai * 128 + wr * 64 + m * 16 + fr;
                const f32x4 g0 = acc[ai][0][m][0] + bg0, g1 = acc[ai][0][m][1] + bg1, u0 = acc[ai][1][m][0] + bu0, u1 = acc[ai][1][m][1] + bu1;
                float a[8];
#pragma unroll
                for (int j = 0; j < 4; ++j) {
                    const float gc = fminf(g0[j], 7.f), uc = __builtin_amdgcn_fmed3f(u0[j], -7.f, 7.f);
                    a[j] = __builtin_fmaf(uc, gc, gc) * __builtin_amdgcn_rcpf(1.f + __builtin_amdgcn_exp2f(-2.4554669595930157f * gc));
                    const float gd = fminf(g1[j], 7.f), ud = __builtin_amdgcn_fmed3f(u1[j], -7.f, 7.f);
                    a[4 + j] = __builtin_fmaf(ud, gd, gd) * __builtin_amdgcn_rcpf(1.f + __builtin_amdgcn_exp2f(-2.4554669595930157f * gd)); }
                { u32x4 w; w.x = pg8::cvt_pk_bf16(a[0], a[1]); w.y = pg8::cvt_pk_bf16(a[2], a[3]); w.z = pg8::cvt_pk_bf16(a[4], a[5]); w.w = pg8::cvt_pk_bf16(a[6], a[7]);
                    *(u32x4*)(ACT + (size_t)(u.x3 + r) * FF + f0) = w; } }
    }
};
__device__ __forceinline__ void phase7(const Params& p, LAS unsigned char* lds) {
    LAS int* tab = (LAS int*)(lds + TAB_OFF); build_expert_tables256(p, tab, 8);
    unsigned char* ws = p.ws;
    LAS int* IDX = (LAS int*)(lds + IDX_OFF);
    { const int* LIST = (const int*)(ws + WS_LIST); const int nun = tab[98] < IDX_UNITS ? tab[98] : IDX_UNITS;
      for (int j = threadIdx.x; j < nun * 256; j += NTHR) { const int n = j >> 8, i = j & 255, e = tab[UTAB_OFF + 4 * n], r0 = tab[UTAB_OFF + 4 * n + 1], nval = tab[e] - r0;
          IDX[j] = LIST[(size_t)e * T + r0 + (i < nval ? i : 0)]; }
      __syncthreads(); }
    PolP7 P{(const bf16_t*)(ws + WS_H1B), (const bf16_t*)(ws + WS_WT_GU), IDX, (bf16_t*)(ws + WS_ACT), p.in[23], tab, (int)gridDim.x, (int)blockIdx.x};
    pg8::gemm_phase(lds, P, D, (PROBE_GEMM == 7 && blockIdx.x == 0) ? (unsigned long long*)(ws + WS_CTL + 32768) : nullptr);
}

struct PolP8 {
    static constexpr bool PERM = true, GATHER = false;
    const bf16_t* ACT; const bf16_t* WD; const float* RG; bf16_t* YR; const float* BD; const LAS int* tab; int G, c;
    __device__ __forceinline__ bool next(int i, pg8::Unit& u) const { if (i >= __builtin_amdgcn_readfirstlane(tab[98])) return false;
        const int e = __builtin_amdgcn_readfirstlane(tab[UTAB_OFF + 4 * i]), r0 = __builtin_amdgcn_readfirstlane(tab[UTAB_OFF + 4 * i + 1]), pn = __builtin_amdgcn_readfirstlane(tab[UTAB_OFF + 4 * i + 2]), prow0 = __builtin_amdgcn_readfirstlane(tab[UTAB_OFF + 4 * i + 3]);
        u.A = (const char*)(ACT + (size_t)prow0 * FF); u.B0 = (const char*)(WD + ((size_t)e * D + pn * 256) * FF); u.B1 = u.B0 + (size_t)128 * FF * 2;
        u.x4 = __builtin_amdgcn_readfirstlane(tab[e]) - r0;
        u.x0 = e; u.x1 = r0; u.x2 = pn; u.x3 = prow0; return true; }
    __device__ __forceinline__ void epi(const f32x4 (&acc)[2][2][4][2], const pg8::Unit& u, int wr, int wc, int fr, int fq) const {
        const int e = u.x0, nval = u.x4; const float* rg = RG + (size_t)e * T + u.x1;
        float gt[2][4];
#pragma unroll
        for (int ai = 0; ai < 2; ++ai)
#pragma unroll
            for (int m = 0; m < 4; ++m) { const int r = ai * 128 + wr * 64 + m * 16 + fr; gt[ai][m] = rg[r < nval ? r : 0]; }
        f32x4 bs[2][2];
#pragma unroll
        for (int bj = 0; bj < 2; ++bj) { const float* bias = BD + (size_t)e * D + u.x2 * 256 + bj * 128 + wc * 32 + 8 * fq; bs[bj][0] = *(const f32x4*)bias; bs[bj][1] = *(const f32x4*)(bias + 4); }
#pragma unroll
        for (int ai = 0; ai < 2; ++ai)
#pragma unroll
            for (int m = 0; m < 4; ++m) { const int r = ai * 128 + wr * 64 + m * 16 + fr; const float g = gt[ai][m];
#pragma unroll
                for (int bj = 0; bj < 2; ++bj) { const int col = u.x2 * 256 + bj * 128 + wc * 32 + 8 * fq;
                    const f32x4 v0 = (acc[ai][bj][m][0] + bs[bj][0]) * g, v1 = (acc[ai][bj][m][1] + bs[bj][1]) * g;
                    u32x4 w; w.x = pg8::cvt_pk_bf16(v0[0], v0[1]); w.y = pg8::cvt_pk_bf16(v0[2], v0[3]); w.z = pg8::cvt_pk_bf16(v1[0], v1[1]); w.w = pg8::cvt_pk_bf16(v1[2], v1[3]);
                    *(u32x4*)(YR + (size_t)(u.x3 + r) * D + col) = w; } }
    }
};
__device__ __forceinline__ void phase8(const Params& p, LAS unsigned char* lds) {
    LAS int* tab = (LAS int*)(lds + TAB_OFF); build_expert_tables256(p, tab, 4);
    unsigned char* ws = p.ws;
    PolP8 P{(const bf16_t*)(ws + WS_ACT), (const bf16_t*)(ws + WS_WT_DN), (const float*)(ws + WS_ROWGATE), (bf16_t*)(ws + WS_YROWS), p.in[25], tab, (int)gridDim.x, (int)blockIdx.x};
    pg8::gemm_phase(lds, P, FF, (PROBE_GEMM == 8 && blockIdx.x == 0) ? (unsigned long long*)(ws + WS_CTL + 32768) : nullptr);
}

__device__ __forceinline__ void phase9(const Params& p, LAS unsigned char* lds) {
    LAS int* tab = (LAS int*)lds; build_expert_tables(p, tab);
    const int tid = threadIdx.x, lane = tid & 63, wave = tid >> 6;
    const int gw = blockIdx.x * NWAVES + wave, NGW = gridDim.x * NWAVES;
    unsigned char* ws = p.ws; const bf16_t* H1B = (const bf16_t*)(ws + WS_H1B); const bf16_t* YR = (const bf16_t*)(ws + WS_YROWS); const int* SEL = (const int*)(ws + WS_SEL);
    typedef int i32x4 __attribute__((ext_vector_type(4)));
    i32x4 sa = {0, 0, 0, 0}, sb = sa;
    if (gw < T) { sa = *(const i32x4*)(SEL + (size_t)gw * 8); sb = *(const i32x4*)(SEL + (size_t)gw * 8 + 4); }
    for (int t = gw; t < T; t += NGW) {
        const i32x4 ca = sa, cb = sb;
        if (t + NGW < T) { sa = *(const i32x4*)(SEL + (size_t)(t + NGW) * 8); sb = *(const i32x4*)(SEL + (size_t)(t + NGW) * 8 + 4); }
        const bf16_t* y0 = YR + (size_t)(tab[32 + ca.x] + ca.y) * D + 4 * lane; const bf16_t* y1 = YR + (size_t)(tab[32 + ca.z] + ca.w) * D + 4 * lane;
        const bf16_t* y2 = YR + (size_t)(tab[32 + cb.x] + cb.y) * D + 4 * lane; const bf16_t* y3 = YR + (size_t)(tab[32 + cb.z] + cb.w) * D + 4 * lane;
        const bf16_t* hr = H1B + (size_t)t * D + 4 * lane;
        u32x2 hb[4], q0[4], q1[4], q2[4], q3[4];
#pragma unroll
        for (int j = 0; j < 4; ++j) { hb[j] = *(const u32x2*)(hr + 256 * j); q0[j] = *(const u32x2*)(y0 + 256 * j); q1[j] = *(const u32x2*)(y1 + 256 * j); q2[j] = *(const u32x2*)(y2 + 256 * j); q3[j] = *(const u32x2*)(y3 + 256 * j); }
        f32x4 v[4];
#pragma unroll
        for (int j = 0; j < 4; ++j) {
            v[j].x = ALPHA * bflo(hb[j].x) + ((bflo(q0[j].x) + bflo(q1[j].x)) + (bflo(q2[j].x) + bflo(q3[j].x)));
            v[j].y = ALPHA * bfhi(hb[j].x) + ((bfhi(q0[j].x) + bfhi(q1[j].x)) + (bfhi(q2[j].x) + bfhi(q3[j].x)));
            v[j].z = ALPHA * bflo(hb[j].y) + ((bflo(q0[j].y) + bflo(q1[j].y)) + (bflo(q2[j].y) + bflo(q3[j].y)));
            v[j].w = ALPHA * bfhi(hb[j].y) + ((bfhi(q0[j].y) + bfhi(q1[j].y)) + (bfhi(q2[j].y) + bfhi(q3[j].y))); }
        ln_row(v, p.in[26], p.in[27], lane);
        f32x4* orow = (f32x4*)(p.out + (size_t)t * D) + lane;
#pragma unroll
        for (int j = 0; j < 4; ++j) orow[64 * j] = v[j];
    }
}

#define XB_TMO      128
#define XB_XCNT(j)  (256  + 64 * (j))
#define XB_XSUB(j)  (1280 + 64 * (j))
#define XB_XGEN(j)  (2304 + 64 * (j))
#define XB_TOP      3328
#define XB_TOPGEN   3392
#define XCD_BAR_WORDS 3456
#define XB_SPIN_CAP (1u << 22)
__device__ __forceinline__ unsigned xb_ld(unsigned* p)              { return __hip_atomic_load(p, __ATOMIC_RELAXED, __HIP_MEMORY_SCOPE_AGENT); }
__device__ __forceinline__ unsigned xb_add(unsigned* p, unsigned v) { return __hip_atomic_fetch_add(p, v, __ATOMIC_RELAXED, __HIP_MEMORY_SCOPE_AGENT); }
__device__ __forceinline__ unsigned xb_xcc_id() { return (unsigned)__builtin_amdgcn_s_getreg((3 << 11) | 20) & 0xFu; }
#define XB_SPIN(cond, bar) do { unsigned _sp = 0; while (cond) { __builtin_amdgcn_s_sleep(1); \
    if ((++_sp & 255u) == 0u) { if (xb_ld(&(bar)[XB_TMO])) break; if (_sp > XB_SPIN_CAP) { atomicAdd(&(bar)[XB_TMO], 1u); break; } } } } while (0)
struct XcdBarrier { unsigned* bar; unsigned x; volatile LAS unsigned* st; };
__device__ __forceinline__ XcdBarrier xcd_barrier_post(unsigned* bar, volatile LAS unsigned* st) {
    XcdBarrier b; b.bar = bar; b.x = xb_xcc_id(); b.st = st;
    if (threadIdx.x == 0) (void)xb_add(&bar[XB_XCNT(b.x)], 1u);
    return b;
}
__device__ __forceinline__ void xcd_barrier_complete(unsigned* bar, unsigned x, unsigned& nloc, unsigned& nx) {
    const unsigned G = gridDim.x * gridDim.y * gridDim.z;
    unsigned sum, cnt, mine, sp = 0u;
    for (;;) {
        sum = 0u; cnt = 0u; mine = 0u;
#pragma unroll
        for (unsigned j = 0; j < 16; ++j) { const unsigned c = xb_ld(&bar[XB_XCNT(j)]); sum += c; cnt += (c > 0u) ? 1u : 0u; mine = (j == x) ? c : mine; }
        if (sum == G) break;
        __builtin_amdgcn_s_sleep(1);
        if ((++sp & 255u) == 0u) { if (xb_ld(&bar[XB_TMO])) break; if (sp > XB_SPIN_CAP) { atomicAdd(&bar[XB_TMO], 1u); break; } }
    }
    nloc = mine > 0u ? mine : 1u; nx = cnt > 0u ? cnt : 1u;
}
__device__ __forceinline__ void xcd_barrier(const XcdBarrier& b) {
    asm volatile("s_waitcnt vmcnt(0)" ::: "memory");
    __syncthreads();
    if (threadIdx.x == 0) {
        unsigned* bar = b.bar;
        __builtin_amdgcn_s_waitcnt(0);
        unsigned nloc = b.st[0], nx = b.st[1];
        if (nloc == 0u) { xcd_barrier_complete(bar, b.x, nloc, nx); b.st[0] = nloc; b.st[1] = nx; }
        const unsigned old = xb_add(&bar[XB_XSUB(b.x)], 1u);
        const unsigned gen = old / nloc;
        if (old + 1u == (gen + 1u) * nloc) {
            __builtin_amdgcn_fence(__ATOMIC_RELEASE, "agent");
            asm volatile("s_waitcnt vmcnt(0)" ::: "memory");
            const unsigned og = xb_add(&bar[XB_TOP], 1u);
            const unsigned tg = og / nx;
            if (og + 1u == (tg + 1u) * nx) xb_add(&bar[XB_TOPGEN], 1u);
            else XB_SPIN(xb_ld(&bar[XB_TOPGEN]) == tg, bar);
            __builtin_amdgcn_fence(__ATOMIC_ACQUIRE, "agent");
            xb_add(&bar[XB_XGEN(b.x)], 1u);
            asm volatile("s_waitcnt vmcnt(0)" ::: "memory");
        } else {
            XB_SPIN(xb_ld(&bar[XB_XGEN(b.x)]) == gen, bar);
            __builtin_amdgcn_fence(__ATOMIC_ACQUIRE, "agent");
            asm volatile("s_waitcnt vmcnt(0)" ::: "memory");
        }
    }
    __syncthreads();
}

constexpr int NPHASE = 10;
constexpr int LDS_BYTES = 131072 + 2048 + IDX_UNITS * 1024;
__global__ void __launch_bounds__(NTHR, 2) mk_fwd(Params p) {
    extern __shared__ __attribute__((aligned(16))) unsigned char lds_raw[];
    LAS unsigned char* lds = (LAS unsigned char*)lds_raw;
    const int lo = p.ph_lo, hi = p.ph_hi;
    volatile LAS unsigned* barst = (volatile LAS unsigned*)(lds + BARST_OFF);
    if (threadIdx.x < 2) barst[threadIdx.x] = 0u;
    __syncthreads();
    XcdBarrier xbar; xbar.bar = (unsigned*)(p.ws + WS_CTL) + CW_BAR; xbar.x = xb_xcc_id(); xbar.st = barst;
    if (MK_ONE_LAUNCH && blockIdx.x == 0 && lo == 0) { u32x4* z = (u32x4*)(p.ws + WS_CTL); for (int i = threadIdx.x; i < CTL_ZERO_BYTES / 16; i += NTHR) z[i] = (u32x4){0u, 0u, 0u, 0u}; }
#ifdef ONLY_PHASE
#define IN(k) ((k) == ONLY_PHASE && lo <= (k) && (k) < hi)
#else
#define IN(k) (lo <= (k) && (k) < hi)
#endif
#define SEAM(k) do { if (IN(k) && IN((k) + 1)) { if ((k) == 0) { cg::this_grid().sync(); if (threadIdx.x == 0) (void)xb_add(&xbar.bar[XB_XCNT(xbar.x)], 1u); } else xcd_barrier(xbar); } if (PROBE_TS == (k)) ts1 = __builtin_amdgcn_s_memrealtime(); } while (0)
#define RUN(k, call) do { if (IN(k)) { if (PROBE_TS == (k)) ts0 = __builtin_amdgcn_s_memrealtime(); call; if (REPEAT_PHASE == (k)) { cg::this_grid().sync(); call; } } } while (0)
    unsigned long long ts0 = 0, ts1 = 0;
    { int rep = 0;
    RUN(0, phase0(p, lds));
    SEAM(0);
    RUN(1, phase1(p, lds));
    SEAM(1);
    RUN(2, phase2(p, lds));
    SEAM(2);
    if (IN(3)) { const int nrep = (REPEAT_PHASE == 3) ? 2 : 1; if (PROBE_TS == 3) ts0 = __builtin_amdgcn_s_memrealtime();
#pragma unroll 1
        for (rep = 0; rep < nrep; ++rep) { if (rep) cg::this_grid().sync(); phase3(p, lds, rep); } }
    SEAM(3);
    RUN(4, phase4(p));
    SEAM(4);
    RUN(5, phase5(p, lds));
    SEAM(5);
    rep = 0; RUN(6, (phase6(p, lds, rep), ++rep));
    SEAM(6);
    RUN(7, phase7(p, lds));
    SEAM(7);
    RUN(8, phase8(p, lds));
    SEAM(8);
    RUN(9, phase9(p, lds));
    if (PROBE_TS == 9) ts1 = __builtin_amdgcn_s_memrealtime();
    if (PROBE_GEMM >= 0 && blockIdx.x == 0) { __syncthreads(); if (threadIdx.x == 0) p.out[0] += (float)(((const unsigned long long*)(p.ws + WS_CTL + 32768))[PROBE_PART]) * 1e-4f; }
    if (PROBE_TS >= 0 && blockIdx.x == 0 && threadIdx.x == 0) p.out[0] += (float)(ts1 - ts0) * 1e-4f;
    }
#undef RUN
#undef IN
#undef SEAM
}

extern "C" void kernel_launch(void* const* d_in, const int* in_sizes, int n_in, void* d_out, int out_size, void* d_ws, size_t ws_size, hipStream_t stream) {
    static int grid = 0;
    if (grid == 0) {
        if (n_in != 28 || out_size != T * D || ws_size < WS_END) { fprintf(stderr, "kernel_launch: unexpected shapes: n_in %d out %d ws %zu (need %zu)\n", n_in, out_size, ws_size, (size_t)WS_END); grid = -1; return; }
        int dev = 0, cus = 0, per_cu = 0;
        hipGetDevice(&dev); hipDeviceGetAttribute(&cus, hipDeviceAttributeMultiprocessorCount, dev);
        hipFuncSetAttribute((const void*)mk_fwd, hipFuncAttributeMaxDynamicSharedMemorySize, LDS_BYTES);
        hipOccupancyMaxActiveBlocksPerMultiprocessor(&per_cu, (const void*)mk_fwd, NTHR, LDS_BYTES);
        (void)hipGetLastError();
        if (per_cu < 1) { fprintf(stderr, "kernel_launch: occupancy query says %d blocks per CU\n", per_cu); per_cu = 1; }
        grid = cus;
    }
    if (grid < 0) return;
#if !MK_ONE_LAUNCH
    hipMemsetAsync((char*)d_ws + WS_CTL, 0, CTL_ZERO_BYTES, stream);
#endif
    Params p{};
    for (int i = 0; i < 28; ++i) p.in[i] = (const float*)d_in[i];
    p.out = (float*)d_out; p.ws = (unsigned char*)d_ws;
#if MK_ONE_LAUNCH
    p.ph_lo = 0; p.ph_hi = NPHASE;
    void* args[] = {&p};
    hipError_t e = hipLaunchCooperativeKernel((const void*)mk_fwd, dim3(grid), dim3(NTHR), args, LDS_BYTES, stream);
    if (e != hipSuccess) fprintf(stderr, "cooperative launch failed: %s (grid %d)\n", hipGetErrorString(e), grid);
#else
    for (int ph = 0; ph < NPHASE; ++ph) { p.ph_lo = ph; p.ph_hi = ph + 1; hipLaunchKernelGGL(mk_fwd, dim3(grid), dim3(NTHR), LDS_BYTES, stream, p); }
#endif
}
```

```cpp
#include <hip/hip_runtime.h>
#include <hip/hip_cooperative_groups.h>
#include <cstdio>
#include <cstdint>
namespace cg = cooperative_groups;

#ifndef REPEAT_PHASE
#define REPEAT_PHASE -1
#endif
#ifndef PROBE_TS
#define PROBE_TS -1
#endif
#ifndef PROBE_GEMM
#define PROBE_GEMM -1
#endif
#ifndef PROBE_PART
#define PROBE_PART 0
#endif
#ifndef MK_ONE_LAUNCH
#define MK_ONE_LAUNCH 1
#endif

typedef unsigned short bf16_t;
typedef short bf16x8 __attribute__((ext_vector_type(8)));
typedef short bf16x4 __attribute__((ext_vector_type(4)));
typedef float f32x4 __attribute__((ext_vector_type(4)));
typedef float f32x2 __attribute__((ext_vector_type(2)));
typedef unsigned u32x4 __attribute__((ext_vector_type(4)));
typedef unsigned u32x2 __attribute__((ext_vector_type(2)));

constexpr int D = 1024, BATCH = 16, SEQ = 2048, T = BATCH * SEQ;
constexpr int NMEM = 256, HD = 64;
constexpr int RH = 6, RC = 384;
constexpr int RWKV_IN = 1344;
constexpr int AH = 6, AW = 384, MH = 4, MW = 256;
constexpr int IN_W = 2752, IN_WP = 2816;
constexpr int PA_W = IN_WP - RWKV_IN;
constexpr int NE = 32, TOPK = 4, FF = 1024;
constexpr float LN_EPS = 1e-5f, GN_EPS = 64e-5f;
constexpr float ALPHA = 1.189207115002721f;
constexpr int NTHR = 512, NWAVES = 8;

constexpr size_t MiB = 1u << 20;
constexpr size_t WS_CTL = 0;
constexpr size_t WS_WT_IN = 1 * MiB;
constexpr size_t WS_LORA = 6 * MiB + 512 * 1024;
constexpr size_t WS_WT_OUT = 7 * MiB;
constexpr size_t WS_WT_KV = 9 * MiB;
constexpr size_t WS_KVM = 10 * MiB;
constexpr size_t WS_MEMB = 14 * MiB;
constexpr size_t WS_LIST = 22 * MiB;
constexpr size_t WS_ROWGATE = 26 * MiB;
constexpr size_t WS_SEL = 30 * MiB;
constexpr size_t WS_BONUS = 31 * MiB;
constexpr size_t WS_WRT = 31 * MiB + 800 * 1024;
constexpr size_t WS_WT_GU = 32 * MiB;
constexpr size_t WS_WT_DN = 160 * MiB;
constexpr size_t WS_H0B = 224 * MiB;
constexpr size_t WS_H1B = 288 * MiB;
constexpr size_t WS_YMIX = 352 * MiB;
constexpr size_t WS_PR = 416 * MiB;
constexpr size_t WS_ATTO = 416 * MiB;
constexpr size_t WS_PA = 500 * MiB;
constexpr size_t WS_SSH = 592 * MiB;
constexpr size_t WS_SDIR = 736 * MiB;
constexpr size_t WS_ACT = 352 * MiB;
constexpr size_t WS_YROWS = 624 * MiB;
constexpr size_t WS_END = 1024 * MiB;
constexpr size_t DO_Y = 0, DO_G = 96 * MiB, DO_LSE = 120 * MiB;
constexpr int ROWS_PAD = T * TOPK + NE * 256;

constexpr int CW_CNT = 0;
constexpr int CNT_SET = (REPEAT_PHASE == 6) ? 32 : 0;
constexpr int CW_ATTQ = 64;
constexpr int CW_SCANQ = 128;
constexpr int CW_BAR = 4096;
constexpr int CTL_ZERO_BYTES = 65536;
constexpr int BARST_OFF = 131072 + 1536;

#define LAS __attribute__((address_space(3)))

struct Params { const float* in[28]; float* out; unsigned char* ws; int ph_lo, ph_hi; };

__device__ __forceinline__ unsigned f2bf(float f) { unsigned u = __builtin_bit_cast(unsigned, f); return (u + 0x7fffu + ((u >> 16) & 1u)) >> 16; }
__device__ __forceinline__ unsigned pk2(float lo, float hi) { return f2bf(lo) | (f2bf(hi) << 16); }
__device__ __forceinline__ float bf2f(unsigned b) { return __builtin_bit_cast(float, b << 16); }
__device__ __forceinline__ float bflo(unsigned w) { return __builtin_bit_cast(float, w << 16); }
__device__ __forceinline__ float bfhi(unsigned w) { return __builtin_bit_cast(float, w & 0xffff0000u); }
template <int CTRL> __device__ __forceinline__ float dpp_mov(float v) {
    return __builtin_bit_cast(float, __builtin_amdgcn_update_dpp(0, __builtin_bit_cast(int, v), CTRL, 0xF, 0xF, true));
}
__device__ __forceinline__ float sum16(float v) {
    v += dpp_mov<0xB1>(v);
    v += dpp_mov<0x4E>(v);
    v += dpp_mov<0x141>(v);
    v += dpp_mov<0x140>(v);
    return v;
}
__device__ __forceinline__ float wave_sum(float v) {
    v = sum16(v);
    const int iv = __builtin_bit_cast(int, v);
    const float a = __builtin_bit_cast(float, __builtin_amdgcn_readlane(iv, 0)), b = __builtin_bit_cast(float, __builtin_amdgcn_readlane(iv, 16));
    const float c = __builtin_bit_cast(float, __builtin_amdgcn_readlane(iv, 32)), d = __builtin_bit_cast(float, __builtin_amdgcn_readlane(iv, 48));
    return (a + b) + (c + d);
}
__device__ __forceinline__ float sigmoidf_(float x) { return 1.f / (1.f + __expf(-x)); }

struct P0Item { const float* W; bf16_t* WT; int K, N, item; };
__device__ __forceinline__ void p0_item_load(const P0Item& I, float (&reg)[32], int lane) {
    const int nblk = I.N / 32, kb = I.item / nblk, nb = I.item % nblk, k0 = 64 * kb, n0 = 32 * nb;
    const float* src = I.W + (size_t)(k0 + (lane >> 5)) * I.N + n0 + (lane & 31);
#pragma unroll
    for (int i = 0; i < 32; ++i) reg[i] = src[(size_t)(2 * i) * I.N];
}
__device__ __forceinline__ void p0_item_store(const P0Item& I, const float (&reg)[32], LAS float* scr, int lane) {
    const int nblk = I.N / 32, kb = I.item / nblk, nb = I.item % nblk, k0 = 64 * kb, n0 = 32 * nb;
#pragma unroll
    for (int i = 0; i < 32; ++i) scr[(2 * i + (lane >> 5)) * 33 + (lane & 31)] = reg[i];
    asm volatile("s_waitcnt lgkmcnt(0)" ::: "memory");
    const int c = lane & 7;
#pragma unroll
    for (int j = 0; j < 4; ++j) { const int n = (lane >> 3) + 8 * j; const LAS float* s = scr + (8 * c) * 33 + n;
        u32x4 o; o.x = pk2(s[0 * 33], s[1 * 33]); o.y = pk2(s[2 * 33], s[3 * 33]); o.z = pk2(s[4 * 33], s[5 * 33]); o.w = pk2(s[6 * 33], s[7 * 33]);
        *(u32x4*)(I.WT + (size_t)(n0 + n) * I.K + k0 + 8 * c) = o; }
    asm volatile("s_waitcnt lgkmcnt(0)" ::: "memory");
}
__device__ __forceinline__ void ln_row(f32x4 (&v)[4], const float* __restrict__ g, const float* __restrict__ b, int lane) {
    float s = 0.f;
#pragma unroll
    for (int j = 0; j < 4; ++j) s += (v[j].x + v[j].y) + (v[j].z + v[j].w);
    const float mean = wave_sum(s) * (1.f / D); float s2 = 0.f;
#pragma unroll
    for (int j = 0; j < 4; ++j) { v[j] = v[j] - mean; s2 += (v[j].x * v[j].x + v[j].y * v[j].y) + (v[j].z * v[j].z + v[j].w * v[j].w); }
    const float rstd = 1.f / sqrtf(wave_sum(s2) * (1.f / D) + LN_EPS);
#pragma unroll
    for (int j = 0; j < 4; ++j) { const f32x4 gg = *(const f32x4*)(g + 4 * lane + 256 * j), bb = *(const f32x4*)(b + 4 * lane + 256 * j); v[j] = v[j] * rstd * gg + bb; }
}
__device__ __forceinline__ void store_row_bf16(bf16_t* orow, const f32x4 (&v)[4], int lane) {
#pragma unroll
    for (int j = 0; j < 4; ++j) { u32x2 o; o.x = pk2(v[j].x, v[j].y); o.y = pk2(v[j].z, v[j].w); *(u32x2*)(orow + 4 * lane + 256 * j) = o; }
}

constexpr int P0_I_IN = 16 * (IN_W / 32), P0_I_OUT = 16 * 32, P0_I_KV = 16 * 16, P0_I_GU = 16 * 64, P0_I_DN = 16 * 32;
constexpr int P0_NSMALL = P0_I_IN + P0_I_OUT + P0_I_KV;
constexpr int P0_NMOE = NE * P0_I_GU + NE * P0_I_DN;
__device__ __forceinline__ P0Item p0_make_small_item(const float* w_in, const float* w_out, const float* w_kv, unsigned char* ws, int it) { P0Item I; int r = it;
    if (r < P0_I_IN) { I.W = w_in; I.WT = (bf16_t*)(ws + WS_WT_IN); I.K = D; I.N = IN_W; I.item = r; return I; } r -= P0_I_IN;
    if (r < P0_I_OUT) { I.W = w_out; I.WT = (bf16_t*)(ws + WS_WT_OUT); I.K = D; I.N = D; I.item = r; return I; } r -= P0_I_OUT;
    { I.W = w_kv; I.WT = (bf16_t*)(ws + WS_WT_KV); I.K = D; I.N = 2 * MW; I.item = r; return I; } }
__device__ __forceinline__ P0Item p0_make_moe_item(const float* wgu, const float* wdn, unsigned char* ws, int r) { P0Item I;
    const bool gu = r < NE * P0_I_GU; const int r2 = gu ? r : r - NE * P0_I_GU; const int per = gu ? P0_I_GU : P0_I_DN; const int e = r2 / per;
    I.W = (gu ? wgu : wdn) + (size_t)e * D * 2 * FF * (gu ? 1 : 0) + (size_t)e * FF * D * (gu ? 0 : 1);
    I.WT = (bf16_t*)(ws + (gu ? WS_WT_GU : WS_WT_DN)) + (size_t)e * (gu ? 2 * FF * D : D * FF);
    I.K = gu ? D : FF; I.N = gu ? 2 * FF : D; I.item = r2 % per; return I; }
__device__ __forceinline__ void phase0(const Params& p, LAS unsigned char* lds) {
    const int tid = threadIdx.x, lane = tid & 63, wave = tid >> 6;
    const int gw = blockIdx.x * NWAVES + wave, NGW = gridDim.x * NWAVES;
    LAS float* scr = (LAS float*)(lds + wave * 16384);
    unsigned char* ws = p.ws;
    constexpr int NITEMS = P0_NSMALL;
    const float* w_in = p.in[4]; const float* w_out = p.in[17]; const float* w_kv = p.in[16];
    asm volatile("" : "+s"(w_in), "+s"(w_out), "+s"(w_kv));
    auto mk = [&](int it) { return p0_make_small_item(w_in, w_out, w_kv, ws, it); };
    { float ra[32], rb[32]; int it = gw;
      if (it < NITEMS) { const P0Item I0 = mk(it); p0_item_load(I0, ra, lane); }
      for (; it < NITEMS; it += 2 * NGW) {
          const P0Item Ia = mk(it); const bool hb = it + NGW < NITEMS; P0Item Ib = Ia;
          if (hb) { Ib = mk(it + NGW); p0_item_load(Ib, rb, lane); }
          p0_item_store(Ia, ra, scr, lane);
          if (it + 2 * NGW < NITEMS) { const P0Item Ic = mk(it + 2 * NGW); p0_item_load(Ic, ra, lane); }
          if (hb) p0_item_store(Ib, rb, scr, lane);
      } }
    { u32x4* z = (u32x4*)((bf16_t*)(ws + WS_WT_IN) + (size_t)IN_W * D); const int n16 = (IN_WP - IN_W) * D * 2 / 16;
      for (int i = blockIdx.x * NTHR + tid; i < n16; i += gridDim.x * NTHR) z[i] = (u32x4){0u, 0u, 0u, 0u}; }
    { const float* wr = p.in[20]; bf16_t* wh = (bf16_t*)(ws + WS_WRT); bf16_t* wl = wh + NE * D;
      for (int i = blockIdx.x * NTHR + tid; i < NE * D; i += gridDim.x * NTHR) { const int e = i / D, k = i % D; const float w = wr[k * NE + e]; const unsigned h = f2bf(w); wh[i] = (bf16_t)h; wl[i] = (bf16_t)f2bf(w - bf2f(h)); } }
    { bf16_t* wu = (bf16_t*)(ws + WS_LORA); bf16_t* au = wu + 2 * RC * 32; bf16_t* gu = au + 2 * RC * 32;
      for (int i = blockIdx.x * NTHR + tid; i < 2 * RC * 32; i += gridDim.x * NTHR) { const int dch = i >> 5, j = i & 31, d = dch / RC, ch = dch % RC; wu[i] = (bf16_t)f2bf(p.in[7][(size_t)(d * 32 + j) * RC + ch]); au[i] = (bf16_t)f2bf(p.in[9][(size_t)(d * 32 + j) * RC + ch]); }
      for (int i = blockIdx.x * NTHR + tid; i < RC * 64; i += gridDim.x * NTHR) { const int ch = i >> 6, j = i & 63; gu[i] = (bf16_t)f2bf(p.in[10][(size_t)j * RC + ch]); } }
    for (int m = gw; m < T; m += NGW) {
        const f32x4* xr = (const f32x4*)(p.in[0] + (size_t)m * D) + lane; f32x4 v[4];
#pragma unroll
        for (int j = 0; j < 4; ++j) v[j] = xr[64 * j];
        ln_row(v, p.in[2], p.in[3], lane);
        store_row_bf16((bf16_t*)(ws + WS_H0B) + (size_t)m * D, v, lane);
    }
    for (int m = gw; m < BATCH * NMEM; m += NGW) {
        const f32x4* xr = (const f32x4*)(p.in[1] + (size_t)m * D) + lane; f32x4 v[4];
#pragma unroll
        for (int j = 0; j < 4; ++j) v[j] = xr[64 * j];
        store_row_bf16((bf16_t*)(ws + WS_MEMB) + (size_t)m * D, v, lane);
    }
}

template <class ARow, class BRow, class Epi>
__device__ __forceinline__ void sgemm_tile(int K, ARow arow, BRow brow, Epi epi) {
    const int tid = threadIdx.x, wid = tid >> 6, lane = tid & 63, wm = wid >> 1, wn = wid & 1, fr = lane & 15, fq = lane >> 4;
    f32x4 acc[2][4];
#pragma unroll
    for (int m = 0; m < 2; ++m)
#pragma unroll
        for (int n = 0; n < 4; ++n) acc[m][n] = (f32x4){0.f, 0.f, 0.f, 0.f};
    const bf16_t* ap[2]; const bf16_t* bp[4];
#pragma unroll
    for (int m = 0; m < 2; ++m) ap[m] = arow(wm * 32 + m * 16 + fr) + fq * 8;
#pragma unroll
    for (int n = 0; n < 4; ++n) bp[n] = brow(wn * 64 + n * 16 + fr) + fq * 8;
    for (int k = 0; k < K; k += 32) {
        bf16x8 a[2], b[4];
#pragma unroll
        for (int m = 0; m < 2; ++m) a[m] = *(const bf16x8*)(ap[m] + k);
#pragma unroll
        for (int n = 0; n < 4; ++n) b[n] = *(const bf16x8*)(bp[n] + k);
#pragma unroll
        for (int m = 0; m < 2; ++m)
#pragma unroll
            for (int n = 0; n < 4; ++n) acc[m][n] = __builtin_amdgcn_mfma_f32_16x16x32_bf16(b[n], a[m], acc[m][n], 0, 0, 0);
    }
#pragma unroll
    for (int m = 0; m < 2; ++m)
#pragma unroll
        for (int n = 0; n < 4; ++n) epi(wm * 32 + m * 16 + fr, wn * 64 + n * 16 + 4 * fq, acc[m][n], n);
}


namespace pg8 {
constexpr int BM = 256, BK = 64, HALF = 128, HTB = HALF * BK * 2, STAGE_BYTES = 8 * HTB, NXCD = 8, WGM = 8;
__host__ __device__ __forceinline__ int lds_byte(int r, int c) { const int st = (r >> 4) * 2 + (c >> 5), rr = r & 15, cc = c & 31, ob = rr * 64 + cc * 2; return st * 1024 + (ob ^ (((ob >> 9) & 1) << 5)); }
__host__ __device__ __forceinline__ void stage_rc(int b, int& R, int& C) { const int st = b / 1024, sb = b % 1024, swz = sb ^ (((sb >> 9) & 1) << 5); R = (st >> 1) * 16 + swz / 64; C = (st & 1) * 32 + (swz % 64) / 2; }
__host__ __device__ __forceinline__ int perm32(int rho) { const int n = rho >> 4, i = rho & 15; return 8 * (i >> 2) + 4 * n + (i & 3); }
struct Unit { const char* A; const char* B0; const char* B1; int x0, x1, x2, x3, x4; };
__device__ __forceinline__ unsigned cvt_pk_bf16(float lo, float hi) { unsigned r; asm volatile("v_cvt_pk_bf16_f32 %0, %1, %2" : "=v"(r) : "v"(lo), "v"(hi)); return r; }

__device__ __forceinline__ const char* uni_ptr(const char* p) { const unsigned long long v = (unsigned long long)p; const unsigned lo = __builtin_amdgcn_readfirstlane((unsigned)v), hi = __builtin_amdgcn_readfirstlane((unsigned)(v >> 32)); return (const char*)(((unsigned long long)hi << 32) | lo); }
__device__ __forceinline__ bool static_order(int nM, int nN, int G, int c, int i, int& pm, int& pn) {
    const int nwg = nM * nN; const long L = (long)i * G + c; if (L >= nwg) return false;
    int wgid = (int)L; { const int q = nwg / NXCD, r = nwg % NXCD, xcd = wgid % NXCD, off = wgid / NXCD; wgid = (xcd < r ? xcd * (q + 1) : r * (q + 1) + (xcd - r) * q) + off; }
    const int nig = WGM * nN, gid = wgid / nig, fm = gid * WGM, gsz = (nM - fm) < WGM ? (nM - fm) : WGM;
    pm = fm + ((wgid % nig) % gsz); pn = (wgid % nig) / gsz; return true;
}

template <class Pol>
__device__ __forceinline__ void gemm_phase(LAS unsigned char* lds, const Pol& P, const int K, unsigned long long* stat = nullptr) {
    unsigned long long tK = 0, tE = 0, tmark = 0, tstart = stat ? __builtin_amdgcn_s_memrealtime() : 0;
    const int tid = threadIdx.x, wid = __builtin_amdgcn_readfirstlane(tid >> 6), lane = tid & 63, wr = wid >> 2, wc = wid & 3, fr = lane & 15, fq = lane >> 4;
    const int nt = K / BK;
    int R0, C0; stage_rc(tid * 16, R0, C0);
    const int Rb0 = Pol::PERM ? ((R0 & ~31) + perm32(R0 & 31)) : R0;
    const unsigned vB = (unsigned)(Rb0 * K + C0) * 2u;
    const size_t pstep = (size_t)64 * K * 2;
    const size_t kstep = (size_t)(BK * 2);
    const unsigned ldsw = (unsigned)wid * 1024u;
    const int aoff = lds_byte(wr * 64 + fr, fq * 8), boff = lds_byte(wc * 32 + fr, fq * 8);
#define PG8_SA(b, h) (((b) * 2 + (h)) * HTB)
#define PG8_SB(b, h) ((4 + (b) * 2 + (h)) * HTB)
#define PG8_STAGE_B(bufoff, gbase) do { _Pragma("unroll") for (int _i = 0; _i < 2; ++_i) \
        __builtin_amdgcn_global_load_lds((const unsigned*)(uni_ptr((const char*)(gbase) + _i * pstep) + vB), (LAS unsigned*)(lds + (bufoff) + ldsw + _i * 8192), 16, 0, 0); } while (0)
#define PG8_STAGE_A(bufoff, gbase, vo, h) do { _Pragma("unroll") for (int _i = 0; _i < 2; ++_i) { \
        if constexpr (Pol::GATHER) __builtin_amdgcn_global_load_lds((const unsigned*)(uni_ptr((const char*)(gbase)) + (vo)[h][_i]), (LAS unsigned*)(lds + (bufoff) + ldsw + _i * 8192), 16, 0, 0); \
        else __builtin_amdgcn_global_load_lds((const unsigned*)(uni_ptr((const char*)(gbase) + ((h) * 2 + _i) * pstep) + (vo)[0][0]), (LAS unsigned*)(lds + (bufoff) + ldsw + _i * 8192), 16, 0, 0); } } while (0)
#define PG8_LDA(dst, b, h) do { _Pragma("unroll") for (int m = 0; m < 4; ++m) _Pragma("unroll") for (int k = 0; k < 2; ++k) dst[m][k] = *(const LAS bf16x8*)(lds + PG8_SA(b, h) + aoff + m * 2048 + k * 1024); } while (0)
#define PG8_LDB(dst, b, h) do { _Pragma("unroll") for (int n = 0; n < 2; ++n) _Pragma("unroll") for (int k = 0; k < 2; ++k) dst[n][k] = *(const LAS bf16x8*)(lds + PG8_SB(b, h) + boff + n * 2048 + k * 1024); } while (0)
#define PG8_MMA(ai, bj, At, Bt) do { __builtin_amdgcn_s_setprio(1); _Pragma("unroll") for (int m = 0; m < 4; ++m) _Pragma("unroll") for (int n = 0; n < 2; ++n) _Pragma("unroll") for (int k = 0; k < 2; ++k) \
        acc[ai][bj][m][n] = __builtin_amdgcn_mfma_f32_16x16x32_bf16(Bt[n][k], At[m][k], acc[ai][bj][m][n], 0, 0, 0); __builtin_amdgcn_s_setprio(0); } while (0)
#define PG8_WAIT_V(n) asm volatile("s_waitcnt vmcnt(" #n ")" ::: "memory")
#define PG8_WAIT_L(n) asm volatile("s_waitcnt lgkmcnt(" #n ")" ::: "memory")
#define PG8_BAR __builtin_amdgcn_s_barrier()
#define PG8_SCHED __builtin_amdgcn_sched_barrier(0)
    Unit cur, nxt; int ui = 0;
    if (!P.next(0, cur)) return;
    f32x4 acc[2][2][4][2];
#pragma unroll
    for (int a = 0; a < 2; ++a)
#pragma unroll
        for (int b = 0; b < 2; ++b)
#pragma unroll
            for (int m = 0; m < 4; ++m)
#pragma unroll
                for (int n = 0; n < 2; ++n) acc[a][b][m][n] = (f32x4){0.f, 0.f, 0.f, 0.f};
    bf16x8 At[4][2], B0[2][2], B1[2][2];
    unsigned vAc[2][2], vAn[2][2];
    if constexpr (Pol::GATHER) { P.rows_issue(cur, R0, vAc); P.rows_finish(C0, K, vAc); }
    else { vAc[0][0] = (unsigned)(R0 * K + C0) * 2u; vAc[0][1] = vAc[1][0] = vAc[1][1] = 0u; }
    asm volatile("s_waitcnt vmcnt(0)" ::: "memory");
    PG8_STAGE_B(PG8_SB(0, 0), cur.B0); PG8_STAGE_B(PG8_SB(0, 1), cur.B1); PG8_STAGE_A(PG8_SA(0, 0), cur.A, vAc, 0); PG8_STAGE_A(PG8_SA(0, 1), cur.A, vAc, 1);
    if (wr == 1) PG8_BAR;
    PG8_WAIT_V(2); PG8_BAR;
    PG8_STAGE_B(PG8_SB(1, 0), cur.B0 + kstep); PG8_STAGE_A(PG8_SA(1, 0), cur.A + kstep, vAc, 0); PG8_STAGE_B(PG8_SB(1, 1), cur.B1 + kstep);
    PG8_WAIT_V(6); PG8_BAR;
    for (;;) {
        const bool has_next = P.next(ui + 1, nxt);
        if (!has_next) nxt = cur;
        if (stat) tmark = __builtin_amdgcn_s_memrealtime();
        for (int t = 0; t < nt; t += 2) {
            const bool last = (t == nt - 2);
            if constexpr (Pol::GATHER) {
                if (last && has_next) { P.rows_issue(nxt, R0, vAn); vAc[0][0] = (vAn[0][0] * (unsigned)K + (unsigned)C0) * 2u; vAc[0][1] = (vAn[0][1] * (unsigned)K + (unsigned)C0) * 2u; }
            }
            const char* a1 = cur.A + (size_t)(t + 1) * kstep;
            const char* a2 = last ? nxt.A : cur.A + (size_t)(t + 2) * kstep;
            const char* b20 = last ? nxt.B0 : cur.B0 + (size_t)(t + 2) * kstep; const char* b21 = last ? nxt.B1 : cur.B1 + (size_t)(t + 2) * kstep;
            const char* a3 = a2 + kstep; const char* b30 = b20 + kstep; const char* b31 = b21 + kstep;
            PG8_LDB(B0, 0, 0); PG8_LDB(B1, 0, 1); PG8_SCHED; PG8_LDA(At, 0, 0); PG8_STAGE_A(PG8_SA(1, 1), a1, vAc, 1);
            if constexpr (Pol::GATHER) { if (last && has_next) { vAc[1][0] = (vAn[1][0] * (unsigned)K + (unsigned)C0) * 2u; vAc[1][1] = (vAn[1][1] * (unsigned)K + (unsigned)C0) * 2u; } }
            PG8_WAIT_V(8); PG8_WAIT_L(0); PG8_BAR; PG8_MMA(0, 0, At, B0); PG8_MMA(0, 1, At, B1); PG8_BAR; PG8_SCHED;
            PG8_LDA(At, 0, 1); PG8_STAGE_B(PG8_SB(0, 0), b20); PG8_STAGE_B(PG8_SB(0, 1), b21); PG8_STAGE_A(PG8_SA(0, 0), a2, vAc, 0);
            PG8_WAIT_V(8); PG8_WAIT_L(0); PG8_BAR; PG8_MMA(1, 0, At, B0); PG8_MMA(1, 1, At, B1); PG8_BAR; PG8_SCHED;
            PG8_LDB(B0, 1, 0); PG8_LDB(B1, 1, 1); PG8_SCHED; PG8_LDA(At, 1, 0); PG8_STAGE_A(PG8_SA(0, 1), a2, vAc, 1);
            PG8_WAIT_V(8); PG8_WAIT_L(0); PG8_BAR; PG8_MMA(0, 0, At, B0); PG8_MMA(0, 1, At, B1); PG8_BAR; PG8_SCHED;
            PG8_LDA(At, 1, 1); PG8_STAGE_B(PG8_SB(1, 0), b30); PG8_STAGE_B(PG8_SB(1, 1), b31); PG8_STAGE_A(PG8_SA(1, 0), a3, vAc, 0);
            PG8_WAIT_V(8); PG8_WAIT_L(0); PG8_BAR; PG8_MMA(1, 0, At, B0); PG8_MMA(1, 1, At, B1); PG8_BAR; PG8_SCHED;
        }
        if (stat) { const unsigned long long n_ = __builtin_amdgcn_s_memrealtime(); tK += n_ - tmark; tmark = n_; }
        if (wr == 0) PG8_BAR;
        P.epi(acc, cur, wr, wc, fr, fq);
        if (stat) { const unsigned long long n_ = __builtin_amdgcn_s_memrealtime(); tE += n_ - tmark; }
        if (!has_next) break;
#pragma unroll
        for (int a = 0; a < 2; ++a)
#pragma unroll
            for (int b = 0; b < 2; ++b)
#pragma unroll
                for (int m = 0; m < 4; ++m)
#pragma unroll
                    for (int n = 0; n < 2; ++n) acc[a][b][m][n] = (f32x4){0.f, 0.f, 0.f, 0.f};
        cur = nxt; ++ui;
        if (wr == 1) PG8_BAR;
    }
    PG8_WAIT_V(0);
    PG8_BAR;
    if (stat && threadIdx.x == 0) { stat[0] = tK; stat[1] = tE; stat[2] = __builtin_amdgcn_s_memrealtime() - tstart; }
#undef PG8_SA
#undef PG8_SB
#undef PG8_STAGE_A
#undef PG8_STAGE_B
#undef PG8_LDA
#undef PG8_LDB
#undef PG8_MMA
#undef PG8_WAIT_V
#undef PG8_WAIT_L
#undef PG8_BAR
#undef PG8_SCHED
}
}

struct PolP1 {
    static constexpr bool PERM = true, GATHER = false;
    const bf16_t* A; const bf16_t* Bt; bf16_t* PR; bf16_t* PA; const bf16_t* MB; const bf16_t* WK; bf16_t* KVM; int G, c;
    __device__ __forceinline__ bool next(int i, pg8::Unit& u) const { int pm, pn; constexpr int NMAIN = (T / 256) * (IN_WP / 256), NKV = (BATCH * NMEM / 256) * (2 * MW / 256);
        if (pg8::static_order(T / 256, IN_WP / 256, G, c, i, pm, pn)) {
            u.A = (const char*)(A + (size_t)pm * 256 * D); u.B0 = (const char*)(Bt + (size_t)pn * 256 * D); u.B1 = u.B0 + (size_t)128 * D * 2; u.x0 = pm; u.x1 = pn; u.x2 = 0; u.x3 = 0; u.x4 = 0; return true; }
        const long L = (long)i * G + c - NMAIN; if (L < 0 || L >= NKV) return false;
        pm = (int)(L >> 1); pn = (int)(L & 1);
        u.A = (const char*)(MB + (size_t)pm * 256 * D); u.B0 = (const char*)(WK + (size_t)pn * 256 * D); u.B1 = u.B0 + (size_t)128 * D * 2; u.x0 = pm; u.x1 = pn; u.x2 = 1; u.x3 = 0; u.x4 = 0; return true; }
    __device__ __forceinline__ void epi(const f32x4 (&acc)[2][2][4][2], const pg8::Unit& u, int wr, int wc, int fr, int fq) const {
        const int row0 = u.x0 * 256 + wr * 64 + fr;
#pragma unroll
        for (int bj = 0; bj < 2; ++bj) { const int col = u.x1 * 256 + bj * 128 + wc * 32 + 8 * fq;
            bf16_t* base; int pitch; float sc = 1.f;
            if (u.x2) { base = KVM + col; pitch = 2 * MW; }
            else if (col < RWKV_IN) { base = PR + col; pitch = RWKV_IN; }
            else { const int ca = col - RWKV_IN; base = PA + ca; pitch = PA_W; sc = (ca < AW || (ca >= 3 * AW && ca < 3 * AW + MW)) ? 0.125f : 1.f; }
#pragma unroll
            for (int ai = 0; ai < 2; ++ai)
#pragma unroll
                for (int m = 0; m < 4; ++m) { const f32x4 v0 = acc[ai][bj][m][0] * sc, v1 = acc[ai][bj][m][1] * sc;
                    u32x4 w; w.x = pg8::cvt_pk_bf16(v0[0], v0[1]); w.y = pg8::cvt_pk_bf16(v0[2], v0[3]); w.z = pg8::cvt_pk_bf16(v1[0], v1[1]); w.w = pg8::cvt_pk_bf16(v1[2], v1[3]);
                    *(u32x4*)(base + (size_t)(row0 + ai * 128 + m * 16) * pitch) = w; } }
    }
};
__device__ __forceinline__ void phase1(const Params& p, LAS unsigned char* lds) {
    unsigned char* ws = p.ws;
    PolP1 P{(const bf16_t*)(ws + WS_H0B), (const bf16_t*)(ws + WS_WT_IN), (bf16_t*)(ws + WS_PR), (bf16_t*)(ws + WS_PA), (const bf16_t*)(ws + WS_MEMB), (const bf16_t*)(ws + WS_WT_KV), (bf16_t*)(ws + WS_KVM), (int)gridDim.x, (int)blockIdx.x};
    pg8::gemm_phase(lds, P, D, (PROBE_GEMM == 1 && blockIdx.x == 0) ? (unsigned long long*)(ws + WS_CTL + 32768) : nullptr);
}

constexpr int P2_AP = 200;
__device__ __forceinline__ f32x4 p2_shift(const bf16_t* cur, int po, int no, float pm, float nm, const float* mu) {
    const u32x2 c = *(const u32x2*)cur, pv = *(const u32x2*)(cur + po), nv = *(const u32x2*)(cur + no);
    const f32x4 m = *(const f32x4*)mu;
    const f32x4 cc = {bflo(c.x), bfhi(c.x), bflo(c.y), bfhi(c.y)}, pp = {bflo(pv.x), bfhi(pv.x), bflo(pv.y), bfhi(pv.y)}, nn = {bflo(nv.x), bfhi(nv.x), bflo(nv.y), bfhi(nv.y)};
    return cc + m * (0.5f * (pp * pm + nn * nm) - cc);
}
constexpr int P2_CST = 8 * 16 * P2_AP * 2;
constexpr int P2_WOFF = P2_CST + 10 * RC * 4, P2_WBUF = 24576;
struct P2Pre { u32x2 rc, rp, rn, vc, vp, vn; };
__device__ __forceinline__ f32x4 p2_lerp(u32x2 c, u32x2 pv, u32x2 nv, float pm, float nm, f32x4 m) {
    const f32x4 cc = {bflo(c.x), bfhi(c.x), bflo(c.y), bfhi(c.y)}, pp = {bflo(pv.x), bfhi(pv.x), bflo(pv.y), bfhi(pv.y)}, nn = {bflo(nv.x), bfhi(nv.x), bflo(nv.y), bfhi(nv.y)};
    return cc + m * (0.5f * (pp * pm + nn * nm) - cc);
}
__device__ __forceinline__ void p2_fetch(P2Pre& P, const bf16_t* prow, int po, int no, const bf16_t* WU, const bf16_t* AU, const bf16_t* GU, int it, int fr, int fq) {
    const int h = it >> 2, ct = it & 3, ch = h * 64 + 16 * ct + 4 * fq;
    P.rc = *(const u32x2*)(prow + ch); P.rp = *(const u32x2*)(prow + ch + po); P.rn = *(const u32x2*)(prow + ch + no);
    P.vc = *(const u32x2*)(prow + 2 * RC + ch); P.vp = *(const u32x2*)(prow + 2 * RC + ch + po); P.vn = *(const u32x2*)(prow + 2 * RC + ch + no);
}
__device__ __forceinline__ void p2_wfetch(const bf16_t* WU, const bf16_t* AU, const bf16_t* GU, int h, int tid, u32x4 (&wr)[3]) {
#pragma unroll
    for (int q = 0; q < 3; ++q) { const int idx = tid + NTHR * q; const bf16_t* src;
        if (q < 2) { const int d = (idx & 511) >> 8, row = (idx & 255) >> 2, part = idx & 3; src = (q == 0 ? WU : AU) + ((size_t)(d * RC + h * 64 + row) * 32 + part * 8); }
        else { const int row = (idx - 1024) >> 3, part = idx & 7; src = GU + ((size_t)(h * 64 + row) * 64 + part * 8); }
        wr[q] = *(const u32x4*)src; }
}
__device__ __forceinline__ void p2_wput(LAS unsigned char* wb, int tid, const u32x4 (&wr)[3]) {
#pragma unroll
    for (int q = 0; q < 3; ++q) *(LAS u32x4*)(wb + (tid + NTHR * q) * 16) = wr[q];
}
__device__ __forceinline__ void phase2(const Params& p, LAS unsigned char* lds) {
    int tid_ = threadIdx.x; asm volatile("" : "+v"(tid_)); const int tid = tid_, lane = tid & 63, wave = tid >> 6, fr = lane & 15, fq = lane >> 4;
    unsigned char* ws = p.ws;
    const bf16_t* PR = (const bf16_t*)(ws + WS_PR);
    const float* mu = p.in[5];
    const bf16_t* WU = (const bf16_t*)(ws + WS_LORA); const bf16_t* AU = WU + 2 * RC * 32; const bf16_t* GU = AU + 2 * RC * 32;
    LAS bf16_t* ACT = (LAS bf16_t*)(lds + wave * (16 * P2_AP * 2));
    LAS float* CST = (LAS float*)(lds + P2_CST);
    unsigned char* SSH = ws + WS_SSH; unsigned char* SDIR = ws + WS_SDIR;
    bf16_t* G = (bf16_t*)((unsigned char*)p.out + DO_G); float* BON = (float*)(ws + WS_BONUS);
    __syncthreads();
    for (int i = tid; i < 10 * RC; i += NTHR) { const int a = i / RC, c = i % RC; float v;
        if (a < 3) v = mu[a * RC + c]; else if (a < 5) v = p.in[6][(a - 3) * RC + c]; else if (a < 7) v = p.in[8][(a - 5) * RC + c]; else v = p.in[11 + (a - 7)][c];
        CST[i] = v; }
    u32x4 wreg[3];
    p2_wfetch(WU, AU, GU, 0, tid, wreg); p2_wput(lds + P2_WOFF, tid, wreg);
    __syncthreads();
    { const int tile = blockIdx.x * NWAVES + wave;
        const int t0 = tile * 16;
#pragma unroll 4
        for (int i = 0; i < 12; ++i) { const int grp = lane + 64 * i, tok = grp / 48, c4 = (grp % 48) * 4, t = t0 + tok, sq = t & (SEQ - 1);
            f32x4 v = p2_shift(PR + (size_t)t * RWKV_IN + 3 * RC + c4, sq > 0 ? -RWKV_IN : 0, sq < SEQ - 1 ? RWKV_IN : 0, sq > 0 ? 1.f : 0.f, sq < SEQ - 1 ? 1.f : 0.f, mu + 3 * RC + c4);
            { const float sc = c4 < 64 ? 1.f : 2.f, mul = c4 < 64 ? 1.f : 2.f, add = c4 < 64 ? 0.f : -1.f; const bool raw = c4 >= 128;
#pragma unroll
              for (int e = 0; e < 4; ++e) { const float a = sigmoidf_(sc * v[e]) * mul + add; v[e] = raw ? v[e] : a; } }
            u32x2 o; o.x = pk2(v.x, v.y); o.y = pk2(v.z, v.w); *(LAS u32x2*)(ACT + tok * P2_AP + c4) = o; }
        asm volatile("s_waitcnt lgkmcnt(0)" ::: "memory");
        const int t = t0 + fr, sq = t & (SEQ - 1), b = t >> 11; const int po = sq > 0 ? -RWKV_IN : 0, no = sq < SEQ - 1 ? RWKV_IN : 0; const float pm = sq > 0 ? 1.f : 0.f, nm = sq < SEQ - 1 ? 1.f : 0.f;
        const bf16_t* prow = PR + (size_t)t * RWKV_IN;
        const LAS bf16_t* arowp = ACT + fr * P2_AP + 8 * fq;
        u32x2 kq[4][3];
#pragma unroll
        for (int ct = 0; ct < 4; ++ct) { const int ch = RC + 16 * ct + 4 * fq; kq[ct][0] = *(const u32x2*)(prow + ch); kq[ct][1] = *(const u32x2*)(prow + ch + po); kq[ct][2] = *(const u32x2*)(prow + ch + no); }
        P2Pre cur, nxt; p2_fetch(cur, prow, po, no, WU, AU, GU, 0, fr, fq);
#pragma unroll 1
        for (int h = 0; h < RH; ++h) {
            if (h + 1 < RH) p2_wfetch(WU, AU, GU, h + 1, tid, wreg);
            const LAS unsigned char* wbuf = lds + P2_WOFF + (h & 1) * P2_WBUF;
            f32x4 kp[4]; float ss = 0.f;
#pragma unroll
            for (int ct = 0; ct < 4; ++ct) { const int ch = h * 64 + 16 * ct + 4 * fq; kp[ct] = p2_lerp(kq[ct][0], kq[ct][1], kq[ct][2], pm, nm, *(const LAS f32x4*)(CST + RC + ch));
                const f32x4 kkv = kp[ct] * *(const LAS f32x4*)(CST + 7 * RC + ch); ss += (kkv.x * kkv.x + kkv.y * kkv.y) + (kkv.z * kkv.z + kkv.w * kkv.w); }
            ss += __shfl_xor(ss, 16); ss += __shfl_xor(ss, 32);
            const float rn = 1.f / fmaxf(sqrtf(ss), 1e-12f);
            float bon = 0.f;
            unsigned char* shrec = SSH + ((size_t)(b * RH + h) * SEQ + sq) * 384;
            unsigned char* d0rec = SDIR + ((size_t)((0 * BATCH + b) * RH + h) * SEQ + sq) * 512; unsigned char* d1rec = SDIR + ((size_t)((1 * BATCH + b) * RH + h) * SEQ + sq) * 512;
#pragma unroll
            for (int ct = 0; ct < 4; ++ct) { const int ch = h * 64 + 16 * ct + 4 * fq, cl = 16 * ct + 4 * fq, it = h * 4 + ct;
                const f32x4 r = p2_lerp(cur.rc, cur.rp, cur.rn, pm, nm, *(const LAS f32x4*)(CST + ch)), v = p2_lerp(cur.vc, cur.vp, cur.vn, pm, nm, *(const LAS f32x4*)(CST + 2 * RC + ch)), k = kp[ct];
                const LAS unsigned char* wl_ = wbuf + ((16 * ct + fr) * 4 + fq) * 16;
                const bf16x8 fw0 = *(const LAS bf16x8*)wl_, fw1 = *(const LAS bf16x8*)(wl_ + 4096), fa0 = *(const LAS bf16x8*)(wl_ + 8192), fa1 = *(const LAS bf16x8*)(wl_ + 12288);
                const LAS unsigned char* gl_ = wbuf + 16384 + ((16 * ct + fr) * 8 + fq) * 16;
                const bf16x8 fg0 = *(const LAS bf16x8*)gl_, fg1 = *(const LAS bf16x8*)(gl_ + 64);
                const f32x4 z = {0.f, 0.f, 0.f, 0.f};
                const f32x4 wl0 = __builtin_amdgcn_mfma_f32_16x16x32_bf16(fw0, *(const LAS bf16x8*)(arowp + 64), z, 0, 0, 0);
                const f32x4 wl1 = __builtin_amdgcn_mfma_f32_16x16x32_bf16(fw1, *(const LAS bf16x8*)(arowp + 96), z, 0, 0, 0);
                const f32x4 al0 = __builtin_amdgcn_mfma_f32_16x16x32_bf16(fa0, *(const LAS bf16x8*)(arowp + 128), z, 0, 0, 0);
                const f32x4 al1 = __builtin_amdgcn_mfma_f32_16x16x32_bf16(fa1, *(const LAS bf16x8*)(arowp + 160), z, 0, 0, 0);
                f32x4 gg = __builtin_amdgcn_mfma_f32_16x16x32_bf16(fg0, *(const LAS bf16x8*)(arowp), z, 0, 0, 0);
                gg = __builtin_amdgcn_mfma_f32_16x16x32_bf16(fg1, *(const LAS bf16x8*)(arowp + 32), gg, 0, 0, 0);
                const f32x4 w00 = *(const LAS f32x4*)(CST + 3 * RC + ch), w01 = *(const LAS f32x4*)(CST + 4 * RC + ch), a00 = *(const LAS f32x4*)(CST + 5 * RC + ch), a01 = *(const LAS f32x4*)(CST + 6 * RC + ch);
                const f32x4 kkw = *(const LAS f32x4*)(CST + 7 * RC + ch), kaw = *(const LAS f32x4*)(CST + 8 * RC + ch), rkw = *(const LAS f32x4*)(CST + 9 * RC + ch);
                f32x4 dec0, dec1, kd0, kd1, bb0, bb1, kkn;
#pragma unroll
                for (int e = 0; e < 4; ++e) {
                    dec0[e] = __expf(-0.6065306597126334f * sigmoidf_(w00[e] + wl0[e])); dec1[e] = __expf(-0.6065306597126334f * sigmoidf_(w01[e] + wl1[e]));
                    const float a0 = sigmoidf_(a00[e] + al0[e]), a1 = sigmoidf_(a01[e] + al1[e]);
                    kkn[e] = k[e] * kkw[e] * rn; kd0[e] = k[e] * (1.f + (a0 - 1.f) * kaw[e]); kd1[e] = k[e] * (1.f + (a1 - 1.f) * kaw[e]);
                    bb0[e] = kkn[e] * a0; bb1[e] = kkn[e] * a1; bon += r[e] * (kd0[e] + kd1[e]) * rkw[e]; }
                if (it + 1 < 4 * RH) p2_fetch(nxt, prow, po, no, WU, AU, GU, it + 1, fr, fq);
                if (ct == 3 && h + 1 < RH) {
#pragma unroll
                    for (int c2 = 0; c2 < 4; ++c2) { const int chn = RC + (h + 1) * 64 + 16 * c2 + 4 * fq; kq[c2][0] = *(const u32x2*)(prow + chn); kq[c2][1] = *(const u32x2*)(prow + chn + po); kq[c2][2] = *(const u32x2*)(prow + chn + no); } }
                { u32x2 o; o.x = pk2(r.x, r.y); o.y = pk2(r.z, r.w); *(u32x2*)(shrec + cl * 2) = o; o.x = pk2(v.x, v.y); o.y = pk2(v.z, v.w); *(u32x2*)(shrec + 128 + cl * 2) = o;
                  o.x = pk2(kkn.x, kkn.y); o.y = pk2(kkn.z, kkn.w); *(u32x2*)(shrec + 256 + cl * 2) = o;
                  *(f32x4*)(d0rec + cl * 4) = dec0; o.x = pk2(kd0.x, kd0.y); o.y = pk2(kd0.z, kd0.w); *(u32x2*)(d0rec + 256 + cl * 2) = o; o.x = pk2(bb0.x, bb0.y); o.y = pk2(bb0.z, bb0.w); *(u32x2*)(d0rec + 384 + cl * 2) = o;
                  *(f32x4*)(d1rec + cl * 4) = dec1; o.x = pk2(kd1.x, kd1.y); o.y = pk2(kd1.z, kd1.w); *(u32x2*)(d1rec + 256 + cl * 2) = o; o.x = pk2(bb1.x, bb1.y); o.y = pk2(bb1.z, bb1.w); *(u32x2*)(d1rec + 384 + cl * 2) = o; }
                u32x2 go; go.x = pk2(gg.x, gg.y); go.y = pk2(gg.z, gg.w); *(u32x2*)(G + (size_t)t * RC + ch) = go;
                cur = nxt;
                asm volatile("" ::: "memory");
            }
            bon += __shfl_xor(bon, 16); bon += __shfl_xor(bon, 32);
            if (fq == 0) BON[t * RH + h] = bon;
            if (h + 1 < RH) { p2_wput(lds + P2_WOFF + ((h + 1) & 1) * P2_WBUF, tid, wreg); __syncthreads(); }
        }
    }
}

typedef float f32x2_t __attribute__((ext_vector_type(2))); typedef __bf16 bf16x2_t __attribute__((ext_vector_type(2)));
__device__ __forceinline__ unsigned cvtpk(float lo, float hi) { const f32x2_t v = {lo, hi}; const bf16x2_t b = __builtin_convertvector(v, bf16x2_t); return __builtin_bit_cast(unsigned, b); }
constexpr int SC_TC = 32;
constexpr int SC_W = 0, SC_KK = 256, SC_RP = 384, SC_Z = 512, SC_UB = 640, SC_V = 1152, SC_STEPB = 1280;
constexpr int SC_BUFB = SC_TC * SC_STEPB;
struct ScanProd { const unsigned char* g0; const unsigned char* g1; long gstep0, gstep1; int ldst; int kind; };
__device__ __forceinline__ ScanProd scan_prod_init(const unsigned char* sh, const unsigned char* dr, int dir, int ptid) {
    ScanProd P; const int wi = ptid % 48, st0 = ptid / 48; int shift = 0; bool sh0 = false;
    P.g1 = dr; P.gstep1 = 0;
    if (wi < 16) { P.g0 = dr + wi * 16; P.ldst = SC_W + wi * 16; P.kind = 0; }
    else if (wi < 24) { const int c = wi - 16, ct = c >> 1; P.g0 = dr + 256 + c * 16; P.g1 = dr + 384 + c * 16; P.ldst = SC_UB + (ct >> 1) * 256 + (c & 1) * 128 + (ct & 1) * 8; P.kind = 1; }
    else if (wi < 32) { const int c = wi - 24; P.g0 = sh + 128 + c * 16; P.ldst = SC_V + c * 16; P.kind = 0; sh0 = true; }
    else { const int c = (wi - 32) & 7; const bool isr = wi >= 40; P.g0 = sh + (isr ? 0 : 256) + c * 16; sh0 = true; shift = isr ? 1 : 0; P.kind = 2;
        const int ct = c >> 1, fqb = 2 * (c & 1), pp = 32 * (ct >> 1) + 8 * fqb + (ct & 1) * 4; P.ldst = (isr ? SC_RP : SC_KK) + pp * 2; }
    const long rec0 = sh0 ? 384 : 512;
    const long t0 = dir ? (long)(SEQ - 1 - (st0 - shift)) : (long)(st0 - shift), t1 = dir ? (long)(SEQ - 1 - st0) : (long)st0;
    P.g0 += t0 * rec0; P.gstep0 = dir ? -rec0 : rec0; P.g1 += t1 * 512; P.gstep1 = dir ? -512 : 512; P.ldst += st0 * SC_STEPB; return P;
}
__device__ __forceinline__ void scan_fetch(const ScanProd& P, int c, u32x4 (&reg)[SC_TC / 4], u32x4 (&reg2)[SC_TC / 4]) {
    const unsigned char* a = P.g0 + (long)(c * SC_TC) * P.gstep0; const unsigned char* b = P.g1 + (long)(c * SC_TC) * P.gstep1;
#pragma unroll
    for (int q = 0; q < SC_TC / 4; ++q) { reg[q] = *(const u32x4*)(a + (long)(4 * q) * P.gstep0); reg2[q] = *(const u32x4*)(b + (long)(4 * q) * P.gstep1); }
}
__device__ __forceinline__ void scan_put(const ScanProd& P, LAS unsigned char* buf, const u32x4 (&reg)[SC_TC / 4], const u32x4 (&reg2)[SC_TC / 4]) {
    LAS unsigned char* d = buf + P.ldst;
    if (P.kind == 0) {
#pragma unroll
        for (int q = 0; q < SC_TC / 4; ++q) *(LAS u32x4*)(d + 4 * q * SC_STEPB) = reg[q];
    } else if (P.kind == 1) {
#pragma unroll
        for (int q = 0; q < SC_TC / 4; ++q) { const unsigned kw[4] = {reg[q].x, reg[q].y, reg[q].z, reg[q].w}, bw[4] = {reg2[q].x, reg2[q].y, reg2[q].z, reg2[q].w};
#pragma unroll
            for (int e = 0; e < 4; ++e) { const unsigned k0 = kw[e] & 0xffffu, k1 = kw[e] >> 16, b0 = bw[e] & 0xffffu, b1 = bw[e] >> 16;
                *(LAS u32x2*)(d + 4 * q * SC_STEPB + (2 * e) * 16) = (u32x2){k0 | (b0 << 16), b0};
                *(LAS u32x2*)(d + 4 * q * SC_STEPB + (2 * e + 1) * 16) = (u32x2){k1 | (b1 << 16), b1}; } }
    } else {
#pragma unroll
        for (int q = 0; q < SC_TC / 4; ++q) { *(LAS u32x2*)(d + 4 * q * SC_STEPB) = (u32x2){reg[q].x, reg[q].y}; *(LAS u32x2*)(d + 4 * q * SC_STEPB + 16) = (u32x2){reg[q].z, reg[q].w}; }
    }
}
__device__ __forceinline__ void scan_block(const Params& p, LAS unsigned char* lds, int sid) {
    const int tid = threadIdx.x, lane = tid & 63, wave = tid >> 6;
    const int dir = sid / (BATCH * RH), bh = sid % (BATCH * RH), b = bh / RH, h = bh % RH;
    const unsigned char* sh = p.ws + WS_SSH + (size_t)bh * SEQ * 384;
    const unsigned char* dr = p.ws + WS_SDIR + (size_t)(dir * BATCH * RH + bh) * SEQ * 512;
    float* Y = (float*)((unsigned char*)p.out + DO_Y) + (size_t)dir * T * RC;
    LAS unsigned char* buf0 = lds; LAS unsigned char* buf1 = lds + SC_BUFB;
    constexpr int NCH = SEQ / SC_TC;
    __syncthreads();
    for (int i = tid; i < 2 * SC_TC * 32; i += NTHR) { const int st = i >> 5, e = i & 31; *(LAS unsigned*)(lds + st * SC_STEPB + SC_Z + e * 4) = 0u; }
    const ScanProd SP = scan_prod_init(sh, dr, dir, (tid - 256) & 255);
    const bool prod = wave >= 4 && tid - 256 < 192;
    u32x4 preg[SC_TC / 4], preg2[SC_TC / 4];
    if (prod) { scan_fetch(SP, 0, preg, preg2); scan_put(SP, buf0, preg, preg2); scan_fetch(SP, 1, preg, preg2); }
    constexpr int CPI = 2 * BATCH * RH * 4 * (SEQ / SC_TC) / P0_NMOE;
    static_assert(P0_NMOE * CPI == 2 * BATCH * RH * 4 * (SEQ / SC_TC), "one conversion item per (scan, producer wave, CPI chunks)");
    const int cbase = __builtin_amdgcn_readfirstlane((sid * 4 + (wave - 4)) * (SEQ / SC_TC / CPI));
    const float* wgu = p.in[22]; const float* wdn = p.in[24];
    LAS float* cscr = (LAS float*)(lds + 2 * SC_BUFB + (wave & 3) * 8448);
    __syncthreads();
    const int fr = lane & 15, fq = lane >> 4, sel = (fr & 3) < 2 ? (fr & 3) : 2;
    f32x4 acc[4];
#pragma unroll
    for (int ct = 0; ct < 4; ++ct) acc[ct] = (f32x4){0.f, 0.f, 0.f, 0.f};
    bf16x8 sb0 = (bf16x8){0, 0, 0, 0, 0, 0, 0, 0}, sb1 = sb0;
    float* yrow = Y + (size_t)b * SEQ * RC + h * 64 + 16 * wave + fr;
    float yk = 0.f;
    const int ubo = fq == 0 ? SC_UB + fr * 16 : SC_Z, ubs = fq == 0 ? 256 : 0;
    for (int c = 0; c < NCH; ++c) {
        LAS unsigned char* cur = (c & 1) ? buf1 : buf0; LAS unsigned char* nxt = (c & 1) ? buf0 : buf1;
        if (wave >= 4) {
            if (prod && c + 1 < NCH) { scan_put(SP, nxt, preg, preg2); if (c + 2 < NCH) scan_fetch(SP, c + 2, preg, preg2); }
            if (c % CPI == 0) { float creg[32]; const P0Item Ic = p0_make_moe_item(wgu, wdn, p.ws, cbase + c / CPI); p0_item_load(Ic, creg, lane); p0_item_store(Ic, creg, cscr, lane); }
        } else {
            const LAS unsigned char* ab = cur + SC_KK + 128 * sel + fq * 16;
            const LAS unsigned char* wb = cur + SC_W + fq * 16;
            const LAS unsigned char* ub = cur + ubo;
            const LAS unsigned char* vb = cur + SC_V + (16 * wave + fr) * 2;
            bf16x8 cA0, cA1, nA0, nA1; u32x4 cU[2], nU[2]; f32x4 cW[4], nW[4]; unsigned cV, nV;
#define SC_LOAD(A0, A1, W, U, V, st) do { \
                A0 = *(const LAS bf16x8*)(ab + (st) * SC_STEPB); A1 = *(const LAS bf16x8*)(ab + (st) * SC_STEPB + 64); \
                _Pragma("unroll") for (int ct_ = 0; ct_ < 4; ++ct_) W[ct_] = *(const LAS f32x4*)(wb + (st) * SC_STEPB + ct_ * 64); \
                _Pragma("unroll") for (int cp_ = 0; cp_ < 2; ++cp_) U[cp_] = *(const LAS u32x4*)(ub + (st) * SC_STEPB + cp_ * ubs); \
                V = *(const LAS unsigned short*)(vb + (st) * SC_STEPB); } while (0)
            SC_LOAD(cA0, cA1, cW, cU, cV, 0);
#pragma unroll 1
            for (int g = 0; g < SC_TC / 4; ++g) {
#pragma unroll
                for (int u = 0; u < 4; ++u) {
                    const int st = 4 * g + u;
                    if (st + 1 < SC_TC) SC_LOAD(nA0, nA1, nW, nU, nV, st + 1);
                    f32x4 d = (f32x4){0.f, 0.f, 0.f, 0.f};
                    d = __builtin_amdgcn_mfma_f32_16x16x32_bf16(cA0, sb0, d, 0, 0, 0);
                    d = __builtin_amdgcn_mfma_f32_16x16x32_bf16(cA1, sb1, d, 0, 0, 0);
                    f32x4 cc[4];
#pragma unroll
                    for (int ct = 0; ct < 4; ++ct) {
#pragma unroll
                        for (int i = 0; i < 4; ++i) { float t = acc[ct][i] * cW[ct][i]; asm("" : "+v"(t)); cc[ct][i] = t; } }
                    yk = (((u + 3) & 3) == fq) ? d[1] : yk;
                    if (u == 0) {
                        const int tau = c * SC_TC + 4 * g - 4 + fq;
                        if (tau >= 0) { const int t = dir ? (SEQ - 1 - tau) : tau; yrow[(size_t)t * RC] = yk; } }
                    const float nsa = -d[0];
                    const unsigned t1 = cvtpk(nsa, nsa);
                    const float lo = nsa - __builtin_bit_cast(float, t1 & 0xffff0000u);
                    const unsigned t2 = cvtpk(lo, 0.f);
                    u32x4 bw; bw.x = cV | (t1 << 16); bw.y = t2; bw.z = 0u; bw.w = 0u;
                    const bf16x8 b2 = __builtin_bit_cast(bf16x8, bw);
#pragma unroll
                    for (int ct = 0; ct < 4; ++ct) { u32x4 aw; aw.x = (ct & 1) ? cU[ct >> 1].z : cU[ct >> 1].x; aw.y = (ct & 1) ? cU[ct >> 1].w : cU[ct >> 1].y; aw.z = 0u; aw.w = 0u;
                        acc[ct] = __builtin_amdgcn_mfma_f32_16x16x32_bf16(__builtin_bit_cast(bf16x8, aw), b2, cc[ct], 0, 0, 0); }
                    u32x4 p0, p1;
                    p0.x = cvtpk(acc[0][0], acc[0][1]); p0.y = cvtpk(acc[0][2], acc[0][3]); p0.z = cvtpk(acc[1][0], acc[1][1]); p0.w = cvtpk(acc[1][2], acc[1][3]);
                    p1.x = cvtpk(acc[2][0], acc[2][1]); p1.y = cvtpk(acc[2][2], acc[2][3]); p1.z = cvtpk(acc[3][0], acc[3][1]); p1.w = cvtpk(acc[3][2], acc[3][3]);
                    sb0 = __builtin_bit_cast(bf16x8, p0); sb1 = __builtin_bit_cast(bf16x8, p1);
                    cA0 = nA0; cA1 = nA1; cV = nV;
#pragma unroll
                    for (int i = 0; i < 4; ++i) cW[i] = nW[i];
                    cU[0] = nU[0]; cU[1] = nU[1];
                    asm volatile("" ::: "memory");
                }
            }
#undef SC_LOAD
        }
        __syncthreads();
    }
    if (wave < 4) {
        if (fq < 3) { const int tau = SEQ - 4 + fq, t = dir ? (SEQ - 1 - tau) : tau; yrow[(size_t)t * RC] = yk; }
        const int t = dir ? 0 : (SEQ - 1); const bf16_t* rr = (const bf16_t*)(sh + (size_t)t * 384);
        float accy = 0.f;
#pragma unroll
        for (int j = 0; j < 8; ++j) { accy += bf2f((unsigned)(unsigned short)sb0[j]) * bf2f(rr[16 * (j >> 2) + 4 * fq + (j & 3)]); accy += bf2f((unsigned)(unsigned short)sb1[j]) * bf2f(rr[32 + 16 * (j >> 2) + 4 * fq + (j & 3)]); }
        accy += __shfl_xor(accy, 16); accy += __shfl_xor(accy, 32);
        if (fq == 0) yrow[(size_t)t * RC] = accy;
    }
    __syncthreads();
}

constexpr int AT_P = 72;
constexpr int AT_KOFF = 0, AT_VOFF = 256 * AT_P * 2;
constexpr int ATT_DIL_UNITS = BATCH * AH * 48;
constexpr int ATT_MEM_UNITS = BATCH * MH * 16;
constexpr int ATT_UNITS = ATT_DIL_UNITS + ATT_MEM_UNITS;
struct AttU { const bf16_t* q; const bf16_t* k; const bf16_t* v; long qs, ks; int kind, win0, L, dil; float slope; bf16_t* o; long os; float* lse; long ls; };
__device__ __forceinline__ void att_make_unit(const Params& p, int u, AttU& U) {
    unsigned char* ws = p.ws; const bf16_t* PA = (const bf16_t*)(ws + WS_PA);
    if (u < ATT_DIL_UNITS) {
        const int bh = u / 48, x = u % 48, b = bh / AH, h = bh % AH, br = x >> 4, y = x & 15;
        const int dil = br == 0 ? 1 : (br == 1 ? 4 : 16), L = SEQ / dil, npr = L / 128, r = y / npr, np = y % npr;
        const bf16_t* base = PA + (size_t)(b * SEQ + r) * PA_W + h * 64;
        U.kind = 0; U.win0 = (2 * np - 1) * 64; U.L = L; U.dil = dil; U.slope = exp2f(-8.f * (float)(h + 1) / (float)AH);
        U.qs = (long)dil * PA_W; U.ks = U.qs;
        U.q = base + (long)(np * 128) * U.qs; U.k = base + AW; U.v = base + 2 * AW;
        const size_t tok0 = (size_t)(b * SEQ + r) + (size_t)np * 128 * dil;
        U.o = (bf16_t*)(ws + WS_ATTO) + (size_t)br * T * AW + tok0 * AW + h * 64; U.os = (long)dil * AW;
        U.lse = (float*)((unsigned char*)p.out + DO_LSE) + (size_t)br * T * AH + tok0 * AH + h; U.ls = (long)dil * AH;
    } else {
        const int v = u - ATT_DIL_UNITS, bh = v >> 4, qb = v & 15, b = bh / MH, h = bh % MH;
        const bf16_t* KVM = (const bf16_t*)(ws + WS_KVM);
        U.kind = 1; U.win0 = 0; U.L = NMEM; U.dil = 1; U.slope = 0.f;
        U.q = PA + (size_t)(b * SEQ + qb * 128) * PA_W + 3 * AW + h * 64; U.qs = PA_W;
        U.k = KVM + (size_t)(b * NMEM) * (2 * MW) + h * 64; U.v = U.k + MW; U.ks = 2 * MW;
        U.o = (bf16_t*)(ws + WS_YMIX) + (size_t)(b * SEQ + qb * 128) * D + RC + AW + h * 64; U.os = D;
        U.lse = nullptr; U.ls = 0;
    }
}
__device__ __forceinline__ void att_fetch(const AttU& U, u32x4 (&reg)[8], int tid) {
#pragma unroll
    for (int q = 0; q < 8; ++q) { const int rem = (tid + NTHR * q) & 2047, row = rem >> 3, ch = rem & 7; const int lk = U.win0 + row; const bool ok = lk >= 0 && lk < U.L;
        const bf16_t* src = (q < 4 ? U.k : U.v) + (long)(ok ? lk : 0) * U.ks + ch * 8;
        u32x4 raw = *(const u32x4*)src; if (!ok) raw = (u32x4){0u, 0u, 0u, 0u}; reg[q] = raw; }
}
__device__ __forceinline__ void att_put(LAS unsigned char* lds, const u32x4 (&reg)[8], int tid) {
#pragma unroll
    for (int q = 0; q < 8; ++q) { const int rem = (tid + NTHR * q) & 2047, row = rem >> 3, ch = rem & 7;
        *(LAS u32x4*)(lds + (q < 4 ? AT_KOFF : AT_VOFF) + row * (AT_P * 2) + ch * 16) = reg[q]; }
}
typedef short v4i16_t __attribute__((ext_vector_type(4)));
template <int NT  , bool DIL>
__device__ __forceinline__ void att_compute(const AttU& U, LAS unsigned char* lds, int w, int lane) {
    const int fr = lane & 15, fq = lane >> 4;
    const bf16_t* qp = U.q + (long)(16 * w + fr) * U.qs + fq * 8;
    const bf16x8 q0 = *(const bf16x8*)qp, q1 = *(const bf16x8*)(qp + 32);
    f32x4 sT[NT];
#pragma unroll
    for (int i = 0; i < NT; ++i) {
        if (DIL && i == 9) { sT[i] = (f32x4){-1e30f, -1e30f, -1e30f, -1e30f}; continue; }
        int tt = DIL ? w + i : i; tt = tt > 15 ? 15 : tt;
        const LAS unsigned char* kp = lds + AT_KOFF + (16 * tt + fr) * (AT_P * 2) + fq * 16;
        const bf16x8 k0 = *(const LAS bf16x8*)kp, k1 = *(const LAS bf16x8*)(kp + 64);
        f32x4 a = (f32x4){0.f, 0.f, 0.f, 0.f};
        a = __builtin_amdgcn_mfma_f32_16x16x32_bf16(k0, q0, a, 0, 0, 0);
        a = __builtin_amdgcn_mfma_f32_16x16x32_bf16(k1, q1, a, 0, 0, 0);
        sT[i] = a; if ((i & 3) == 3) asm volatile("" ::: "memory"); }
    float m = -3.0e38f;
    if (DIL) {
        const int c0 = 4 * fq - fr, lb = U.win0 + 16 * w + 4 * fq; const float sd = U.slope * (float)U.dil; const unsigned Lc = (unsigned)U.L;
#pragma unroll
        for (int i = 0; i < NT; ++i) { if (i == 9) continue;
#pragma unroll
            for (int r = 0; r < 4; ++r) { const int dl = 16 * i + r - 64 + c0, ad = dl < 0 ? -dl : dl;
                bool valid = (unsigned)(lb + 16 * i + r) < Lc; if (i == 0 || i >= 7) valid = valid && ad <= 64;
                const float sv = valid ? sT[i][r] - sd * (float)ad : -1e30f; sT[i][r] = sv; m = fmaxf(m, sv); } }
    } else {
#pragma unroll
        for (int i = 0; i < NT; ++i)
#pragma unroll
            for (int r = 0; r < 4; ++r) m = fmaxf(m, sT[i][r]);
    }
    m = fmaxf(m, __shfl_xor(m, 16)); m = fmaxf(m, __shfl_xor(m, 32));
    float l = 0.f;
#pragma unroll
    for (int i = 0; i < NT; ++i)
#pragma unroll
        for (int r = 0; r < 4; ++r) { const float e = __expf(sT[i][r] - m); sT[i][r] = e; l += e; }
    l += __shfl_xor(l, 16); l += __shfl_xor(l, 32);
    f32x4 oT[4];
#pragma unroll
    for (int dt = 0; dt < 4; ++dt) oT[dt] = (f32x4){0.f, 0.f, 0.f, 0.f};
#pragma unroll
    for (int tp = 0; tp < NT / 2; ++tp) {
        int ta = DIL ? w + 2 * tp : 2 * tp, tb = ta + 1; ta = ta > 15 ? 15 : ta; tb = tb > 15 ? 15 : tb;
        u32x4 pw; pw.x = pk2(sT[2 * tp][0], sT[2 * tp][1]); pw.y = pk2(sT[2 * tp][2], sT[2 * tp][3]); pw.z = pk2(sT[2 * tp + 1][0], sT[2 * tp + 1][1]); pw.w = pk2(sT[2 * tp + 1][2], sT[2 * tp + 1][3]);
        const bf16x8 pb = __builtin_bit_cast(bf16x8, pw);
        const LAS unsigned char* va = lds + AT_VOFF + (16 * ta + 4 * fq + (fr >> 2)) * (AT_P * 2) + 8 * (fr & 3);
        const LAS unsigned char* vb = lds + AT_VOFF + (16 * tb + 4 * fq + (fr >> 2)) * (AT_P * 2) + 8 * (fr & 3);
#pragma unroll
        for (int dt = 0; dt < 4; ++dt) {
            const v4i16_t lo = __builtin_amdgcn_ds_read_tr16_b64_v4i16((LAS v4i16_t*)(va + 32 * dt)), hi = __builtin_amdgcn_ds_read_tr16_b64_v4i16((LAS v4i16_t*)(vb + 32 * dt));
            bf16x8 vf; vf[0] = lo[0]; vf[1] = lo[1]; vf[2] = lo[2]; vf[3] = lo[3]; vf[4] = hi[0]; vf[5] = hi[1]; vf[6] = hi[2]; vf[7] = hi[3];
            oT[dt] = __builtin_amdgcn_mfma_f32_16x16x32_bf16(vf, pb, oT[dt], 0, 0, 0); }
        if (tp & 1) asm volatile("" ::: "memory");
    }
    const float inv = 1.f / l;
    bf16_t* op = U.o + (long)(16 * w + fr) * U.os;
#pragma unroll
    for (int dt = 0; dt < 4; ++dt) { u32x2 o; o.x = pk2(oT[dt][0] * inv, oT[dt][1] * inv); o.y = pk2(oT[dt][2] * inv, oT[dt][3] * inv); *(u32x2*)(op + 16 * dt + 4 * fq) = o; }
    if (DIL && fq == 0) U.lse[(long)(16 * w + fr) * U.ls] = m + __logf(l);
}
__device__ __forceinline__ void phase3(const Params& p, LAS unsigned char* lds, int rep) {
    const int tid = threadIdx.x, lane = tid & 63, wave = tid >> 6;
    unsigned* ctl = (unsigned*)(p.ws + WS_CTL);
    LAS unsigned* bc = (LAS unsigned*)(lds + 131072 + 1280);
    for (;;) {
        __syncthreads();
        if (tid == 0) bc[0] = atomicAdd(ctl + CW_SCANQ + 16 * rep, 1u);
        __syncthreads();
        const unsigned sid = __builtin_amdgcn_readfirstlane(bc[0]);
        if (sid >= 2u * BATCH * RH) break;
#pragma unroll 1
        for (int tw = 0; tw < (REPEAT_PHASE == 31 ? 2 : 1); ++tw) scan_block(p, lds, (int)sid);
    }
    constexpr unsigned ATT_BATCH = 2;
    for (;;) {
        __syncthreads();
        if (tid == 0) bc[1] = atomicAdd(ctl + CW_ATTQ + 16 * rep, ATT_BATCH);
        __syncthreads();
        const unsigned ubase = __builtin_amdgcn_readfirstlane(bc[1]);
        if (ubase >= (unsigned)ATT_UNITS) break;
        const unsigned uend = ubase + ATT_BATCH < (unsigned)ATT_UNITS ? ubase + ATT_BATCH : (unsigned)ATT_UNITS;
        { AttU U; att_make_unit(p, (int)ubase, U); u32x4 reg[8]; att_fetch(U, reg, tid); att_put(lds, reg, tid); }
#pragma unroll 1
        for (unsigned ucur = ubase; ucur < uend; ++ucur) {
            __syncthreads();
            u32x4 reg[8];
            if (ucur + 1 < uend) { AttU Un; att_make_unit(p, (int)ucur + 1, Un); att_fetch(Un, reg, tid); }
            { AttU U; att_make_unit(p, (int)ucur, U);
#pragma unroll 1
              for (int tw = 0; tw < (REPEAT_PHASE == 32 ? 2 : 1); ++tw) {
                if (ucur < (unsigned)ATT_DIL_UNITS) att_compute<10, true>(U, lds, wave, lane); else att_compute<16, false>(U, lds, wave, lane); } }
            __syncthreads();
            if (ucur + 1 < uend) att_put(lds, reg, tid);
        }
    }
}

__device__ __forceinline__ void phase4(const Params& p) {
    const int tid = threadIdx.x, lane = tid & 63, wave = tid >> 6;
    const int gw = blockIdx.x * NWAVES + wave, NGW = gridDim.x * NWAVES;
    unsigned char* ws = p.ws; const unsigned char* dob = (const unsigned char*)p.out;
    const float* Yf = (const float*)(dob + DO_Y); const float* Yb = Yf + (size_t)T * RC;
    const bf16_t* G = (const bf16_t*)(dob + DO_G); const float* LSE = (const float*)(dob + DO_LSE);
    const float* BON = (const float*)(ws + WS_BONUS); const float* SSH = (const float*)(ws + WS_SSH);
    const bf16_t* AO = (const bf16_t*)(ws + WS_ATTO); bf16_t* YM = (bf16_t*)(ws + WS_YMIX);
    for (int t = gw; t < T; t += NGW) {
        const int b = t >> 11, s = t & (SEQ - 1);
        float yf[RH], yb[RH], vv[RH], bo[RH]; unsigned short gg[RH], a0[AH], a1[AH], a2[AH]; float l0[AH], l1[AH], l2[AH];
#pragma unroll
        for (int h = 0; h < RH; ++h) { const int ch = h * 64 + lane;
            yf[h] = Yf[(size_t)t * RC + ch]; yb[h] = Yb[(size_t)t * RC + ch]; gg[h] = G[(size_t)t * RC + ch];
            vv[h] = bf2f(((const bf16_t*)SSH)[((size_t)(b * RH + h) * SEQ + s) * 192 + 64 + lane]); bo[h] = BON[t * RH + h];
            a0[h] = AO[(size_t)t * AW + ch]; a1[h] = AO[(size_t)T * AW + (size_t)t * AW + ch]; a2[h] = AO[(size_t)2 * T * AW + (size_t)t * AW + ch];
            l0[h] = LSE[(size_t)t * AH + h]; l1[h] = LSE[(size_t)T * AH + (size_t)t * AH + h]; l2[h] = LSE[(size_t)2 * T * AH + (size_t)t * AH + h]; }
#pragma unroll
        for (int h = 0; h < RH; ++h) { const int ch = h * 64 + lane;
            const float y = yf[h] + yb[h];
            const float mean = wave_sum(y) * (1.f / 64.f); const float dlt = y - mean; const float var = wave_sum(dlt * dlt) * (1.f / 64.f);
            const float yn = dlt * (1.f / sqrtf(var + GN_EPS)) * p.in[14][ch] + p.in[15][ch];
            const float o = (yn + bo[h] * vv[h]) * bf2f(gg[h]);
            YM[(size_t)t * D + ch] = (bf16_t)f2bf(o); }
#pragma unroll
        for (int h = 0; h < AH; ++h) { const int ch = h * 64 + lane;
            const float mx = fmaxf(l0[h], fmaxf(l1[h], l2[h])); const float e0 = __expf(l0[h] - mx), e1 = __expf(l1[h] - mx), e2 = __expf(l2[h] - mx); const float inv = 1.f / (e0 + e1 + e2);
            const float o = (e0 * bf2f(a0[h]) + e1 * bf2f(a1[h]) + e2 * bf2f(a2[h])) * inv;
            YM[(size_t)t * D + RC + ch] = (bf16_t)f2bf(o); }
    }
}

struct PolP5 {
    static constexpr bool PERM = false, GATHER = false;
    const bf16_t* A; const bf16_t* Bt; const bf16_t* H0B; float* PRE; int G, c;
    __device__ __forceinline__ bool next(int i, pg8::Unit& u) const { int pm, pn; if (!pg8::static_order(T / 256, D / 256, G, c, i, pm, pn)) return false;
        u.A = (const char*)(A + (size_t)pm * 256 * D); u.B0 = (const char*)(Bt + (size_t)pn * 256 * D); u.B1 = u.B0 + (size_t)128 * D * 2; u.x0 = pm; u.x1 = pn; u.x2 = 0; u.x3 = 0; u.x4 = 0; return true; }
    __device__ __forceinline__ void epi(const f32x4 (&acc)[2][2][4][2], const pg8::Unit& u, int wr, int wc, int fr, int fq) const {
        const int row0 = u.x0 * 256 + wr * 64 + fr, col0 = u.x1 * 256 + wc * 32 + 4 * fq;
        u32x2 hb[2][4][2][2];
#pragma unroll
        for (int ai = 0; ai < 2; ++ai)
#pragma unroll
            for (int m = 0; m < 4; ++m)
#pragma unroll
                for (int bj = 0; bj < 2; ++bj)
#pragma unroll
                    for (int n = 0; n < 2; ++n) hb[ai][m][bj][n] = *(const u32x2*)(H0B + (size_t)(row0 + ai * 128 + m * 16) * D + col0 + bj * 128 + n * 16);
#pragma unroll
        for (int ai = 0; ai < 2; ++ai)
#pragma unroll
            for (int m = 0; m < 4; ++m) { const size_t ro = (size_t)(row0 + ai * 128 + m * 16) * D + col0;
#pragma unroll
                for (int bj = 0; bj < 2; ++bj)
#pragma unroll
                    for (int n = 0; n < 2; ++n) { const size_t off = ro + bj * 128 + n * 16; const u32x2 h2 = hb[ai][m][bj][n]; const f32x4 v = acc[ai][bj][m][n];
                        f32x4 o; o.x = v.x + ALPHA * bflo(h2.x); o.y = v.y + ALPHA * bfhi(h2.x); o.z = v.z + ALPHA * bflo(h2.y); o.w = v.w + ALPHA * bfhi(h2.y); *(f32x4*)(PRE + off) = o; } }
    }
};
__device__ __forceinline__ void phase5(const Params& p, LAS unsigned char* lds) {
    unsigned char* ws = p.ws;
    PolP5 P{(const bf16_t*)(ws + WS_YMIX), (const bf16_t*)(ws + WS_WT_OUT), (const bf16_t*)(ws + WS_H0B), p.out, (int)gridDim.x, (int)blockIdx.x};
    pg8::gemm_phase(lds, P, D, (PROBE_GEMM == 5 && blockIdx.x == 0) ? (unsigned long long*)(ws + WS_CTL + 32768) : nullptr);
}

constexpr int P6_TP = 1032;
constexpr int P6_TH = 0, P6_TL = 16 * P6_TP * 2, P6_PART = 2 * 16 * P6_TP * 2, P6_LC = P6_PART + 8 * 16 * 32 * 4, P6_BASE = P6_LC + 128, P6_ENT = P6_BASE + 128, P6_MAXENT = 2048;
__device__ __forceinline__ void phase6(const Params& p, LAS unsigned char* lds, int rep) {
    const int tid = threadIdx.x, lane = tid & 63, wave = tid >> 6, fr = lane & 15, fq = lane >> 4;
    unsigned char* ws = p.ws; unsigned* ctl = (unsigned*)(ws + WS_CTL);
    const bf16_t* WRH = (const bf16_t*)(ws + WS_WRT); const bf16_t* WRL = WRH + NE * D;
    LAS bf16_t* TH = (LAS bf16_t*)(lds + P6_TH); LAS bf16_t* TL = (LAS bf16_t*)(lds + P6_TL); LAS float* PART = (LAS float*)(lds + P6_PART);
    LAS int* LC = (LAS int*)(lds + P6_LC); LAS int* BASE = (LAS int*)(lds + P6_BASE); LAS int* ENT = (LAS int*)(lds + P6_ENT);
    int* LIST = (int*)(ws + WS_LIST); float* RG = (float*)(ws + WS_ROWGATE); int* SEL = (int*)(ws + WS_SEL);
    __syncthreads();
    if (tid < NE) LC[tid] = 0;
    __syncthreads();
    int it = 0;
    for (int tile = blockIdx.x; tile < T / 16; tile += gridDim.x, ++it) {
        const int t0 = tile * 16;
#pragma unroll
        for (int q = 0; q < 2; ++q) { const int tt = 2 * wave + q, t = t0 + tt;
            const f32x4* xr = (const f32x4*)(p.out + (size_t)t * D) + lane; f32x4 v[4];
#pragma unroll
            for (int j = 0; j < 4; ++j) v[j] = xr[64 * j];
            ln_row(v, p.in[18], p.in[19], lane);
            bf16_t* orow = (bf16_t*)(ws + WS_H1B) + (size_t)t * D;
#pragma unroll
            for (int j = 0; j < 4; ++j) { const unsigned h0 = f2bf(v[j].x), h1 = f2bf(v[j].y), h2 = f2bf(v[j].z), h3 = f2bf(v[j].w);
                u32x2 hi; hi.x = h0 | (h1 << 16); hi.y = h2 | (h3 << 16);
                u32x2 lo; lo.x = pk2(v[j].x - bf2f(h0), v[j].y - bf2f(h1)); lo.y = pk2(v[j].z - bf2f(h2), v[j].w - bf2f(h3));
                *(u32x2*)(orow + 4 * lane + 256 * j) = hi;
                *(LAS u32x2*)(TH + tt * P6_TP + 4 * lane + 256 * j) = hi; *(LAS u32x2*)(TL + tt * P6_TP + 4 * lane + 256 * j) = lo; } }
        __syncthreads();
        f32x4 acc0 = (f32x4){0.f, 0.f, 0.f, 0.f}, acc1 = acc0;
#pragma unroll
        for (int ks = 0; ks < 4; ++ks) { const int k0 = 128 * wave + 32 * ks + 8 * fq;
            const bf16x8 ah = *(const LAS bf16x8*)(TH + fr * P6_TP + k0), al = *(const LAS bf16x8*)(TL + fr * P6_TP + k0);
            const bf16x8 bh0 = *(const bf16x8*)(WRH + (size_t)fr * D + k0), bl0 = *(const bf16x8*)(WRL + (size_t)fr * D + k0);
            const bf16x8 bh1 = *(const bf16x8*)(WRH + (size_t)(16 + fr) * D + k0), bl1 = *(const bf16x8*)(WRL + (size_t)(16 + fr) * D + k0);
            acc0 = __builtin_amdgcn_mfma_f32_16x16x32_bf16(ah, bh0, acc0, 0, 0, 0); acc0 = __builtin_amdgcn_mfma_f32_16x16x32_bf16(ah, bl0, acc0, 0, 0, 0); acc0 = __builtin_amdgcn_mfma_f32_16x16x32_bf16(al, bh0, acc0, 0, 0, 0);
            acc1 = __builtin_amdgcn_mfma_f32_16x16x32_bf16(ah, bh1, acc1, 0, 0, 0); acc1 = __builtin_amdgcn_mfma_f32_16x16x32_bf16(ah, bl1, acc1, 0, 0, 0); acc1 = __builtin_amdgcn_mfma_f32_16x16x32_bf16(al, bh1, acc1, 0, 0, 0); }
#pragma unroll
        for (int r = 0; r < 4; ++r) { PART[(wave * 16 + 4 * fq + r) * 32 + fr] = acc0[r]; PART[(wave * 16 + 4 * fq + r) * 32 + 16 + fr] = acc1[r]; }
        __syncthreads();
        const int e = lane & 31, tt = 2 * wave + (lane >> 5), t = t0 + tt;
        float logit = p.in[21][e];
#pragma unroll
        for (int v = 0; v < 8; ++v) logit += PART[(v * 16 + tt) * 32 + e];
        float cur = logit; float tv0 = 0.f, tv1 = 0.f, tv2 = 0.f, tv3 = 0.f; int te0 = 0, te1 = 0, te2 = 0, te3 = 0;
#pragma unroll
        for (int k = 0; k < 4; ++k) { float bv = cur; int bi = e;
#pragma unroll
            for (int o = 1; o < 32; o <<= 1) { const float ov = __shfl_xor(bv, o); const int oi = __shfl_xor(bi, o); if (ov > bv || (ov == bv && oi < bi)) { bv = ov; bi = oi; } }
            if (k == 0) { tv0 = bv; te0 = bi; } if (k == 1) { tv1 = bv; te1 = bi; } if (k == 2) { tv2 = bv; te2 = bi; } if (k == 3) { tv3 = bv; te3 = bi; }
            if (e == bi) cur = -3.0e38f; }
        const float e1 = __expf(tv1 - tv0), e2 = __expf(tv2 - tv0), e3 = __expf(tv3 - tv0); const float inv = 1.f / (1.f + e1 + e2 + e3);
        if (e < 4) { int ee = te0; float gg = inv;
            if (e == 1) { ee = te1; gg = e1 * inv; } if (e == 2) { ee = te2; gg = e2 * inv; } if (e == 3) { ee = te3; gg = e3 * inv; }
            const int lr = __hip_atomic_fetch_add((int*)(LC + ee), 1, __ATOMIC_RELAXED, __HIP_MEMORY_SCOPE_WORKGROUP); const int n = (it * 16 + tt) * 4 + e;
            if (n < P6_MAXENT) { ENT[4 * n] = t * 4 + e; ENT[4 * n + 1] = ee; ENT[4 * n + 2] = lr; ENT[4 * n + 3] = __builtin_bit_cast(int, gg); } }
    }
    __syncthreads();
    if (tid < NE) BASE[tid] = (int)atomicAdd(ctl + CW_CNT + 32 * rep + tid, (unsigned)LC[tid]);
    __syncthreads();
    const int nent = it * 64 < P6_MAXENT ? it * 64 : P6_MAXENT;
    for (int n = tid; n < nent; n += NTHR) { const int tk = ENT[4 * n], ee = ENT[4 * n + 1], rank = BASE[ee] + ENT[4 * n + 2];
        LIST[(size_t)ee * T + rank] = tk >> 2; RG[(size_t)ee * T + rank] = __builtin_bit_cast(float, ENT[4 * n + 3]); SEL[(size_t)tk * 2] = ee; SEL[(size_t)tk * 2 + 1] = rank; }
}

__device__ __forceinline__ void build_expert_tables(const Params& p, LAS int* tab) {
    const unsigned* ctl = (const unsigned*)(p.ws + WS_CTL);
    __syncthreads();
    if (threadIdx.x < NE) tab[threadIdx.x] = (int)__hip_atomic_load(ctl + CW_CNT + CNT_SET + threadIdx.x, __ATOMIC_RELAXED, __HIP_MEMORY_SCOPE_AGENT);
    __syncthreads();
    if (threadIdx.x == 0) { int ps = 0, ts = 0;
        for (int e = 0; e < NE; ++e) { const int c = tab[e]; tab[32 + e] = ps; tab[64 + e] = ts; ps += (c + 255) / 256 * 256; ts += (c + 127) / 128; }
        tab[64 + NE] = ts; }
    __syncthreads();
}

constexpr int TAB_OFF = 131072, UTAB_OFF = 100, UTAB_MAX = 48;
constexpr int IDX_OFF = 131072 + 2048, IDX_UNITS = 20;
__device__ __forceinline__ void build_expert_tables256(const Params& p, LAS int* tab, int npn  ) {
    const unsigned* ctl = (const unsigned*)(p.ws + WS_CTL);
    __syncthreads();
    if (threadIdx.x < NE) tab[threadIdx.x] = (int)__hip_atomic_load(ctl + CW_CNT + CNT_SET + threadIdx.x, __ATOMIC_RELAXED, __HIP_MEMORY_SCOPE_AGENT);
    __syncthreads();
    if (threadIdx.x == 0) { int ps = 0, ts = 0;
        for (int e = 0; e < NE; ++e) { const int c = tab[e]; tab[32 + e] = ps; tab[64 + e] = ts; ps += (c + 255) / 256 * 256; ts += (c + 255) / 256; }
        tab[64 + NE] = ts;
        int e = 0, n = 0;
        if (gridDim.x == 256) { const int g = blockIdx.x & 7, sl = blockIdx.x >> 3, mpx = 32 / npn  , mround = 8 * mpx;
            for (int i = 0; n < UTAB_MAX; ++i) { const int mt_g = i * mround + g * mpx + sl / npn, pn = sl % npn; if (i * mround >= ts) break; if (mt_g >= ts) continue;
                while (e + 1 < NE && mt_g >= tab[64 + e + 1]) ++e;
                const int r0 = (mt_g - tab[64 + e]) * 256;
                tab[UTAB_OFF + 4 * n] = e; tab[UTAB_OFF + 4 * n + 1] = r0; tab[UTAB_OFF + 4 * n + 2] = pn; tab[UTAB_OFF + 4 * n + 3] = tab[32 + e] + r0; ++n; }
        } else { const int nun = ts * npn;
        for (int L = blockIdx.x; L < nun && n < UTAB_MAX; L += gridDim.x, ++n) { const int pn = L % npn, mt_g = L / npn;
            while (e + 1 < NE && mt_g >= tab[64 + e + 1]) ++e;
            const int r0 = (mt_g - tab[64 + e]) * 256;
            tab[UTAB_OFF + 4 * n] = e; tab[UTAB_OFF + 4 * n + 1] = r0; tab[UTAB_OFF + 4 * n + 2] = pn; tab[UTAB_OFF + 4 * n + 3] = tab[32 + e] + r0; } }
        tab[98] = n; }
    __syncthreads();
}
struct PolP7 {
    static constexpr bool PERM = true, GATHER = true;
    const bf16_t* H1B; const bf16_t* WG; const LAS int* IDX; bf16_t* ACT; const float* BGU; const LAS int* tab; int G, c;
    __device__ __forceinline__ bool next(int i, pg8::Unit& u) const { if (i >= __builtin_amdgcn_readfirstlane(tab[98])) return false;
        const int e = __builtin_amdgcn_readfirstlane(tab[UTAB_OFF + 4 * i]), r0 = __builtin_amdgcn_readfirstlane(tab[UTAB_OFF + 4 * i + 1]), pn = __builtin_amdgcn_readfirstlane(tab[UTAB_OFF + 4 * i + 2]);
        u.A = (const char*)H1B; u.B0 = (const char*)(WG + ((size_t)e * 2 * FF + pn * 128) * D); u.B1 = u.B0 + (size_t)FF * D * 2;
        u.x0 = e; u.x1 = i; u.x2 = pn; u.x3 = __builtin_amdgcn_readfirstlane(tab[UTAB_OFF + 4 * i + 3]); u.x4 = __builtin_amdgcn_readfirstlane(tab[e]) - r0; return true; }
    __device__ __forceinline__ void rows_issue(const pg8::Unit& u, int R0, unsigned (&raw)[2][2]) const { const LAS int* lst = IDX + u.x1 * 256 + R0;
#pragma unroll
        for (int h = 0; h < 2; ++h)
#pragma unroll
            for (int i = 0; i < 2; ++i) raw[h][i] = (unsigned)lst[h * 128 + i * 64]; }
    __device__ __forceinline__ void rows_finish(int C0, int K, unsigned (&raw)[2][2]) const {
#pragma unroll
        for (int h = 0; h < 2; ++h)
#pragma unroll
            for (int i = 0; i < 2; ++i) raw[h][i] = (raw[h][i] * (unsigned)K + (unsigned)C0) * 2u; }
    __device__ __forceinline__ void epi(const f32x4 (&acc)[2][2][4][2], const pg8::Unit& u, int wr, int wc, int fr, int fq) const {
        const int e = u.x0, f0 = u.x2 * 128 + wc * 32 + 8 * fq;
        const float* bias = BGU + (size_t)e * 2 * FF + f0;
        const f32x4 bg0 = *(const f32x4*)bias, bg1 = *(const f32x4*)(bias + 4), bu0 = *(const f32x4*)(bias + FF), bu1 = *(const f32x4*)(bias + FF + 4);
#pragma unroll
        for (int ai = 0; ai < 2; ++ai)
#pragma unroll
            for (int m = 0; m < 4; ++m) { const int r = ai * 128 + wr * 64 + m * 16 + fr;
                const f32x4 g0 = acc[ai][0][m][0] + bg0, g1 = acc[ai][0][m][1] + bg1, u0 = acc[ai][1][m][0] + bu0, u1 = acc[ai][1][m][1] + bu1;
                float a[8];
#pragma unroll
                for (int j = 0; j < 4; ++j) {
                    const float gc = fminf(g0[j], 7.f), uc = __builtin_amdgcn_fmed3f(u0[j], -7.f, 7.f);
                    a[j] = __builtin_fmaf(uc, gc, gc) * __builtin_amdgcn_rcpf(1.f + __builtin_amdgcn_exp2f(-2.4554669595930157f * gc));
                    const float gd = fminf(g1[j], 7.f), ud = __builtin_amdgcn_fmed3f(u1[j], -7.f, 7.f);
                    a[4 + j] = __builtin_fmaf(ud, gd, gd) * __builtin_amdgcn_rcpf(1.f + __builtin_amdgcn_exp2f(-2.4554669595930157f * gd)); }
                { u32x4 w; w.x = pg8::cvt_pk_bf16(a[0], a[1]); w.y = pg8::cvt_pk_bf16(a[2], a[3]); w.z = pg8::cvt_pk_bf16(a[4], a[5]); w.w = pg8::cvt_pk_bf16(a[6], a[7]);
                    *(u32x4*)(ACT + (size_t)(u.x3 + r) * FF + f0) = w; } }
    }
};
__device__ __forceinline__ void phase7(const Params& p, LAS unsigned char* lds) {
    LAS int* tab = (LAS int*)(lds + TAB_OFF); build_expert_tables256(p, tab, 8);
    unsigned char* ws = p.ws;
    LAS int* IDX = (LAS int*)(lds + IDX_OFF);
    { const int* LIST = (const int*)(ws + WS_LIST); const int nun = tab[98] < IDX_UNITS ? tab[98] : IDX_UNITS;
      for (int j = threadIdx.x; j < nun * 256; j += NTHR) { const int n = j >> 8, i = j & 255, e = tab[UTAB_OFF + 4 * n], r0 = tab[UTAB_OFF + 4 * n + 1], nval = tab[e] - r0;
          IDX[j] = LIST[(size_t)e * T + r0 + (i < nval ? i : 0)]; }
      __syncthreads(); }
    PolP7 P{(const bf16_t*)(ws + WS_H1B), (const bf16_t*)(ws + WS_WT_GU), IDX, (bf16_t*)(ws + WS_ACT), p.in[23], tab, (int)gridDim.x, (int)blockIdx.x};
    pg8::gemm_phase(lds, P, D, (PROBE_GEMM == 7 && blockIdx.x == 0) ? (unsigned long long*)(ws + WS_CTL + 32768) : nullptr);
}

struct PolP8 {
    static constexpr bool PERM = true, GATHER = false;
    const bf16_t* ACT; const bf16_t* WD; const float* RG; bf16_t* YR; const float* BD; const LAS int* tab; int G, c;
    __device__ __forceinline__ bool next(int i, pg8::Unit& u) const { if (i >= __builtin_amdgcn_readfirstlane(tab[98])) return false;
        const int e = __builtin_amdgcn_readfirstlane(tab[UTAB_OFF + 4 * i]), r0 = __builtin_amdgcn_readfirstlane(tab[UTAB_OFF + 4 * i + 1]), pn = __builtin_amdgcn_readfirstlane(tab[UTAB_OFF + 4 * i + 2]), prow0 = __builtin_amdgcn_readfirstlane(tab[UTAB_OFF + 4 * i + 3]);
        u.A = (const char*)(ACT + (size_t)prow0 * FF); u.B0 = (const char*)(WD + ((size_t)e * D + pn * 256) * FF); u.B1 = u.B0 + (size_t)128 * FF * 2;
        u.x4 = __builtin_amdgcn_readfirstlane(tab[e]) - r0;
        u.x0 = e; u.x1 = r0; u.x2 = pn; u.x3 = prow0; return true; }
    __device__ __forceinline__ void epi(const f32x4 (&acc)[2][2][4][2], const pg8::Unit& u, int wr, int wc, int fr, int fq) const {
        const int e = u.x0, nval = u.x4; const float* rg = RG + (size_t)e * T + u.x1;
        float gt[2][4];
#pragma unroll
        for (int ai = 0; ai < 2; ++ai)
#pragma unroll
            for (int m = 0; m < 4; ++m) { const int r = ai * 128 + wr * 64 + m * 16 + fr; gt[ai][m] = rg[r < nval ? r : 0]; }
        f32x4 bs[2][2];
#pragma unroll
        for (int bj = 0; bj < 2; ++bj) { const float* bias = BD + (size_t)e * D + u.x2 * 256 + bj * 128 + wc * 32 + 8 * fq; bs[bj][0] = *(const f32x4*)bias; bs[bj][1] = *(const f32x4*)(bias + 4); }
#pragma unroll
        for (int ai = 0; ai < 2; ++ai)
#pragma unroll
            for (int m = 0; m < 4; ++m) { const int r = ai * 128 + wr * 64 + m * 16 + fr; const float g = gt[ai][m];
#pragma unroll
                for (int bj = 0; bj < 2; ++bj) { const int col = u.x2 * 256 + bj * 128 + wc * 32 + 8 * fq;
                    const f32x4 v0 = (acc[ai][bj][m][0] + bs[bj][0]) * g, v1 = (acc[ai][bj][m][1] + bs[bj][1]) * g;
                    u32x4 w; w.x = pg8::cvt_pk_bf16(v0[0], v0[1]); w.y = pg8::cvt_pk_bf16(v0[2], v0[3]); w.z = pg8::cvt_pk_bf16(v1[0], v1[1]); w.w = pg8::cvt_pk_bf16(v1[2], v1[3]);
                    *(u32x4*)(YR + (size_t)(u.x3 + r) * D + col) = w; } }
    }
};
__device__ __forceinline__ void phase8(const Params& p, LAS unsigned char* lds) {
    LAS int* tab = (LAS int*)(lds + TAB_OFF); build_expert_tables256(p, tab, 4);
    unsigned char* ws = p.ws;
    PolP8 P{(const bf16_t*)(ws + WS_ACT), (const bf16_t*)(ws + WS_WT_DN), (const float*)(ws + WS_ROWGATE), (bf16_t*)(ws + WS_YROWS), p.in[25], tab, (int)gridDim.x, (int)blockIdx.x};
    pg8::gemm_phase(lds, P, FF, (PROBE_GEMM == 8 && blockIdx.x == 0) ? (unsigned long long*)(ws + WS_CTL + 32768) : nullptr);
}

__device__ __forceinline__ void phase9(const Params& p, LAS unsigned char* lds) {
    LAS int* tab = (LAS int*)lds; build_expert_tables(p, tab);
    const int tid = threadIdx.x, lane = tid & 63, wave = tid >> 6;
    const int gw = blockIdx.x * NWAVES + wave, NGW = gridDim.x * NWAVES;
    unsigned char* ws = p.ws; const bf16_t* H1B = (const bf16_t*)(ws + WS_H1B); const bf16_t* YR = (const bf16_t*)(ws + WS_YROWS); const int* SEL = (const int*)(ws + WS_SEL);
    typedef int i32x4 __attribute__((ext_vector_type(4)));
    i32x4 sa = {0, 0, 0, 0}, sb = sa;
    if (gw < T) { sa = *(const i32x4*)(SEL + (size_t)gw * 8); sb = *(const i32x4*)(SEL + (size_t)gw * 8 + 4); }
    for (int t = gw; t < T; t += NGW) {
        const i32x4 ca = sa, cb = sb;
        if (t + NGW < T) { sa = *(const i32x4*)(SEL + (size_t)(t + NGW) * 8); sb = *(const i32x4*)(SEL + (size_t)(t + NGW) * 8 + 4); }
        const bf16_t* y0 = YR + (size_t)(tab[32 + ca.x] + ca.y) * D + 4 * lane; const bf16_t* y1 = YR + (size_t)(tab[32 + ca.z] + ca.w) * D + 4 * lane;
        const bf16_t* y2 = YR + (size_t)(tab[32 + cb.x] + cb.y) * D + 4 * lane; const bf16_t* y3 = YR + (size_t)(tab[32 + cb.z] + cb.w) * D + 4 * lane;
        const bf16_t* hr = H1B + (size_t)t * D + 4 * lane;
        u32x2 hb[4], q0[4], q1[4], q2[4], q3[4];
#pragma unroll
        for (int j = 0; j < 4; ++j) { hb[j] = *(const u32x2*)(hr + 256 * j); q0[j] = *(const u32x2*)(y0 + 256 * j); q1[j] = *(const u32x2*)(y1 + 256 * j); q2[j] = *(const u32x2*)(y2 + 256 * j); q3[j] = *(const u32x2*)(y3 + 256 * j); }
        f32x4 v[4];
#pragma unroll
        for (int j = 0; j < 4; ++j) {
            v[j].x = ALPHA * bflo(hb[j].x) + ((bflo(q0[j].x) + bflo(q1[j].x)) + (bflo(q2[j].x) + bflo(q3[j].x)));
            v[j].y = ALPHA * bfhi(hb[j].x) + ((bfhi(q0[j].x) + bfhi(q1[j].x)) + (bfhi(q2[j].x) + bfhi(q3[j].x)));
            v[j].z = ALPHA * bflo(hb[j].y) + ((bflo(q0[j].y) + bflo(q1[j].y)) + (bflo(q2[j].y) + bflo(q3[j].y)));
            v[j].w = ALPHA * bfhi(hb[j].y) + ((bfhi(q0[j].y) + bfhi(q1[j].y)) + (bfhi(q2[j].y) + bfhi(q3[j].y))); }
        ln_row(v, p.in[26], p.in[27], lane);
        f32x4* orow = (f32x4*)(p.out + (size_t)t * D) + lane;
#pragma unroll
        for (int j = 0; j < 4; ++j) orow[64 * j] = v[j];
    }
}

#define XB_TMO      128
#define XB_XCNT(j)  (256  + 64 * (j))
#define XB_XSUB(j)  (1280 + 64 * (j))
#define XB_XGEN(j)  (2304 + 64 * (j))
#define XB_TOP      3328
#define XB_TOPGEN   3392
#define XCD_BAR_WORDS 3456
#define XB_SPIN_CAP (1u << 22)
__device__ __forceinline__ unsigned xb_ld(unsigned* p)              { return __hip_atomic_load(p, __ATOMIC_RELAXED, __HIP_MEMORY_SCOPE_AGENT); }
__device__ __forceinline__ unsigned xb_add(unsigned* p, unsigned v) { return __hip_atomic_fetch_add(p, v, __ATOMIC_RELAXED, __HIP_MEMORY_SCOPE_AGENT); }
__device__ __forceinline__ unsigned xb_xcc_id() { return (unsigned)__builtin_amdgcn_s_getreg((3 << 11) | 20) & 0xFu; }
#define XB_SPIN(cond, bar) do { unsigned _sp = 0; while (cond) { __builtin_amdgcn_s_sleep(1); \
    if ((++_sp & 255u) == 0u) { if (xb_ld(&(bar)[XB_TMO])) break; if (_sp > XB_SPIN_CAP) { atomicAdd(&(bar)[XB_TMO], 1u); break; } } } } while (0)
struct XcdBarrier { unsigned* bar; unsigned x; volatile LAS unsigned* st; };
__device__ __forceinline__ XcdBarrier xcd_barrier_post(unsigned* bar, volatile LAS unsigned* st) {
    XcdBarrier b; b.bar = bar; b.x = xb_xcc_id(); b.st = st;
    if (threadIdx.x == 0) (void)xb_add(&bar[XB_XCNT(b.x)], 1u);
    return b;
}
__device__ __forceinline__ void xcd_barrier_complete(unsigned* bar, unsigned x, unsigned& nloc, unsigned& nx) {
    const unsigned G = gridDim.x * gridDim.y * gridDim.z;
    unsigned sum, cnt, mine, sp = 0u;
    for (;;) {
        sum = 0u; cnt = 0u; mine = 0u;
#pragma unroll
        for (unsigned j = 0; j < 16; ++j) { const unsigned c = xb_ld(&bar[XB_XCNT(j)]); sum += c; cnt += (c > 0u) ? 1u : 0u; mine = (j == x) ? c : mine; }
        if (sum == G) break;
        __builtin_amdgcn_s_sleep(1);
        if ((++sp & 255u) == 0u) { if (xb_ld(&bar[XB_TMO])) break; if (sp > XB_SPIN_CAP) { atomicAdd(&bar[XB_TMO], 1u); break; } }
    }
    nloc = mine > 0u ? mine : 1u; nx = cnt > 0u ? cnt : 1u;
}
__device__ __forceinline__ void xcd_barrier(const XcdBarrier& b) {
    asm volatile("s_waitcnt vmcnt(0)" ::: "memory");
    __syncthreads();
    if (threadIdx.x == 0) {
        unsigned* bar = b.bar;
        __builtin_amdgcn_s_waitcnt(0);
        unsigned nloc = b.st[0], nx = b.st[1];
        if (nloc == 0u) { xcd_barrier_complete(bar, b.x, nloc, nx); b.st[0] = nloc; b.st[1] = nx; }
        const unsigned old = xb_add(&bar[XB_XSUB(b.x)], 1u);
        const unsigned gen = old / nloc;
        if (old + 1u == (gen + 1u) * nloc) {
            __builtin_amdgcn_fence(__ATOMIC_RELEASE, "agent");
            asm volatile("s_waitcnt vmcnt(0)" ::: "memory");
            const unsigned og = xb_add(&bar[XB_TOP], 1u);
            const unsigned tg = og / nx;
            if (og + 1u == (tg + 1u) * nx) xb_add(&bar[XB_TOPGEN], 1u);
            else XB_SPIN(xb_ld(&bar[XB_TOPGEN]) == tg, bar);
            __builtin_amdgcn_fence(__ATOMIC_ACQUIRE, "agent");
            xb_add(&bar[XB_XGEN(b.x)], 1u);
            asm volatile("s_waitcnt vmcnt(0)" ::: "memory");
        } else {
            XB_SPIN(xb_ld(&bar[XB_XGEN(b.x)]) == gen, bar);
            __builtin_amdgcn_fence(__ATOMIC_ACQUIRE, "agent");
            asm volatile("s_waitcnt vmcnt(0)" ::: "memory");
        }
    }
    __syncthreads();
}

constexpr int NPHASE = 10;
constexpr int LDS_BYTES = 131072 + 2048 + IDX_UNITS * 1024;
__global__ void __launch_bounds__(NTHR, 2) mk_fwd(Params p) {
    extern __shared__ __attribute__((aligned(16))) unsigned char lds_raw[];
    LAS unsigned char* lds = (LAS unsigned char*)lds_raw;
    const int lo = p.ph_lo, hi = p.ph_hi;
    volatile LAS unsigned* barst = (volatile LAS unsigned*)(lds + BARST_OFF);
    if (threadIdx.x < 2) barst[threadIdx.x] = 0u;
    __syncthreads();
    XcdBarrier xbar; xbar.bar = (unsigned*)(p.ws + WS_CTL) + CW_BAR; xbar.x = xb_xcc_id(); xbar.st = barst;
    if (MK_ONE_LAUNCH && blockIdx.x == 0 && lo == 0) { u32x4* z = (u32x4*)(p.ws + WS_CTL); for (int i = threadIdx.x; i < CTL_ZERO_BYTES / 16; i += NTHR) z[i] = (u32x4){0u, 0u, 0u, 0u}; }
#ifdef ONLY_PHASE
#define IN(k) ((k) == ONLY_PHASE && lo <= (k) && (k) < hi)
#else
#define IN(k) (lo <= (k) && (k) < hi)
#endif
#define SEAM(k) do { if (IN(k) && IN((k) + 1)) { if ((k) == 0) { cg::this_grid().sync(); if (threadIdx.x == 0) (void)xb_add(&xbar.bar[XB_XCNT(xbar.x)], 1u); } else xcd_barrier(xbar); } if (PROBE_TS == (k)) ts1 = __builtin_amdgcn_s_memrealtime(); } while (0)
#define RUN(k, call) do { if (IN(k)) { if (PROBE_TS == (k)) ts0 = __builtin_amdgcn_s_memrealtime(); call; if (REPEAT_PHASE == (k)) { cg::this_grid().sync(); call; } } } while (0)
    unsigned long long ts0 = 0, ts1 = 0;
    { int rep = 0;
    RUN(0, phase0(p, lds));
    SEAM(0);
    RUN(1, phase1(p, lds));
    SEAM(1);
    RUN(2, phase2(p, lds));
    SEAM(2);
    if (IN(3)) { const int nrep = (REPEAT_PHASE == 3) ? 2 : 1; if (PROBE_TS == 3) ts0 = __builtin_amdgcn_s_memrealtime();
#pragma unroll 1
        for (rep = 0; rep < nrep; ++rep) { if (rep) cg::this_grid().sync(); phase3(p, lds, rep); } }
    SEAM(3);
    RUN(4, phase4(p));
    SEAM(4);
    RUN(5, phase5(p, lds));
    SEAM(5);
    rep = 0; RUN(6, (phase6(p, lds, rep), ++rep));
    SEAM(6);
    RUN(7, phase7(p, lds));
    SEAM(7);
    RUN(8, phase8(p, lds));
    SEAM(8);
    RUN(9, phase9(p, lds));
    if (PROBE_TS == 9) ts1 = __builtin_amdgcn_s_memrealtime();
    if (PROBE_GEMM >= 0 && blockIdx.x == 0) { __syncthreads(); if (threadIdx.x == 0) p.out[0] += (float)(((const unsigned long long*)(p.ws + WS_CTL + 32768))[PROBE_PART]) * 1e-4f; }
    if (PROBE_TS >= 0 && blockIdx.x == 0 && threadIdx.x == 0) p.out[0] += (float)(ts1 - ts0) * 1e-4f;
    }
#undef RUN
#undef IN
#undef SEAM
}

extern "C" void kernel_launch(void* const* d_in, const int* in_sizes, int n_in, void* d_out, int out_size, void* d_ws, size_t ws_size, hipStream_t stream) {
    static int grid = 0;
    if (grid == 0) {
        if (n_in != 28 || out_size != T * D || ws_size < WS_END) { fprintf(stderr, "kernel_launch: unexpected shapes: n_in %d out %d ws %zu (need %zu)\n", n_in, out_size, ws_size, (size_t)WS_END); grid = -1; return; }
        int dev = 0, cus = 0, per_cu = 0;
        hipGetDevice(&dev); hipDeviceGetAttribute(&cus, hipDeviceAttributeMultiprocessorCount, dev);
        hipFuncSetAttribute((const void*)mk_fwd, hipFuncAttributeMaxDynamicSharedMemorySize, LDS_BYTES);
        hipOccupancyMaxActiveBlocksPerMultiprocessor(&per_cu, (const void*)mk_fwd, NTHR, LDS_BYTES);
        (void)hipGetLastError();
        if (per_cu < 1) { fprintf(stderr, "kernel_launch: occupancy query says %d blocks per CU\n", per_cu); per_cu = 1; }
        grid = cus;
    }
    if (grid < 0) return;
#if !MK_ONE_LAUNCH
    hipMemsetAsync((char*)d_ws + WS_CTL, 0, CTL_ZERO_BYTES, stream);
#endif
    Params p{};
    for (int i = 0; i < 28; ++i) p.in[i] = (const float*)d_in[i];
    p.out = (float*)d_out; p.ws = (unsigned char*)d_ws;
#if MK_ONE_LAUNCH
    p.ph_lo = 0; p.ph_hi = NPHASE;
    void* args[] = {&p};
    hipError_t e = hipLaunchCooperativeKernel((const void*)mk_fwd, dim3(grid), dim3(NTHR), args, LDS_BYTES, stream);
    if (e != hipSuccess) fprintf(stderr, "cooperative launch failed: %s (grid %d)\n", hipGetErrorString(e), grid);
#else
    for (int ph = 0; ph < NPHASE; ++ph) { p.ph_lo = ph; p.ph_hi = ph + 1; hipLaunchKernelGGL(mk_fwd, dim3(grid), dim3(NTHR), LDS_BYTES, stream, p); }
#endif
}
```
